# Optimizing an MI355X kernel written in HIP

```python
import jax, jax.numpy as jnp
from jax import lax
import numpy as np

D_MODEL = 1024
BATCH = 8
SEQ = 2048
DEPTH = 4

N_MIXERS = 2
MIX_HEADS = 6
HEAD_DIM = 128
MIX_WIDTH = MIX_HEADS * HEAD_DIM
N_XATTN_HEADS = 4
XATTN_HEAD_DIM = 64
XATTN_WIDTH = N_XATTN_HEADS * XATTN_HEAD_DIM
N_MEM = 256
IN_WIDTH = 4 * MIX_WIDTH + XATTN_WIDTH
CAT_WIDTH = MIX_WIDTH + XATTN_WIDTH
D_FF = -(-(8 * D_MODEL) // (3 * 256)) * 256
N_HGRN_LAYERS = (DEPTH + N_MIXERS - 1) // N_MIXERS
N_RET_LAYERS = DEPTH - N_HGRN_LAYERS
HGRN_CHUNK = 32
RET_CHUNK = 64
ROPE_BASE = 10000.0
EPS = 1e-6
EXP_CLAMP = 30.0

kernel_name = "hgrn2_retention_interleaved_memxattn"


def rmsnorm(x, w):
    xf = x.astype(jnp.float32)
    y = xf * lax.rsqrt(jnp.mean(xf * xf, axis=-1, keepdims=True) + EPS)
    return (y * w.astype(jnp.float32)).astype(x.dtype)


def to_heads(t, h):
    b, s, _ = t.shape
    return t.reshape(b, s, h, -1)


def to_chunks(t, c):
    b, s, h, d = t.shape
    return t.reshape(b, s // c, c, h, d).transpose(0, 3, 1, 2, 4)


def from_chunks(t):
    b, h, n, c, d = t.shape
    return t.transpose(0, 2, 3, 1, 4).reshape(b, n * c, h, d)


def rope(t, positions):
    half = t.shape[-1] // 2
    inv_freq = ROPE_BASE ** (-jnp.linspace(0.0, 1.0, half, dtype=jnp.float32))
    ang = positions.astype(jnp.float32)[:, :, None] * inv_freq
    cos, sin = jnp.cos(ang)[:, :, None, :], jnp.sin(ang)[:, :, None, :]
    t1, t2 = t[..., :half].astype(jnp.float32), t[..., half:].astype(jnp.float32)
    return jnp.concatenate([t1 * cos - t2 * sin, t1 * sin + t2 * cos], axis=-1)


def hgrn2_chunked(q, k, v, g):
    c = HGRN_CHUNK
    q, k, v, g = (to_chunks(t, c) for t in (q, k, v, g))
    q, k = q.astype(jnp.float32), k.astype(jnp.float32)
    b = jnp.cumsum(g.astype(jnp.float32), axis=3)
    ref = b[:, :, :, c // 2 - 1:c // 2, :]
    b_last = b[:, :, :, -1:, :]
    scores = jnp.einsum('bhnck,bhnsk->bhncs', q * jnp.exp(b - ref), k * jnp.exp(ref - b))
    causal = jnp.tril(jnp.ones((c, c), dtype=bool))
    scores = jnp.where(causal, scores, 0.0)
    o_intra = jnp.einsum('bhncs,bhnsv->bhncv', scores, v)
    q_out = jnp.moveaxis(q * jnp.exp(b), 2, 0)
    k_st = jnp.moveaxis(k * jnp.exp(b_last - b), 2, 0)
    v_c = jnp.moveaxis(v, 2, 0)
    dec = jnp.moveaxis(jnp.exp(b_last[:, :, :, 0, :]), 2, 0)

    def step(s, xs):
        qo, ks, vc, dc = xs
        o = jnp.einsum('bhck,bhkv->bhcv', qo, s)
        s = s * dc[..., None] + jnp.einsum('bhck,bhcv->bhkv', ks, vc)
        return s, o

    bsz, h, _, _, dk = q.shape
    s0 = jnp.zeros((bsz, h, dk, v.shape[-1]), jnp.float32)
    _, o_inter = lax.scan(step, s0, (q_out, k_st, v_c, dec))
    return from_chunks(o_intra + jnp.moveaxis(o_inter, 0, 2))


def retention_chunked(q, k, v, log_gamma):
    c = RET_CHUNK
    q, k, v = (to_chunks(t, c) for t in (q, k, v))
    pos = jnp.arange(c, dtype=jnp.float32)
    lg = log_gamma[:, None]
    rel = pos[:, None] - pos[None, :]
    decay_mask = jnp.where(rel >= 0, jnp.exp(lg[:, :, None] * jnp.maximum(rel, 0.0)), 0.0)
    scores = jnp.einsum('bhncd,bhnsd->bhncs', q, k) * decay_mask[None, :, None]
    o_intra = jnp.einsum('bhncs,bhnsv->bhncv', scores, v)
    q_dec = jnp.exp(lg * (pos + 1.0))[None, :, :, None]
    k_dec = jnp.exp(lg * (c - 1.0 - pos))[None, :, :, None]
    chunk_dec = jnp.exp(log_gamma * c)[None, :, None, None]

    def step(s, xs):
        qc, kc, vc = xs
        o = jnp.einsum('bhcd,bhdv->bhcv', qc, s) * q_dec
        s = s * chunk_dec + jnp.einsum('bhcd,bhcv->bhdv', kc * k_dec, vc)
        return s, o

    bsz, h, _, _, dk = q.shape
    s0 = jnp.zeros((bsz, h, dk, v.shape[-1]), jnp.float32)
    xs = (jnp.moveaxis(q, 2, 0), jnp.moveaxis(k, 2, 0), jnp.moveaxis(v, 2, 0))
    _, o_inter = lax.scan(step, s0, xs)
    return from_chunks(o_intra + jnp.moveaxis(o_inter, 0, 2))


def memory_cross_attention(xq, mem_k, mem_v):
    s = jnp.einsum('bthd,bmhd->bhtm', xq, mem_k).astype(jnp.float32) * (XATTN_HEAD_DIM ** -0.5)
    p = jax.nn.softmax(s, axis=-1)
    return jnp.einsum('bhtm,bmhd->bthd', p.astype(mem_v.dtype), mem_v)


def setup_inputs(seed: int = 0) -> dict:
    key = jax.random.key(seed)
    ks = jax.random.split(key, 20)
    f32 = jnp.float32

    def w(k, shape, fan_in):
        return jax.random.normal(k, shape, f32) * (fan_in ** -0.5)

    def gain(k, shape):
        return 1.0 + 0.02 * jax.random.normal(k, shape, f32)

    offset = jax.random.randint(ks[2], (BATCH, 1), 0, 1024, dtype=jnp.int32)
    positions = offset + jnp.arange(SEQ, dtype=jnp.int32)[None, :]
    return {
        "x": jax.random.normal(ks[0], (BATCH, SEQ, D_MODEL), f32),
        "mem": jax.random.normal(ks[1], (BATCH, N_MEM, D_MODEL), f32),
        "positions": positions,
        "norm_mix": gain(ks[3], (DEPTH, D_MODEL)),
        "w_in": w(ks[4], (DEPTH, D_MODEL, IN_WIDTH), D_MODEL),
        "w_out": w(ks[5], (DEPTH, CAT_WIDTH, D_MODEL), CAT_WIDTH),
        "norm_mem": gain(ks[6], (DEPTH, D_MODEL)),
        "w_mem_kv": w(ks[7], (DEPTH, D_MODEL, 2 * XATTN_WIDTH), D_MODEL),
        "hgrn_lb_logits": 0.1 * jax.random.normal(ks[8], (N_HGRN_LAYERS, MIX_WIDTH), f32),
        "hgrn_out_norm": gain(ks[9], (N_HGRN_LAYERS, MIX_WIDTH)),
        "ret_out_norm": gain(ks[10], (N_RET_LAYERS, MIX_HEADS, HEAD_DIM)),
        "norm_ffn": gain(ks[11], (DEPTH, D_MODEL)),
        "w_ffn_in": w(ks[12], (DEPTH, D_MODEL, 2 * D_FF), D_MODEL),
        "w_ffn_out": w(ks[13], (DEPTH, D_FF, D_MODEL), D_FF),
        "norm_final": gain(ks[14], (D_MODEL,)),
    }


def reference(x, mem, positions, norm_mix, w_in, w_out, norm_mem, w_mem_kv, hgrn_lb_logits,
              hgrn_out_norm, ret_out_norm, norm_ffn, w_ffn_in, w_ffn_out, norm_final):
    bsz, seq, _ = x.shape
    p_lb = jax.nn.softmax(hgrn_lb_logits.astype(jnp.float32), axis=0)
    lower_bounds = jnp.cumsum(p_lb, axis=0) - p_lb[0]
    log_gamma = jnp.log(1.0 - 2.0 ** (-5.0 - jnp.arange(MIX_HEADS, dtype=jnp.float32)))

    for i in range(DEPTH):
        h = rmsnorm(x, norm_mix[i])
        z = h @ w_in[i]
        za = z[..., 0 * MIX_WIDTH:1 * MIX_WIDTH]
        zb = z[..., 1 * MIX_WIDTH:2 * MIX_WIDTH]
        zc = z[..., 2 * MIX_WIDTH:3 * MIX_WIDTH]
        zg = z[..., 3 * MIX_WIDTH:4 * MIX_WIDTH]
        zx = z[..., 4 * MIX_WIDTH:]

        if i % N_MIXERS == 0:
            j = i // N_MIXERS
            lb = lower_bounds[j]
            fr = zb.astype(jnp.float32)
            g = jax.nn.log_sigmoid(fr) + jnp.log1p(lb * jnp.exp(jnp.minimum(-fr, EXP_CLAMP)))
            k_in = (1.0 - lb) * jax.nn.sigmoid(-fr)
            o = hgrn2_chunked(to_heads(jax.nn.silu(za), MIX_HEADS), to_heads(k_in, MIX_HEADS),
                              to_heads(zc, MIX_HEADS), to_heads(g, MIX_HEADS))
            o = o.reshape(bsz, seq, MIX_WIDTH)
            mix = rmsnorm(o, hgrn_out_norm[j]) * jax.nn.sigmoid(zg.astype(jnp.float32))
        else:
            j = i // N_MIXERS
            q = rope(to_heads(za, MIX_HEADS), positions)
            k = rope(to_heads(zb, MIX_HEADS), positions) * (HEAD_DIM ** -0.5)
            v = to_heads(zc, MIX_HEADS).astype(jnp.float32)
            o = retention_chunked(q, k, v, log_gamma)
            o = rmsnorm(o, ret_out_norm[j]).reshape(bsz, seq, MIX_WIDTH)
            mix = o * jax.nn.silu(zg.astype(jnp.float32))

        memh = rmsnorm(mem, norm_mem[i])
        mkv = memh @ w_mem_kv[i]
        mem_k = to_heads(mkv[..., :XATTN_WIDTH], N_XATTN_HEADS)
        mem_v = to_heads(mkv[..., XATTN_WIDTH:], N_XATTN_HEADS)
        xo = memory_cross_attention(to_heads(zx, N_XATTN_HEADS), mem_k, mem_v)
        xo = xo.reshape(bsz, seq, XATTN_WIDTH)

        cat = jnp.concatenate([mix.astype(x.dtype), xo.astype(x.dtype)], axis=-1)
        x = x + cat @ w_out[i]

        hf = rmsnorm(x, norm_ffn[i])
        gu = hf @ w_ffn_in[i]
        x = x + (jax.nn.silu(gu[..., :D_FF]) * gu[..., D_FF:]) @ w_ffn_out[i]

    return rmsnorm(x, norm_final)
```

```cpp
#include <hip/hip_runtime.h>
#include <cstdio>
#include <cstdint>

#ifndef DBG_SKIP
#define DBG_SKIP 0
#endif
#ifndef MK_N_LAUNCHES
#define MK_N_LAUNCHES 1
#endif

#define GAS __attribute__((address_space(1)))
#define LAS __attribute__((address_space(3)))
typedef unsigned short bf16_t;
typedef short bf16x8 __attribute__((ext_vector_type(8)));
typedef float f32x4 __attribute__((ext_vector_type(4)));
typedef float f32x2 __attribute__((ext_vector_type(2)));
typedef unsigned u32x4 __attribute__((ext_vector_type(4)));
typedef unsigned u32x2 __attribute__((ext_vector_type(2)));

constexpr int BATCH = 8, SEQ = 2048, D = 1024, DEPTH = 4;
constexpr int M = BATCH * SEQ;
constexpr int NH = 6, HD = 128, MIXW = 768, XW = 256, NXH = 4, XHD = 64, NMEM = 256;
constexpr int NIN = 3328, DFF = 2816, NFI = 2 * DFF;
constexpr int MROWS = BATCH * NMEM;
constexpr float EPS = 1e-6f;

constexpr size_t MiB = 1u << 20;
constexpr size_t WS_CTL = 0, CTL_ZERO_BYTES = 1 * MiB;
constexpr size_t WS_LB = 1 * MiB;
constexpr size_t WS_SSQA = 2 * MiB;
constexpr size_t WS_SSQD = 3 * MiB;
constexpr size_t WS_COS = 4 * MiB, WS_SIN = 8 * MiB;
constexpr size_t WS_MEMB = 12 * MiB;
constexpr size_t WS_MKV = 16 * MiB;
constexpr size_t WS_WIN = 24 * MiB;
constexpr size_t WS_WOUT = 50 * MiB;
constexpr size_t WS_WFI = 58 * MiB;
constexpr size_t WS_WFO = 102 * MiB;
constexpr size_t WS_WM = 124 * MiB;
constexpr size_t WS_XB = 128 * MiB;
constexpr size_t WS_CAT = 160 * MiB;
constexpr size_t WS_Z = 192 * MiB;
constexpr size_t WS_F = 296 * MiB;
constexpr size_t WS_ACT = 192 * MiB;
constexpr size_t WS_END = 344 * MiB;
static_assert(WS_WIN + (size_t)DEPTH * NIN * D * 2 <= WS_WOUT && WS_WOUT + (size_t)DEPTH * D * D * 2 <= WS_WFI && WS_WFI + (size_t)DEPTH * NFI * D * 2 <= WS_WFO &&
              WS_WFO + (size_t)DEPTH * D * DFF * 2 <= WS_WM && WS_WM + (size_t)2048 * 1024 * 2 <= WS_XB && WS_Z + (size_t)M * NIN * 2 <= WS_F && WS_F + (size_t)M * MIXW * 4 <= WS_END &&
              WS_ACT + (size_t)M * DFF * 2 <= WS_F, "ws map");
constexpr int CW_BAR = 4096;

namespace pg8 {
constexpr int BM = 256, BK = 64, HALF = 128, HTB = HALF * BK * 2, STAGE_BYTES = 8 * HTB, NXCD = 8, WGM = 8;
__host__ __device__ __forceinline__ int lds_byte(int r, int c) { const int st = (r >> 4) * 2 + (c >> 5), rr = r & 15, cc = c & 31, ob = rr * 64 + cc * 2; return st * 1024 + (ob ^ (((ob >> 9) & 1) << 5)); }
__host__ __device__ __forceinline__ void stage_rc(int b, int& R, int& C) { const int st = b / 1024, sb = b % 1024, swz = sb ^ (((sb >> 9) & 1) << 5); R = (st >> 1) * 16 + swz / 64; C = (st & 1) * 32 + (swz % 64) / 2; }
__host__ __device__ __forceinline__ int perm32(int rho) { const int n = rho >> 4, i = rho & 15; return 8 * (i >> 2) + 4 * n + (i & 3); }
struct Unit { int pm, pn; };
struct Gemm { const bf16_t* A; const bf16_t* Bt; int M, N, K; };
struct StaticOrder {
    int nM, nN, nwg, G, c;
    __host__ __device__ void init(int M_, int N_, int G_, int c_) { nM = M_ / BM; nN = N_ / BM; nwg = nM * nN; G = G_; c = c_; }
    __host__ __device__ bool next(int i, Unit& u) const {
        const long L = (long)i * G + c; if (L >= nwg) return false;
        int wgid = (int)L; { const int q = nwg / NXCD, r = nwg % NXCD, xcd = wgid % NXCD, off = wgid / NXCD; wgid = (xcd < r ? xcd * (q + 1) : r * (q + 1) + (xcd - r) * q) + off; }
        const int nig = WGM * nN, gid = wgid / nig, fm = gid * WGM, gsz = (nM - fm) < WGM ? (nM - fm) : WGM;
        u.pm = fm + ((wgid % nig) % gsz); u.pn = (wgid % nig) / gsz; return true;
    }
    __device__ __forceinline__ void a_ready(const Unit&) const {}
    __device__ __forceinline__ void done(const Unit&) const {}
};
__device__ __forceinline__ unsigned cvt_pk_bf16(float lo, float hi) { unsigned r; asm volatile("v_cvt_pk_bf16_f32 %0, %1, %2" : "=v"(r) : "v"(lo), "v"(hi)); return r; }

template <class Epi, class Sched, bool ALIGN_EPI = false, bool SP2 = false>
__device__ __forceinline__ void gemm_phase(LAS unsigned char* lds, const Gemm g, const Sched& S, const Epi& E) {
    int tid = threadIdx.x; asm volatile("" : "+v"(tid));
    const int wid = __builtin_amdgcn_readfirstlane(tid >> 6), lane = tid & 63, wr = wid >> 2, wc = wid & 3, fr = lane & 15, fq = lane >> 4;
    const int K = g.K, nt = K / BK;
    unsigned voffA[2], voffB[2];
#pragma unroll
    for (int i = 0; i < 2; ++i) { int R, C; stage_rc(tid * 16 + i * 8192, R, C); const int Rb = Epi::PERM ? ((R & ~31) + perm32(R & 31)) : R;
        voffA[i] = (unsigned)(R * K + C) * 2u; voffB[i] = (unsigned)(Rb * K + C) * 2u; }
    asm volatile("" : "+v"(voffA[0]), "+v"(voffA[1]), "+v"(voffB[0]), "+v"(voffB[1]));
    const size_t kstep = (size_t)(BK * 2);
    const size_t hstep = (size_t)HALF * K * 2;
    const size_t tstep = 2 * hstep;
    const unsigned ldsw = (unsigned)wid * 1024u;
    const int aoff = lds_byte(wr * 64 + fr, fq * 8), boff = lds_byte(wc * 32 + fr, fq * 8);
#define PG8_SA(b, h) (((b) * 2 + (h)) * HTB)
#define PG8_SB(b, h) ((4 + (b) * 2 + (h)) * HTB)
#define PG8_STAGE(bufoff, gbase, voff) do { _Pragma("unroll") for (int _i = 0; _i < 2; ++_i) \
        __builtin_amdgcn_global_load_lds((const unsigned*)((const char*)(gbase) + (voff)[_i]), (LAS unsigned*)(lds + (bufoff) + ldsw + _i * 8192), 16, 0, 0); } while (0)
#define PG8_LDA(dst, b, h) do { _Pragma("unroll") for (int m = 0; m < 4; ++m) _Pragma("unroll") for (int k = 0; k < 2; ++k) dst[m][k] = *(const LAS bf16x8*)(lds + PG8_SA(b, h) + aoff + m * 2048 + k * 1024); } while (0)
#define PG8_LDB(dst, b, h) do { _Pragma("unroll") for (int n = 0; n < 2; ++n) _Pragma("unroll") for (int k = 0; k < 2; ++k) dst[n][k] = *(const LAS bf16x8*)(lds + PG8_SB(b, h) + boff + n * 2048 + k * 1024); } while (0)
#define PG8_MMA(ai, bj, At, Bt) do { __builtin_amdgcn_s_setprio(1); _Pragma("unroll") for (int m = 0; m < 4; ++m) _Pragma("unroll") for (int n = 0; n < 2; ++n) _Pragma("unroll") for (int k = 0; k < 2; ++k) \
        acc[ai][bj][m][n] = __builtin_amdgcn_mfma_f32_16x16x32_bf16(Bt[n][k], At[m][k], acc[ai][bj][m][n], 0, 0, 0); __builtin_amdgcn_s_setprio(0); } while (0)
#define PG8_WAIT_V(n) asm volatile("s_waitcnt vmcnt(" #n ")" ::: "memory")
#define PG8_WAIT_L(n) asm volatile("s_waitcnt lgkmcnt(" #n ")" ::: "memory")
#define PG8_BAR __builtin_amdgcn_s_barrier()
#define PG8_SCHED __builtin_amdgcn_sched_barrier(0)
    Unit cur, nxt; int ui = 0;
    if (!S.next(0, cur)) return;
    f32x4 acc[2][2][4][2];
#pragma unroll
    for (int a = 0; a < 2; ++a)
#pragma unroll
        for (int b = 0; b < 2; ++b)
#pragma unroll
            for (int m = 0; m < 4; ++m)
#pragma unroll
                for (int n = 0; n < 2; ++n) acc[a][b][m][n] = (f32x4){0.f, 0.f, 0.f, 0.f};
    bf16x8 At[4][2], B0[2][2], B1[2][2];
    const char* cA = (const char*)g.A + (size_t)cur.pm * tstep; const char* cB = (const char*)g.Bt + (size_t)cur.pn * tstep;
    S.a_ready(cur);
    if constexpr (SP2) {
        PG8_STAGE(PG8_SB(0, 0), cB, voffB); PG8_STAGE(PG8_SB(0, 1), cB + hstep, voffB); PG8_STAGE(PG8_SA(0, 0), cA, voffA); PG8_STAGE(PG8_SA(0, 1), cA + hstep, voffA);
        if (wr == 1) PG8_BAR;
        PG8_WAIT_V(2); PG8_BAR;
        PG8_STAGE(PG8_SB(1, 0), cB + kstep, voffB); PG8_STAGE(PG8_SA(1, 0), cA + kstep, voffA); PG8_STAGE(PG8_SB(1, 1), cB + hstep + kstep, voffB);
        PG8_WAIT_V(6); PG8_BAR;
    } else {
        PG8_STAGE(PG8_SB(0, 0), cB, voffB); PG8_STAGE(PG8_SA(0, 0), cA, voffA); PG8_STAGE(PG8_SB(0, 1), cB + hstep, voffB); PG8_STAGE(PG8_SA(0, 1), cA + hstep, voffA);
        if (wr == 1) PG8_BAR;
        PG8_WAIT_V(4); PG8_BAR;
        PG8_STAGE(PG8_SB(1, 0), cB + kstep, voffB); PG8_STAGE(PG8_SA(1, 0), cA + kstep, voffA); PG8_STAGE(PG8_SB(1, 1), cB + hstep + kstep, voffB);
        PG8_WAIT_V(6); PG8_BAR;
    }
    for (;;) {
        const bool has_next = S.next(ui + 1, nxt);
        const char* nA = has_next ? (const char*)g.A + (size_t)nxt.pm * tstep : cA; const char* nB = has_next ? (const char*)g.Bt + (size_t)nxt.pn * tstep : cB;
        for (int t = 0; t < nt; t += 2) {
            const bool last = (t == nt - 2);
            const char* a1 = cA + (size_t)(t + 1) * kstep;
            const char* a2 = last ? nA : cA + (size_t)(t + 2) * kstep; const char* b2 = last ? nB : cB + (size_t)(t + 2) * kstep;
            const char* a3 = a2 + kstep; const char* b3 = b2 + kstep;
            if (last && has_next) S.a_ready(nxt);
            if constexpr (SP2) {
            PG8_LDB(B0, 0, 0); PG8_LDB(B1, 0, 1); PG8_SCHED; PG8_LDA(At, 0, 0); PG8_STAGE(PG8_SA(1, 1), a1 + hstep, voffA);
            PG8_WAIT_V(8); PG8_WAIT_L(0); PG8_BAR; PG8_MMA(0, 0, At, B0); PG8_MMA(0, 1, At, B1); PG8_BAR; PG8_SCHED;
            PG8_LDA(At, 0, 1); PG8_STAGE(PG8_SB(0, 0), b2, voffB); PG8_STAGE(PG8_SB(0, 1), b2 + hstep, voffB); PG8_STAGE(PG8_SA(0, 0), a2, voffA);
            PG8_WAIT_V(8); PG8_WAIT_L(0); PG8_BAR; PG8_MMA(1, 0, At, B0); PG8_MMA(1, 1, At, B1); PG8_BAR; PG8_SCHED;
            PG8_LDB(B0, 1, 0); PG8_LDB(B1, 1, 1); PG8_SCHED; PG8_LDA(At, 1, 0); PG8_STAGE(PG8_SA(0, 1), a2 + hstep, voffA);
            PG8_WAIT_V(8); PG8_WAIT_L(0); PG8_BAR; PG8_MMA(0, 0, At, B0); PG8_MMA(0, 1, At, B1); PG8_BAR; PG8_SCHED;
            PG8_LDA(At, 1, 1); PG8_STAGE(PG8_SB(1, 0), b3, voffB); PG8_STAGE(PG8_SB(1, 1), b3 + hstep, voffB); PG8_STAGE(PG8_SA(1, 0), a3, voffA);
            PG8_WAIT_V(8); PG8_WAIT_L(0); PG8_BAR; PG8_MMA(1, 0, At, B0); PG8_MMA(1, 1, At, B1); PG8_BAR; PG8_SCHED;
            } else {
            PG8_LDB(B0, 0, 0); PG8_SCHED; PG8_LDA(At, 0, 0); PG8_STAGE(PG8_SA(1, 1), a1 + hstep, voffA);
            PG8_WAIT_L(8); PG8_BAR; PG8_WAIT_L(0); PG8_MMA(0, 0, At, B0); PG8_BAR; PG8_SCHED;
            PG8_LDB(B1, 0, 1); PG8_STAGE(PG8_SB(0, 0), b2, voffB);
            PG8_BAR; PG8_WAIT_L(0); PG8_MMA(0, 1, At, B1); PG8_BAR;
            PG8_LDA(At, 0, 1); PG8_STAGE(PG8_SA(0, 0), a2, voffA);
            PG8_BAR; PG8_WAIT_L(0); PG8_MMA(1, 0, At, B0); PG8_BAR; PG8_SCHED;
            PG8_STAGE(PG8_SB(0, 1), b2 + hstep, voffB);
            PG8_WAIT_V(6); PG8_BAR; PG8_MMA(1, 1, At, B1); PG8_BAR;
            PG8_LDB(B0, 1, 0); PG8_SCHED; PG8_LDA(At, 1, 0); PG8_STAGE(PG8_SA(0, 1), a2 + hstep, voffA);
            PG8_WAIT_L(8); PG8_BAR; PG8_WAIT_L(0); PG8_MMA(0, 0, At, B0); PG8_BAR; PG8_SCHED;
            PG8_LDB(B1, 1, 1); PG8_STAGE(PG8_SB(1, 0), b3, voffB);
            PG8_BAR; PG8_WAIT_L(0); PG8_MMA(0, 1, At, B1); PG8_BAR;
            PG8_LDA(At, 1, 1); PG8_STAGE(PG8_SA(1, 0), a3, voffA);
            PG8_BAR; PG8_WAIT_L(0); PG8_MMA(1, 0, At, B0); PG8_BAR; PG8_SCHED;
            PG8_STAGE(PG8_SB(1, 1), b3 + hstep, voffB);
            PG8_WAIT_V(6); PG8_BAR; PG8_MMA(1, 1, At, B1); PG8_BAR;
            }
        }
        if constexpr (ALIGN_EPI) { if (wr == 0) PG8_BAR; }
        E(acc, cur, wr, wc, fr, fq);
        if (!has_next) break;
#pragma unroll
        for (int a = 0; a < 2; ++a)
#pragma unroll
            for (int b = 0; b < 2; ++b)
#pragma unroll
                for (int m = 0; m < 4; ++m)
#pragma unroll
                    for (int n = 0; n < 2; ++n) acc[a][b][m][n] = (f32x4){0.f, 0.f, 0.f, 0.f};
        cur = nxt; cA = nA; cB = nB; ++ui;
        if constexpr (ALIGN_EPI) { if (wr == 1) PG8_BAR; }
    }
    PG8_WAIT_V(0);
    if constexpr (!ALIGN_EPI) { if (wr == 0) PG8_BAR; }
    PG8_BAR;
#undef PG8_SA
#undef PG8_SB
#undef PG8_STAGE
#undef PG8_LDA
#undef PG8_LDB
#undef PG8_MMA
#undef PG8_WAIT_V
#undef PG8_WAIT_L
#undef PG8_BAR
#undef PG8_SCHED
}
}

__device__ __forceinline__ float bf2f(unsigned h) { return __uint_as_float(h << 16); }
__device__ __forceinline__ unsigned f2bf(float f) { unsigned u = __float_as_uint(f); return (u + 0x7fffu + ((u >> 16) & 1u)) >> 16; }
__device__ __forceinline__ unsigned pk2(float lo, float hi) { return f2bf(lo) | (f2bf(hi) << 16); }
__device__ __forceinline__ float fast_rcp(float x) { return __builtin_amdgcn_rcpf(x); }
__device__ __forceinline__ float sigmoidf_(float x) { return fast_rcp(1.0f + __expf(-x)); }
__device__ __forceinline__ float siluf_(float x) { return x * sigmoidf_(x); }
__device__ __forceinline__ float wave_sum(float v) {
#pragma unroll
    for (int o = 1; o < 64; o <<= 1) v += __shfl_xor(v, o);
    return v;
}
__device__ __forceinline__ float rstd_from_partials(const float* ssq, int row, float invn) {
    const f32x4* p = (const f32x4*)(ssq + (size_t)row * 16);
    const f32x4 a = p[0], b = p[1], c = p[2], d = p[3];
    const f32x4 s = (a + b) + (c + d);
    return rsqrtf(((s[0] + s[1]) + (s[2] + s[3])) * invn + EPS);
}
__device__ __forceinline__ u32x4 pack8(const f32x4 v0, const f32x4 v1) {
    u32x4 w; w.x = pg8::cvt_pk_bf16(v0[0], v0[1]); w.y = pg8::cvt_pk_bf16(v0[2], v0[3]); w.z = pg8::cvt_pk_bf16(v1[0], v1[1]); w.w = pg8::cvt_pk_bf16(v1[2], v1[3]); return w;
}

using pg8::Unit;
struct EpiPlain {
    static constexpr bool PERM = true;
    bf16_t* O; int ldc;
    __device__ __forceinline__ void operator()(const f32x4 (&acc)[2][2][4][2], const Unit& u, int wr, int wc, int fr, int fq) const {
        const int row0 = u.pm * 256 + wr * 64 + fr, col0 = u.pn * 256 + wc * 32 + 8 * fq;
#pragma unroll
        for (int ai = 0; ai < 2; ++ai)
#pragma unroll
            for (int m = 0; m < 4; ++m) { bf16_t* rowp = O + (size_t)(row0 + ai * 128 + m * 16) * ldc + col0;
#pragma unroll
                for (int bj = 0; bj < 2; ++bj) *(u32x4*)(rowp + bj * 128) = pack8(acc[ai][bj][m][0], acc[ai][bj][m][1]); }
    }
};
struct EpiIn {
    static constexpr bool PERM = true;
    bf16_t* Z; float* F; const float* ssq; const float* lb; const float* cosT; const float* sinT; int is_ret;
    __device__ __forceinline__ void operator()(const f32x4 (&acc)[2][2][4][2], const Unit& u, int wr, int wc, int fr, int fq) const {
        const int row0 = u.pm * 256 + wr * 64 + fr, jl = wc * 32 + 8 * fq, t = u.pn;
        if (t < 6) {
            if (!is_ret) {
                const f32x4 lb0 = *(const f32x4*)(lb + t * 128 + (jl >> 1)), lb1 = *(const f32x4*)(lb + t * 128 + (jl >> 1) + 64);
#pragma unroll
                for (int ai = 0; ai < 2; ++ai)
#pragma unroll
                    for (int m = 0; m < 4; ++m) { const int row = row0 + ai * 128 + m * 16; const float rs = rstd_from_partials(ssq, row, 1.0f / D);
                        f32x4 q0, q1, f0, f1;
#pragma unroll
                        for (int i = 0; i < 4; ++i) {
                            q0[i] = siluf_(acc[ai][0][m][0][i] * rs); q1[i] = siluf_(acc[ai][0][m][1][i] * rs);
                            { const float x = acc[ai][1][m][0][i] * rs; const float e = __expf(-x); f0[i] = fast_rcp(1.0f + e) * (1.0f + lb0[i] * fminf(e, 1.0686475e13f)); }
                            { const float x = acc[ai][1][m][1][i] * rs; const float e = __expf(-x); f1[i] = fast_rcp(1.0f + e) * (1.0f + lb1[i] * fminf(e, 1.0686475e13f)); }
                        }
                        *(u32x4*)(Z + (size_t)row * NIN + t * 256 + jl) = pack8(q0, q1);
                        float* fp = F + (size_t)row * MIXW + t * 128 + jl; *(f32x4*)fp = f0; *(f32x4*)(fp + 4) = f1; }
            } else {
#pragma unroll
                for (int ai = 0; ai < 2; ++ai)
#pragma unroll
                    for (int m = 0; m < 4; ++m) { const int row = row0 + ai * 128 + m * 16; const float rs = rstd_from_partials(ssq, row, 1.0f / D);
                        const f32x4 cs = *(const f32x4*)(cosT + (size_t)row * 64 + (jl >> 1)), sn = *(const f32x4*)(sinT + (size_t)row * 64 + (jl >> 1));
                        const float ks = rs * 0.08838834764831845f;
                        f32x4 q0, q1, k0, k1;
#pragma unroll
                        for (int i = 0; i < 4; ++i) {
                            const float a1 = acc[ai][0][m][0][i] * rs, a2 = acc[ai][0][m][1][i] * rs; q0[i] = a1 * cs[i] - a2 * sn[i]; q1[i] = a1 * sn[i] + a2 * cs[i];
                            const float b1 = acc[ai][1][m][0][i] * ks, b2 = acc[ai][1][m][1][i] * ks; k0[i] = b1 * cs[i] - b2 * sn[i]; k1[i] = b1 * sn[i] + b2 * cs[i];
                        }
                        bf16_t* zp = Z + (size_t)row * NIN + t * 256 + jl; *(u32x4*)zp = pack8(q0, q1); *(u32x4*)(zp + 128) = pack8(k0, k1); }
            }
        } else {
            const int mode = (t >= 9 && t < 12) ? (is_ret ? 2 : 1) : 0;
#pragma unroll
            for (int ai = 0; ai < 2; ++ai)
#pragma unroll
                for (int m = 0; m < 4; ++m) { const int row = row0 + ai * 128 + m * 16; const float rs = rstd_from_partials(ssq, row, 1.0f / D);
                    bf16_t* zp = Z + (size_t)row * NIN + t * 256 + jl;
#pragma unroll
                    for (int bj = 0; bj < 2; ++bj) { f32x4 v0 = acc[ai][bj][m][0] * rs, v1 = acc[ai][bj][m][1] * rs;
                        if (mode == 1) {
#pragma unroll
                            for (int i = 0; i < 4; ++i) { v0[i] = sigmoidf_(v0[i]); v1[i] = sigmoidf_(v1[i]); } }
                        else if (mode == 2) {
#pragma unroll
                            for (int i = 0; i < 4; ++i) { v0[i] = siluf_(v0[i]); v1[i] = siluf_(v1[i]); } }
                        *(u32x4*)(zp + bj * 128) = pack8(v0, v1); } }
        }
    }
};
struct EpiRes {
    static constexpr bool PERM = true;
    const float* xin; float* xres; bf16_t* xb; float* ssq;
    __device__ __forceinline__ void operator()(const f32x4 (&acc)[2][2][4][2], const Unit& u, int wr, int wc, int fr, int fq) const {
        const int row0 = u.pm * 256 + wr * 64 + fr, col0 = u.pn * 256 + wc * 32 + 8 * fq;
#pragma unroll
        for (int ai = 0; ai < 2; ++ai)
#pragma unroll
            for (int m = 0; m < 4; ++m) { const int row = row0 + ai * 128 + m * 16; const size_t off = (size_t)row * D + col0; float s = 0.f;
#pragma unroll
                for (int bj = 0; bj < 2; ++bj) {
                    const f32x4 r0 = *(const f32x4*)(xin + off + bj * 128), r1 = *(const f32x4*)(xin + off + bj * 128 + 4);
                    const f32x4 v0 = r0 + acc[ai][bj][m][0], v1 = r1 + acc[ai][bj][m][1];
                    *(f32x4*)(xres + off + bj * 128) = v0; *(f32x4*)(xres + off + bj * 128 + 4) = v1;
                    *(u32x4*)(xb + off + bj * 128) = pack8(v0, v1);
                    s += (v0[0] * v0[0] + v0[1] * v0[1]) + (v0[2] * v0[2] + v0[3] * v0[3]) + (v1[0] * v1[0] + v1[1] * v1[1]) + (v1[2] * v1[2] + v1[3] * v1[3]);
                }
                s += __shfl_xor(s, 16); s += __shfl_xor(s, 32);
                if (fq == 0) ssq[(size_t)row * 16 + u.pn * 4 + wc] = s; }
    }
};
struct EpiFfn {
    static constexpr bool PERM = true;
    bf16_t* act; const float* ssq;
    __device__ __forceinline__ void operator()(const f32x4 (&acc)[2][2][4][2], const Unit& u, int wr, int wc, int fr, int fq) const {
        const int row0 = u.pm * 256 + wr * 64 + fr, jl = wc * 32 + 8 * fq;
#pragma unroll
        for (int ai = 0; ai < 2; ++ai)
#pragma unroll
            for (int m = 0; m < 4; ++m) { const int row = row0 + ai * 128 + m * 16; const float rs = rstd_from_partials(ssq, row, 1.0f / D);
                f32x4 v0, v1;
#pragma unroll
                for (int i = 0; i < 4; ++i) { v0[i] = siluf_(acc[ai][0][m][0][i] * rs) * (acc[ai][1][m][0][i] * rs); v1[i] = siluf_(acc[ai][0][m][1][i] * rs) * (acc[ai][1][m][1][i] * rs); }
                *(u32x4*)(act + (size_t)row * DFF + u.pn * 128 + jl) = pack8(v0, v1); }
    }
};

#define XB_TMO      128
#define XB_XCNT(j)  (256  + 64 * (j))
#define XB_XSUB(j)  (1280 + 64 * (j))
#define XB_XGEN(j)  (2304 + 64 * (j))
#define XB_TOP      3328
#define XB_TOPGEN   3392
#define XCD_BAR_WORDS 3456
#define XB_SPIN_CAP (1u << 18)
__device__ __forceinline__ unsigned xb_ld(unsigned* p)              { return __hip_atomic_load(p, __ATOMIC_RELAXED, __HIP_MEMORY_SCOPE_AGENT); }
__device__ __forceinline__ unsigned xb_add(unsigned* p, unsigned v) { return __hip_atomic_fetch_add(p, v, __ATOMIC_RELAXED, __HIP_MEMORY_SCOPE_AGENT); }
__device__ __forceinline__ unsigned xb_xcc_id() { return (unsigned)__builtin_amdgcn_s_getreg((3 << 11) | 20) & 0xFu; }
#define XB_SPIN(cond, bar) do { unsigned _sp = 0; while (cond) { __builtin_amdgcn_s_sleep(1); \
    if ((++_sp & 255u) == 0u) { if (xb_ld(&(bar)[XB_TMO])) break; if (_sp > XB_SPIN_CAP) { atomicAdd(&(bar)[XB_TMO], 1u); break; } } } } while (0)
struct XcdBarrier { unsigned* bar; unsigned x; volatile LAS unsigned* st; };
__device__ __forceinline__ XcdBarrier xcd_barrier_post(unsigned* bar, volatile LAS unsigned* st) {
    XcdBarrier b; b.bar = bar; b.x = xb_xcc_id(); b.st = st;
    if (threadIdx.x == 0) (void)xb_add(&bar[XB_XCNT(b.x)], 1u);
    return b;
}
__device__ __forceinline__ void xcd_barrier_complete(unsigned* bar, unsigned x, unsigned& nloc, unsigned& nx) {
    const unsigned G = gridDim.x * gridDim.y * gridDim.z;
    unsigned sum, cnt, mine, sp = 0u;
    for (;;) {
        sum = 0u; cnt = 0u; mine = 0u;
#pragma unroll
        for (unsigned j = 0; j < 16; ++j) { const unsigned c = xb_ld(&bar[XB_XCNT(j)]); sum += c; cnt += (c > 0u) ? 1u : 0u; mine = (j == x) ? c : mine; }
        if (sum == G) break;
        __builtin_amdgcn_s_sleep(1);
        if ((++sp & 255u) == 0u) { if (xb_ld(&bar[XB_TMO])) break; if (sp > XB_SPIN_CAP) { atomicAdd(&bar[XB_TMO], 1u); break; } }
    }
    nloc = mine > 0u ? mine : 1u; nx = cnt > 0u ? cnt : 1u;
}
__device__ __forceinline__ void xcd_barrier(const XcdBarrier& b) {
    asm volatile("s_waitcnt vmcnt(0)" ::: "memory");
    __syncthreads();
    if (threadIdx.x == 0) {
        unsigned* bar = b.bar;
        __builtin_amdgcn_s_waitcnt(0);
        unsigned nloc = b.st[0], nx = b.st[1];
        if (nloc == 0u) { xcd_barrier_complete(bar, b.x, nloc, nx); b.st[0] = nloc; b.st[1] = nx; }
        const unsigned old = xb_add(&bar[XB_XSUB(b.x)], 1u);
        const unsigned gen = old / nloc;
        if (old + 1u == (gen + 1u) * nloc) {
            __builtin_amdgcn_fence(__ATOMIC_RELEASE, "agent");
            asm volatile("s_waitcnt vmcnt(0)" ::: "memory");
            const unsigned og = xb_add(&bar[XB_TOP], 1u);
            const unsigned tg = og / nx;
            if (og + 1u == (tg + 1u) * nx) xb_add(&bar[XB_TOPGEN], 1u);
            else XB_SPIN(xb_ld(&bar[XB_TOPGEN]) == tg, bar);
            __builtin_amdgcn_fence(__ATOMIC_ACQUIRE, "agent");
            xb_add(&bar[XB_XGEN(b.x)], 1u);
            asm volatile("s_waitcnt vmcnt(0)" ::: "memory");
        } else {
            XB_SPIN(xb_ld(&bar[XB_XGEN(b.x)]) == gen, bar);
            __builtin_amdgcn_fence(__ATOMIC_ACQUIRE, "agent");
            asm volatile("s_waitcnt vmcnt(0)" ::: "memory");
        }
    }
    __syncthreads();
}

constexpr int RING_BYTES = 131072, LDSCTL_OFF = RING_BYTES, MISC_OFF = LDSCTL_OFF + 320, LDS_BYTES = 147456;
constexpr int NWAVES = 8;

struct Args { const float* in[15]; float* out; unsigned char* ws; int ph_lo, ph_hi; };

__device__ __forceinline__ int win_srccol(int j) {
    const int t = j >> 8;
    if (t >= 6) return j;
    const int jj = j & 255, half = jj >> 7, p = jj & 127, d = 4 * (p >> 3) + (p & 3) + 64 * ((p >> 2) & 1);
    return half * MIXW + t * 128 + d;
}
__device__ __forceinline__ int wfi_srccol(int j) { const int t = j >> 8, jj = j & 255; return (jj < 128 ? 0 : DFF) + t * 128 + (jj & 127); }
__device__ __forceinline__ void transpose_item(const float* W, int K, int N, bf16_t* WT, int ndst, int kind, const float* kscale, int nscale, LAS float* scr, int item, int lane) {
    const int nblk = ndst / 32, kb = item / nblk, nb = item % nblk, k0 = 64 * kb, n0 = 32 * nb;
    const int jd = n0 + (lane & 31);
    const int sc = kind == 0 ? win_srccol(jd) : (kind == 2 ? wfi_srccol(jd) : jd);
#pragma unroll 8
    for (int i = 0; i < 32; ++i) { const int kk = 2 * i + (lane >> 5); float w = W[(size_t)(k0 + kk) * N + sc]; if (kscale && (k0 + kk) < nscale) w *= kscale[k0 + kk]; scr[kk * 33 + (lane & 31)] = w; }
    asm volatile("s_waitcnt lgkmcnt(0)" ::: "memory");
    const int c = lane & 7;
#pragma unroll
    for (int j = 0; j < 4; ++j) { const int n = (lane >> 3) + 8 * j; const LAS float* s = scr + (8 * c) * 33 + n;
        u32x4 o; o.x = pk2(s[0 * 33], s[1 * 33]); o.y = pk2(s[2 * 33], s[3 * 33]); o.z = pk2(s[4 * 33], s[5 * 33]); o.w = pk2(s[6 * 33], s[7 * 33]);
        *(u32x4*)(WT + (size_t)(n0 + n) * K + k0 + 8 * c) = o; }
    asm volatile("s_waitcnt lgkmcnt(0)" ::: "memory");
}

__device__ __forceinline__ void p0_prologue(const Args& a, unsigned char* ws, LAS unsigned char* lds, int gw, int NGW, int wave, int lane) {
    LAS float* scr = (LAS float*)(lds + wave * 16384);
    constexpr int I0 = 16 * (NIN / 32), I1 = 16 * 32, I2 = 16 * (NFI / 32), I3 = (DFF / 64) * 32, I4 = 16 * 16, IL = I0 + I1 + I2 + I3 + I4;
    for (int it = gw; it < DEPTH * IL; it += NGW) {
        const int l = it / IL; int r = it % IL;
        if (r < I0) { transpose_item(a.in[4] + (size_t)l * D * NIN, D, NIN, (bf16_t*)(ws + WS_WIN) + (size_t)l * NIN * D, NIN, 0, a.in[3] + l * D, D, scr, r, lane); continue; } r -= I0;
        if (r < I1) { const float* onw = (l & 1) ? a.in[10] + (l >> 1) * MIXW : a.in[9] + (l >> 1) * MIXW;
                      transpose_item(a.in[5] + (size_t)l * D * D, D, D, (bf16_t*)(ws + WS_WOUT) + (size_t)l * D * D, D, 1, onw, MIXW, scr, r, lane); continue; } r -= I1;
        if (r < I2) { transpose_item(a.in[12] + (size_t)l * D * NFI, D, NFI, (bf16_t*)(ws + WS_WFI) + (size_t)l * NFI * D, NFI, 2, a.in[11] + l * D, D, scr, r, lane); continue; } r -= I2;
        if (r < I3) { transpose_item(a.in[13] + (size_t)l * DFF * D, DFF, D, (bf16_t*)(ws + WS_WFO) + (size_t)l * D * DFF, D, 3, nullptr, 0, scr, r, lane); continue; } r -= I3;
        transpose_item(a.in[7] + (size_t)l * D * 512, D, 512, (bf16_t*)(ws + WS_WM) + (size_t)l * 512 * D, 512, 4, a.in[6] + l * D, D, scr, r, lane);
    }
    for (int m = gw; m < M; m += NGW) {
        const f32x4* xr = (const f32x4*)(a.in[0] + (size_t)m * D) + lane; f32x4 v[4]; float s = 0.f;
#pragma unroll
        for (int j = 0; j < 4; ++j) { v[j] = xr[64 * j]; s += (v[j].x * v[j].x + v[j].y * v[j].y) + (v[j].z * v[j].z + v[j].w * v[j].w); }
        s = wave_sum(s);
        u32x2* o8 = (u32x2*)((bf16_t*)(ws + WS_XB) + (size_t)m * D) + lane;
#pragma unroll
        for (int j = 0; j < 4; ++j) { u32x2 w; w.x = pk2(v[j].x, v[j].y); w.y = pk2(v[j].z, v[j].w); o8[64 * j] = w; }
        if (lane < 16) ((float*)(ws + WS_SSQA))[(size_t)m * 16 + lane] = lane == 0 ? s : 0.f;
    }
    for (int m = gw; m < MROWS; m += NGW) {
        const f32x4* xr = (const f32x4*)(a.in[1] + (size_t)m * D) + lane; f32x4 v[4]; float s = 0.f;
#pragma unroll
        for (int j = 0; j < 4; ++j) { v[j] = xr[64 * j]; s += (v[j].x * v[j].x + v[j].y * v[j].y) + (v[j].z * v[j].z + v[j].w * v[j].w); }
        const float rs = rsqrtf(wave_sum(s) * (1.0f / D) + EPS);
        u32x2* o8 = (u32x2*)((bf16_t*)(ws + WS_MEMB) + (size_t)m * D) + lane;
#pragma unroll
        for (int j = 0; j < 4; ++j) { u32x2 w; w.x = pk2(v[j].x * rs, v[j].y * rs); w.y = pk2(v[j].z * rs, v[j].w * rs); o8[64 * j] = w; }
    }
    for (int m = gw; m < M; m += NGW) {
        const double pos = (double)((const int*)a.in[2])[m];
        const double invf = exp(-9.210340371976184 * ((double)lane / 63.0));
        const double ang = pos * invf;
        ((float*)(ws + WS_COS))[(size_t)m * 64 + lane] = (float)cos(ang);
        ((float*)(ws + WS_SIN))[(size_t)m * 64 + lane] = (float)sin(ang);
    }
    for (int c = gw * 64 + lane; c < MIXW; c += NGW * 64) {
        const float l0 = a.in[8][c], l1 = a.in[8][MIXW + c]; const float mx = fmaxf(l0, l1), e0 = expf(l0 - mx), e1 = expf(l1 - mx);
        ((float*)(ws + WS_LB))[c] = 0.f; ((float*)(ws + WS_LB))[MIXW + c] = e1 / (e0 + e1);
    }
}

__device__ __forceinline__ void scan_unit(unsigned char* ws, LAS unsigned char* lds, int unit, int is_ret, int tid) {
    constexpr int TB = 32;
    bf16_t* Z = (bf16_t*)(ws + WS_Z); const float* F = (const float*)(ws + WS_F);
    const int b = unit / NH, h = unit % NH, vcol = tid >> 2, kp = tid & 3;
    LAS float* qL = (LAS float*)lds;
    LAS float* fL = qL + TB * 144;
    LAS float* kL = fL + TB * 144;
    LAS float* vL = kL + TB * 144;
    LAS float* oL = vL + TB * 128;
    const float gamma = 1.0f - exp2f(-5.0f - (float)h);
    float S[32];
#pragma unroll
    for (int i = 0; i < 32; ++i) S[i] = 0.f;
    for (int c0 = 0; c0 < SEQ; c0 += TB) {
        __syncthreads();
        for (int idx = tid; idx < TB * 128; idx += 512) {
            const int tt = idx >> 7, kk = idx & 127; const size_t tok = (size_t)b * SEQ + c0 + tt;
            const float qv = bf2f(Z[tok * NIN + h * 256 + kk]);
            float fv, kv;
            if (is_ret) { fv = gamma; kv = bf2f(Z[tok * NIN + h * 256 + 128 + kk]); }
            else { fv = F[tok * MIXW + h * 128 + kk]; kv = 1.0f - fv; }
            const float vv = bf2f(Z[tok * NIN + 1536 + h * 128 + kk]);
            const int slot = tt * 144 + (kk >> 5) * 36 + (kk & 31);
            qL[slot] = qv; fL[slot] = fv; kL[slot] = kv; vL[tt * 128 + kk] = vv;
        }
        __syncthreads();
        for (int tt = 0; tt < TB; ++tt) {
            const float vv = vL[tt * 128 + vcol]; float o = 0.f;
            const LAS f32x4* f4 = (const LAS f32x4*)(fL + tt * 144 + kp * 36);
            const LAS f32x4* k4 = (const LAS f32x4*)(kL + tt * 144 + kp * 36);
            const LAS f32x4* q4 = (const LAS f32x4*)(qL + tt * 144 + kp * 36);
#pragma unroll
            for (int i4 = 0; i4 < 8; ++i4) { const f32x4 ff = f4[i4], kk = k4[i4], qq = q4[i4];
#pragma unroll
                for (int j = 0; j < 4; ++j) { S[4 * i4 + j] = S[4 * i4 + j] * ff[j] + kk[j] * vv; o += qq[j] * S[4 * i4 + j]; } }
            o += __shfl_xor(o, 1); o += __shfl_xor(o, 2);
            if (kp == 0) oL[tt * 128 + vcol] = o;
        }
        __syncthreads();
        for (int idx = tid; idx < TB * 128; idx += 512) { const int tt = idx >> 7, kk = idx & 127; const size_t tok = (size_t)b * SEQ + c0 + tt;
            Z[tok * NIN + h * 256 + kk] = (bf16_t)f2bf(oL[idx]); }
    }
}

__device__ __forceinline__ void xattn_unit(unsigned char* ws, LAS unsigned char* lds, int unit, int layer, int tid) {
    const bf16_t* Z = (const bf16_t*)(ws + WS_Z); const bf16_t* MKV = (const bf16_t*)(ws + WS_MKV); bf16_t* CAT = (bf16_t*)(ws + WS_CAT);
    const int b = unit >> 4, hx = (unit >> 2) & 3, tq = unit & 3;
    LAS u32x4* KL = (LAS u32x4*)lds;
    LAS u32x4* VL = KL + 256 * 8;
    __syncthreads();
    for (int c = tid; c < 256 * 8; c += 512) { const int mrow = c >> 3, ch = c & 7; const bf16_t* src = MKV + (size_t)(b * NMEM + mrow) * 2048 + layer * 512 + hx * 64 + ch * 8;
        KL[c] = *(const u32x4*)src; VL[c] = *(const u32x4*)(src + 256); }
    __syncthreads();
    const size_t tok = (size_t)b * SEQ + tq * 512 + tid;
    float q[64], o[64];
    { const u32x4* qp = (const u32x4*)(Z + tok * NIN + 3072 + hx * 64);
#pragma unroll
      for (int c = 0; c < 8; ++c) { const u32x4 w = qp[c];
#pragma unroll
          for (int j = 0; j < 4; ++j) { q[8 * c + 2 * j] = bf2f(w[j] & 0xffffu) * 0.125f; q[8 * c + 2 * j + 1] = bf2f(w[j] >> 16) * 0.125f; } } }
#pragma unroll
    for (int d = 0; d < 64; ++d) o[d] = 0.f;
    float mrun = -1e30f, l = 0.f;
    for (int mm = 0; mm < NMEM; ++mm) {
        float s = 0.f;
#pragma unroll
        for (int c = 0; c < 8; ++c) { const u32x4 w = KL[mm * 8 + c];
#pragma unroll
            for (int j = 0; j < 4; ++j) { s += q[8 * c + 2 * j] * bf2f(w[j] & 0xffffu); s += q[8 * c + 2 * j + 1] * bf2f(w[j] >> 16); } }
        const float mn = fmaxf(mrun, s), alpha = __expf(mrun - mn), p = __expf(s - mn);
        l = l * alpha + p; mrun = mn;
#pragma unroll
        for (int c = 0; c < 8; ++c) { const u32x4 w = VL[mm * 8 + c];
#pragma unroll
            for (int j = 0; j < 4; ++j) { o[8 * c + 2 * j] = o[8 * c + 2 * j] * alpha + p * bf2f(w[j] & 0xffffu); o[8 * c + 2 * j + 1] = o[8 * c + 2 * j + 1] * alpha + p * bf2f(w[j] >> 16); } }
    }
    const float il = 1.0f / l;
    u32x4* op = (u32x4*)(CAT + tok * D + MIXW + hx * 64);
#pragma unroll
    for (int c = 0; c < 8; ++c) { u32x4 w;
#pragma unroll
        for (int j = 0; j < 4; ++j) w[j] = pk2(o[8 * c + 2 * j] * il, o[8 * c + 2 * j + 1] * il);
        op[c] = w; }
}

__device__ __forceinline__ void finish_rows(unsigned char* ws, int is_ret, int gw, int NGW, int lane) {
    const bf16_t* Z = (const bf16_t*)(ws + WS_Z); bf16_t* CAT = (bf16_t*)(ws + WS_CAT);
    for (int row = gw; row < M; row += NGW) {
        float o[3][4], g[3][4]; float ss[3];
#pragma unroll
        for (int j = 0; j < 3; ++j) { const int c = lane * 4 + 256 * j;
            const u32x2 w = *(const u32x2*)(Z + (size_t)row * NIN + (c >> 7) * 256 + (c & 127)), gw2 = *(const u32x2*)(Z + (size_t)row * NIN + 2304 + c);
            o[j][0] = bf2f(w.x & 0xffffu); o[j][1] = bf2f(w.x >> 16); o[j][2] = bf2f(w.y & 0xffffu); o[j][3] = bf2f(w.y >> 16);
            g[j][0] = bf2f(gw2.x & 0xffffu); g[j][1] = bf2f(gw2.x >> 16); g[j][2] = bf2f(gw2.y & 0xffffu); g[j][3] = bf2f(gw2.y >> 16);
            ss[j] = (o[j][0] * o[j][0] + o[j][1] * o[j][1]) + (o[j][2] * o[j][2] + o[j][3] * o[j][3]); }
        float rs[3];
        if (!is_ret) { const float r = rsqrtf(wave_sum(ss[0] + ss[1] + ss[2]) * (1.0f / MIXW) + EPS); rs[0] = rs[1] = rs[2] = r; }
        else {
#pragma unroll
            for (int j = 0; j < 3; ++j) { float s = ss[j];
#pragma unroll
                for (int of = 1; of < 32; of <<= 1) s += __shfl_xor(s, of);
                rs[j] = rsqrtf(s * (1.0f / HD) + EPS); } }
#pragma unroll
        for (int j = 0; j < 3; ++j) { const int c = lane * 4 + 256 * j; u32x2 w; w.x = pk2(o[j][0] * rs[j] * g[j][0], o[j][1] * rs[j] * g[j][1]); w.y = pk2(o[j][2] * rs[j] * g[j][2], o[j][3] * rs[j] * g[j][3]);
            *(u32x2*)(CAT + (size_t)row * D + c) = w; }
    }
}

__device__ __forceinline__ void final_rows(float* out, const float* nf, int gw, int NGW, int lane) {
    const f32x4* wv = (const f32x4*)nf + lane;
    for (int row = gw; row < M; row += NGW) {
        f32x4* xr = (f32x4*)(out + (size_t)row * D) + lane; f32x4 v[4]; float s = 0.f;
#pragma unroll
        for (int j = 0; j < 4; ++j) { v[j] = xr[64 * j]; s += (v[j].x * v[j].x + v[j].y * v[j].y) + (v[j].z * v[j].z + v[j].w * v[j].w); }
        const float rs = rsqrtf(wave_sum(s) * (1.0f / D) + EPS);
#pragma unroll
        for (int j = 0; j < 4; ++j) xr[64 * j] = v[j] * rs * wv[64 * j];
    }
}

constexpr int N_PHASES = 2 + 6 * DEPTH + 1;
__global__ void __launch_bounds__(NWAVES * 64, 2) mega_fwd(Args args) {
    extern __shared__ __attribute__((aligned(16))) unsigned char lds_raw[];
    LAS unsigned char* lds = (LAS unsigned char*)lds_raw;
    volatile LAS unsigned* MISC = (volatile LAS unsigned*)(lds + MISC_OFF);
    const int G = gridDim.x, bx = blockIdx.x;
    unsigned char* ws = args.ws;
    for (int u = threadIdx.x; u < (LDS_BYTES - LDSCTL_OFF) / 4; u += NWAVES * 64) ((LAS unsigned*)(lds + LDSCTL_OFF))[u] = 0u;
    __syncthreads();
    XcdBarrier bar; bar.bar = (unsigned*)(ws + WS_CTL) + CW_BAR; bar.x = 0; bar.st = nullptr;
    if (MK_N_LAUNCHES == 1) bar = xcd_barrier_post((unsigned*)(ws + WS_CTL) + CW_BAR, MISC + 8);
    const int lo = args.ph_lo, hi = args.ph_hi;
#define IN(k) (lo <= (k) && (k) < hi)
#define SEAM(k) do { if (IN(k) && IN((k) + 1)) xcd_barrier(bar); } while (0)
#define OPAQ() unsigned char* wsp = ws; int Gp = G, bxp = bx, tidp = threadIdx.x; asm volatile("" : "+s"(wsp), "+s"(Gp), "+s"(bxp), "+v"(tidp)); \
    const int lanep = tidp & 63, wavep = __builtin_amdgcn_readfirstlane(tidp >> 6), vcup = (Gp % 8 == 0) ? (bxp % 8) * (Gp / 8) + bxp / 8 : bxp, gwp = vcup * NWAVES + wavep, NGWp = Gp * NWAVES; \
    (void)lanep; (void)gwp; (void)NGWp

    if (IN(0) && !(DBG_SKIP & 1)) { OPAQ(); p0_prologue(args, wsp, lds, gwp, NGWp, wavep, lanep); }
    SEAM(0);
    if (IN(1) && !(DBG_SKIP & 16)) { OPAQ();
        pg8::Gemm g{(const bf16_t*)(wsp + WS_MEMB), (const bf16_t*)(wsp + WS_WM), MROWS, 2048, D}; pg8::StaticOrder S; S.init(MROWS, 2048, Gp, bxp);
        EpiPlain E{(bf16_t*)(wsp + WS_MKV), 2048};
        pg8::gemm_phase<EpiPlain, pg8::StaticOrder, true, true>(lds, g, S, E);
    }
    SEAM(1);
    for (int l = 0; l < DEPTH; ++l) {
        const int pb = 2 + 6 * l, is_ret = l & 1;
        if (IN(pb) && !(DBG_SKIP & 32)) { OPAQ();
            pg8::Gemm g{(const bf16_t*)(wsp + WS_XB), (const bf16_t*)(wsp + WS_WIN) + (size_t)l * NIN * D, M, NIN, D}; pg8::StaticOrder S; S.init(M, NIN, Gp, bxp);
            EpiIn E{(bf16_t*)(wsp + WS_Z), (float*)(wsp + WS_F), (const float*)(wsp + WS_SSQA), (const float*)(wsp + WS_LB) + (l >> 1) * MIXW, (const float*)(wsp + WS_COS), (const float*)(wsp + WS_SIN), is_ret};
            pg8::gemm_phase<EpiIn, pg8::StaticOrder, true, true>(lds, g, S, E);
        }
        SEAM(pb);
        if (IN(pb + 1)) { OPAQ();
            const int NS = BATCH * NH;
            if (Gp > NS) {
                if (bxp < NS) { if (!(DBG_SKIP & 2)) scan_unit(wsp, lds, bxp, is_ret, tidp); }
                else for (int u = bxp - NS; u < 128; u += Gp - NS) { if (!(DBG_SKIP & 4)) xattn_unit(wsp, lds, u, l, tidp); }
            } else {
                for (int u = bxp; u < NS; u += Gp) { if (!(DBG_SKIP & 2)) scan_unit(wsp, lds, u, is_ret, tidp); }
                for (int u = bxp; u < 128; u += Gp) { if (!(DBG_SKIP & 4)) xattn_unit(wsp, lds, u, l, tidp); }
            }
            __syncthreads();
        }
        SEAM(pb + 1);
        if (IN(pb + 2) && !(DBG_SKIP & 8)) { OPAQ(); finish_rows(wsp, is_ret, gwp, NGWp, lanep); }
        SEAM(pb + 2);
        if (IN(pb + 3) && !(DBG_SKIP & 64)) { OPAQ();
            pg8::Gemm g{(const bf16_t*)(wsp + WS_CAT), (const bf16_t*)(wsp + WS_WOUT) + (size_t)l * D * D, M, D, D}; pg8::StaticOrder S; S.init(M, D, Gp, bxp);
            EpiRes E{l == 0 ? args.in[0] : args.out, args.out, (bf16_t*)(wsp + WS_XB), (float*)(wsp + WS_SSQD)};
            pg8::gemm_phase<EpiRes, pg8::StaticOrder, true, true>(lds, g, S, E);
        }
        SEAM(pb + 3);
        if (IN(pb + 4) && !(DBG_SKIP & 128)) { OPAQ();
            pg8::Gemm g{(const bf16_t*)(wsp + WS_XB), (const bf16_t*)(wsp + WS_WFI) + (size_t)l * NFI * D, M, NFI, D}; pg8::StaticOrder S; S.init(M, NFI, Gp, bxp);
            EpiFfn E{(bf16_t*)(wsp + WS_ACT), (const float*)(wsp + WS_SSQD)};
            pg8::gemm_phase<EpiFfn, pg8::StaticOrder, true, true>(lds, g, S, E);
        }
        SEAM(pb + 4);
        if (IN(pb + 5) && !(DBG_SKIP & 256)) { OPAQ();
            pg8::Gemm g{(const bf16_t*)(wsp + WS_ACT), (const bf16_t*)(wsp + WS_WFO) + (size_t)l * D * DFF, M, D, DFF}; pg8::StaticOrder S; S.init(M, D, Gp, bxp);
            EpiRes E{args.out, args.out, (bf16_t*)(wsp + WS_XB), (float*)(wsp + WS_SSQA)};
            pg8::gemm_phase<EpiRes, pg8::StaticOrder, true, true>(lds, g, S, E);
        }
        SEAM(pb + 5);
    }
    if (IN(N_PHASES - 1)) { OPAQ(); final_rows(args.out, args.in[14], gwp, NGWp, lanep); }
#undef IN
#undef SEAM
#undef OPAQ
}

extern "C" void kernel_launch(void* const* d_in, const int* in_sizes, int n_in, void* d_out, int out_size, void* d_ws, size_t ws_size, hipStream_t stream) {
    static int grid = 0;
    if (grid == 0) {
        if (n_in != 15 || in_sizes[0] != M * D || out_size != M * D || ws_size < WS_END) {
            fprintf(stderr, "kernel_launch: unexpected shapes: n_in %d in0 %d out %d ws %zu (need %zu)\n", n_in, n_in > 0 ? in_sizes[0] : -1, out_size, ws_size, (size_t)WS_END); grid = -1; return; }
        int dev = 0, cus = 0, per_cu = 0;
        if (hipGetDevice(&dev) != hipSuccess || hipDeviceGetAttribute(&cus, hipDeviceAttributeMultiprocessorCount, dev) != hipSuccess) { grid = -1; return; }
        if (hipFuncSetAttribute((const void*)mega_fwd, hipFuncAttributeMaxDynamicSharedMemorySize, LDS_BYTES) != hipSuccess) { fprintf(stderr, "kernel_launch: hipFuncSetAttribute failed\n"); grid = -1; return; }
        if (hipOccupancyMaxActiveBlocksPerMultiprocessor(&per_cu, (const void*)mega_fwd, NWAVES * 64, LDS_BYTES) != hipSuccess || per_cu < 1)
            fprintf(stderr, "kernel_launch: occupancy query reports %d workgroups per CU\n", per_cu);
        (void)hipGetLastError();
        grid = cus;
    }
    if (grid < 0) return;
    if (hipMemsetAsync((char*)d_ws + WS_CTL, 0, CTL_ZERO_BYTES, stream) != hipSuccess) { fprintf(stderr, "kernel_launch: memset failed\n"); return; }
    Args a{};
    for (int i = 0; i < 15; ++i) a.in[i] = (const float*)d_in[i];
    a.out = (float*)d_out; a.ws = (unsigned char*)d_ws;
    if (MK_N_LAUNCHES == 1) {
        a.ph_lo = 0; a.ph_hi = N_PHASES;
        hipLaunchKernelGGL(mega_fwd, dim3(grid), dim3(NWAVES * 64), LDS_BYTES, stream, a);
    } else {
        for (int p = 0; p < N_PHASES; ++p) { a.ph_lo = p; a.ph_hi = p + 1; hipLaunchKernelGGL(mega_fwd, dim3(grid), dim3(NWAVES * 64), LDS_BYTES, stream, a); }
    }
    const hipError_t le = hipPeekAtLastError();
    if (le != hipSuccess) fprintf(stderr, "kernel_launch: launch failed: %s\n", hipGetErrorName(le));
}
```

```cpp
#include <hip/hip_runtime.h>
#include <cstdio>
#include <cstdint>

#ifndef DBG_SKIP
#define DBG_SKIP 0
#endif
#ifndef MK_N_LAUNCHES
#define MK_N_LAUNCHES 1
#endif

#define GAS __attribute__((address_space(1)))
#define LAS __attribute__((address_space(3)))
typedef unsigned short bf16_t;
typedef short bf16x8 __attribute__((ext_vector_type(8)));
typedef float f32x4 __attribute__((ext_vector_type(4)));
typedef float f32x2 __attribute__((ext_vector_type(2)));
typedef unsigned u32x4 __attribute__((ext_vector_type(4)));
typedef unsigned u32x2 __attribute__((ext_vector_type(2)));

constexpr int BATCH = 8, SEQ = 2048, D = 1024, DEPTH = 4;
constexpr int M = BATCH * SEQ;
constexpr int NH = 6, HD = 128, MIXW = 768, XW = 256, NXH = 4, XHD = 64, NMEM = 256;
constexpr int NIN = 3328, DFF = 2816, NFI = 2 * DFF;
constexpr int MROWS = BATCH * NMEM;
constexpr float EPS = 1e-6f;

constexpr size_t MiB = 1u << 20;
constexpr size_t WS_CTL = 0, CTL_ZERO_BYTES = 1 * MiB;
constexpr size_t WS_LB = 1 * MiB;
constexpr size_t WS_SSQA = 2 * MiB;
constexpr size_t WS_SSQD = 3 * MiB;
constexpr size_t WS_COS = 4 * MiB, WS_SIN = 8 * MiB;
constexpr size_t WS_MEMB = 12 * MiB;
constexpr size_t WS_MKV = 16 * MiB;
constexpr size_t WS_WIN = 24 * MiB;
constexpr size_t WS_WOUT = 50 * MiB;
constexpr size_t WS_WFI = 58 * MiB;
constexpr size_t WS_WFO = 102 * MiB;
constexpr size_t WS_WM = 124 * MiB;
constexpr size_t WS_XB = 128 * MiB;
constexpr size_t WS_CAT = 160 * MiB;
constexpr size_t WS_Z = 192 * MiB;
constexpr size_t WS_F = 296 * MiB;
constexpr size_t WS_KST = 296 * MiB;
constexpr size_t WS_AUX = 320 * MiB;
constexpr size_t WS_SSQO = 323 * MiB;
constexpr size_t WS_ACT = 192 * MiB;
constexpr size_t WS_END = 344 * MiB;
static_assert(WS_WIN + (size_t)DEPTH * NIN * D * 2 <= WS_WOUT && WS_WOUT + (size_t)DEPTH * D * D * 2 <= WS_WFI && WS_WFI + (size_t)DEPTH * NFI * D * 2 <= WS_WFO &&
              WS_WFO + (size_t)DEPTH * D * DFF * 2 <= WS_WM && WS_WM + (size_t)2048 * 1024 * 2 <= WS_XB && WS_Z + (size_t)M * NIN * 2 <= WS_F && WS_F + (size_t)M * MIXW * 4 <= WS_END &&
              WS_ACT + (size_t)M * DFF * 2 <= WS_F, "ws map");
constexpr int CW_BAR = 4096;

namespace pg8 {
constexpr int BM = 256, BK = 64, HALF = 128, HTB = HALF * BK * 2, STAGE_BYTES = 8 * HTB, NXCD = 8, WGM = 8;
__host__ __device__ __forceinline__ int lds_byte(int r, int c) { const int st = (r >> 4) * 2 + (c >> 5), rr = r & 15, cc = c & 31, ob = rr * 64 + cc * 2; return st * 1024 + (ob ^ (((ob >> 9) & 1) << 5)); }
__host__ __device__ __forceinline__ void stage_rc(int b, int& R, int& C) { const int st = b / 1024, sb = b % 1024, swz = sb ^ (((sb >> 9) & 1) << 5); R = (st >> 1) * 16 + swz / 64; C = (st & 1) * 32 + (swz % 64) / 2; }
__host__ __device__ __forceinline__ int perm32(int rho) { const int n = rho >> 4, i = rho & 15; return 8 * (i >> 2) + 4 * n + (i & 3); }
struct Unit { int pm, pn; };
struct Gemm { const bf16_t* A; const bf16_t* Bt; int M, N, K; };
struct StaticOrder {
    int nM, nN, nwg, G, c;
    __host__ __device__ void init(int M_, int N_, int G_, int c_) { nM = M_ / BM; nN = N_ / BM; nwg = nM * nN; G = G_; c = c_; }
    __host__ __device__ bool next(int i, Unit& u) const {
        const long L = (long)i * G + c; if (L >= nwg) return false;
        int wgid = (int)L; { const int q = nwg / NXCD, r = nwg % NXCD, xcd = wgid % NXCD, off = wgid / NXCD; wgid = (xcd < r ? xcd * (q + 1) : r * (q + 1) + (xcd - r) * q) + off; }
        const int nig = WGM * nN, gid = wgid / nig, fm = gid * WGM, gsz = (nM - fm) < WGM ? (nM - fm) : WGM;
        u.pm = fm + ((wgid % nig) % gsz); u.pn = (wgid % nig) / gsz; return true;
    }
    __device__ __forceinline__ void a_ready(const Unit&) const {}
    __device__ __forceinline__ void done(const Unit&) const {}
};
__device__ __forceinline__ unsigned cvt_pk_bf16(float lo, float hi) { unsigned r; asm volatile("v_cvt_pk_bf16_f32 %0, %1, %2" : "=v"(r) : "v"(lo), "v"(hi)); return r; }

template <class Epi, class Sched, bool ALIGN_EPI = false, bool SP2 = false>
__device__ __forceinline__ void gemm_phase(LAS unsigned char* lds, const Gemm g, const Sched& S, const Epi& E, int tid) {
    const int wid = __builtin_amdgcn_readfirstlane(tid >> 6), lane = tid & 63, wr = wid >> 2, wc = wid & 3, fr = lane & 15, fq = lane >> 4;
    const int K = g.K, nt = K / BK;
    unsigned voffA[2], voffB[2];
#pragma unroll
    for (int i = 0; i < 2; ++i) { int R, C; stage_rc(tid * 16 + i * 8192, R, C); const int Rb = Epi::PERM ? ((R & ~31) + perm32(R & 31)) : R;
        voffA[i] = (unsigned)(R * K + C) * 2u; voffB[i] = (unsigned)(Rb * K + C) * 2u; }
    asm volatile("" : "+v"(voffA[0]), "+v"(voffA[1]), "+v"(voffB[0]), "+v"(voffB[1]));
    const size_t kstep = (size_t)(BK * 2);
    const size_t hstep = (size_t)HALF * K * 2;
    const size_t tstep = 2 * hstep;
    const unsigned ldsw = (unsigned)wid * 1024u;
    const int aoff = lds_byte(wr * 64 + fr, fq * 8), boff = lds_byte(wc * 32 + fr, fq * 8);
#define PG8_SA(b, h) (((b) * 2 + (h)) * HTB)
#define PG8_SB(b, h) ((4 + (b) * 2 + (h)) * HTB)
#define PG8_STAGE(bufoff, gbase, voff) do { _Pragma("unroll") for (int _i = 0; _i < 2; ++_i) \
        __builtin_amdgcn_global_load_lds((const unsigned*)((const char*)(gbase) + (voff)[_i]), (LAS unsigned*)(lds + (bufoff) + ldsw + _i * 8192), 16, 0, 0); } while (0)
#define PG8_LDA(dst, b, h) do { _Pragma("unroll") for (int m = 0; m < 4; ++m) _Pragma("unroll") for (int k = 0; k < 2; ++k) dst[m][k] = *(const LAS bf16x8*)(lds + PG8_SA(b, h) + aoff + m * 2048 + k * 1024); } while (0)
#define PG8_LDB(dst, b, h) do { _Pragma("unroll") for (int n = 0; n < 2; ++n) _Pragma("unroll") for (int k = 0; k < 2; ++k) dst[n][k] = *(const LAS bf16x8*)(lds + PG8_SB(b, h) + boff + n * 2048 + k * 1024); } while (0)
#define PG8_MMA(ai, bj, At, Bt) do { __builtin_amdgcn_s_setprio(1); _Pragma("unroll") for (int m = 0; m < 4; ++m) _Pragma("unroll") for (int n = 0; n < 2; ++n) _Pragma("unroll") for (int k = 0; k < 2; ++k) \
        acc[ai][bj][m][n] = __builtin_amdgcn_mfma_f32_16x16x32_bf16(Bt[n][k], At[m][k], acc[ai][bj][m][n], 0, 0, 0); __builtin_amdgcn_s_setprio(0); } while (0)
#define PG8_WAIT_V(n) asm volatile("s_waitcnt vmcnt(" #n ")" ::: "memory")
#define PG8_WAIT_L(n) asm volatile("s_waitcnt lgkmcnt(" #n ")" ::: "memory")
#define PG8_BAR __builtin_amdgcn_s_barrier()
#define PG8_SCHED __builtin_amdgcn_sched_barrier(0)
    Unit cur, nxt; int ui = 0;
    if (!S.next(0, cur)) return;
    f32x4 acc[2][2][4][2];
#pragma unroll
    for (int a = 0; a < 2; ++a)
#pragma unroll
        for (int b = 0; b < 2; ++b)
#pragma unroll
            for (int m = 0; m < 4; ++m)
#pragma unroll
                for (int n = 0; n < 2; ++n) acc[a][b][m][n] = (f32x4){0.f, 0.f, 0.f, 0.f};
    bf16x8 At[4][2], B0[2][2], B1[2][2];
    const char* cA = (const char*)g.A + (size_t)cur.pm * tstep; const char* cB = (const char*)g.Bt + (size_t)cur.pn * tstep;
    S.a_ready(cur);
    if constexpr (SP2) {
        PG8_STAGE(PG8_SB(0, 0), cB, voffB); PG8_STAGE(PG8_SB(0, 1), cB + hstep, voffB); PG8_STAGE(PG8_SA(0, 0), cA, voffA); PG8_STAGE(PG8_SA(0, 1), cA + hstep, voffA);
        if (wr == 1) PG8_BAR;
        PG8_WAIT_V(2); PG8_BAR;
        PG8_STAGE(PG8_SB(1, 0), cB + kstep, voffB); PG8_STAGE(PG8_SA(1, 0), cA + kstep, voffA); PG8_STAGE(PG8_SB(1, 1), cB + hstep + kstep, voffB);
        PG8_WAIT_V(6); PG8_BAR;
    } else {
        PG8_STAGE(PG8_SB(0, 0), cB, voffB); PG8_STAGE(PG8_SA(0, 0), cA, voffA); PG8_STAGE(PG8_SB(0, 1), cB + hstep, voffB); PG8_STAGE(PG8_SA(0, 1), cA + hstep, voffA);
        if (wr == 1) PG8_BAR;
        PG8_WAIT_V(4); PG8_BAR;
        PG8_STAGE(PG8_SB(1, 0), cB + kstep, voffB); PG8_STAGE(PG8_SA(1, 0), cA + kstep, voffA); PG8_STAGE(PG8_SB(1, 1), cB + hstep + kstep, voffB);
        PG8_WAIT_V(6); PG8_BAR;
    }
    for (;;) {
        const bool has_next = S.next(ui + 1, nxt);
        const char* nA = has_next ? (const char*)g.A + (size_t)nxt.pm * tstep : cA; const char* nB = has_next ? (const char*)g.Bt + (size_t)nxt.pn * tstep : cB;
        for (int t = 0; t < nt; t += 2) {
            const bool last = (t == nt - 2);
            const char* a1 = cA + (size_t)(t + 1) * kstep;
            const char* a2 = last ? nA : cA + (size_t)(t + 2) * kstep; const char* b2 = last ? nB : cB + (size_t)(t + 2) * kstep;
            const char* a3 = a2 + kstep; const char* b3 = b2 + kstep;
            if (last && has_next) S.a_ready(nxt);
            if constexpr (Epi::MID_T > 0) { if (t == Epi::MID_T) E.mid(acc, cur, wr, wc, fr, fq); }
            if constexpr (SP2) {
            PG8_LDB(B0, 0, 0); PG8_LDB(B1, 0, 1); PG8_SCHED; PG8_LDA(At, 0, 0); PG8_STAGE(PG8_SA(1, 1), a1 + hstep, voffA);
            PG8_WAIT_V(8); PG8_WAIT_L(0); PG8_BAR; PG8_MMA(0, 0, At, B0); PG8_MMA(0, 1, At, B1); PG8_BAR; PG8_SCHED;
            PG8_LDA(At, 0, 1); PG8_STAGE(PG8_SB(0, 0), b2, voffB); PG8_STAGE(PG8_SB(0, 1), b2 + hstep, voffB); PG8_STAGE(PG8_SA(0, 0), a2, voffA);
            PG8_WAIT_V(8); PG8_WAIT_L(0); PG8_BAR; PG8_MMA(1, 0, At, B0); PG8_MMA(1, 1, At, B1); PG8_BAR; PG8_SCHED;
            PG8_LDB(B0, 1, 0); PG8_LDB(B1, 1, 1); PG8_SCHED; PG8_LDA(At, 1, 0); PG8_STAGE(PG8_SA(0, 1), a2 + hstep, voffA);
            PG8_WAIT_V(8); PG8_WAIT_L(0); PG8_BAR; PG8_MMA(0, 0, At, B0); PG8_MMA(0, 1, At, B1); PG8_BAR; PG8_SCHED;
            PG8_LDA(At, 1, 1); PG8_STAGE(PG8_SB(1, 0), b3, voffB); PG8_STAGE(PG8_SB(1, 1), b3 + hstep, voffB); PG8_STAGE(PG8_SA(1, 0), a3, voffA);
            PG8_WAIT_V(8); PG8_WAIT_L(0); PG8_BAR; PG8_MMA(1, 0, At, B0); PG8_MMA(1, 1, At, B1); PG8_BAR; PG8_SCHED;
            } else {
            PG8_LDB(B0, 0, 0); PG8_SCHED; PG8_LDA(At, 0, 0); PG8_STAGE(PG8_SA(1, 1), a1 + hstep, voffA);
            PG8_WAIT_L(8); PG8_BAR; PG8_WAIT_L(0); PG8_MMA(0, 0, At, B0); PG8_BAR; PG8_SCHED;
            PG8_LDB(B1, 0, 1); PG8_STAGE(PG8_SB(0, 0), b2, voffB);
            PG8_BAR; PG8_WAIT_L(0); PG8_MMA(0, 1, At, B1); PG8_BAR;
            PG8_LDA(At, 0, 1); PG8_STAGE(PG8_SA(0, 0), a2, voffA);
            PG8_BAR; PG8_WAIT_L(0); PG8_MMA(1, 0, At, B0); PG8_BAR; PG8_SCHED;
            PG8_STAGE(PG8_SB(0, 1), b2 + hstep, voffB);
            PG8_WAIT_V(6); PG8_BAR; PG8_MMA(1, 1, At, B1); PG8_BAR;
            PG8_LDB(B0, 1, 0); PG8_SCHED; PG8_LDA(At, 1, 0); PG8_STAGE(PG8_SA(0, 1), a2 + hstep, voffA);
            PG8_WAIT_L(8); PG8_BAR; PG8_WAIT_L(0); PG8_MMA(0, 0, At, B0); PG8_BAR; PG8_SCHED;
            PG8_LDB(B1, 1, 1); PG8_STAGE(PG8_SB(1, 0), b3, voffB);
            PG8_BAR; PG8_WAIT_L(0); PG8_MMA(0, 1, At, B1); PG8_BAR;
            PG8_LDA(At, 1, 1); PG8_STAGE(PG8_SA(1, 0), a3, voffA);
            PG8_BAR; PG8_WAIT_L(0); PG8_MMA(1, 0, At, B0); PG8_BAR; PG8_SCHED;
            PG8_STAGE(PG8_SB(1, 1), b3 + hstep, voffB);
            PG8_WAIT_V(6); PG8_BAR; PG8_MMA(1, 1, At, B1); PG8_BAR;
            }
        }
        if constexpr (ALIGN_EPI) { if (wr == 0) PG8_BAR; }
        E(acc, cur, wr, wc, fr, fq);
        if (!has_next) break;
#pragma unroll
        for (int a = 0; a < 2; ++a)
#pragma unroll
            for (int b = 0; b < 2; ++b)
#pragma unroll
                for (int m = 0; m < 4; ++m)
#pragma unroll
                    for (int n = 0; n < 2; ++n) acc[a][b][m][n] = (f32x4){0.f, 0.f, 0.f, 0.f};
        cur = nxt; cA = nA; cB = nB; ++ui;
        if constexpr (ALIGN_EPI) { if (wr == 1) PG8_BAR; }
    }
    PG8_WAIT_V(0);
    if constexpr (!ALIGN_EPI) { if (wr == 0) PG8_BAR; }
    PG8_BAR;
#undef PG8_SA
#undef PG8_SB
#undef PG8_STAGE
#undef PG8_LDA
#undef PG8_LDB
#undef PG8_MMA
#undef PG8_WAIT_V
#undef PG8_WAIT_L
#undef PG8_BAR
#undef PG8_SCHED
}
}

__device__ __forceinline__ int lane_id_volatile() { int l; asm volatile("v_mbcnt_lo_u32_b32 %0, -1, 0\n\tv_mbcnt_hi_u32_b32 %0, -1, %0" : "=v"(l)); return l; }
__device__ __forceinline__ float bf2f(unsigned h) { return __uint_as_float(h << 16); }
__device__ __forceinline__ unsigned f2bf(float f) { unsigned u = __float_as_uint(f); return (u + 0x7fffu + ((u >> 16) & 1u)) >> 16; }
__device__ __forceinline__ unsigned pk2(float lo, float hi) { return f2bf(lo) | (f2bf(hi) << 16); }
__device__ __forceinline__ float fast_rcp(float x) { return __builtin_amdgcn_rcpf(x); }
__device__ __forceinline__ float sigmoidf_(float x) { return fast_rcp(1.0f + __expf(-x)); }
__device__ __forceinline__ float siluf_(float x) { return x * sigmoidf_(x); }
__device__ __forceinline__ float wave_sum(float v) {
#pragma unroll
    for (int o = 1; o < 64; o <<= 1) v += __shfl_xor(v, o);
    return v;
}
__device__ __forceinline__ float rstd_from_partials(const float* ssq, int row, float invn) {
    const f32x4* p = (const f32x4*)(ssq + (size_t)row * 16);
    const f32x4 a = p[0], b = p[1], c = p[2], d = p[3];
    const f32x4 s = (a + b) + (c + d);
    return rsqrtf(((s[0] + s[1]) + (s[2] + s[3])) * invn + EPS);
}
__device__ __forceinline__ u32x4 pack8(const f32x4 v0, const f32x4 v1) {
    u32x4 w; w.x = pg8::cvt_pk_bf16(v0[0], v0[1]); w.y = pg8::cvt_pk_bf16(v0[2], v0[3]); w.z = pg8::cvt_pk_bf16(v1[0], v1[1]); w.w = pg8::cvt_pk_bf16(v1[2], v1[3]); return w;
}

#define DPP_SHR(x, n) __int_as_float(__builtin_amdgcn_update_dpp(0, __float_as_int(x), 0x110 + (n), 0xf, 0xf, false))
__device__ __forceinline__ float rowscan16(float x) {
    x += DPP_SHR(x, 1); x += DPP_SHR(x, 2); x += DPP_SHR(x, 4); x += DPP_SHR(x, 8); return x;
}
__device__ __forceinline__ float bcast15(float x) { return __shfl(x, 15, 16); }
__device__ __forceinline__ float expc(float x) { return __expf(fminf(x, 80.0f)); }
using pg8::Unit;
struct EpiPlain {
    static constexpr bool PERM = true; static constexpr int MID_T = 0;
    bf16_t* O; int ldc;
    __device__ __forceinline__ void operator()(const f32x4 (&acc)[2][2][4][2], const Unit& u, int wr, int wc, int fr, int fq) const {
        const int row0 = u.pm * 256 + wr * 64 + fr, col0 = u.pn * 256 + wc * 32 + 8 * fq;
#pragma unroll
        for (int ai = 0; ai < 2; ++ai)
#pragma unroll
            for (int m = 0; m < 4; ++m) { bf16_t* rowp = O + (size_t)(row0 + ai * 128 + m * 16) * ldc + col0;
#pragma unroll
                for (int bj = 0; bj < 2; ++bj) *(u32x4*)(rowp + bj * 128) = pack8(acc[ai][bj][m][0], acc[ai][bj][m][1]); }
    }
};
struct EpiIn {
    static constexpr bool PERM = true; static constexpr int MID_T = 0;
    bf16_t* Z; bf16_t* KST; float* AUX; const float* ssq; const float* lb; const float* cosT; const float* sinT; int is_ret;
    __device__ __forceinline__ void operator()(const f32x4 (&acc)[2][2][4][2], const Unit& u, int wr, int wc, int fr, int fq) const {
        const int row0 = u.pm * 256 + wr * 64 + fr, jl = wc * 32 + 8 * fq, t = u.pn;
        if (t < 6) {
            if (!is_ret) {
                const f32x4 lb0 = *(const f32x4*)(lb + t * 128 + (jl >> 1)), lb1 = *(const f32x4*)(lb + t * 128 + (jl >> 1) + 64);
#pragma unroll
                for (int ai = 0; ai < 2; ++ai)
#pragma unroll
                    for (int mp = 0; mp < 2; ++mp) {
                        const int tok0 = u.pm * 256 + ai * 128 + wr * 64 + mp * 32, rlo = tok0 + fr, rhi = rlo + 16;
                        const float rs0 = rstd_from_partials(ssq, rlo, 1.0f / D), rs1 = rstd_from_partials(ssq, rhi, 1.0f / D);
                        f32x4 qsv[2][2], ksv[2][2], ktv[2][2], erv[2], dcv[2];
#pragma unroll
                        for (int n = 0; n < 2; ++n)
#pragma unroll
                            for (int i = 0; i < 4; ++i) {
                                const float lbv = n ? lb1[i] : lb0[i];
                                float g[2], kk[2], qq[2];
#pragma unroll
                                for (int e = 0; e < 2; ++e) {
                                    const float x = acc[ai][1][2 * mp + e][n][i] * (e ? rs1 : rs0), za = acc[ai][0][2 * mp + e][n][i] * (e ? rs1 : rs0);
                                    const float a = __expf(-fabsf(x)), r = fast_rcp(1.0f + a);
                                    const float sneg = x >= 0.f ? a * r : r;
                                    const float em = x >= 0.f ? a : fminf(fast_rcp(a), 1.0686475e13f);
                                    g[e] = (fminf(x, 0.f) - __logf(1.0f + a)) + __logf(1.0f + lbv * em);
                                    kk[e] = (1.0f - lbv) * sneg;
                                    qq[e] = siluf_(za);
                                }
                                const float blo = rowscan16(g[0]), ref = bcast15(blo), bhi = ref + rowscan16(g[1]), blast = bcast15(bhi);
                                qsv[0][n][i] = qq[0] * expc(blo - ref); qsv[1][n][i] = qq[1] * expc(bhi - ref);
                                ksv[0][n][i] = kk[0] * expc(ref - blo); ksv[1][n][i] = kk[1] * expc(ref - bhi);
                                ktv[0][n][i] = kk[0] * __expf(blast - blo); ktv[1][n][i] = kk[1] * __expf(blast - bhi);
                                erv[n][i] = __expf(ref); dcv[n][i] = __expf(blast);
                            }
                        bf16_t* zlo = Z + (size_t)rlo * NIN + t * 256 + jl; bf16_t* zhi = Z + (size_t)rhi * NIN + t * 256 + jl;
                        *(u32x4*)zlo = pack8(qsv[0][0], qsv[0][1]); *(u32x4*)(zlo + 128) = pack8(ksv[0][0], ksv[0][1]);
                        *(u32x4*)zhi = pack8(qsv[1][0], qsv[1][1]); *(u32x4*)(zhi + 128) = pack8(ksv[1][0], ksv[1][1]);
                        *(u32x4*)(KST + (size_t)rlo * MIXW + t * 128 + jl) = pack8(ktv[0][0], ktv[0][1]);
                        *(u32x4*)(KST + (size_t)rhi * MIXW + t * 128 + jl) = pack8(ktv[1][0], ktv[1][1]);
                        if (fr == 15) { float* ap = AUX + ((size_t)((tok0 >> 11) * NH + t) * 64 + ((tok0 & 2047) >> 5)) * 256 + jl;
                            *(f32x4*)ap = erv[0]; *(f32x4*)(ap + 4) = erv[1]; *(f32x4*)(ap + 128) = dcv[0]; *(f32x4*)(ap + 132) = dcv[1]; }
                    }
            } else {
                const float lg = __log2f(1.0f - exp2f(-5.0f - (float)t));
#pragma unroll
                for (int ai = 0; ai < 2; ++ai)
#pragma unroll
                    for (int m = 0; m < 4; ++m) { const int row = row0 + ai * 128 + m * 16; const float rs = rstd_from_partials(ssq, row, 1.0f / D);
                        const f32x4 cs = *(const f32x4*)(cosT + (size_t)row * 64 + (jl >> 1)), sn = *(const f32x4*)(sinT + (size_t)row * 64 + (jl >> 1));
                        const float cp1 = (float)(16 * (m & 1) + fr + 1), pw = exp2f(cp1 * lg), ipw = exp2f(-cp1 * lg);
                        const float qsc = rs * pw, ksc = rs * 0.08838834764831845f * ipw;
                        f32x4 q0, q1, k0, k1;
#pragma unroll
                        for (int i = 0; i < 4; ++i) {
                            const float a1 = acc[ai][0][m][0][i] * qsc, a2 = acc[ai][0][m][1][i] * qsc; q0[i] = a1 * cs[i] - a2 * sn[i]; q1[i] = a1 * sn[i] + a2 * cs[i];
                            const float b1 = acc[ai][1][m][0][i] * ksc, b2 = acc[ai][1][m][1][i] * ksc; k0[i] = b1 * cs[i] - b2 * sn[i]; k1[i] = b1 * sn[i] + b2 * cs[i];
                        }
                        bf16_t* zp = Z + (size_t)row * NIN + t * 256 + jl; *(u32x4*)zp = pack8(q0, q1); *(u32x4*)(zp + 128) = pack8(k0, k1); }
            }
        } else {
            const int mode = (t >= 9 && t < 12) ? (is_ret ? 2 : 1) : 0;
#pragma unroll
            for (int ai = 0; ai < 2; ++ai)
#pragma unroll
                for (int m = 0; m < 4; ++m) { const int row = row0 + ai * 128 + m * 16; const float rs = rstd_from_partials(ssq, row, 1.0f / D);
                    bf16_t* zp = Z + (size_t)row * NIN + t * 256 + jl;
#pragma unroll
                    for (int bj = 0; bj < 2; ++bj) { f32x4 v0 = acc[ai][bj][m][0] * rs, v1 = acc[ai][bj][m][1] * rs;
                        if (mode == 1) {
#pragma unroll
                            for (int i = 0; i < 4; ++i) { v0[i] = sigmoidf_(v0[i]); v1[i] = sigmoidf_(v1[i]); } }
                        else if (mode == 2) {
#pragma unroll
                            for (int i = 0; i < 4; ++i) { v0[i] = siluf_(v0[i]); v1[i] = siluf_(v1[i]); } }
                        *(u32x4*)(zp + bj * 128) = pack8(v0, v1); } }
        }
    }
};
struct EpiRes {
    static constexpr bool PERM = true; static constexpr int MID_T = 0;
    const float* xin; float* xres; bf16_t* xb; float* ssq;
    __device__ __forceinline__ void operator()(const f32x4 (&acc)[2][2][4][2], const Unit& u, int wr, int wc, int fr, int fq) const {
        const int row0 = u.pm * 256 + wr * 64 + fr, col0 = u.pn * 256 + wc * 32 + 8 * fq;
#pragma unroll
        for (int ai = 0; ai < 2; ++ai)
#pragma unroll
            for (int m = 0; m < 4; ++m) { const int row = row0 + ai * 128 + m * 16; const size_t off = (size_t)row * D + col0; float s = 0.f;
#pragma unroll
                for (int bj = 0; bj < 2; ++bj) {
                    const f32x4 r0 = *(const f32x4*)(xin + off + bj * 128), r1 = *(const f32x4*)(xin + off + bj * 128 + 4);
                    const f32x4 v0 = r0 + acc[ai][bj][m][0], v1 = r1 + acc[ai][bj][m][1];
                    *(f32x4*)(xres + off + bj * 128) = v0; *(f32x4*)(xres + off + bj * 128 + 4) = v1;
                    *(u32x4*)(xb + off + bj * 128) = pack8(v0, v1);
                    s += (v0[0] * v0[0] + v0[1] * v0[1]) + (v0[2] * v0[2] + v0[3] * v0[3]) + (v1[0] * v1[0] + v1[1] * v1[1]) + (v1[2] * v1[2] + v1[3] * v1[3]);
                }
                s += __shfl_xor(s, 16); s += __shfl_xor(s, 32);
                if (fq == 0) ssq[(size_t)row * 16 + u.pn * 4 + wc] = s; }
    }
};
struct EpiResC {
    static constexpr bool PERM = true; static constexpr int MID_T = 12;
    EpiRes base; const float* ssqo;
    __device__ __forceinline__ void mid(f32x4 (&acc)[2][2][4][2], const Unit& u, int wr, int wc, int fr, int fq) const {
        if (!ssqo) return;
        const int row0 = u.pm * 256 + wr * 64 + fr;
#pragma unroll
        for (int ai = 0; ai < 2; ++ai)
#pragma unroll
            for (int m = 0; m < 4; ++m) { const int row = row0 + ai * 128 + m * 16;
                const f32x4 a = *(const f32x4*)(ssqo + (size_t)row * 8), b = *(const f32x4*)(ssqo + (size_t)row * 8 + 4);
                const float rs = rsqrtf(((a[0] + a[1]) + (a[2] + a[3]) + (b[0] + b[1])) * (1.0f / MIXW) + EPS);
#pragma unroll
                for (int bj = 0; bj < 2; ++bj)
#pragma unroll
                    for (int n = 0; n < 2; ++n) acc[ai][bj][m][n] = acc[ai][bj][m][n] * rs;
                asm volatile("" ::: "memory"); }
    }
    __device__ __forceinline__ void operator()(const f32x4 (&acc)[2][2][4][2], const Unit& u, int wr, int wc, int fr, int fq) const { base(acc, u, wr, wc, fr, fq); }
};
struct EpiFfn {
    static constexpr bool PERM = true; static constexpr int MID_T = 0;
    bf16_t* act; const float* ssq;
    __device__ __forceinline__ void operator()(const f32x4 (&acc)[2][2][4][2], const Unit& u, int wr, int wc, int fr, int fq) const {
        const int row0 = u.pm * 256 + wr * 64 + fr, jl = wc * 32 + 8 * fq;
#pragma unroll
        for (int ai = 0; ai < 2; ++ai)
#pragma unroll
            for (int m = 0; m < 4; ++m) { const int row = row0 + ai * 128 + m * 16; const float rs = rstd_from_partials(ssq, row, 1.0f / D);
                f32x4 v0, v1;
#pragma unroll
                for (int i = 0; i < 4; ++i) { v0[i] = siluf_(acc[ai][0][m][0][i] * rs) * (acc[ai][1][m][0][i] * rs); v1[i] = siluf_(acc[ai][0][m][1][i] * rs) * (acc[ai][1][m][1][i] * rs); }
                *(u32x4*)(act + (size_t)row * DFF + u.pn * 128 + jl) = pack8(v0, v1); }
    }
};

#define XB_TMO      128
#define XB_XCNT(j)  (256  + 64 * (j))
#define XB_XSUB(j)  (1280 + 64 * (j))
#define XB_XGEN(j)  (2304 + 64 * (j))
#define XB_TOP      3328
#define XB_TOPGEN   3392
#define XCD_BAR_WORDS 3456
#define XB_SPIN_CAP (1u << 18)
__device__ __forceinline__ unsigned xb_ld(unsigned* p)              { return __hip_atomic_load(p, __ATOMIC_RELAXED, __HIP_MEMORY_SCOPE_AGENT); }
__device__ __forceinline__ unsigned xb_add(unsigned* p, unsigned v) { return __hip_atomic_fetch_add(p, v, __ATOMIC_RELAXED, __HIP_MEMORY_SCOPE_AGENT); }
__device__ __forceinline__ unsigned xb_xcc_id() { return (unsigned)__builtin_amdgcn_s_getreg((3 << 11) | 20) & 0xFu; }
#define XB_SPIN(cond, bar) do { unsigned _sp = 0; while (cond) { __builtin_amdgcn_s_sleep(1); \
    if ((++_sp & 255u) == 0u) { if (xb_ld(&(bar)[XB_TMO])) break; if (_sp > XB_SPIN_CAP) { atomicAdd(&(bar)[XB_TMO], 1u); break; } } } } while (0)
struct XcdBarrier { unsigned* bar; unsigned x; volatile LAS unsigned* st; };
__device__ __forceinline__ XcdBarrier xcd_barrier_post(unsigned* bar, volatile LAS unsigned* st) {
    XcdBarrier b; b.bar = bar; b.x = xb_xcc_id(); b.st = st;
    if (threadIdx.x == 0) (void)xb_add(&bar[XB_XCNT(b.x)], 1u);
    return b;
}
__device__ __forceinline__ void xcd_barrier_complete(unsigned* bar, unsigned x, unsigned& nloc, unsigned& nx) {
    const unsigned G = gridDim.x * gridDim.y * gridDim.z;
    unsigned sum, cnt, mine, sp = 0u;
    for (;;) {
        sum = 0u; cnt = 0u; mine = 0u;
#pragma unroll
        for (unsigned j = 0; j < 16; ++j) { const unsigned c = xb_ld(&bar[XB_XCNT(j)]); sum += c; cnt += (c > 0u) ? 1u : 0u; mine = (j == x) ? c : mine; }
        if (sum == G) break;
        __builtin_amdgcn_s_sleep(1);
        if ((++sp & 255u) == 0u) { if (xb_ld(&bar[XB_TMO])) break; if (sp > XB_SPIN_CAP) { atomicAdd(&bar[XB_TMO], 1u); break; } }
    }
    nloc = mine > 0u ? mine : 1u; nx = cnt > 0u ? cnt : 1u;
}
__device__ __forceinline__ void xcd_barrier(const XcdBarrier& b, bool leader) {
    asm volatile("s_waitcnt vmcnt(0)" ::: "memory");
    __syncthreads();
    if (leader) {
        unsigned* bar = b.bar;
        __builtin_amdgcn_s_waitcnt(0);
        unsigned nloc = b.st[0], nx = b.st[1];
        if (nloc == 0u) { xcd_barrier_complete(bar, b.x, nloc, nx); b.st[0] = nloc; b.st[1] = nx; }
        const unsigned old = xb_add(&bar[XB_XSUB(b.x)], 1u);
        const unsigned gen = old / nloc;
        if (old + 1u == (gen + 1u) * nloc) {
            __builtin_amdgcn_fence(__ATOMIC_RELEASE, "agent");
            asm volatile("s_waitcnt vmcnt(0)" ::: "memory");
            const unsigned og = xb_add(&bar[XB_TOP], 1u);
            const unsigned tg = og / nx;
            if (og + 1u == (tg + 1u) * nx) xb_add(&bar[XB_TOPGEN], 1u);
            else XB_SPIN(xb_ld(&bar[XB_TOPGEN]) == tg, bar);
            __builtin_amdgcn_fence(__ATOMIC_ACQUIRE, "agent");
            xb_add(&bar[XB_XGEN(b.x)], 1u);
            asm volatile("s_waitcnt vmcnt(0)" ::: "memory");
        } else {
            XB_SPIN(xb_ld(&bar[XB_XGEN(b.x)]) == gen, bar);
            __builtin_amdgcn_fence(__ATOMIC_ACQUIRE, "agent");
            asm volatile("s_waitcnt vmcnt(0)" ::: "memory");
        }
    }
    __syncthreads();
}

constexpr int RING_BYTES = 131072, LDSCTL_OFF = RING_BYTES, MISC_OFF = LDSCTL_OFF + 320, LDS_BYTES = 147456;
constexpr int NWAVES = 8;

struct Args { const float* in[15]; float* out; unsigned char* ws; int ph_lo, ph_hi; };

__device__ __forceinline__ int win_srccol(int j) {
    const int t = j >> 8;
    if (t >= 6) return j;
    const int jj = j & 255, half = jj >> 7, p = jj & 127, d = 4 * (p >> 3) + (p & 3) + 64 * ((p >> 2) & 1);
    return half * MIXW + t * 128 + d;
}
__device__ __forceinline__ int wfi_srccol(int j) { const int t = j >> 8, jj = j & 255; return (jj < 128 ? 0 : DFF) + t * 128 + (jj & 127); }
__device__ __forceinline__ void transpose_item(const float* W, int K, int N, bf16_t* WT, int ndst, int kind, const float* kscale, int nscale, LAS float* scr, int item, int lane) {
    const int nblk = ndst / 32, kb = item / nblk, nb = item % nblk, k0 = 64 * kb, n0 = 32 * nb;
    const int jd = n0 + (lane & 31);
    const int sc = kind == 0 ? win_srccol(jd) : (kind == 2 ? wfi_srccol(jd) : jd);
#pragma unroll 8
    for (int i = 0; i < 32; ++i) { const int kk = 2 * i + (lane >> 5); float w = W[(size_t)(k0 + kk) * N + sc]; if (kscale && (k0 + kk) < nscale) w *= kscale[k0 + kk]; scr[kk * 33 + (lane & 31)] = w; }
    asm volatile("s_waitcnt lgkmcnt(0)" ::: "memory");
    const int c = lane & 7;
#pragma unroll
    for (int j = 0; j < 4; ++j) { const int n = (lane >> 3) + 8 * j; const LAS float* s = scr + (8 * c) * 33 + n;
        u32x4 o; o.x = pk2(s[0 * 33], s[1 * 33]); o.y = pk2(s[2 * 33], s[3 * 33]); o.z = pk2(s[4 * 33], s[5 * 33]); o.w = pk2(s[6 * 33], s[7 * 33]);
        *(u32x4*)(WT + (size_t)(n0 + n) * K + k0 + 8 * c) = o; }
    asm volatile("s_waitcnt lgkmcnt(0)" ::: "memory");
}

__device__ __forceinline__ void p0_prologue(const Args& a, unsigned char* ws, LAS unsigned char* lds, int gw, int NGW, int wave, int lane) {
    LAS float* scr = (LAS float*)(lds + wave * 16384);
    constexpr int I0 = 16 * (NIN / 32), I1 = 16 * 32, I2 = 16 * (NFI / 32), I3 = (DFF / 64) * 32, I4 = 16 * 16, IL = I0 + I1 + I2 + I3 + I4;
    for (int it = gw; it < DEPTH * IL; it += NGW) {
        const int l = it / IL; int r = it % IL;
        if (r < I0) { transpose_item(a.in[4] + (size_t)l * D * NIN, D, NIN, (bf16_t*)(ws + WS_WIN) + (size_t)l * NIN * D, NIN, 0, a.in[3] + l * D, D, scr, r, lane); continue; } r -= I0;
        if (r < I1) { const float* onw = (l & 1) ? a.in[10] + (l >> 1) * MIXW : a.in[9] + (l >> 1) * MIXW;
                      transpose_item(a.in[5] + (size_t)l * D * D, D, D, (bf16_t*)(ws + WS_WOUT) + (size_t)l * D * D, D, 1, onw, MIXW, scr, r, lane); continue; } r -= I1;
        if (r < I2) { transpose_item(a.in[12] + (size_t)l * D * NFI, D, NFI, (bf16_t*)(ws + WS_WFI) + (size_t)l * NFI * D, NFI, 2, a.in[11] + l * D, D, scr, r, lane); continue; } r -= I2;
        if (r < I3) { transpose_item(a.in[13] + (size_t)l * DFF * D, DFF, D, (bf16_t*)(ws + WS_WFO) + (size_t)l * D * DFF, D, 3, nullptr, 0, scr, r, lane); continue; } r -= I3;
        transpose_item(a.in[7] + (size_t)l * D * 512, D, 512, (bf16_t*)(ws + WS_WM) + (size_t)l * 512 * D, 512, 4, a.in[6] + l * D, D, scr, r, lane);
    }
    for (int m = gw; m < M; m += NGW) {
        const f32x4* xr = (const f32x4*)(a.in[0] + (size_t)m * D) + lane; f32x4 v[4]; float s = 0.f;
#pragma unroll
        for (int j = 0; j < 4; ++j) { v[j] = xr[64 * j]; s += (v[j].x * v[j].x + v[j].y * v[j].y) + (v[j].z * v[j].z + v[j].w * v[j].w); }
        s = wave_sum(s);
        u32x2* o8 = (u32x2*)((bf16_t*)(ws + WS_XB) + (size_t)m * D) + lane;
#pragma unroll
        for (int j = 0; j < 4; ++j) { u32x2 w; w.x = pk2(v[j].x, v[j].y); w.y = pk2(v[j].z, v[j].w); o8[64 * j] = w; }
        if (lane < 16) ((float*)(ws + WS_SSQA))[(size_t)m * 16 + lane] = lane == 0 ? s : 0.f;
    }
    for (int m = gw; m < MROWS; m += NGW) {
        const f32x4* xr = (const f32x4*)(a.in[1] + (size_t)m * D) + lane; f32x4 v[4]; float s = 0.f;
#pragma unroll
        for (int j = 0; j < 4; ++j) { v[j] = xr[64 * j]; s += (v[j].x * v[j].x + v[j].y * v[j].y) + (v[j].z * v[j].z + v[j].w * v[j].w); }
        const float rs = rsqrtf(wave_sum(s) * (1.0f / D) + EPS);
        u32x2* o8 = (u32x2*)((bf16_t*)(ws + WS_MEMB) + (size_t)m * D) + lane;
#pragma unroll
        for (int j = 0; j < 4; ++j) { u32x2 w; w.x = pk2(v[j].x * rs, v[j].y * rs); w.y = pk2(v[j].z * rs, v[j].w * rs); o8[64 * j] = w; }
    }
    for (int m = gw; m < M; m += NGW) {
        const double pos = (double)((const int*)a.in[2])[m];
        const double invf = exp(-9.210340371976184 * ((double)lane / 63.0));
        const double ang = pos * invf;
        ((float*)(ws + WS_COS))[(size_t)m * 64 + lane] = (float)cos(ang);
        ((float*)(ws + WS_SIN))[(size_t)m * 64 + lane] = (float)sin(ang);
    }
    for (int c = gw * 64 + lane; c < MIXW; c += NGW * 64) {
        const float l0 = a.in[8][c], l1 = a.in[8][MIXW + c]; const float mx = fmaxf(l0, l1), e0 = expf(l0 - mx), e1 = expf(l1 - mx);
        ((float*)(ws + WS_LB))[c] = 0.f; ((float*)(ws + WS_LB))[MIXW + c] = e1 / (e0 + e1);
    }
}

__device__ __forceinline__ void scan_unit(unsigned char* ws, LAS unsigned char* lds, int unit, int is_ret, int tid) {
    constexpr int TB = 32;
    bf16_t* Z = (bf16_t*)(ws + WS_Z); const float* F = (const float*)(ws + WS_F);
    const int b = unit / NH, h = unit % NH, vcol = tid >> 2, kp = tid & 3;
    LAS float* qL = (LAS float*)lds;
    LAS float* fL = qL + TB * 144;
    LAS float* kL = fL + TB * 144;
    LAS float* vL = kL + TB * 144;
    LAS float* oL = vL + TB * 128;
    const float gamma = 1.0f - exp2f(-5.0f - (float)h);
    float S[32];
#pragma unroll
    for (int i = 0; i < 32; ++i) S[i] = 0.f;
    for (int c0 = 0; c0 < SEQ; c0 += TB) {
        __syncthreads();
        for (int idx = tid; idx < TB * 128; idx += 512) {
            const int tt = idx >> 7, kk = idx & 127; const size_t tok = (size_t)b * SEQ + c0 + tt;
            const float qv = bf2f(Z[tok * NIN + h * 256 + kk]);
            float fv, kv;
            if (is_ret) { fv = gamma; kv = bf2f(Z[tok * NIN + h * 256 + 128 + kk]); }
            else { fv = F[tok * MIXW + h * 128 + kk]; kv = 1.0f - fv; }
            const float vv = bf2f(Z[tok * NIN + 1536 + h * 128 + kk]);
            const int slot = tt * 144 + (kk >> 5) * 36 + (kk & 31);
            qL[slot] = qv; fL[slot] = fv; kL[slot] = kv; vL[tt * 128 + kk] = vv;
        }
        __syncthreads();
        for (int tt = 0; tt < TB; ++tt) {
            const float vv = vL[tt * 128 + vcol]; float o = 0.f;
            const LAS f32x4* f4 = (const LAS f32x4*)(fL + tt * 144 + kp * 36);
            const LAS f32x4* k4 = (const LAS f32x4*)(kL + tt * 144 + kp * 36);
            const LAS f32x4* q4 = (const LAS f32x4*)(qL + tt * 144 + kp * 36);
#pragma unroll
            for (int i4 = 0; i4 < 8; ++i4) { const f32x4 ff = f4[i4], kk = k4[i4], qq = q4[i4];
#pragma unroll
                for (int j = 0; j < 4; ++j) { S[4 * i4 + j] = S[4 * i4 + j] * ff[j] + kk[j] * vv; o += qq[j] * S[4 * i4 + j]; } }
            o += __shfl_xor(o, 1); o += __shfl_xor(o, 2);
            if (kp == 0) oL[tt * 128 + vcol] = o;
        }
        __syncthreads();
        for (int idx = tid; idx < TB * 128; idx += 512) { const int tt = idx >> 7, kk = idx & 127; const size_t tok = (size_t)b * SEQ + c0 + tt;
            Z[tok * NIN + h * 256 + kk] = (bf16_t)f2bf(oL[idx]); }
    }
}

typedef float f32x16 __attribute__((ext_vector_type(16)));
constexpr int SC_QS = 0, SC_KT = 8448, SC_VT = 18688, SC_P = 28928, SC_AUX = 31488, SC_OUT = 32512, SC_SSQ = 40960, SC_BUF = 41472;
constexpr int NCHUNK = SEQ / 32;
struct HRegs { u32x4 qs[2], ka[2], va[2], gate[2]; float aux; };
struct SRegs { u32x4 kf[8], qf[8]; };
__device__ __forceinline__ bf16x8 as_bf16x8(u32x4 v) { return __builtin_bit_cast(bf16x8, v); }

template <int IS_RET>
__device__ __forceinline__ void helper_load(HRegs& R, const bf16_t* Z, const bf16_t* KST, const float* AUXG, int b, int h, int unit, int ht, int hw, int lane, int chunk_stage, int chunk_gate) {
    asm volatile("" : "+v"(ht));
    if (chunk_stage < NCHUNK) {
        const size_t tok0 = (size_t)b * SEQ + chunk_stage * 32;
#pragma unroll
        for (int i = 0; i < 2; ++i) { const int p = ht + 256 * i, c = p >> 4, j16 = p & 15; R.qs[i] = *(const u32x4*)(Z + (tok0 + c) * NIN + h * 256 + 8 * j16); }
        const int cpair = ht & 15, koct = ht >> 4;
#pragma unroll
        for (int i = 0; i < 2; ++i) { const size_t tk = tok0 + 2 * cpair + i;
            R.ka[i] = IS_RET ? *(const u32x4*)(Z + tk * NIN + h * 256 + 128 + 8 * koct) : *(const u32x4*)(KST + tk * MIXW + h * 128 + 8 * koct);
            R.va[i] = *(const u32x4*)(Z + tk * NIN + 1536 + h * 128 + 8 * koct); }
        if (!IS_RET) R.aux = AUXG[((size_t)unit * 64 + chunk_stage) * 256 + ht];
    }
    if (chunk_gate >= 0) { const size_t tok0 = (size_t)b * SEQ + chunk_gate * 32;
#pragma unroll
        for (int i = 0; i < 2; ++i) { const int p = ht + 256 * i, c = p >> 4, v0 = 8 * (p & 15); R.gate[i] = *(const u32x4*)(Z + (tok0 + c) * NIN + 2304 + h * 128 + v0); } }
}
template <int IS_RET>
__device__ __forceinline__ void helper_stage(const HRegs& R, LAS unsigned char* buf, int ht, int hw, int lane) {
    asm volatile("" : "+v"(ht));
#pragma unroll
    for (int i = 0; i < 2; ++i) { const int p = ht + 256 * i, c = p >> 4, j16 = p & 15; LAS unsigned char* dst = buf + SC_QS + c * 264 + 16 * j16;
        *(LAS u32x2*)dst = (u32x2){R.qs[i].x, R.qs[i].y}; *(LAS u32x2*)(dst + 8) = (u32x2){R.qs[i].z, R.qs[i].w}; }
    const int cpair = ht & 15, koct = ht >> 4;
#pragma unroll
    for (int j = 0; j < 8; ++j) { const int sh = 16 * (j & 1);
        const unsigned wk = ((R.ka[0][j >> 1] >> sh) & 0xffffu) | (((R.ka[1][j >> 1] >> sh) & 0xffffu) << 16);
        const unsigned wv = ((R.va[0][j >> 1] >> sh) & 0xffffu) | (((R.va[1][j >> 1] >> sh) & 0xffffu) << 16);
        *(LAS unsigned*)(buf + SC_KT + (8 * koct + j) * 80 + 4 * cpair) = wk;
        *(LAS unsigned*)(buf + SC_VT + (8 * koct + j) * 80 + 4 * cpair) = wv; }
    if (!IS_RET) *(LAS float*)(buf + SC_AUX + ht * 4) = R.aux;
}
__device__ __forceinline__ void scores_load(SRegs& R, const bf16_t* Z, int b, int h, int lane, int chunk) {
    if (chunk >= NCHUNK) return;
    asm volatile("" : "+v"(lane));
    const int l31 = lane & 31, hh = lane >> 5; const bf16_t* zr = Z + ((size_t)b * SEQ + chunk * 32 + l31) * NIN + h * 256 + 8 * hh;
#pragma unroll
    for (int kk = 0; kk < 8; ++kk) { R.kf[kk] = *(const u32x4*)(zr + 128 + 16 * kk); R.qf[kk] = *(const u32x4*)(zr + 16 * kk); }
}
__device__ __forceinline__ void scores_stage(const SRegs& R, LAS unsigned char* buf, int lane) {
    asm volatile("" : "+v"(lane));
    const int l31 = lane & 31, hh = lane >> 5;
    f32x16 d;
#pragma unroll
    for (int r = 0; r < 16; ++r) d[r] = 0.f;
#pragma unroll
    for (int kk = 0; kk < 8; ++kk) d = __builtin_amdgcn_mfma_f32_32x32x16_bf16(as_bf16x8(R.kf[kk]), as_bf16x8(R.qf[kk]), d, 0, 0, 0);
#pragma unroll
    for (int q = 0; q < 4; ++q) { float v4[4];
#pragma unroll
        for (int i = 0; i < 4; ++i) { const int srow = 8 * q + 4 * hh + i; v4[i] = (srow <= l31) ? d[4 * q + i] : 0.f; }
        u32x2 w; w.x = pg8::cvt_pk_bf16(v4[0], v4[1]); w.y = pg8::cvt_pk_bf16(v4[2], v4[3]);
        *(LAS u32x2*)(buf + SC_P + l31 * 80 + (8 * q + 4 * hh) * 2) = w; }
}
template <int IS_RET>
__device__ __forceinline__ void helper_finalize(const HRegs& R, LAS unsigned char* buf, bf16_t* CAT, float* SSQO, int b, int h, int ht, int chunk) {
    asm volatile("" : "+v"(ht));
    const size_t tok0 = (size_t)b * SEQ + chunk * 32;
#pragma unroll
    for (int i = 0; i < 2; ++i) { const int p = ht + 256 * i, c = p >> 4, v0 = 8 * (p & 15);
        const u32x2 lo = *(const LAS u32x2*)(buf + SC_OUT + c * 264 + v0 * 2), hi = *(const LAS u32x2*)(buf + SC_OUT + c * 264 + v0 * 2 + 8);
        const LAS float* sq = (const LAS float*)(buf + SC_SSQ);
        const float ssum = (sq[c] + sq[32 + c]) + (sq[64 + c] + sq[96 + c]);
        const float sc = IS_RET ? rsqrtf(ssum * (1.0f / HD) + EPS) : 1.0f;
        const unsigned ow[4] = {lo.x, lo.y, hi.x, hi.y}; u32x4 out;
#pragma unroll
        for (int j = 0; j < 4; ++j) out[j] = pk2(bf2f(ow[j] & 0xffffu) * sc * bf2f(R.gate[i][j] & 0xffffu), bf2f(ow[j] >> 16) * sc * bf2f(R.gate[i][j] >> 16));
        *(u32x4*)(CAT + (tok0 + c) * D + h * 128 + v0) = out;
        if (!IS_RET && (p & 15) == 0) SSQO[(tok0 + c) * 8 + h] = ssum; }
}
template <int IS_RET>
__device__ __forceinline__ void mfma_step(f32x16 (&S)[4], LAS unsigned char* buf, int w, int lane, float g32) {
    asm volatile("" : "+v"(lane));
    const int l31 = lane & 31, hh = lane >> 5, vs = 32 * w;
    bf16x8 sf[4][2];
#pragma unroll
    for (int kt = 0; kt < 4; ++kt) { f32x16 t = S[kt];
        if (!IS_RET) {
#pragma unroll
            for (int q = 0; q < 4; ++q) { const f32x4 e = *(const LAS f32x4*)(buf + SC_AUX + (32 * kt + 8 * q + 4 * hh) * 4);
#pragma unroll
                for (int i = 0; i < 4; ++i) t[4 * q + i] *= e[i]; } }
#pragma unroll
        for (int s2 = 0; s2 < 2; ++s2) { u32x4 pk;
#pragma unroll
            for (int j = 0; j < 4; ++j) pk[j] = pg8::cvt_pk_bf16(t[8 * s2 + 2 * j], t[8 * s2 + 2 * j + 1]);
            sf[kt][s2] = as_bf16x8(pk); } }
    f32x16 o;
#pragma unroll
    for (int r = 0; r < 16; ++r) o[r] = 0.f;
#pragma unroll
    for (int kt = 0; kt < 4; ++kt)
#pragma unroll
        for (int s2 = 0; s2 < 2; ++s2) { const LAS unsigned char* ad = buf + SC_QS + l31 * 264 + (32 * kt + 16 * s2 + 4 * hh) * 2;
            const u32x2 lo = *(const LAS u32x2*)ad, hi = *(const LAS u32x2*)(ad + 16);
            o = __builtin_amdgcn_mfma_f32_32x32x16_bf16(sf[kt][s2], as_bf16x8((u32x4){lo.x, lo.y, hi.x, hi.y}), o, 0, 0, 0); }
    bf16x8 vt[2];
#pragma unroll
    for (int kk = 0; kk < 2; ++kk) { vt[kk] = *(const LAS bf16x8*)(buf + SC_VT + (vs + l31) * 80 + 32 * kk + 16 * hh);
        const bf16x8 pf = *(const LAS bf16x8*)(buf + SC_P + l31 * 80 + 32 * kk + 16 * hh);
        o = __builtin_amdgcn_mfma_f32_32x32x16_bf16(vt[kk], pf, o, 0, 0, 0); }
#pragma unroll
    for (int kt = 0; kt < 4; ++kt) {
        if (!IS_RET) {
#pragma unroll
            for (int q = 0; q < 4; ++q) { const f32x4 e = *(const LAS f32x4*)(buf + SC_AUX + 512 + (32 * kt + 8 * q + 4 * hh) * 4);
#pragma unroll
                for (int i = 0; i < 4; ++i) S[kt][4 * q + i] *= e[i]; } }
#pragma unroll
        for (int kk = 0; kk < 2; ++kk) { const bf16x8 kf = *(const LAS bf16x8*)(buf + SC_KT + (32 * kt + l31) * 80 + 32 * kk + 16 * hh);
            S[kt] = __builtin_amdgcn_mfma_f32_32x32x16_bf16(kf, vt[kk], S[kt], 0, 0, 0); }
        if (IS_RET) S[kt] = S[kt] * g32;
    }
    float ss = 0.f;
#pragma unroll
    for (int r = 0; r < 16; ++r) ss += o[r] * o[r];
    ss += __shfl_xor(ss, 32);
    if (hh == 0) *(LAS float*)(buf + SC_SSQ + (w * 32 + l31) * 4) = ss;
#pragma unroll
    for (int q = 0; q < 4; ++q) { u32x2 wv; wv.x = pg8::cvt_pk_bf16(o[4 * q], o[4 * q + 1]); wv.y = pg8::cvt_pk_bf16(o[4 * q + 2], o[4 * q + 3]);
        *(LAS u32x2*)(buf + SC_OUT + l31 * 264 + (vs + 8 * q + 4 * hh) * 2) = wv; }
}
template <int IS_RET>
__device__ __forceinline__ void scan2_unit(unsigned char* ws, LAS unsigned char* lds, int unit, int tid) {
    const bf16_t* Z = (const bf16_t*)(ws + WS_Z); const bf16_t* KST = (const bf16_t*)(ws + WS_KST); const float* AUXG = (const float*)(ws + WS_AUX);
    bf16_t* CAT = (bf16_t*)(ws + WS_CAT); float* SSQO = (float*)(ws + WS_SSQO);
    const int b = unit / NH, h = unit % NH, wave = __builtin_amdgcn_readfirstlane(tid >> 6), lane = tid & 63;
    const int ht = tid - 256, hw = wave - 4;
    const float g32 = exp2f(32.0f * __log2f(1.0f - exp2f(-5.0f - (float)h)));
    __syncthreads();
    if (wave < 4) {
        f32x16 S[4];
#pragma unroll
        for (int kt = 0; kt < 4; ++kt)
#pragma unroll
            for (int r = 0; r < 16; ++r) S[kt][r] = 0.f;
        __syncthreads();
        for (int n = 0; n < NCHUNK; ++n) { mfma_step<IS_RET>(S, lds + (n & 1) * SC_BUF, wave, lane, g32); __syncthreads(); }
    } else {
        HRegs RA, RB; SRegs RS;
        helper_load<IS_RET>(RA, Z, KST, AUXG, b, h, unit, ht, hw, lane, 0, -1);
        if (hw == 0) scores_load(RS, Z, b, h, lane, 0);
        if (hw == 1) scores_load(RS, Z, b, h, lane, 1);
        helper_stage<IS_RET>(RA, lds, ht, hw, lane);
        if (hw == 0) { scores_stage(RS, lds, lane); scores_load(RS, Z, b, h, lane, 2); }
        helper_load<IS_RET>(RB, Z, KST, AUXG, b, h, unit, ht, hw, lane, 1, -1);
        __syncthreads();
        for (int n = 0; n < NCHUNK; n += 2) {
            helper_load<IS_RET>(RA, Z, KST, AUXG, b, h, unit, ht, hw, lane, n + 2, n);
            helper_stage<IS_RET>(RB, lds + SC_BUF, ht, hw, lane);
            if (hw == 1) { scores_stage(RS, lds + SC_BUF, lane); scores_load(RS, Z, b, h, lane, n + 3); }
            if (n >= 1) helper_finalize<IS_RET>(RB, lds + SC_BUF, CAT, SSQO, b, h, ht, n - 1);
            __syncthreads();
            helper_load<IS_RET>(RB, Z, KST, AUXG, b, h, unit, ht, hw, lane, n + 3, n + 1);
            if (n + 2 < NCHUNK) { helper_stage<IS_RET>(RA, lds, ht, hw, lane); if (hw == 0) { scores_stage(RS, lds, lane); scores_load(RS, Z, b, h, lane, n + 4); } }
            helper_finalize<IS_RET>(RA, lds, CAT, SSQO, b, h, ht, n);
            __syncthreads();
        }
        helper_finalize<IS_RET>(RB, lds + SC_BUF, CAT, SSQO, b, h, ht, NCHUNK - 1);
    }
}

__device__ __forceinline__ void xattn_unit(unsigned char* ws, LAS unsigned char* lds, int unit, int layer, int tid) {
    const bf16_t* Z = (const bf16_t*)(ws + WS_Z); const bf16_t* MKV = (const bf16_t*)(ws + WS_MKV); bf16_t* CAT = (bf16_t*)(ws + WS_CAT);
    const int b = unit >> 4, hx = (unit >> 2) & 3, tq = unit & 3;
    LAS u32x4* KL = (LAS u32x4*)lds;
    LAS u32x4* VL = KL + 256 * 8;
    __syncthreads();
    for (int c = tid; c < 256 * 8; c += 512) { const int mrow = c >> 3, ch = c & 7; const bf16_t* src = MKV + (size_t)(b * NMEM + mrow) * 2048 + layer * 512 + hx * 64 + ch * 8;
        KL[c] = *(const u32x4*)src; VL[c] = *(const u32x4*)(src + 256); }
    __syncthreads();
    const size_t tok = (size_t)b * SEQ + tq * 512 + tid;
    float q[64], o[64];
    { const u32x4* qp = (const u32x4*)(Z + tok * NIN + 3072 + hx * 64);
#pragma unroll
      for (int c = 0; c < 8; ++c) { const u32x4 w = qp[c];
#pragma unroll
          for (int j = 0; j < 4; ++j) { q[8 * c + 2 * j] = bf2f(w[j] & 0xffffu) * 0.125f; q[8 * c + 2 * j + 1] = bf2f(w[j] >> 16) * 0.125f; } } }
#pragma unroll
    for (int d = 0; d < 64; ++d) o[d] = 0.f;
    float mrun = -1e30f, l = 0.f;
    for (int mm = 0; mm < NMEM; ++mm) {
        float s = 0.f;
#pragma unroll
        for (int c = 0; c < 8; ++c) { const u32x4 w = KL[mm * 8 + c];
#pragma unroll
            for (int j = 0; j < 4; ++j) { s += q[8 * c + 2 * j] * bf2f(w[j] & 0xffffu); s += q[8 * c + 2 * j + 1] * bf2f(w[j] >> 16); } }
        const float mn = fmaxf(mrun, s), alpha = __expf(mrun - mn), p = __expf(s - mn);
        l = l * alpha + p; mrun = mn;
#pragma unroll
        for (int c = 0; c < 8; ++c) { const u32x4 w = VL[mm * 8 + c];
#pragma unroll
            for (int j = 0; j < 4; ++j) { o[8 * c + 2 * j] = o[8 * c + 2 * j] * alpha + p * bf2f(w[j] & 0xffffu); o[8 * c + 2 * j + 1] = o[8 * c + 2 * j + 1] * alpha + p * bf2f(w[j] >> 16); } }
    }
    const float il = 1.0f / l;
    u32x4* op = (u32x4*)(CAT + tok * D + MIXW + hx * 64);
#pragma unroll
    for (int c = 0; c < 8; ++c) { u32x4 w;
#pragma unroll
        for (int j = 0; j < 4; ++j) w[j] = pk2(o[8 * c + 2 * j] * il, o[8 * c + 2 * j + 1] * il);
        op[c] = w; }
}

__device__ __forceinline__ void finish_rows(unsigned char* ws, int is_ret, int gw, int NGW, int lane) {
    const bf16_t* Z = (const bf16_t*)(ws + WS_Z); bf16_t* CAT = (bf16_t*)(ws + WS_CAT);
    for (int row = gw; row < M; row += NGW) {
        float o[3][4], g[3][4]; float ss[3];
#pragma unroll
        for (int j = 0; j < 3; ++j) { const int c = lane * 4 + 256 * j;
            const u32x2 w = *(const u32x2*)(Z + (size_t)row * NIN + (c >> 7) * 256 + (c & 127)), gw2 = *(const u32x2*)(Z + (size_t)row * NIN + 2304 + c);
            o[j][0] = bf2f(w.x & 0xffffu); o[j][1] = bf2f(w.x >> 16); o[j][2] = bf2f(w.y & 0xffffu); o[j][3] = bf2f(w.y >> 16);
            g[j][0] = bf2f(gw2.x & 0xffffu); g[j][1] = bf2f(gw2.x >> 16); g[j][2] = bf2f(gw2.y & 0xffffu); g[j][3] = bf2f(gw2.y >> 16);
            ss[j] = (o[j][0] * o[j][0] + o[j][1] * o[j][1]) + (o[j][2] * o[j][2] + o[j][3] * o[j][3]); }
        float rs[3];
        if (!is_ret) { const float r = rsqrtf(wave_sum(ss[0] + ss[1] + ss[2]) * (1.0f / MIXW) + EPS); rs[0] = rs[1] = rs[2] = r; }
        else {
#pragma unroll
            for (int j = 0; j < 3; ++j) { float s = ss[j];
#pragma unroll
                for (int of = 1; of < 32; of <<= 1) s += __shfl_xor(s, of);
                rs[j] = rsqrtf(s * (1.0f / HD) + EPS); } }
#pragma unroll
        for (int j = 0; j < 3; ++j) { const int c = lane * 4 + 256 * j; u32x2 w; w.x = pk2(o[j][0] * rs[j] * g[j][0], o[j][1] * rs[j] * g[j][1]); w.y = pk2(o[j][2] * rs[j] * g[j][2], o[j][3] * rs[j] * g[j][3]);
            *(u32x2*)(CAT + (size_t)row * D + c) = w; }
    }
}

__device__ __forceinline__ void final_rows(float* out, const float* nf, int gw, int NGW, int lane) {
    const f32x4* wv = (const f32x4*)nf + lane;
    for (int row = gw; row < M; row += NGW) {
        f32x4* xr = (f32x4*)(out + (size_t)row * D) + lane; f32x4 v[4]; float s = 0.f;
#pragma unroll
        for (int j = 0; j < 4; ++j) { v[j] = xr[64 * j]; s += (v[j].x * v[j].x + v[j].y * v[j].y) + (v[j].z * v[j].z + v[j].w * v[j].w); }
        const float rs = rsqrtf(wave_sum(s) * (1.0f / D) + EPS);
#pragma unroll
        for (int j = 0; j < 4; ++j) xr[64 * j] = v[j] * rs * wv[64 * j];
    }
}

constexpr int N_PHASES = 2 + 5 * DEPTH + 1;
__global__ void __launch_bounds__(NWAVES * 64, 2) mega_fwd(Args args) {
    extern __shared__ __attribute__((aligned(16))) unsigned char lds_raw[];
    LAS unsigned char* lds = (LAS unsigned char*)lds_raw;
    volatile LAS unsigned* MISC = (volatile LAS unsigned*)(lds + MISC_OFF);
    const int G = gridDim.x, bx = blockIdx.x;
    const int wave_s = __builtin_amdgcn_readfirstlane(threadIdx.x >> 6);
    unsigned char* ws = args.ws;
    for (int u = threadIdx.x; u < (LDS_BYTES - LDSCTL_OFF) / 4; u += NWAVES * 64) ((LAS unsigned*)(lds + LDSCTL_OFF))[u] = 0u;
    __syncthreads();
    XcdBarrier bar; bar.bar = (unsigned*)(ws + WS_CTL) + CW_BAR; bar.x = 0; bar.st = nullptr;
    if (MK_N_LAUNCHES == 1) bar = xcd_barrier_post((unsigned*)(ws + WS_CTL) + CW_BAR, MISC + 8);
    const int lo = args.ph_lo, hi = args.ph_hi;
#define IN(k) (lo <= (k) && (k) < hi)
#define SEAM(k) do { if (IN(k) && IN((k) + 1)) xcd_barrier(bar, wave_s == 0 && lane_id_volatile() == 0); } while (0)
#define OPAQ() unsigned char* wsp = ws; int Gp = G, bxp = bx, tidp = wave_s * 64 + lane_id_volatile(); asm volatile("" : "+s"(wsp), "+s"(Gp), "+s"(bxp), "+v"(tidp)); \
    const int lanep = tidp & 63, wavep = __builtin_amdgcn_readfirstlane(tidp >> 6), vcup = (Gp % 8 == 0) ? (bxp % 8) * (Gp / 8) + bxp / 8 : bxp, gwp = vcup * NWAVES + wavep, NGWp = Gp * NWAVES; \
    (void)lanep; (void)gwp; (void)NGWp

    if (IN(0) && !(DBG_SKIP & 1)) { OPAQ(); p0_prologue(args, wsp, lds, gwp, NGWp, wavep, lanep); }
    SEAM(0);
    if (IN(1) && !(DBG_SKIP & 16)) { OPAQ();
        pg8::Gemm g{(const bf16_t*)(wsp + WS_MEMB), (const bf16_t*)(wsp + WS_WM), MROWS, 2048, D}; pg8::StaticOrder S; S.init(MROWS, 2048, Gp, bxp);
        EpiPlain E{(bf16_t*)(wsp + WS_MKV), 2048};
        pg8::gemm_phase<EpiPlain, pg8::StaticOrder, true, true>(lds, g, S, E, tidp);
    }
    SEAM(1);
    for (int l = 0; l < DEPTH; ++l) {
        const int pb = 2 + 5 * l, is_ret = l & 1;
        if (IN(pb) && !(DBG_SKIP & 32)) { OPAQ();
            pg8::Gemm g{(const bf16_t*)(wsp + WS_XB), (const bf16_t*)(wsp + WS_WIN) + (size_t)l * NIN * D, M, NIN, D}; pg8::StaticOrder S; S.init(M, NIN, Gp, bxp);
            EpiIn E{(bf16_t*)(wsp + WS_Z), (bf16_t*)(wsp + WS_KST), (float*)(wsp + WS_AUX), (const float*)(wsp + WS_SSQA), (const float*)(wsp + WS_LB) + (l >> 1) * MIXW, (const float*)(wsp + WS_COS), (const float*)(wsp + WS_SIN), is_ret};
            pg8::gemm_phase<EpiIn, pg8::StaticOrder, true, true>(lds, g, S, E, tidp);
        }
        SEAM(pb);
        if (IN(pb + 1)) { OPAQ();
            const int NS = BATCH * NH;
            if (Gp > NS) {
                if (bxp < NS) { if (!(DBG_SKIP & 2)) { if (is_ret) scan2_unit<1>(wsp, lds, bxp, tidp); else scan2_unit<0>(wsp, lds, bxp, tidp); } }
                else for (int u = bxp - NS; u < 128; u += Gp - NS) { if (!(DBG_SKIP & 4)) xattn_unit(wsp, lds, u, l, tidp); }
            } else {
                for (int u = bxp; u < NS; u += Gp) { if (!(DBG_SKIP & 2)) { if (is_ret) scan2_unit<1>(wsp, lds, u, tidp); else scan2_unit<0>(wsp, lds, u, tidp); } }
                for (int u = bxp; u < 128; u += Gp) { if (!(DBG_SKIP & 4)) xattn_unit(wsp, lds, u, l, tidp); }
            }
            __syncthreads();
        }
        SEAM(pb + 1);
        if (IN(pb + 2) && !(DBG_SKIP & 64)) { OPAQ();
            pg8::Gemm g{(const bf16_t*)(wsp + WS_CAT), (const bf16_t*)(wsp + WS_WOUT) + (size_t)l * D * D, M, D, D}; pg8::StaticOrder S; S.init(M, D, Gp, bxp);
            EpiResC E{EpiRes{l == 0 ? args.in[0] : args.out, args.out, (bf16_t*)(wsp + WS_XB), (float*)(wsp + WS_SSQD)}, is_ret ? nullptr : (const float*)(wsp + WS_SSQO)};
            pg8::gemm_phase<EpiResC, pg8::StaticOrder, true, true>(lds, g, S, E, tidp);
        }
        SEAM(pb + 2);
        if (IN(pb + 3) && !(DBG_SKIP & 128)) { OPAQ();
            pg8::Gemm g{(const bf16_t*)(wsp + WS_XB), (const bf16_t*)(wsp + WS_WFI) + (size_t)l * NFI * D, M, NFI, D}; pg8::StaticOrder S; S.init(M, NFI, Gp, bxp);
            EpiFfn E{(bf16_t*)(wsp + WS_ACT), (const float*)(wsp + WS_SSQD)};
            pg8::gemm_phase<EpiFfn, pg8::StaticOrder, true, true>(lds, g, S, E, tidp);
        }
        SEAM(pb + 3);
        if (IN(pb + 4) && !(DBG_SKIP & 256)) { OPAQ();
            pg8::Gemm g{(const bf16_t*)(wsp + WS_ACT), (const bf16_t*)(wsp + WS_WFO) + (size_t)l * D * DFF, M, D, DFF}; pg8::StaticOrder S; S.init(M, D, Gp, bxp);
            EpiRes E{args.out, args.out, (bf16_t*)(wsp + WS_XB), (float*)(wsp + WS_SSQA)};
            pg8::gemm_phase<EpiRes, pg8::StaticOrder, true, true>(lds, g, S, E, tidp);
        }
        SEAM(pb + 4);
    }
    if (IN(N_PHASES - 1)) { OPAQ(); final_rows(args.out, args.in[14], gwp, NGWp, lanep); }
#undef IN
#undef SEAM
#undef OPAQ
}

extern "C" void kernel_launch(void* const* d_in, const int* in_sizes, int n_in, void* d_out, int out_size, void* d_ws, size_t ws_size, hipStream_t stream) {
    static int grid = 0;
    if (grid == 0) {
        if (n_in != 15 || in_sizes[0] != M * D || out_size != M * D || ws_size < WS_END) {
            fprintf(stderr, "kernel_launch: unexpected shapes: n_in %d in0 %d out %d ws %zu (need %zu)\n", n_in, n_in > 0 ? in_sizes[0] : -1, out_size, ws_size, (size_t)WS_END); grid = -1; return; }
        int dev = 0, cus = 0, per_cu = 0;
        if (hipGetDevice(&dev) != hipSuccess || hipDeviceGetAttribute(&cus, hipDeviceAttributeMultiprocessorCount, dev) != hipSuccess) { grid = -1; return; }
        if (hipFuncSetAttribute((const void*)mega_fwd, hipFuncAttributeMaxDynamicSharedMemorySize, LDS_BYTES) != hipSuccess) { fprintf(stderr, "kernel_launch: hipFuncSetAttribute failed\n"); grid = -1; return; }
        if (hipOccupancyMaxActiveBlocksPerMultiprocessor(&per_cu, (const void*)mega_fwd, NWAVES * 64, LDS_BYTES) != hipSuccess || per_cu < 1)
            fprintf(stderr, "kernel_launch: occupancy query reports %d workgroups per CU\n", per_cu);
        (void)hipGetLastError();
        grid = cus;
    }
    if (grid < 0) return;
    if (hipMemsetAsync((char*)d_ws + WS_CTL, 0, CTL_ZERO_BYTES, stream) != hipSuccess) { fprintf(stderr, "kernel_launch: memset failed\n"); return; }
    Args a{};
    for (int i = 0; i < 15; ++i) a.in[i] = (const float*)d_in[i];
    a.out = (float*)d_out; a.ws = (unsigned char*)d_ws;
    if (MK_N_LAUNCHES == 1) {
        a.ph_lo = 0; a.ph_hi = N_PHASES;
        hipLaunchKernelGGL(mega_fwd, dim3(grid), dim3(NWAVES * 64), LDS_BYTES, stream, a);
    } else {
        for (int p = 0; p < N_PHASES; ++p) { a.ph_lo = p; a.ph_hi = p + 1; hipLaunchKernelGGL(mega_fwd, dim3(grid), dim3(NWAVES * 64), LDS_BYTES, stream, a); }
    }
    const hipError_t le = hipPeekAtLastError();
    if (le != hipSuccess) fprintf(stderr, "kernel_launch: launch failed: %s\n", hipGetErrorName(le));
}
```

```cpp
#include <hip/hip_runtime.h>
#include <cstdio>
#include <cstdint>

#ifndef DBG_SKIP
#define DBG_SKIP 0
#endif
#ifndef MK_N_LAUNCHES
#define MK_N_LAUNCHES 1
#endif

#define GAS __attribute__((address_space(1)))
#define LAS __attribute__((address_space(3)))
typedef unsigned short bf16_t;
typedef short bf16x8 __attribute__((ext_vector_type(8)));
typedef float f32x4 __attribute__((ext_vector_type(4)));
typedef float f32x2 __attribute__((ext_vector_type(2)));
typedef unsigned u32x4 __attribute__((ext_vector_type(4)));
typedef unsigned u32x2 __attribute__((ext_vector_type(2)));

constexpr int BATCH = 8, SEQ = 2048, D = 1024, DEPTH = 4;
constexpr int M = BATCH * SEQ;
constexpr int NH = 6, HD = 128, MIXW = 768, XW = 256, NXH = 4, XHD = 64, NMEM = 256;
constexpr int NIN = 3328, DFF = 2816, NFI = 2 * DFF;
constexpr int MROWS = BATCH * NMEM;
constexpr float EPS = 1e-6f;

constexpr size_t MiB = 1u << 20;
constexpr size_t WS_CTL = 0, CTL_ZERO_BYTES = 1 * MiB;
constexpr size_t WS_LB = 1 * MiB;
constexpr size_t WS_SSQA = 2 * MiB;
constexpr size_t WS_SSQD = 3 * MiB;
constexpr size_t WS_COS = 4 * MiB, WS_SIN = 8 * MiB;
constexpr size_t WS_MEMB = 12 * MiB;
constexpr size_t WS_MKV = 16 * MiB;
constexpr size_t WS_WIN = 24 * MiB;
constexpr size_t WS_WOUT = 50 * MiB;
constexpr size_t WS_WFI = 58 * MiB;
constexpr size_t WS_WFO = 102 * MiB;
constexpr size_t WS_WM = 124 * MiB;
constexpr size_t WS_XB = 128 * MiB;
constexpr size_t WS_CAT = 160 * MiB;
constexpr size_t WS_Z = 192 * MiB;
constexpr size_t WS_F = 296 * MiB;
constexpr size_t WS_KST = 296 * MiB;
constexpr size_t WS_AUX = 320 * MiB;
constexpr size_t WS_SSQO = 323 * MiB;
constexpr size_t WS_ACT = 192 * MiB;
constexpr size_t WS_END = 344 * MiB;
static_assert(WS_WIN + (size_t)DEPTH * NIN * D * 2 <= WS_WOUT && WS_WOUT + (size_t)DEPTH * D * D * 2 <= WS_WFI && WS_WFI + (size_t)DEPTH * NFI * D * 2 <= WS_WFO &&
              WS_WFO + (size_t)DEPTH * D * DFF * 2 <= WS_WM && WS_WM + (size_t)2048 * 1024 * 2 <= WS_XB && WS_Z + (size_t)M * NIN * 2 <= WS_F && WS_F + (size_t)M * MIXW * 4 <= WS_END &&
              WS_ACT + (size_t)M * DFF * 2 <= WS_F, "ws map");
constexpr int CW_BAR = 4096;

__device__ __forceinline__ int lane_id_volatile() { int l; asm volatile("v_mbcnt_lo_u32_b32 %0, -1, 0\n\tv_mbcnt_hi_u32_b32 %0, -1, %0" : "=v"(l)); return l; }
namespace pg8 {
constexpr int BM = 256, BK = 64, HALF = 128, HTB = HALF * BK * 2, STAGE_BYTES = 8 * HTB, NXCD = 8, WGM = 8;
__host__ __device__ __forceinline__ int lds_byte(int r, int c) { const int st = (r >> 4) * 2 + (c >> 5), rr = r & 15, cc = c & 31, ob = rr * 64 + cc * 2; return st * 1024 + (ob ^ (((ob >> 9) & 1) << 5)); }
__host__ __device__ __forceinline__ void stage_rc(int b, int& R, int& C) { const int st = b / 1024, sb = b % 1024, swz = sb ^ (((sb >> 9) & 1) << 5); R = (st >> 1) * 16 + swz / 64; C = (st & 1) * 32 + (swz % 64) / 2; }
__host__ __device__ __forceinline__ int perm32(int rho) { const int n = rho >> 4, i = rho & 15; return 8 * (i >> 2) + 4 * n + (i & 3); }
struct Unit { int pm, pn; };
struct Gemm { const bf16_t* A; const bf16_t* Bt; int M, N, K; };
struct StaticOrder {
    int nM, nN, nwg, G, c;
    __host__ __device__ void init(int M_, int N_, int G_, int c_) { nM = M_ / BM; nN = N_ / BM; nwg = nM * nN; G = G_; c = c_; }
    __host__ __device__ bool next(int i, Unit& u) const {
        const long L = (long)i * G + c; if (L >= nwg) return false;
        int wgid = (int)L; { const int q = nwg / NXCD, r = nwg % NXCD, xcd = wgid % NXCD, off = wgid / NXCD; wgid = (xcd < r ? xcd * (q + 1) : r * (q + 1) + (xcd - r) * q) + off; }
        const int nig = WGM * nN, gid = wgid / nig, fm = gid * WGM, gsz = (nM - fm) < WGM ? (nM - fm) : WGM;
        u.pm = fm + ((wgid % nig) % gsz); u.pn = (wgid % nig) / gsz; return true;
    }
    __device__ __forceinline__ void a_ready(const Unit&) const {}
    __device__ __forceinline__ void done(const Unit&) const {}
};
__device__ __forceinline__ unsigned cvt_pk_bf16(float lo, float hi) { unsigned r; asm volatile("v_cvt_pk_bf16_f32 %0, %1, %2" : "=v"(r) : "v"(lo), "v"(hi)); return r; }

template <class Epi, class Sched, bool ALIGN_EPI = false, bool SP2 = false>
__device__ __forceinline__ void gemm_phase(LAS unsigned char* lds, const Gemm g, const Sched& S, const Epi& E, int tid) {
    const int wid = __builtin_amdgcn_readfirstlane(tid >> 6), lane = tid & 63, wr = wid >> 2, wc = wid & 3, fr = lane & 15, fq = lane >> 4;
    const int K = g.K, nt = K / BK;
    unsigned voffA[2], voffB[2];
#pragma unroll
    for (int i = 0; i < 2; ++i) { int R, C; stage_rc(tid * 16 + i * 8192, R, C); const int Rb = Epi::PERM ? ((R & ~31) + perm32(R & 31)) : R;
        voffA[i] = (unsigned)(R * K + C) * 2u; voffB[i] = (unsigned)(Rb * K + C) * 2u; }
    asm volatile("" : "+v"(voffA[0]), "+v"(voffA[1]), "+v"(voffB[0]), "+v"(voffB[1]));
    const size_t kstep = (size_t)(BK * 2);
    const size_t hstep = (size_t)HALF * K * 2;
    const size_t tstep = 2 * hstep;
    const unsigned ldsw = (unsigned)wid * 1024u;
    const int aoff = lds_byte(wr * 64 + fr, fq * 8), boff = lds_byte(wc * 32 + fr, fq * 8);
#define PG8_SA(b, h) (((b) * 2 + (h)) * HTB)
#define PG8_SB(b, h) ((4 + (b) * 2 + (h)) * HTB)
#define PG8_STAGE(bufoff, gbase, voff) do { _Pragma("unroll") for (int _i = 0; _i < 2; ++_i) \
        __builtin_amdgcn_global_load_lds((const unsigned*)((const char*)(gbase) + (voff)[_i]), (LAS unsigned*)(lds + (bufoff) + ldsw + _i * 8192), 16, 0, 0); } while (0)
#define PG8_LDA(dst, b, h) do { _Pragma("unroll") for (int m = 0; m < 4; ++m) _Pragma("unroll") for (int k = 0; k < 2; ++k) dst[m][k] = *(const LAS bf16x8*)(lds + PG8_SA(b, h) + aoff + m * 2048 + k * 1024); } while (0)
#define PG8_LDB(dst, b, h) do { _Pragma("unroll") for (int n = 0; n < 2; ++n) _Pragma("unroll") for (int k = 0; k < 2; ++k) dst[n][k] = *(const LAS bf16x8*)(lds + PG8_SB(b, h) + boff + n * 2048 + k * 1024); } while (0)
#define PG8_MMA(ai, bj, At, Bt) do { __builtin_amdgcn_s_setprio(1); _Pragma("unroll") for (int m = 0; m < 4; ++m) _Pragma("unroll") for (int n = 0; n < 2; ++n) _Pragma("unroll") for (int k = 0; k < 2; ++k) \
        acc[ai][bj][m][n] = __builtin_amdgcn_mfma_f32_16x16x32_bf16(Bt[n][k], At[m][k], acc[ai][bj][m][n], 0, 0, 0); __builtin_amdgcn_s_setprio(0); } while (0)
#define PG8_WAIT_V(n) asm volatile("s_waitcnt vmcnt(" #n ")" ::: "memory")
#define PG8_WAIT_L(n) asm volatile("s_waitcnt lgkmcnt(" #n ")" ::: "memory")
#define PG8_BAR __builtin_amdgcn_s_barrier()
#define PG8_SCHED __builtin_amdgcn_sched_barrier(0)
    Unit cur, nxt; int ui = 0;
    if (!S.next(0, cur)) return;
    f32x4 acc[2][2][4][2];
#pragma unroll
    for (int a = 0; a < 2; ++a)
#pragma unroll
        for (int b = 0; b < 2; ++b)
#pragma unroll
            for (int m = 0; m < 4; ++m)
#pragma unroll
                for (int n = 0; n < 2; ++n) acc[a][b][m][n] = (f32x4){0.f, 0.f, 0.f, 0.f};
    bf16x8 At[4][2], B0[2][2], B1[2][2];
    const char* cA = (const char*)g.A + (size_t)cur.pm * tstep; const char* cB = (const char*)g.Bt + (size_t)cur.pn * tstep;
    S.a_ready(cur);
    if constexpr (SP2) {
        PG8_STAGE(PG8_SB(0, 0), cB, voffB); PG8_STAGE(PG8_SB(0, 1), cB + hstep, voffB); PG8_STAGE(PG8_SA(0, 0), cA, voffA); PG8_STAGE(PG8_SA(0, 1), cA + hstep, voffA);
        if (wr == 1) PG8_BAR;
        PG8_WAIT_V(2); PG8_BAR;
        PG8_STAGE(PG8_SB(1, 0), cB + kstep, voffB); PG8_STAGE(PG8_SA(1, 0), cA + kstep, voffA); PG8_STAGE(PG8_SB(1, 1), cB + hstep + kstep, voffB);
        PG8_WAIT_V(6); PG8_BAR;
    } else {
        PG8_STAGE(PG8_SB(0, 0), cB, voffB); PG8_STAGE(PG8_SA(0, 0), cA, voffA); PG8_STAGE(PG8_SB(0, 1), cB + hstep, voffB); PG8_STAGE(PG8_SA(0, 1), cA + hstep, voffA);
        if (wr == 1) PG8_BAR;
        PG8_WAIT_V(4); PG8_BAR;
        PG8_STAGE(PG8_SB(1, 0), cB + kstep, voffB); PG8_STAGE(PG8_SA(1, 0), cA + kstep, voffA); PG8_STAGE(PG8_SB(1, 1), cB + hstep + kstep, voffB);
        PG8_WAIT_V(6); PG8_BAR;
    }
    for (;;) {
        const bool has_next = S.next(ui + 1, nxt);
        const char* nA = has_next ? (const char*)g.A + (size_t)nxt.pm * tstep : cA; const char* nB = has_next ? (const char*)g.Bt + (size_t)nxt.pn * tstep : cB;
        for (int t = 0; t < nt; t += 2) {
            const bool last = (t == nt - 2);
            const char* a1 = cA + (size_t)(t + 1) * kstep;
            const char* a2 = last ? nA : cA + (size_t)(t + 2) * kstep; const char* b2 = last ? nB : cB + (size_t)(t + 2) * kstep;
            const char* a3 = a2 + kstep; const char* b3 = b2 + kstep;
            if (last && has_next) S.a_ready(nxt);
            if constexpr (Epi::MID_T > 0) { if (t == Epi::MID_T) { const int l2 = lane_id_volatile(); E.mid(acc, cur, wr, wc, l2 & 15, l2 >> 4); } }
            if constexpr (SP2) {
            PG8_LDB(B0, 0, 0); PG8_LDB(B1, 0, 1); PG8_SCHED; PG8_LDA(At, 0, 0); PG8_STAGE(PG8_SA(1, 1), a1 + hstep, voffA);
            PG8_WAIT_V(8); PG8_WAIT_L(0); PG8_BAR; PG8_MMA(0, 0, At, B0); PG8_MMA(0, 1, At, B1); PG8_BAR; PG8_SCHED;
            PG8_LDA(At, 0, 1); PG8_STAGE(PG8_SB(0, 0), b2, voffB); PG8_STAGE(PG8_SB(0, 1), b2 + hstep, voffB); PG8_STAGE(PG8_SA(0, 0), a2, voffA);
            PG8_WAIT_V(8); PG8_WAIT_L(0); PG8_BAR; PG8_MMA(1, 0, At, B0); PG8_MMA(1, 1, At, B1); PG8_BAR; PG8_SCHED;
            PG8_LDB(B0, 1, 0); PG8_LDB(B1, 1, 1); PG8_SCHED; PG8_LDA(At, 1, 0); PG8_STAGE(PG8_SA(0, 1), a2 + hstep, voffA);
            PG8_WAIT_V(8); PG8_WAIT_L(0); PG8_BAR; PG8_MMA(0, 0, At, B0); PG8_MMA(0, 1, At, B1); PG8_BAR; PG8_SCHED;
            PG8_LDA(At, 1, 1); PG8_STAGE(PG8_SB(1, 0), b3, voffB); PG8_STAGE(PG8_SB(1, 1), b3 + hstep, voffB); PG8_STAGE(PG8_SA(1, 0), a3, voffA);
            PG8_WAIT_V(8); PG8_WAIT_L(0); PG8_BAR; PG8_MMA(1, 0, At, B0); PG8_MMA(1, 1, At, B1); PG8_BAR; PG8_SCHED;
            } else {
            PG8_LDB(B0, 0, 0); PG8_SCHED; PG8_LDA(At, 0, 0); PG8_STAGE(PG8_SA(1, 1), a1 + hstep, voffA);
            PG8_WAIT_L(8); PG8_BAR; PG8_WAIT_L(0); PG8_MMA(0, 0, At, B0); PG8_BAR; PG8_SCHED;
            PG8_LDB(B1, 0, 1); PG8_STAGE(PG8_SB(0, 0), b2, voffB);
            PG8_BAR; PG8_WAIT_L(0); PG8_MMA(0, 1, At, B1); PG8_BAR;
            PG8_LDA(At, 0, 1); PG8_STAGE(PG8_SA(0, 0), a2, voffA);
            PG8_BAR; PG8_WAIT_L(0); PG8_MMA(1, 0, At, B0); PG8_BAR; PG8_SCHED;
            PG8_STAGE(PG8_SB(0, 1), b2 + hstep, voffB);
            PG8_WAIT_V(6); PG8_BAR; PG8_MMA(1, 1, At, B1); PG8_BAR;
            PG8_LDB(B0, 1, 0); PG8_SCHED; PG8_LDA(At, 1, 0); PG8_STAGE(PG8_SA(0, 1), a2 + hstep, voffA);
            PG8_WAIT_L(8); PG8_BAR; PG8_WAIT_L(0); PG8_MMA(0, 0, At, B0); PG8_BAR; PG8_SCHED;
            PG8_LDB(B1, 1, 1); PG8_STAGE(PG8_SB(1, 0), b3, voffB);
            PG8_BAR; PG8_WAIT_L(0); PG8_MMA(0, 1, At, B1); PG8_BAR;
            PG8_LDA(At, 1, 1); PG8_STAGE(PG8_SA(1, 0), a3, voffA);
            PG8_BAR; PG8_WAIT_L(0); PG8_MMA(1, 0, At, B0); PG8_BAR; PG8_SCHED;
            PG8_STAGE(PG8_SB(1, 1), b3 + hstep, voffB);
            PG8_WAIT_V(6); PG8_BAR; PG8_MMA(1, 1, At, B1); PG8_BAR;
            }
        }
        if constexpr (ALIGN_EPI) { if (wr == 0) PG8_BAR; }
        { const int l2 = lane_id_volatile(); E(acc, cur, wr, wc, l2 & 15, l2 >> 4); }
        if (!has_next) break;
#pragma unroll
        for (int a = 0; a < 2; ++a)
#pragma unroll
            for (int b = 0; b < 2; ++b)
#pragma unroll
                for (int m = 0; m < 4; ++m)
#pragma unroll
                    for (int n = 0; n < 2; ++n) acc[a][b][m][n] = (f32x4){0.f, 0.f, 0.f, 0.f};
        cur = nxt; cA = nA; cB = nB; ++ui;
        if constexpr (ALIGN_EPI) { if (wr == 1) PG8_BAR; }
    }
    PG8_WAIT_V(0);
    if constexpr (!ALIGN_EPI) { if (wr == 0) PG8_BAR; }
    PG8_BAR;
#undef PG8_SA
#undef PG8_SB
#undef PG8_STAGE
#undef PG8_LDA
#undef PG8_LDB
#undef PG8_MMA
#undef PG8_WAIT_V
#undef PG8_WAIT_L
#undef PG8_BAR
#undef PG8_SCHED
}
}

__device__ __forceinline__ float bf2f(unsigned h) { return __uint_as_float(h << 16); }
__device__ __forceinline__ unsigned f2bf(float f) { unsigned u = __float_as_uint(f); return (u + 0x7fffu + ((u >> 16) & 1u)) >> 16; }
__device__ __forceinline__ unsigned pk2(float lo, float hi) { return f2bf(lo) | (f2bf(hi) << 16); }
__device__ __forceinline__ float fast_rcp(float x) { return __builtin_amdgcn_rcpf(x); }
__device__ __forceinline__ float sigmoidf_(float x) { return fast_rcp(1.0f + __expf(-x)); }
__device__ __forceinline__ float siluf_(float x) { return x * sigmoidf_(x); }
__device__ __forceinline__ float shfl_xor_l(float v, int lane, int mask) { return __int_as_float(__builtin_amdgcn_ds_bpermute((lane ^ mask) << 2, __float_as_int(v))); }
__device__ __forceinline__ float wave_sum(float v, int lane) {
#pragma unroll
    for (int o = 1; o < 64; o <<= 1) v += shfl_xor_l(v, lane, o);
    return v;
}
__device__ __forceinline__ float rstd_from_partials(const float* ssq, int row, float invn) {
    const f32x4* p = (const f32x4*)(ssq + (size_t)row * 16);
    const f32x4 a = p[0], b = p[1], c = p[2], d = p[3];
    const f32x4 s = (a + b) + (c + d);
    return rsqrtf(((s[0] + s[1]) + (s[2] + s[3])) * invn + EPS);
}
__device__ __forceinline__ u32x4 pack8(const f32x4 v0, const f32x4 v1) {
    u32x4 w; w.x = pg8::cvt_pk_bf16(v0[0], v0[1]); w.y = pg8::cvt_pk_bf16(v0[2], v0[3]); w.z = pg8::cvt_pk_bf16(v1[0], v1[1]); w.w = pg8::cvt_pk_bf16(v1[2], v1[3]); return w;
}

#define DPP_SHR(x, n) __int_as_float(__builtin_amdgcn_update_dpp(0, __float_as_int(x), 0x110 + (n), 0xf, 0xf, false))
__device__ __forceinline__ float rowscan16(float x) {
    x += DPP_SHR(x, 1); x += DPP_SHR(x, 2); x += DPP_SHR(x, 4); x += DPP_SHR(x, 8); return x;
}
__device__ __forceinline__ float bcast15(float x, int lane) { return __int_as_float(__builtin_amdgcn_ds_bpermute((lane | 15) << 2, __float_as_int(x))); }
__device__ __forceinline__ float expc(float x) { return __expf(fminf(x, 80.0f)); }
using pg8::Unit;
struct EpiPlain {
    static constexpr bool PERM = true; static constexpr int MID_T = 0;
    bf16_t* O; int ldc;
    __device__ __forceinline__ void operator()(const f32x4 (&acc)[2][2][4][2], const Unit& u, int wr, int wc, int fr, int fq) const {
        const int row0 = u.pm * 256 + wr * 64 + fr, col0 = u.pn * 256 + wc * 32 + 8 * fq;
#pragma unroll
        for (int ai = 0; ai < 2; ++ai)
#pragma unroll
            for (int m = 0; m < 4; ++m) { bf16_t* rowp = O + (size_t)(row0 + ai * 128 + m * 16) * ldc + col0;
#pragma unroll
                for (int bj = 0; bj < 2; ++bj) *(u32x4*)(rowp + bj * 128) = pack8(acc[ai][bj][m][0], acc[ai][bj][m][1]); }
    }
};
struct EpiIn {
    static constexpr bool PERM = true; static constexpr int MID_T = 0;
    bf16_t* Z; bf16_t* KST; float* AUX; const float* ssq; const float* lb; const float* cosT; const float* sinT; int is_ret;
    __device__ __forceinline__ void operator()(const f32x4 (&acc)[2][2][4][2], const Unit& u, int wr, int wc, int fr, int fq) const {
        const int row0 = u.pm * 256 + wr * 64 + fr, jl = wc * 32 + 8 * fq, t = u.pn;
        if (t < 6) {
            if (!is_ret) {
                const f32x4 lb0 = *(const f32x4*)(lb + t * 128 + (jl >> 1)), lb1 = *(const f32x4*)(lb + t * 128 + (jl >> 1) + 64);
#pragma unroll
                for (int ai = 0; ai < 2; ++ai)
#pragma unroll
                    for (int mp = 0; mp < 2; ++mp) {
                        const int tok0 = u.pm * 256 + ai * 128 + wr * 64 + mp * 32, rlo = tok0 + fr, rhi = rlo + 16;
                        const float rs0 = rstd_from_partials(ssq, rlo, 1.0f / D), rs1 = rstd_from_partials(ssq, rhi, 1.0f / D);
                        f32x4 qsv[2][2], ksv[2][2], ktv[2][2], erv[2], dcv[2];
#pragma unroll
                        for (int n = 0; n < 2; ++n)
#pragma unroll
                            for (int i = 0; i < 4; ++i) {
                                const float lbv = n ? lb1[i] : lb0[i];
                                float g[2], kk[2], qq[2];
#pragma unroll
                                for (int e = 0; e < 2; ++e) {
                                    const float x = acc[ai][1][2 * mp + e][n][i] * (e ? rs1 : rs0), za = acc[ai][0][2 * mp + e][n][i] * (e ? rs1 : rs0);
                                    const float a = __expf(-fabsf(x)), r = fast_rcp(1.0f + a);
                                    const float sneg = x >= 0.f ? a * r : r;
                                    const float em = x >= 0.f ? a : fminf(fast_rcp(a), 1.0686475e13f);
                                    g[e] = (fminf(x, 0.f) - __logf(1.0f + a)) + __logf(1.0f + lbv * em);
                                    kk[e] = (1.0f - lbv) * sneg;
                                    qq[e] = siluf_(za);
                                }
                                const float blo = rowscan16(g[0]), ref = bcast15(blo, fq * 16 + fr), bhi = ref + rowscan16(g[1]), blast = bcast15(bhi, fq * 16 + fr);
                                qsv[0][n][i] = qq[0] * expc(blo - ref); qsv[1][n][i] = qq[1] * expc(bhi - ref);
                                ksv[0][n][i] = kk[0] * expc(ref - blo); ksv[1][n][i] = kk[1] * expc(ref - bhi);
                                ktv[0][n][i] = kk[0] * __expf(blast - blo); ktv[1][n][i] = kk[1] * __expf(blast - bhi);
                                erv[n][i] = __expf(ref); dcv[n][i] = __expf(blast);
                            }
                        bf16_t* zlo = Z + (size_t)rlo * NIN + t * 256 + jl; bf16_t* zhi = Z + (size_t)rhi * NIN + t * 256 + jl;
                        *(u32x4*)zlo = pack8(qsv[0][0], qsv[0][1]); *(u32x4*)(zlo + 128) = pack8(ksv[0][0], ksv[0][1]);
                        *(u32x4*)zhi = pack8(qsv[1][0], qsv[1][1]); *(u32x4*)(zhi + 128) = pack8(ksv[1][0], ksv[1][1]);
                        *(u32x4*)(KST + (size_t)rlo * MIXW + t * 128 + jl) = pack8(ktv[0][0], ktv[0][1]);
                        *(u32x4*)(KST + (size_t)rhi * MIXW + t * 128 + jl) = pack8(ktv[1][0], ktv[1][1]);
                        if (fr == 15) { float* ap = AUX + ((size_t)((tok0 >> 11) * NH + t) * 64 + ((tok0 & 2047) >> 5)) * 256 + jl;
                            *(f32x4*)ap = erv[0]; *(f32x4*)(ap + 4) = erv[1]; *(f32x4*)(ap + 128) = dcv[0]; *(f32x4*)(ap + 132) = dcv[1]; }
                    }
            } else {
                const float lg = __log2f(1.0f - exp2f(-5.0f - (float)t));
#pragma unroll
                for (int ai = 0; ai < 2; ++ai)
#pragma unroll
                    for (int m = 0; m < 4; ++m) { const int row = row0 + ai * 128 + m * 16; const float rs = rstd_from_partials(ssq, row, 1.0f / D);
                        const f32x4 cs = *(const f32x4*)(cosT + (size_t)row * 64 + (jl >> 1)), sn = *(const f32x4*)(sinT + (size_t)row * 64 + (jl >> 1));
                        const float cp1 = (float)(16 * (m & 1) + fr + 1), pw = exp2f(cp1 * lg), ipw = exp2f(-cp1 * lg);
                        const float qsc = rs * pw, ksc = rs * 0.08838834764831845f * ipw;
                        f32x4 q0, q1, k0, k1;
#pragma unroll
                        for (int i = 0; i < 4; ++i) {
                            const float a1 = acc[ai][0][m][0][i] * qsc, a2 = acc[ai][0][m][1][i] * qsc; q0[i] = a1 * cs[i] - a2 * sn[i]; q1[i] = a1 * sn[i] + a2 * cs[i];
                            const float b1 = acc[ai][1][m][0][i] * ksc, b2 = acc[ai][1][m][1][i] * ksc; k0[i] = b1 * cs[i] - b2 * sn[i]; k1[i] = b1 * sn[i] + b2 * cs[i];
                        }
                        bf16_t* zp = Z + (size_t)row * NIN + t * 256 + jl; *(u32x4*)zp = pack8(q0, q1); *(u32x4*)(zp + 128) = pack8(k0, k1); }
            }
        } else {
            const int mode = (t >= 9 && t < 12) ? (is_ret ? 2 : 1) : 0;
#pragma unroll
            for (int ai = 0; ai < 2; ++ai)
#pragma unroll
                for (int m = 0; m < 4; ++m) { const int row = row0 + ai * 128 + m * 16; const float rs = rstd_from_partials(ssq, row, 1.0f / D);
                    bf16_t* zp = Z + (size_t)row * NIN + t * 256 + jl;
#pragma unroll
                    for (int bj = 0; bj < 2; ++bj) { f32x4 v0 = acc[ai][bj][m][0] * rs, v1 = acc[ai][bj][m][1] * rs;
                        if (mode == 1) {
#pragma unroll
                            for (int i = 0; i < 4; ++i) { v0[i] = sigmoidf_(v0[i]); v1[i] = sigmoidf_(v1[i]); } }
                        else if (mode == 2) {
#pragma unroll
                            for (int i = 0; i < 4; ++i) { v0[i] = siluf_(v0[i]); v1[i] = siluf_(v1[i]); } }
                        *(u32x4*)(zp + bj * 128) = pack8(v0, v1); } }
        }
    }
};
struct EpiRes {
    static constexpr bool PERM = true; static constexpr int MID_T = 0;
    const float* xin; float* xres; bf16_t* xb; float* ssq;
    __device__ __forceinline__ void operator()(const f32x4 (&acc)[2][2][4][2], const Unit& u, int wr, int wc, int fr, int fq) const {
        const int row0 = u.pm * 256 + wr * 64 + fr, col0 = u.pn * 256 + wc * 32 + 8 * fq;
#pragma unroll
        for (int ai = 0; ai < 2; ++ai)
#pragma unroll
            for (int m = 0; m < 4; ++m) { const int row = row0 + ai * 128 + m * 16; const size_t off = (size_t)row * D + col0; float s = 0.f;
#pragma unroll
                for (int bj = 0; bj < 2; ++bj) {
                    const f32x4 r0 = *(const f32x4*)(xin + off + bj * 128), r1 = *(const f32x4*)(xin + off + bj * 128 + 4);
                    const f32x4 v0 = r0 + acc[ai][bj][m][0], v1 = r1 + acc[ai][bj][m][1];
                    *(f32x4*)(xres + off + bj * 128) = v0; *(f32x4*)(xres + off + bj * 128 + 4) = v1;
                    *(u32x4*)(xb + off + bj * 128) = pack8(v0, v1);
                    s += (v0[0] * v0[0] + v0[1] * v0[1]) + (v0[2] * v0[2] + v0[3] * v0[3]) + (v1[0] * v1[0] + v1[1] * v1[1]) + (v1[2] * v1[2] + v1[3] * v1[3]);
                }
                s += shfl_xor_l(s, fq * 16 + fr, 16); s += shfl_xor_l(s, fq * 16 + fr, 32);
                if (fq == 0) ssq[(size_t)row * 16 + u.pn * 4 + wc] = s; }
    }
};
struct EpiResC {
    static constexpr bool PERM = true; static constexpr int MID_T = 12;
    EpiRes base; const float* ssqo;
    __device__ __forceinline__ void mid(f32x4 (&acc)[2][2][4][2], const Unit& u, int wr, int wc, int fr, int fq) const {
        if (!ssqo) return;
        const int row0 = u.pm * 256 + wr * 64 + fr;
#pragma unroll
        for (int ai = 0; ai < 2; ++ai)
#pragma unroll
            for (int m = 0; m < 4; ++m) { const int row = row0 + ai * 128 + m * 16;
                const f32x4 a = *(const f32x4*)(ssqo + (size_t)row * 8), b = *(const f32x4*)(ssqo + (size_t)row * 8 + 4);
                const float rs = rsqrtf(((a[0] + a[1]) + (a[2] + a[3]) + (b[0] + b[1])) * (1.0f / MIXW) + EPS);
#pragma unroll
                for (int bj = 0; bj < 2; ++bj)
#pragma unroll
                    for (int n = 0; n < 2; ++n) acc[ai][bj][m][n] = acc[ai][bj][m][n] * rs;
                asm volatile("" ::: "memory"); }
    }
    __device__ __forceinline__ void operator()(const f32x4 (&acc)[2][2][4][2], const Unit& u, int wr, int wc, int fr, int fq) const { base(acc, u, wr, wc, fr, fq); }
};
struct EpiFfn {
    static constexpr bool PERM = true; static constexpr int MID_T = 0;
    bf16_t* act; const float* ssq;
    __device__ __forceinline__ void operator()(const f32x4 (&acc)[2][2][4][2], const Unit& u, int wr, int wc, int fr, int fq) const {
        const int row0 = u.pm * 256 + wr * 64 + fr, jl = wc * 32 + 8 * fq;
#pragma unroll
        for (int ai = 0; ai < 2; ++ai)
#pragma unroll
            for (int m = 0; m < 4; ++m) { const int row = row0 + ai * 128 + m * 16; const float rs = rstd_from_partials(ssq, row, 1.0f / D);
                f32x4 v0, v1;
#pragma unroll
                for (int i = 0; i < 4; ++i) { v0[i] = siluf_(acc[ai][0][m][0][i] * rs) * (acc[ai][1][m][0][i] * rs); v1[i] = siluf_(acc[ai][0][m][1][i] * rs) * (acc[ai][1][m][1][i] * rs); }
                *(u32x4*)(act + (size_t)row * DFF + u.pn * 128 + jl) = pack8(v0, v1); }
    }
};

#define XB_TMO      128
#define XB_XCNT(j)  (256  + 64 * (j))
#define XB_XSUB(j)  (1280 + 64 * (j))
#define XB_XGEN(j)  (2304 + 64 * (j))
#define XB_TOP      3328
#define XB_TOPGEN   3392
#define XCD_BAR_WORDS 3456
#define XB_SPIN_CAP (1u << 18)
__device__ __forceinline__ unsigned xb_ld(unsigned* p)              { return __hip_atomic_load(p, __ATOMIC_RELAXED, __HIP_MEMORY_SCOPE_AGENT); }
__device__ __forceinline__ unsigned xb_add(unsigned* p, unsigned v) { return __hip_atomic_fetch_add(p, v, __ATOMIC_RELAXED, __HIP_MEMORY_SCOPE_AGENT); }
__device__ __forceinline__ unsigned xb_xcc_id() { return (unsigned)__builtin_amdgcn_s_getreg((3 << 11) | 20) & 0xFu; }
#define XB_SPIN(cond, bar) do { unsigned _sp = 0; while (cond) { __builtin_amdgcn_s_sleep(1); \
    if ((++_sp & 255u) == 0u) { if (xb_ld(&(bar)[XB_TMO])) break; if (_sp > XB_SPIN_CAP) { atomicAdd(&(bar)[XB_TMO], 1u); break; } } } } while (0)
struct XcdBarrier { unsigned* bar; unsigned x; volatile LAS unsigned* st; };
__device__ __forceinline__ XcdBarrier xcd_barrier_post(unsigned* bar, volatile LAS unsigned* st) {
    XcdBarrier b; b.bar = bar; b.x = xb_xcc_id(); b.st = st;
    if (threadIdx.x == 0) (void)xb_add(&bar[XB_XCNT(b.x)], 1u);
    return b;
}
__device__ __forceinline__ void xcd_barrier_complete(unsigned* bar, unsigned x, unsigned& nloc, unsigned& nx) {
    const unsigned G = gridDim.x * gridDim.y * gridDim.z;
    unsigned sum, cnt, mine, sp = 0u;
    for (;;) {
        sum = 0u; cnt = 0u; mine = 0u;
#pragma unroll
        for (unsigned j = 0; j < 16; ++j) { const unsigned c = xb_ld(&bar[XB_XCNT(j)]); sum += c; cnt += (c > 0u) ? 1u : 0u; mine = (j == x) ? c : mine; }
        if (sum == G) break;
        __builtin_amdgcn_s_sleep(1);
        if ((++sp & 255u) == 0u) { if (xb_ld(&bar[XB_TMO])) break; if (sp > XB_SPIN_CAP) { atomicAdd(&bar[XB_TMO], 1u); break; } }
    }
    nloc = mine > 0u ? mine : 1u; nx = cnt > 0u ? cnt : 1u;
}
__device__ __forceinline__ void xcd_barrier(const XcdBarrier& b, bool leader) {
    asm volatile("s_waitcnt vmcnt(0)" ::: "memory");
    __syncthreads();
    if (leader) {
        unsigned* bar = b.bar;
        __builtin_amdgcn_s_waitcnt(0);
        unsigned nloc = b.st[0], nx = b.st[1];
        if (nloc == 0u) { xcd_barrier_complete(bar, b.x, nloc, nx); b.st[0] = nloc; b.st[1] = nx; }
        const unsigned old = xb_add(&bar[XB_XSUB(b.x)], 1u);
        const unsigned gen = old / nloc;
        if (old + 1u == (gen + 1u) * nloc) {
            __builtin_amdgcn_fence(__ATOMIC_RELEASE, "agent");
            asm volatile("s_waitcnt vmcnt(0)" ::: "memory");
            const unsigned og = xb_add(&bar[XB_TOP], 1u);
            const unsigned tg = og / nx;
            if (og + 1u == (tg + 1u) * nx) xb_add(&bar[XB_TOPGEN], 1u);
            else XB_SPIN(xb_ld(&bar[XB_TOPGEN]) == tg, bar);
            __builtin_amdgcn_fence(__ATOMIC_ACQUIRE, "agent");
            xb_add(&bar[XB_XGEN(b.x)], 1u);
            asm volatile("s_waitcnt vmcnt(0)" ::: "memory");
        } else {
            XB_SPIN(xb_ld(&bar[XB_XGEN(b.x)]) == gen, bar);
            __builtin_amdgcn_fence(__ATOMIC_ACQUIRE, "agent");
            asm volatile("s_waitcnt vmcnt(0)" ::: "memory");
        }
    }
    __syncthreads();
}

constexpr int RING_BYTES = 131072, LDSCTL_OFF = RING_BYTES, MISC_OFF = LDSCTL_OFF + 320, LDS_BYTES = 147456;
constexpr int NWAVES = 8;

struct Args { const float* in[15]; float* out; unsigned char* ws; int ph_lo, ph_hi; };

__device__ __forceinline__ int win_srccol(int j) {
    const int t = j >> 8;
    if (t >= 6) return j;
    const int jj = j & 255, half = jj >> 7, p = jj & 127, d = 4 * (p >> 3) + (p & 3) + 64 * ((p >> 2) & 1);
    return half * MIXW + t * 128 + d;
}
__device__ __forceinline__ int wfi_srccol(int j) { const int t = j >> 8, jj = j & 255; return (jj < 128 ? 0 : DFF) + t * 128 + (jj & 127); }
__device__ __forceinline__ void transpose_item(const float* W, int K, int N, bf16_t* WT, int ndst, int kind, const float* kscale, int nscale, LAS float* scr, int item, int lane) {
    const int nblk = ndst / 32, kb = item / nblk, nb = item % nblk, k0 = 64 * kb, n0 = 32 * nb;
    const int jd = n0 + (lane & 31);
    const int sc = kind == 0 ? win_srccol(jd) : (kind == 2 ? wfi_srccol(jd) : jd);
#pragma unroll 8
    for (int i = 0; i < 32; ++i) { const int kk = 2 * i + (lane >> 5); float w = W[(size_t)(k0 + kk) * N + sc]; if (kscale && (k0 + kk) < nscale) w *= kscale[k0 + kk]; scr[kk * 33 + (lane & 31)] = w; }
    asm volatile("s_waitcnt lgkmcnt(0)" ::: "memory");
    const int c = lane & 7;
#pragma unroll
    for (int j = 0; j < 4; ++j) { const int n = (lane >> 3) + 8 * j; const LAS float* s = scr + (8 * c) * 33 + n;
        u32x4 o; o.x = pk2(s[0 * 33], s[1 * 33]); o.y = pk2(s[2 * 33], s[3 * 33]); o.z = pk2(s[4 * 33], s[5 * 33]); o.w = pk2(s[6 * 33], s[7 * 33]);
        *(u32x4*)(WT + (size_t)(n0 + n) * K + k0 + 8 * c) = o; }
    asm volatile("s_waitcnt lgkmcnt(0)" ::: "memory");
}

__device__ __forceinline__ void p0_prologue(const Args& a, unsigned char* ws, LAS unsigned char* lds, int gw, int NGW, int wave, int lane) {
    LAS float* scr = (LAS float*)(lds + wave * 16384);
    constexpr int I0 = 16 * (NIN / 32), I1 = 16 * 32, I2 = 16 * (NFI / 32), I3 = (DFF / 64) * 32, I4 = 16 * 16, IL = I0 + I1 + I2 + I3 + I4;
    for (int it = gw; it < DEPTH * IL; it += NGW) {
        const int l = it / IL; int r = it % IL;
        if (r < I0) { transpose_item(a.in[4] + (size_t)l * D * NIN, D, NIN, (bf16_t*)(ws + WS_WIN) + (size_t)l * NIN * D, NIN, 0, a.in[3] + l * D, D, scr, r, lane); continue; } r -= I0;
        if (r < I1) { const float* onw = (l & 1) ? a.in[10] + (l >> 1) * MIXW : a.in[9] + (l >> 1) * MIXW;
                      transpose_item(a.in[5] + (size_t)l * D * D, D, D, (bf16_t*)(ws + WS_WOUT) + (size_t)l * D * D, D, 1, onw, MIXW, scr, r, lane); continue; } r -= I1;
        if (r < I2) { transpose_item(a.in[12] + (size_t)l * D * NFI, D, NFI, (bf16_t*)(ws + WS_WFI) + (size_t)l * NFI * D, NFI, 2, a.in[11] + l * D, D, scr, r, lane); continue; } r -= I2;
        if (r < I3) { transpose_item(a.in[13] + (size_t)l * DFF * D, DFF, D, (bf16_t*)(ws + WS_WFO) + (size_t)l * D * DFF, D, 3, nullptr, 0, scr, r, lane); continue; } r -= I3;
        transpose_item(a.in[7] + (size_t)l * D * 512, D, 512, (bf16_t*)(ws + WS_WM) + (size_t)l * 512 * D, 512, 4, a.in[6] + l * D, D, scr, r, lane);
    }
    for (int m = gw; m < M; m += NGW) {
        const f32x4* xr = (const f32x4*)(a.in[0] + (size_t)m * D) + lane; f32x4 v[4]; float s = 0.f;
#pragma unroll
        for (int j = 0; j < 4; ++j) { v[j] = xr[64 * j]; s += (v[j].x * v[j].x + v[j].y * v[j].y) + (v[j].z * v[j].z + v[j].w * v[j].w); }
        s = wave_sum(s, lane);
        u32x2* o8 = (u32x2*)((bf16_t*)(ws + WS_XB) + (size_t)m * D) + lane;
#pragma unroll
        for (int j = 0; j < 4; ++j) { u32x2 w; w.x = pk2(v[j].x, v[j].y); w.y = pk2(v[j].z, v[j].w); o8[64 * j] = w; }
        if (lane < 16) ((float*)(ws + WS_SSQA))[(size_t)m * 16 + lane] = lane == 0 ? s : 0.f;
    }
    for (int m = gw; m < MROWS; m += NGW) {
        const f32x4* xr = (const f32x4*)(a.in[1] + (size_t)m * D) + lane; f32x4 v[4]; float s = 0.f;
#pragma unroll
        for (int j = 0; j < 4; ++j) { v[j] = xr[64 * j]; s += (v[j].x * v[j].x + v[j].y * v[j].y) + (v[j].z * v[j].z + v[j].w * v[j].w); }
        const float rs = rsqrtf(wave_sum(s, lane) * (1.0f / D) + EPS);
        u32x2* o8 = (u32x2*)((bf16_t*)(ws + WS_MEMB) + (size_t)m * D) + lane;
#pragma unroll
        for (int j = 0; j < 4; ++j) { u32x2 w; w.x = pk2(v[j].x * rs, v[j].y * rs); w.y = pk2(v[j].z * rs, v[j].w * rs); o8[64 * j] = w; }
    }
    for (int m = gw; m < M; m += NGW) {
        const double pos = (double)((const int*)a.in[2])[m];
        const double invf = exp(-9.210340371976184 * ((double)lane / 63.0));
        const double ang = pos * invf;
        ((float*)(ws + WS_COS))[(size_t)m * 64 + lane] = (float)cos(ang);
        ((float*)(ws + WS_SIN))[(size_t)m * 64 + lane] = (float)sin(ang);
    }
    for (int c = gw * 64 + lane; c < MIXW; c += NGW * 64) {
        const float l0 = a.in[8][c], l1 = a.in[8][MIXW + c]; const float mx = fmaxf(l0, l1), e0 = expf(l0 - mx), e1 = expf(l1 - mx);
        ((float*)(ws + WS_LB))[c] = 0.f; ((float*)(ws + WS_LB))[MIXW + c] = e1 / (e0 + e1);
    }
}

typedef float f32x16 __attribute__((ext_vector_type(16)));
constexpr int SC_QS = 0, SC_KT = 8448, SC_VT = 18688, SC_P = 28928, SC_AUX = 31488, SC_OUT = 32512, SC_SSQ = 40960, SC_BUF = 41472;
constexpr int NCHUNK = SEQ / 32;
struct HRegs { u32x4 qs[2], ka[2], va[2], gate[2]; float aux; };
struct SRegs { u32x4 kf[8], qf[8]; };
__device__ __forceinline__ bf16x8 as_bf16x8(u32x4 v) { return __builtin_bit_cast(bf16x8, v); }

template <int IS_RET>
__device__ __forceinline__ void helper_load(HRegs& R, const bf16_t* Z, const bf16_t* KST, const float* AUXG, int b, int h, int unit, int ht, int hw, int lane, int chunk_stage, int chunk_gate) {
    asm volatile("" : "+v"(ht));
    if (chunk_stage < NCHUNK) {
        const size_t tok0 = (size_t)b * SEQ + chunk_stage * 32;
#pragma unroll
        for (int i = 0; i < 2; ++i) { const int p = ht + 256 * i, c = p >> 4, j16 = p & 15; R.qs[i] = *(const u32x4*)(Z + (tok0 + c) * NIN + h * 256 + 8 * j16); }
        const int cpair = ht & 15, koct = ht >> 4;
#pragma unroll
        for (int i = 0; i < 2; ++i) { const size_t tk = tok0 + 2 * cpair + i;
            R.ka[i] = IS_RET ? *(const u32x4*)(Z + tk * NIN + h * 256 + 128 + 8 * koct) : *(const u32x4*)(KST + tk * MIXW + h * 128 + 8 * koct);
            R.va[i] = *(const u32x4*)(Z + tk * NIN + 1536 + h * 128 + 8 * koct); }
        if (!IS_RET) R.aux = AUXG[((size_t)unit * 64 + chunk_stage) * 256 + ht];
    }
    if (chunk_gate >= 0) { const size_t tok0 = (size_t)b * SEQ + chunk_gate * 32;
#pragma unroll
        for (int i = 0; i < 2; ++i) { const int p = ht + 256 * i, c = p >> 4, v0 = 8 * (p & 15); R.gate[i] = *(const u32x4*)(Z + (tok0 + c) * NIN + 2304 + h * 128 + v0); } }
}
template <int IS_RET>
__device__ __forceinline__ void helper_stage(const HRegs& R, LAS unsigned char* buf, int ht, int hw, int lane) {
    asm volatile("" : "+v"(ht));
#pragma unroll
    for (int i = 0; i < 2; ++i) { const int p = ht + 256 * i, c = p >> 4, j16 = p & 15; LAS unsigned char* dst = buf + SC_QS + c * 264 + 16 * j16;
        *(LAS u32x2*)dst = (u32x2){R.qs[i].x, R.qs[i].y}; *(LAS u32x2*)(dst + 8) = (u32x2){R.qs[i].z, R.qs[i].w}; }
    const int cpair = ht & 15, koct = ht >> 4;
#pragma unroll
    for (int j = 0; j < 8; ++j) { const int sh = 16 * (j & 1);
        const unsigned wk = ((R.ka[0][j >> 1] >> sh) & 0xffffu) | (((R.ka[1][j >> 1] >> sh) & 0xffffu) << 16);
        const unsigned wv = ((R.va[0][j >> 1] >> sh) & 0xffffu) | (((R.va[1][j >> 1] >> sh) & 0xffffu) << 16);
        *(LAS unsigned*)(buf + SC_KT + (8 * koct + j) * 80 + 4 * cpair) = wk;
        *(LAS unsigned*)(buf + SC_VT + (8 * koct + j) * 80 + 4 * cpair) = wv; }
    if (!IS_RET) *(LAS float*)(buf + SC_AUX + ht * 4) = R.aux;
}
__device__ __forceinline__ void scores_load(SRegs& R, const bf16_t* Z, int b, int h, int lane, int chunk) {
    if (chunk >= NCHUNK) return;
    asm volatile("" : "+v"(lane));
    const int l31 = lane & 31, hh = lane >> 5; const bf16_t* zr = Z + ((size_t)b * SEQ + chunk * 32 + l31) * NIN + h * 256 + 8 * hh;
#pragma unroll
    for (int kk = 0; kk < 8; ++kk) { R.kf[kk] = *(const u32x4*)(zr + 128 + 16 * kk); R.qf[kk] = *(const u32x4*)(zr + 16 * kk); }
}
__device__ __forceinline__ void scores_stage(const SRegs& R, LAS unsigned char* buf, int lane) {
    asm volatile("" : "+v"(lane));
    const int l31 = lane & 31, hh = lane >> 5;
    f32x16 d;
#pragma unroll
    for (int r = 0; r < 16; ++r) d[r] = 0.f;
#pragma unroll
    for (int kk = 0; kk < 8; ++kk) d = __builtin_amdgcn_mfma_f32_32x32x16_bf16(as_bf16x8(R.kf[kk]), as_bf16x8(R.qf[kk]), d, 0, 0, 0);
#pragma unroll
    for (int q = 0; q < 4; ++q) { float v4[4];
#pragma unroll
        for (int i = 0; i < 4; ++i) { const int srow = 8 * q + 4 * hh + i; v4[i] = (srow <= l31) ? d[4 * q + i] : 0.f; }
        u32x2 w; w.x = pg8::cvt_pk_bf16(v4[0], v4[1]); w.y = pg8::cvt_pk_bf16(v4[2], v4[3]);
        *(LAS u32x2*)(buf + SC_P + l31 * 80 + (8 * q + 4 * hh) * 2) = w; }
}
template <int IS_RET>
__device__ __forceinline__ void helper_finalize(const HRegs& R, LAS unsigned char* buf, bf16_t* CAT, float* SSQO, int b, int h, int ht, int chunk) {
    asm volatile("" : "+v"(ht));
    const size_t tok0 = (size_t)b * SEQ + chunk * 32;
#pragma unroll
    for (int i = 0; i < 2; ++i) { const int p = ht + 256 * i, c = p >> 4, v0 = 8 * (p & 15);
        const u32x2 lo = *(const LAS u32x2*)(buf + SC_OUT + c * 264 + v0 * 2), hi = *(const LAS u32x2*)(buf + SC_OUT + c * 264 + v0 * 2 + 8);
        const LAS float* sq = (const LAS float*)(buf + SC_SSQ);
        const float ssum = (sq[c] + sq[32 + c]) + (sq[64 + c] + sq[96 + c]);
        const float sc = IS_RET ? rsqrtf(ssum * (1.0f / HD) + EPS) : 1.0f;
        const unsigned ow[4] = {lo.x, lo.y, hi.x, hi.y}; u32x4 out;
#pragma unroll
        for (int j = 0; j < 4; ++j) out[j] = pk2(bf2f(ow[j] & 0xffffu) * sc * bf2f(R.gate[i][j] & 0xffffu), bf2f(ow[j] >> 16) * sc * bf2f(R.gate[i][j] >> 16));
        *(u32x4*)(CAT + (tok0 + c) * D + h * 128 + v0) = out;
        if (!IS_RET && (p & 15) == 0) SSQO[(tok0 + c) * 8 + h] = ssum; }
}
template <int IS_RET>
__device__ __forceinline__ void mfma_step(f32x16 (&S)[4], LAS unsigned char* buf, int w, int lane, float g32) {
    asm volatile("" : "+v"(lane));
    const int l31 = lane & 31, hh = lane >> 5, vs = 32 * w;
    bf16x8 sf[4][2];
#pragma unroll
    for (int kt = 0; kt < 4; ++kt) { f32x16 t = S[kt];
        if (!IS_RET) {
#pragma unroll
            for (int q = 0; q < 4; ++q) { const f32x4 e = *(const LAS f32x4*)(buf + SC_AUX + (32 * kt + 8 * q + 4 * hh) * 4);
#pragma unroll
                for (int i = 0; i < 4; ++i) t[4 * q + i] *= e[i]; } }
#pragma unroll
        for (int s2 = 0; s2 < 2; ++s2) { u32x4 pk;
#pragma unroll
            for (int j = 0; j < 4; ++j) pk[j] = pg8::cvt_pk_bf16(t[8 * s2 + 2 * j], t[8 * s2 + 2 * j + 1]);
            sf[kt][s2] = as_bf16x8(pk); } }
    f32x16 o;
#pragma unroll
    for (int r = 0; r < 16; ++r) o[r] = 0.f;
#pragma unroll
    for (int kt = 0; kt < 4; ++kt)
#pragma unroll
        for (int s2 = 0; s2 < 2; ++s2) { const LAS unsigned char* ad = buf + SC_QS + l31 * 264 + (32 * kt + 16 * s2 + 4 * hh) * 2;
            const u32x2 lo = *(const LAS u32x2*)ad, hi = *(const LAS u32x2*)(ad + 16);
            o = __builtin_amdgcn_mfma_f32_32x32x16_bf16(sf[kt][s2], as_bf16x8((u32x4){lo.x, lo.y, hi.x, hi.y}), o, 0, 0, 0); }
    bf16x8 vt[2];
#pragma unroll
    for (int kk = 0; kk < 2; ++kk) { vt[kk] = *(const LAS bf16x8*)(buf + SC_VT + (vs + l31) * 80 + 32 * kk + 16 * hh);
        const bf16x8 pf = *(const LAS bf16x8*)(buf + SC_P + l31 * 80 + 32 * kk + 16 * hh);
        o = __builtin_amdgcn_mfma_f32_32x32x16_bf16(vt[kk], pf, o, 0, 0, 0); }
#pragma unroll
    for (int kt = 0; kt < 4; ++kt) {
        if (!IS_RET) {
#pragma unroll
            for (int q = 0; q < 4; ++q) { const f32x4 e = *(const LAS f32x4*)(buf + SC_AUX + 512 + (32 * kt + 8 * q + 4 * hh) * 4);
#pragma unroll
                for (int i = 0; i < 4; ++i) S[kt][4 * q + i] *= e[i]; } }
#pragma unroll
        for (int kk = 0; kk < 2; ++kk) { const bf16x8 kf = *(const LAS bf16x8*)(buf + SC_KT + (32 * kt + l31) * 80 + 32 * kk + 16 * hh);
            S[kt] = __builtin_amdgcn_mfma_f32_32x32x16_bf16(kf, vt[kk], S[kt], 0, 0, 0); }
        if (IS_RET) S[kt] = S[kt] * g32;
    }
    float ss = 0.f;
#pragma unroll
    for (int r = 0; r < 16; ++r) ss += o[r] * o[r];
    ss += shfl_xor_l(ss, lane, 32);
    if (hh == 0) *(LAS float*)(buf + SC_SSQ + (w * 32 + l31) * 4) = ss;
#pragma unroll
    for (int q = 0; q < 4; ++q) { u32x2 wv; wv.x = pg8::cvt_pk_bf16(o[4 * q], o[4 * q + 1]); wv.y = pg8::cvt_pk_bf16(o[4 * q + 2], o[4 * q + 3]);
        *(LAS u32x2*)(buf + SC_OUT + l31 * 264 + (vs + 8 * q + 4 * hh) * 2) = wv; }
}
template <int IS_RET>
__device__ __forceinline__ void scan2_unit(unsigned char* ws, LAS unsigned char* lds, int unit, int tid) {
    const bf16_t* Z = (const bf16_t*)(ws + WS_Z); const bf16_t* KST = (const bf16_t*)(ws + WS_KST); const float* AUXG = (const float*)(ws + WS_AUX);
    bf16_t* CAT = (bf16_t*)(ws + WS_CAT); float* SSQO = (float*)(ws + WS_SSQO);
    const int b = unit / NH, h = unit % NH, wave = __builtin_amdgcn_readfirstlane(tid >> 6), lane = tid & 63;
    const int ht = tid - 256, hw = wave - 4;
    const float g32 = exp2f(32.0f * __log2f(1.0f - exp2f(-5.0f - (float)h)));
    __syncthreads();
    if (wave < 4) {
        f32x16 S[4];
#pragma unroll
        for (int kt = 0; kt < 4; ++kt)
#pragma unroll
            for (int r = 0; r < 16; ++r) S[kt][r] = 0.f;
        __syncthreads();
        for (int n = 0; n < NCHUNK; ++n) { mfma_step<IS_RET>(S, lds + (n & 1) * SC_BUF, wave, lane, g32); __syncthreads(); }
    } else {
        HRegs RA, RB; SRegs RS;
        helper_load<IS_RET>(RA, Z, KST, AUXG, b, h, unit, ht, hw, lane, 0, -1);
        if (hw == 0) scores_load(RS, Z, b, h, lane, 0);
        if (hw == 1) scores_load(RS, Z, b, h, lane, 1);
        helper_stage<IS_RET>(RA, lds, ht, hw, lane);
        if (hw == 0) { scores_stage(RS, lds, lane); scores_load(RS, Z, b, h, lane, 2); }
        helper_load<IS_RET>(RB, Z, KST, AUXG, b, h, unit, ht, hw, lane, 1, -1);
        __syncthreads();
        for (int n = 0; n < NCHUNK; n += 2) {
            helper_load<IS_RET>(RA, Z, KST, AUXG, b, h, unit, ht, hw, lane, n + 2, n);
            helper_stage<IS_RET>(RB, lds + SC_BUF, ht, hw, lane);
            if (hw == 1) { scores_stage(RS, lds + SC_BUF, lane); scores_load(RS, Z, b, h, lane, n + 3); }
            if (n >= 1) helper_finalize<IS_RET>(RB, lds + SC_BUF, CAT, SSQO, b, h, ht, n - 1);
            __syncthreads();
            helper_load<IS_RET>(RB, Z, KST, AUXG, b, h, unit, ht, hw, lane, n + 3, n + 1);
            if (n + 2 < NCHUNK) { helper_stage<IS_RET>(RA, lds, ht, hw, lane); if (hw == 0) { scores_stage(RS, lds, lane); scores_load(RS, Z, b, h, lane, n + 4); } }
            helper_finalize<IS_RET>(RA, lds, CAT, SSQO, b, h, ht, n);
            __syncthreads();
        }
        helper_finalize<IS_RET>(RB, lds + SC_BUF, CAT, SSQO, b, h, ht, NCHUNK - 1);
    }
}

constexpr int XA_K = 0, XA_KP = 144, XA_VT = 256 * XA_KP, XA_VP = 520;
__device__ __forceinline__ void xattn2_unit(unsigned char* ws, LAS unsigned char* lds, int unit, int layer, int tid) {
    const bf16_t* Z = (const bf16_t*)(ws + WS_Z); const bf16_t* MKV = (const bf16_t*)(ws + WS_MKV); bf16_t* CAT = (bf16_t*)(ws + WS_CAT);
    const int b = unit >> 5, hx = (unit >> 3) & 3, qb = unit & 7;
    __syncthreads();
    {   const bf16_t* src = MKV + (size_t)(b * NMEM) * 2048 + layer * 512 + hx * 64;
#pragma unroll
        for (int i = 0; i < 4; ++i) { const int piece = tid + 512 * i, key = piece >> 3, j = piece & 7;
            *(LAS u32x4*)(lds + XA_K + key * XA_KP + 16 * j) = *(const u32x4*)(src + (size_t)key * 2048 + 8 * j); }
        const int kp = tid & 127;
#pragma unroll
        for (int i = 0; i < 2; ++i) { const int doct = (tid >> 7) + 4 * i;
            const u32x4 a0 = *(const u32x4*)(src + (size_t)(2 * kp) * 2048 + 256 + 8 * doct), a1 = *(const u32x4*)(src + (size_t)(2 * kp + 1) * 2048 + 256 + 8 * doct);
#pragma unroll
            for (int j = 0; j < 8; ++j) { const int sh = 16 * (j & 1);
                *(LAS unsigned*)(lds + XA_VT + (8 * doct + j) * XA_VP + 4 * kp) = ((a0[j >> 1] >> sh) & 0xffffu) | (((a1[j >> 1] >> sh) & 0xffffu) << 16); } }
    }
    __syncthreads();
    const int wave = tid >> 6, lane = tid & 63, l31 = lane & 31, hh = lane >> 5;
    const size_t tok = (size_t)b * SEQ + qb * 256 + wave * 32 + l31;
    bf16x8 qf[4];
#pragma unroll
    for (int ks = 0; ks < 4; ++ks) qf[ks] = *(const bf16x8*)(Z + tok * NIN + 3072 + hx * 64 + 16 * ks + 8 * hh);
    f32x16 st[8];
#pragma unroll
    for (int T = 0; T < 8; ++T) {
#pragma unroll
        for (int r = 0; r < 16; ++r) st[T][r] = 0.f;
#pragma unroll
        for (int ks = 0; ks < 4; ++ks) { const bf16x8 kf = *(const LAS bf16x8*)(lds + XA_K + (32 * T + l31) * XA_KP + (16 * ks + 8 * hh) * 2);
            st[T] = __builtin_amdgcn_mfma_f32_32x32x16_bf16(kf, qf[ks], st[T], 0, 0, 0); } }
    float mx = -1e30f;
#pragma unroll
    for (int T = 0; T < 8; ++T)
#pragma unroll
        for (int r = 0; r < 16; ++r) mx = fmaxf(mx, st[T][r]);
    mx = fmaxf(mx, shfl_xor_l(mx, lane, 32));
    const float c2 = 0.125f * 1.4426950408889634f, mc = mx * c2;
    float sum = 0.f;
#pragma unroll
    for (int T = 0; T < 8; ++T)
#pragma unroll
        for (int r = 0; r < 16; ++r) { const float p = exp2f(st[T][r] * c2 - mc); st[T][r] = p; sum += p; }
    sum += shfl_xor_l(sum, lane, 32);
    f32x16 ot[2];
#pragma unroll
    for (int dt = 0; dt < 2; ++dt)
#pragma unroll
        for (int r = 0; r < 16; ++r) ot[dt][r] = 0.f;
#pragma unroll
    for (int T = 0; T < 8; ++T)
#pragma unroll
        for (int s2 = 0; s2 < 2; ++s2) { u32x4 pk;
#pragma unroll
            for (int j = 0; j < 4; ++j) pk[j] = pg8::cvt_pk_bf16(st[T][8 * s2 + 2 * j], st[T][8 * s2 + 2 * j + 1]);
#pragma unroll
            for (int dt = 0; dt < 2; ++dt) { const LAS unsigned char* ad = lds + XA_VT + (32 * dt + l31) * XA_VP + (32 * T + 16 * s2 + 4 * hh) * 2;
                const u32x2 lo = *(const LAS u32x2*)ad, hi = *(const LAS u32x2*)(ad + 16);
                ot[dt] = __builtin_amdgcn_mfma_f32_32x32x16_bf16(as_bf16x8((u32x4){lo.x, lo.y, hi.x, hi.y}), as_bf16x8(pk), ot[dt], 0, 0, 0); } }
    const float il = 1.0f / sum;
    bf16_t* op = CAT + tok * D + MIXW + hx * 64 + 4 * hh;
#pragma unroll
    for (int dt = 0; dt < 2; ++dt)
#pragma unroll
        for (int q = 0; q < 4; ++q) { u32x2 w; w.x = pg8::cvt_pk_bf16(ot[dt][4 * q] * il, ot[dt][4 * q + 1] * il); w.y = pg8::cvt_pk_bf16(ot[dt][4 * q + 2] * il, ot[dt][4 * q + 3] * il);
            *(u32x2*)(op + 32 * dt + 8 * q) = w; }
}

__device__ __forceinline__ void final_rows(float* out, const float* nf, int gw, int NGW, int lane) {
    const f32x4* wv = (const f32x4*)nf + lane;
    for (int row = gw; row < M; row += NGW) {
        f32x4* xr = (f32x4*)(out + (size_t)row * D) + lane; f32x4 v[4]; float s = 0.f;
#pragma unroll
        for (int j = 0; j < 4; ++j) { v[j] = xr[64 * j]; s += (v[j].x * v[j].x + v[j].y * v[j].y) + (v[j].z * v[j].z + v[j].w * v[j].w); }
        const float rs = rsqrtf(wave_sum(s, lane) * (1.0f / D) + EPS);
#pragma unroll
        for (int j = 0; j < 4; ++j) xr[64 * j] = v[j] * rs * wv[64 * j];
    }
}

constexpr int N_PHASES = 2 + 5 * DEPTH + 1;
__global__ void __launch_bounds__(NWAVES * 64, 2) mega_fwd(Args args) {
    extern __shared__ __attribute__((aligned(16))) unsigned char lds_raw[];
    LAS unsigned char* lds = (LAS unsigned char*)lds_raw;
    volatile LAS unsigned* MISC = (volatile LAS unsigned*)(lds + MISC_OFF);
    const int G = gridDim.x, bx = blockIdx.x;
    const int wave_s = __builtin_amdgcn_readfirstlane(threadIdx.x >> 6);
    unsigned char* ws = args.ws;
    for (int u = threadIdx.x; u < (LDS_BYTES - LDSCTL_OFF) / 4; u += NWAVES * 64) ((LAS unsigned*)(lds + LDSCTL_OFF))[u] = 0u;
    __syncthreads();
    XcdBarrier bar; bar.bar = (unsigned*)(ws + WS_CTL) + CW_BAR; bar.x = 0; bar.st = nullptr;
    if (MK_N_LAUNCHES == 1) bar = xcd_barrier_post((unsigned*)(ws + WS_CTL) + CW_BAR, MISC + 8);
    const int lo = args.ph_lo, hi = args.ph_hi;
#define IN(k) (lo <= (k) && (k) < hi)
#define SEAM(k) do { if (IN(k) && IN((k) + 1)) xcd_barrier(bar, wave_s == 0 && lane_id_volatile() == 0); } while (0)
#define OPAQ() unsigned char* wsp = ws; int Gp = G, bxp = bx, tidp = wave_s * 64 + lane_id_volatile(); asm volatile("" : "+s"(wsp), "+s"(Gp), "+s"(bxp), "+v"(tidp)); \
    const int lanep = tidp & 63, wavep = __builtin_amdgcn_readfirstlane(tidp >> 6), vcup = (Gp % 8 == 0) ? (bxp % 8) * (Gp / 8) + bxp / 8 : bxp, gwp = vcup * NWAVES + wavep, NGWp = Gp * NWAVES; \
    (void)lanep; (void)gwp; (void)NGWp

    if (IN(0) && !(DBG_SKIP & 1)) { OPAQ(); p0_prologue(args, wsp, lds, gwp, NGWp, wavep, lanep); }
    SEAM(0);
    if (IN(1) && !(DBG_SKIP & 16)) { OPAQ();
        pg8::Gemm g{(const bf16_t*)(wsp + WS_MEMB), (const bf16_t*)(wsp + WS_WM), MROWS, 2048, D}; pg8::StaticOrder S; S.init(MROWS, 2048, Gp, bxp);
        EpiPlain E{(bf16_t*)(wsp + WS_MKV), 2048};
        pg8::gemm_phase<EpiPlain, pg8::StaticOrder, true, true>(lds, g, S, E, tidp);
    }
    SEAM(1);
    for (int l = 0; l < DEPTH; ++l) {
        const int pb = 2 + 5 * l, is_ret = l & 1;
        if (IN(pb) && !(DBG_SKIP & 32)) { OPAQ();
            pg8::Gemm g{(const bf16_t*)(wsp + WS_XB), (const bf16_t*)(wsp + WS_WIN) + (size_t)l * NIN * D, M, NIN, D}; pg8::StaticOrder S; S.init(M, NIN, Gp, bxp);
            EpiIn E{(bf16_t*)(wsp + WS_Z), (bf16_t*)(wsp + WS_KST), (float*)(wsp + WS_AUX), (const float*)(wsp + WS_SSQA), (const float*)(wsp + WS_LB) + (l >> 1) * MIXW, (const float*)(wsp + WS_COS), (const float*)(wsp + WS_SIN), is_ret};
            pg8::gemm_phase<EpiIn, pg8::StaticOrder, true, true>(lds, g, S, E, tidp);
        }
        SEAM(pb);
        if (IN(pb + 1)) { OPAQ();
            const int NS = BATCH * NH;
            if (Gp > NS) {
                if (bxp < NS) { if (!(DBG_SKIP & 2)) { if (is_ret) scan2_unit<1>(wsp, lds, bxp, tidp); else scan2_unit<0>(wsp, lds, bxp, tidp); } }
                else for (int u = bxp - NS; u < 256; u += Gp - NS) { if (!(DBG_SKIP & 4)) xattn2_unit(wsp, lds, u, l, tidp); }
            } else {
                for (int u = bxp; u < NS; u += Gp) { if (!(DBG_SKIP & 2)) { if (is_ret) scan2_unit<1>(wsp, lds, u, tidp); else scan2_unit<0>(wsp, lds, u, tidp); } }
                for (int u = bxp; u < 256; u += Gp) { if (!(DBG_SKIP & 4)) xattn2_unit(wsp, lds, u, l, tidp); }
            }
            __syncthreads();
        }
        SEAM(pb + 1);
        if (IN(pb + 2) && !(DBG_SKIP & 64)) { OPAQ();
            pg8::Gemm g{(const bf16_t*)(wsp + WS_CAT), (const bf16_t*)(wsp + WS_WOUT) + (size_t)l * D * D, M, D, D}; pg8::StaticOrder S; S.init(M, D, Gp, bxp);
            EpiResC E{EpiRes{l == 0 ? args.in[0] : args.out, args.out, (bf16_t*)(wsp + WS_XB), (float*)(wsp + WS_SSQD)}, is_ret ? nullptr : (const float*)(wsp + WS_SSQO)};
            pg8::gemm_phase<EpiResC, pg8::StaticOrder, true, true>(lds, g, S, E, tidp);
        }
        SEAM(pb + 2);
        if (IN(pb + 3) && !(DBG_SKIP & 128)) { OPAQ();
            pg8::Gemm g{(const bf16_t*)(wsp + WS_XB), (const bf16_t*)(wsp + WS_WFI) + (size_t)l * NFI * D, M, NFI, D}; pg8::StaticOrder S; S.init(M, NFI, Gp, bxp);
            EpiFfn E{(bf16_t*)(wsp + WS_ACT), (const float*)(wsp + WS_SSQD)};
            pg8::gemm_phase<EpiFfn, pg8::StaticOrder, true, true>(lds, g, S, E, tidp);
        }
        SEAM(pb + 3);
        if (IN(pb + 4) && !(DBG_SKIP & 256)) { OPAQ();
            pg8::Gemm g{(const bf16_t*)(wsp + WS_ACT), (const bf16_t*)(wsp + WS_WFO) + (size_t)l * D * DFF, M, D, DFF}; pg8::StaticOrder S; S.init(M, D, Gp, bxp);
            EpiRes E{args.out, args.out, (bf16_t*)(wsp + WS_XB), (float*)(wsp + WS_SSQA)};
            pg8::gemm_phase<EpiRes, pg8::StaticOrder, true, true>(lds, g, S, E, tidp);
        }
        SEAM(pb + 4);
    }
    if (IN(N_PHASES - 1)) { OPAQ(); final_rows(args.out, args.in[14], gwp, NGWp, lanep); }
#undef IN
#undef SEAM
#undef OPAQ
}

extern "C" void kernel_launch(void* const* d_in, const int* in_sizes, int n_in, void* d_out, int out_size, void* d_ws, size_t ws_size, hipStream_t stream) {
    static int grid = 0;
    if (grid == 0) {
        if (n_in != 15 || in_sizes[0] != M * D || out_size != M * D || ws_size < WS_END) {
            fprintf(stderr, "kernel_launch: unexpected shapes: n_in %d in0 %d out %d ws %zu (need %zu)\n", n_in, n_in > 0 ? in_sizes[0] : -1, out_size, ws_size, (size_t)WS_END); grid = -1; return; }
        int dev = 0, cus = 0, per_cu = 0;
        if (hipGetDevice(&dev) != hipSuccess || hipDeviceGetAttribute(&cus, hipDeviceAttributeMultiprocessorCount, dev) != hipSuccess) { grid = -1; return; }
        if (hipFuncSetAttribute((const void*)mega_fwd, hipFuncAttributeMaxDynamicSharedMemorySize, LDS_BYTES) != hipSuccess) { fprintf(stderr, "kernel_launch: hipFuncSetAttribute failed\n"); grid = -1; return; }
        if (hipOccupancyMaxActiveBlocksPerMultiprocessor(&per_cu, (const void*)mega_fwd, NWAVES * 64, LDS_BYTES) != hipSuccess || per_cu < 1)
            fprintf(stderr, "kernel_launch: occupancy query reports %d workgroups per CU\n", per_cu);
        (void)hipGetLastError();
        grid = cus;
    }
    if (grid < 0) return;
    if (hipMemsetAsync((char*)d_ws + WS_CTL, 0, CTL_ZERO_BYTES, stream) != hipSuccess) { fprintf(stderr, "kernel_launch: memset failed\n"); return; }
    Args a{};
    for (int i = 0; i < 15; ++i) a.in[i] = (const float*)d_in[i];
    a.out = (float*)d_out; a.ws = (unsigned char*)d_ws;
    if (MK_N_LAUNCHES == 1) {
        a.ph_lo = 0; a.ph_hi = N_PHASES;
        hipLaunchKernelGGL(mega_fwd, dim3(grid), dim3(NWAVES * 64), LDS_BYTES, stream, a);
    } else {
        for (int p = 0; p < N_PHASES; ++p) { a.ph_lo = p; a.ph_hi = p + 1; hipLaunchKernelGGL(mega_fwd, dim3(grid), dim3(NWAVES * 64), LDS_BYTES, stream, a); }
    }
    const hipError_t le = hipPeekAtLastError();
    if (le != hipSuccess) fprintf(stderr, "kernel_launch: launch failed: %s\n", hipGetErrorName(le));
}
```

```cpp
#include <hip/hip_runtime.h>
#include <cstdio>
#include <cstdint>

#ifndef DBG_SKIP
#define DBG_SKIP 0
#endif
#ifndef PROBE_REP
#define PROBE_REP 0
#endif
#ifndef PROBE_VAR
#define PROBE_VAR 0
#endif
#ifndef MK_N_LAUNCHES
#define MK_N_LAUNCHES 1
#endif

#define GAS __attribute__((address_space(1)))
#define LAS __attribute__((address_space(3)))
typedef unsigned short bf16_t;
typedef short bf16x8 __attribute__((ext_vector_type(8)));
typedef float f32x4 __attribute__((ext_vector_type(4)));
typedef float f32x2 __attribute__((ext_vector_type(2)));
typedef unsigned u32x4 __attribute__((ext_vector_type(4)));
typedef unsigned u32x2 __attribute__((ext_vector_type(2)));

constexpr int BATCH = 8, SEQ = 2048, D = 1024, DEPTH = 4;
constexpr int M = BATCH * SEQ;
constexpr int NH = 6, HD = 128, MIXW = 768, XW = 256, NXH = 4, XHD = 64, NMEM = 256;
constexpr int NIN = 3328, DFF = 2816, NFI = 2 * DFF;
constexpr int MROWS = BATCH * NMEM;
constexpr float EPS = 1e-6f;
constexpr int NVS = 2;
constexpr int VPR = 16 / NVS;

constexpr size_t MiB = 1u << 20;
constexpr size_t WS_CTL = 0, CTL_ZERO_BYTES = 1 * MiB;
constexpr size_t WS_LB = 1 * MiB;
constexpr size_t WS_SSQA = 2 * MiB;
constexpr size_t WS_SSQD = 3 * MiB;
constexpr size_t WS_COS = 4 * MiB, WS_SIN = 8 * MiB;
constexpr size_t WS_MEMB = 12 * MiB;
constexpr size_t WS_MKV = 16 * MiB;
constexpr size_t WS_WIN = 24 * MiB;
constexpr size_t WS_WOUT = 50 * MiB;
constexpr size_t WS_WFI = 58 * MiB;
constexpr size_t WS_WFO = 102 * MiB;
constexpr size_t WS_WM = 124 * MiB;
constexpr size_t WS_XB = 128 * MiB;
constexpr size_t WS_CAT = 160 * MiB;
constexpr size_t WS_Z = 192 * MiB;
constexpr size_t WS_F = 296 * MiB;
constexpr size_t WS_KST = 296 * MiB;
constexpr size_t WS_AUX = 320 * MiB;
constexpr size_t WS_SSQO = 323 * MiB;
constexpr size_t WS_ACT = 192 * MiB;
constexpr size_t WS_END = 344 * MiB;
static_assert(WS_WIN + (size_t)DEPTH * NIN * D * 2 <= WS_WOUT && WS_WOUT + (size_t)DEPTH * D * D * 2 <= WS_WFI && WS_WFI + (size_t)DEPTH * NFI * D * 2 <= WS_WFO &&
              WS_WFO + (size_t)DEPTH * D * DFF * 2 <= WS_WM && WS_WM + (size_t)2048 * 1024 * 2 <= WS_XB && WS_Z + (size_t)M * NIN * 2 <= WS_F && WS_F + (size_t)M * MIXW * 4 <= WS_END &&
              WS_ACT + (size_t)M * DFF * 2 <= WS_F, "ws map");
constexpr int CW_BAR = 4096;

__device__ __forceinline__ int lane_id_volatile() { int l; asm volatile("v_mbcnt_lo_u32_b32 %0, -1, 0\n\tv_mbcnt_hi_u32_b32 %0, -1, %0" : "=v"(l)); return l; }
namespace pg8 {
constexpr int BM = 256, BK = 64, HALF = 128, HTB = HALF * BK * 2, STAGE_BYTES = 8 * HTB, NXCD = 8, WGM = 8;
__host__ __device__ __forceinline__ int lds_byte(int r, int c) { const int st = (r >> 4) * 2 + (c >> 5), rr = r & 15, cc = c & 31, ob = rr * 64 + cc * 2; return st * 1024 + (ob ^ (((ob >> 9) & 1) << 5)); }
__host__ __device__ __forceinline__ void stage_rc(int b, int& R, int& C) { const int st = b / 1024, sb = b % 1024, swz = sb ^ (((sb >> 9) & 1) << 5); R = (st >> 1) * 16 + swz / 64; C = (st & 1) * 32 + (swz % 64) / 2; }
__host__ __device__ __forceinline__ int perm32(int rho) { const int n = rho >> 4, i = rho & 15; return 8 * (i >> 2) + 4 * n + (i & 3); }
struct Unit { int pm, pn; };
struct Gemm { const bf16_t* A; const bf16_t* Bt; int M, N, K; };
struct StaticOrder {
    int nM, nN, nwg, G, c;
    __host__ __device__ void init(int M_, int N_, int G_, int c_) { nM = M_ / BM; nN = N_ / BM; nwg = nM * nN; G = G_; c = c_; }
    __host__ __device__ bool next(int i, Unit& u) const {
        const long L = (long)i * G + c; if (L >= nwg) return false;
        int wgid = (int)L; { const int q = nwg / NXCD, r = nwg % NXCD, xcd = wgid % NXCD, off = wgid / NXCD; wgid = (xcd < r ? xcd * (q + 1) : r * (q + 1) + (xcd - r) * q) + off; }
        const int nig = WGM * nN, gid = wgid / nig, fm = gid * WGM, gsz = (nM - fm) < WGM ? (nM - fm) : WGM;
        u.pm = fm + ((wgid % nig) % gsz); u.pn = (wgid % nig) / gsz; return true;
    }
    __device__ __forceinline__ void a_ready(const Unit&) const {}
    __device__ __forceinline__ void done(const Unit&) const {}
};
struct XccOrder {
    int rank, n, slot, nx, nN;
    __device__ __forceinline__ bool next(int i, Unit& u) const {
        const int per = 8 * nN, t = i * n + rank, nb = (8 - slot + nx - 1) / nx;
        if (slot >= 8 || t >= nb * per) return false;
        const int bi = t / per, tt = t - bi * per; u.pm = 8 * (slot + bi * nx) + (tt & 7); u.pn = tt >> 3; return true;
    }
    __device__ __forceinline__ void a_ready(const Unit&) const {}
};
struct XccOrderMem {
    int rank, n, slot, nx;
    __device__ __forceinline__ bool next(int i, Unit& u) const {
        const int t = i * n + rank, nb = (8 - slot + nx - 1) / nx;
        if (slot >= 8 || t >= nb * 8) return false;
        u.pm = slot + (t >> 3) * nx; u.pn = t & 7; return true;
    }
    __device__ __forceinline__ void a_ready(const Unit&) const {}
};
struct OneUnit {
    int pm, pn;
    __device__ __forceinline__ bool next(int i, Unit& u) const { if (i) return false; u.pm = pm; u.pn = pn; return true; }
    __device__ __forceinline__ void a_ready(const Unit&) const {}
};
__device__ __forceinline__ unsigned cvt_pk_bf16(float lo, float hi) { unsigned r; asm volatile("v_cvt_pk_bf16_f32 %0, %1, %2" : "=v"(r) : "v"(lo), "v"(hi)); return r; }

template <class Epi, class Sched, bool ALIGN_EPI = false, bool SP2 = false>
__device__ __forceinline__ void gemm_phase(LAS unsigned char* lds, const Gemm g, const Sched& S, const Epi& E, int tid) {
    asm volatile("" : "+v"(tid));
    const int wid = __builtin_amdgcn_readfirstlane(tid >> 6), lane = tid & 63, wr = wid >> 2, wc = wid & 3, fr = lane & 15, fq = lane >> 4;
    const int K = g.K, nt = K / BK;
    unsigned voffA[2], voffB[2];
#pragma unroll
    for (int i = 0; i < 2; ++i) { int R, C; stage_rc(tid * 16 + i * 8192, R, C); const int Rb = Epi::PERM ? ((R & ~31) + perm32(R & 31)) : R;
        voffA[i] = (unsigned)(R * K + C) * 2u; voffB[i] = (unsigned)(Rb * K + C) * 2u; }
    asm volatile("" : "+v"(voffA[0]), "+v"(voffA[1]), "+v"(voffB[0]), "+v"(voffB[1]));
    const size_t kstep = (size_t)(BK * 2);
    const size_t hstep = (size_t)HALF * K * 2;
    const size_t tstep = 2 * hstep;
    const unsigned ldsw = (unsigned)wid * 1024u;
    const int aoff = lds_byte(wr * 64 + fr, fq * 8), boff = lds_byte(wc * 32 + fr, fq * 8);
#define PG8_SA(b, h) (((b) * 2 + (h)) * HTB)
#define PG8_SB(b, h) ((4 + (b) * 2 + (h)) * HTB)
#define PG8_STAGE(bufoff, gbase, voff) do { _Pragma("unroll") for (int _i = 0; _i < 2; ++_i) \
        __builtin_amdgcn_global_load_lds((const unsigned*)((const char*)(gbase) + (voff)[_i]), (LAS unsigned*)(lds + (bufoff) + ldsw + _i * 8192), 16, 0, 0); } while (0)
#define PG8_LDA(dst, b, h) do { _Pragma("unroll") for (int m = 0; m < 4; ++m) _Pragma("unroll") for (int k = 0; k < 2; ++k) dst[m][k] = *(const LAS bf16x8*)(lds + PG8_SA(b, h) + aoff + m * 2048 + k * 1024); } while (0)
#define PG8_LDB(dst, b, h) do { _Pragma("unroll") for (int n = 0; n < 2; ++n) _Pragma("unroll") for (int k = 0; k < 2; ++k) dst[n][k] = *(const LAS bf16x8*)(lds + PG8_SB(b, h) + boff + n * 2048 + k * 1024); } while (0)
#define PG8_MMA(ai, bj, At, Bt) do { __builtin_amdgcn_s_setprio(1); _Pragma("unroll") for (int m = 0; m < 4; ++m) _Pragma("unroll") for (int n = 0; n < 2; ++n) _Pragma("unroll") for (int k = 0; k < 2; ++k) \
        acc[ai][bj][m][n] = __builtin_amdgcn_mfma_f32_16x16x32_bf16(Bt[n][k], At[m][k], acc[ai][bj][m][n], 0, 0, 0); __builtin_amdgcn_s_setprio(0); } while (0)
#define PG8_WAIT_V(n) asm volatile("s_waitcnt vmcnt(" #n ")" ::: "memory")
#define PG8_WAIT_L(n) asm volatile("s_waitcnt lgkmcnt(" #n ")" ::: "memory")
#define PG8_BAR __builtin_amdgcn_s_barrier()
#define PG8_SCHED __builtin_amdgcn_sched_barrier(0)
    Unit cur, nxt; int ui = 0;
    if (!S.next(0, cur)) return;
    f32x4 acc[2][2][4][2];
#pragma unroll
    for (int a = 0; a < 2; ++a)
#pragma unroll
        for (int b = 0; b < 2; ++b)
#pragma unroll
            for (int m = 0; m < 4; ++m)
#pragma unroll
                for (int n = 0; n < 2; ++n) acc[a][b][m][n] = (f32x4){0.f, 0.f, 0.f, 0.f};
    bf16x8 At[4][2], B0[2][2], B1[2][2];
    const char* cA = (const char*)g.A + (size_t)cur.pm * tstep; const char* cB = (const char*)g.Bt + (size_t)cur.pn * tstep;
    S.a_ready(cur);
    if constexpr (SP2) {
        PG8_STAGE(PG8_SB(0, 0), cB, voffB); PG8_STAGE(PG8_SB(0, 1), cB + hstep, voffB); PG8_STAGE(PG8_SA(0, 0), cA, voffA); PG8_STAGE(PG8_SA(0, 1), cA + hstep, voffA);
        if (wr == 1) PG8_BAR;
        PG8_WAIT_V(2); PG8_BAR;
        PG8_STAGE(PG8_SB(1, 0), cB + kstep, voffB); PG8_STAGE(PG8_SA(1, 0), cA + kstep, voffA); PG8_STAGE(PG8_SB(1, 1), cB + hstep + kstep, voffB);
        PG8_WAIT_V(6); PG8_BAR;
    } else {
        PG8_STAGE(PG8_SB(0, 0), cB, voffB); PG8_STAGE(PG8_SA(0, 0), cA, voffA); PG8_STAGE(PG8_SB(0, 1), cB + hstep, voffB); PG8_STAGE(PG8_SA(0, 1), cA + hstep, voffA);
        if (wr == 1) PG8_BAR;
        PG8_WAIT_V(4); PG8_BAR;
        PG8_STAGE(PG8_SB(1, 0), cB + kstep, voffB); PG8_STAGE(PG8_SA(1, 0), cA + kstep, voffA); PG8_STAGE(PG8_SB(1, 1), cB + hstep + kstep, voffB);
        PG8_WAIT_V(6); PG8_BAR;
    }
    for (;;) {
        const bool has_next = S.next(ui + 1, nxt);
        const char* nA = has_next ? (const char*)g.A + (size_t)nxt.pm * tstep : cA; const char* nB = has_next ? (const char*)g.Bt + (size_t)nxt.pn * tstep : cB;
        for (int t = 0; t < nt; t += 2) {
            const bool last = (t == nt - 2);
            const char* a1 = cA + (size_t)(t + 1) * kstep;
            const char* a2 = last ? nA : cA + (size_t)(t + 2) * kstep; const char* b2 = last ? nB : cB + (size_t)(t + 2) * kstep;
            const char* a3 = a2 + kstep; const char* b3 = b2 + kstep;
            if (last && has_next) S.a_ready(nxt);
            if constexpr (Epi::MID_T > 0) { if (t == Epi::MID_T) { const int l2 = lane_id_volatile(); E.mid(acc, cur, wr, wc, l2 & 15, l2 >> 4); } }
            if constexpr (SP2) {
            PG8_LDB(B0, 0, 0); PG8_LDB(B1, 0, 1); PG8_SCHED; PG8_LDA(At, 0, 0); PG8_STAGE(PG8_SA(1, 1), a1 + hstep, voffA);
            PG8_WAIT_V(8); PG8_WAIT_L(0); PG8_BAR; PG8_MMA(0, 0, At, B0); PG8_MMA(0, 1, At, B1); PG8_BAR; PG8_SCHED;
            PG8_LDA(At, 0, 1); PG8_STAGE(PG8_SB(0, 0), b2, voffB); PG8_STAGE(PG8_SB(0, 1), b2 + hstep, voffB); PG8_STAGE(PG8_SA(0, 0), a2, voffA);
            PG8_WAIT_V(8); PG8_WAIT_L(0); PG8_BAR; PG8_MMA(1, 0, At, B0); PG8_MMA(1, 1, At, B1); PG8_BAR; PG8_SCHED;
            PG8_LDB(B0, 1, 0); PG8_LDB(B1, 1, 1); PG8_SCHED; PG8_LDA(At, 1, 0); PG8_STAGE(PG8_SA(0, 1), a2 + hstep, voffA);
            PG8_WAIT_V(8); PG8_WAIT_L(0); PG8_BAR; PG8_MMA(0, 0, At, B0); PG8_MMA(0, 1, At, B1); PG8_BAR; PG8_SCHED;
            PG8_LDA(At, 1, 1); PG8_STAGE(PG8_SB(1, 0), b3, voffB); PG8_STAGE(PG8_SB(1, 1), b3 + hstep, voffB); PG8_STAGE(PG8_SA(1, 0), a3, voffA);
            PG8_WAIT_V(8); PG8_WAIT_L(0); PG8_BAR; PG8_MMA(1, 0, At, B0); PG8_MMA(1, 1, At, B1); PG8_BAR; PG8_SCHED;
            } else {
            PG8_LDB(B0, 0, 0); PG8_SCHED; PG8_LDA(At, 0, 0); PG8_STAGE(PG8_SA(1, 1), a1 + hstep, voffA);
            PG8_WAIT_L(8); PG8_BAR; PG8_WAIT_L(0); PG8_MMA(0, 0, At, B0); PG8_BAR; PG8_SCHED;
            PG8_LDB(B1, 0, 1); PG8_STAGE(PG8_SB(0, 0), b2, voffB);
            PG8_BAR; PG8_WAIT_L(0); PG8_MMA(0, 1, At, B1); PG8_BAR;
            PG8_LDA(At, 0, 1); PG8_STAGE(PG8_SA(0, 0), a2, voffA);
            PG8_BAR; PG8_WAIT_L(0); PG8_MMA(1, 0, At, B0); PG8_BAR; PG8_SCHED;
            PG8_STAGE(PG8_SB(0, 1), b2 + hstep, voffB);
            PG8_WAIT_V(6); PG8_BAR; PG8_MMA(1, 1, At, B1); PG8_BAR;
            PG8_LDB(B0, 1, 0); PG8_SCHED; PG8_LDA(At, 1, 0); PG8_STAGE(PG8_SA(0, 1), a2 + hstep, voffA);
            PG8_WAIT_L(8); PG8_BAR; PG8_WAIT_L(0); PG8_MMA(0, 0, At, B0); PG8_BAR; PG8_SCHED;
            PG8_LDB(B1, 1, 1); PG8_STAGE(PG8_SB(1, 0), b3, voffB);
            PG8_BAR; PG8_WAIT_L(0); PG8_MMA(0, 1, At, B1); PG8_BAR;
            PG8_LDA(At, 1, 1); PG8_STAGE(PG8_SA(1, 0), a3, voffA);
            PG8_BAR; PG8_WAIT_L(0); PG8_MMA(1, 0, At, B0); PG8_BAR; PG8_SCHED;
            PG8_STAGE(PG8_SB(1, 1), b3 + hstep, voffB);
            PG8_WAIT_V(6); PG8_BAR; PG8_MMA(1, 1, At, B1); PG8_BAR;
            }
        }
        if constexpr (ALIGN_EPI) { if (wr == 0) PG8_BAR; }
        { const int l2 = lane_id_volatile(); E(acc, cur, wr, wc, l2 & 15, l2 >> 4); }
        if (!has_next) break;
#pragma unroll
        for (int a = 0; a < 2; ++a)
#pragma unroll
            for (int b = 0; b < 2; ++b)
#pragma unroll
                for (int m = 0; m < 4; ++m)
#pragma unroll
                    for (int n = 0; n < 2; ++n) acc[a][b][m][n] = (f32x4){0.f, 0.f, 0.f, 0.f};
        cur = nxt; cA = nA; cB = nB; ++ui;
        if constexpr (ALIGN_EPI) { if (wr == 1) PG8_BAR; }
    }
    PG8_WAIT_V(0);
    if constexpr (!ALIGN_EPI) { if (wr == 0) PG8_BAR; }
    PG8_BAR;
#undef PG8_SA
#undef PG8_SB
#undef PG8_STAGE
#undef PG8_LDA
#undef PG8_LDB
#undef PG8_MMA
#undef PG8_WAIT_V
#undef PG8_WAIT_L
#undef PG8_BAR
#undef PG8_SCHED
}
}

__device__ __forceinline__ float bf2f(unsigned h) { return __uint_as_float(h << 16); }
__device__ __forceinline__ unsigned f2bf(float f) { unsigned u = __float_as_uint(f); return (u + 0x7fffu + ((u >> 16) & 1u)) >> 16; }
__device__ __forceinline__ unsigned pk2(float lo, float hi) { return f2bf(lo) | (f2bf(hi) << 16); }
__device__ __forceinline__ float fast_rcp(float x) { return __builtin_amdgcn_rcpf(x); }
__device__ __forceinline__ float sigmoidf_(float x) { return fast_rcp(1.0f + __expf(-x)); }
__device__ __forceinline__ float siluf_(float x) { return x * sigmoidf_(x); }
__device__ __forceinline__ float shfl_xor_l(float v, int lane, int mask) { return __int_as_float(__builtin_amdgcn_ds_bpermute((lane ^ mask) << 2, __float_as_int(v))); }
__device__ __forceinline__ float wave_sum(float v, int lane) {
#pragma unroll
    for (int o = 1; o < 64; o <<= 1) v += shfl_xor_l(v, lane, o);
    return v;
}
__device__ __forceinline__ float rstd_from_partials(const float* ssq, int row, float invn) {
    const f32x4* p = (const f32x4*)(ssq + (size_t)row * 16);
    const f32x4 a = p[0], b = p[1], c = p[2], d = p[3];
    const f32x4 s = (a + b) + (c + d);
    return rsqrtf(((s[0] + s[1]) + (s[2] + s[3])) * invn + EPS);
}
constexpr int RSTD_TAB_OFF = 132096;
__device__ __forceinline__ void rstd_table(const float* ssq, int pm, LAS float* tab, int wr, int wc, int fr, int fq) {
    const int t = (wr * 4 + wc) * 64 + fq * 16 + fr;
    if (t < 256) { const GAS f32x4* p = (const GAS f32x4*)((const GAS float*)ssq + (size_t)(pm * 256 + t) * 16);
        const f32x4 a = p[0], b = p[1], c = p[2], d = p[3]; const f32x4 sm = (a + b) + (c + d);
        tab[t] = rsqrtf(((sm[0] + sm[1]) + (sm[2] + sm[3])) * (1.0f / D) + EPS); }
    asm volatile("s_waitcnt lgkmcnt(0)" ::: "memory"); __builtin_amdgcn_s_barrier(); asm volatile("" ::: "memory");
}
__device__ __forceinline__ u32x4 pack8(const f32x4 v0, const f32x4 v1) {
    u32x4 w; w.x = pg8::cvt_pk_bf16(v0[0], v0[1]); w.y = pg8::cvt_pk_bf16(v0[2], v0[3]); w.z = pg8::cvt_pk_bf16(v1[0], v1[1]); w.w = pg8::cvt_pk_bf16(v1[2], v1[3]); return w;
}

#define DPP_SHR(x, n) __int_as_float(__builtin_amdgcn_update_dpp(0, __float_as_int(x), 0x110 + (n), 0xf, 0xf, false))
__device__ __forceinline__ float rowscan16(float x) {
    x += DPP_SHR(x, 1); x += DPP_SHR(x, 2); x += DPP_SHR(x, 4); x += DPP_SHR(x, 8); return x;
}
__device__ __forceinline__ float bcast15(float x, int lane) { return __int_as_float(__builtin_amdgcn_ds_bpermute((lane | 15) << 2, __float_as_int(x))); }
__device__ __forceinline__ float expc(float x) { return __expf(fminf(x, 80.0f)); }
using pg8::Unit;
struct EpiPlain {
    static constexpr bool PERM = true; static constexpr int MID_T = 0;
    bf16_t* O; int ldc;
    __device__ __forceinline__ void operator()(const f32x4 (&acc)[2][2][4][2], const Unit& u, int wr, int wc, int fr, int fq) const {
        const int row0 = u.pm * 256 + wr * 64 + fr, col0 = u.pn * 256 + wc * 32 + 8 * fq;
#pragma unroll
        for (int ai = 0; ai < 2; ++ai)
#pragma unroll
            for (int m = 0; m < 4; ++m) { bf16_t* rowp = O + (size_t)(row0 + ai * 128 + m * 16) * ldc + col0;
#pragma unroll
                for (int bj = 0; bj < 2; ++bj) *(GAS u32x4*)((GAS bf16_t*)rowp + bj * 128) = pack8(acc[ai][bj][m][0], acc[ai][bj][m][1]); }
    }
};
struct EpiIn {
    static constexpr bool PERM = true; static constexpr int MID_T = 0;
    bf16_t* Z; bf16_t* KST; float* AUX; const float* ssq; const float* lb; const float* cosT; const float* sinT; int is_ret; LAS float* tab;
    __device__ __forceinline__ void operator()(const f32x4 (&acc)[2][2][4][2], const Unit& u, int wr, int wc, int fr, int fq) const {
        const int row0 = u.pm * 256 + wr * 64 + fr, jl = wc * 32 + 8 * fq, t = u.pn;
        rstd_table(ssq, u.pm, tab, wr, wc, fr, fq);
        const LAS float* tl = tab + wr * 64 + fr;
        if (t < 6) {
            if (!is_ret) {
                const f32x4 lb0 = *(const GAS f32x4*)((const GAS float*)lb + t * 128 + (jl >> 1)), lb1 = *(const GAS f32x4*)((const GAS float*)lb + t * 128 + (jl >> 1) + 64);
#pragma unroll
                for (int ai = 0; ai < 2; ++ai)
#pragma unroll
                    for (int mp = 0; mp < 2; ++mp) {
                        const int tok0 = u.pm * 256 + ai * 128 + wr * 64 + mp * 32, rlo = tok0 + fr, rhi = rlo + 16;
                        const float rs0 = tl[ai * 128 + mp * 32], rs1 = tl[ai * 128 + mp * 32 + 16];
                        f32x4 qsv[2][2], ksv[2][2], ktv[2][2], erv[2], dcv[2];
#pragma unroll
                        for (int n = 0; n < 2; ++n)
#pragma unroll
                            for (int i = 0; i < 4; ++i) {
                                const float lbv = n ? lb1[i] : lb0[i];
                                float g[2], kk[2], qq[2];
#pragma unroll
                                for (int e = 0; e < 2; ++e) {
                                    const float x = acc[ai][1][2 * mp + e][n][i] * (e ? rs1 : rs0), za = acc[ai][0][2 * mp + e][n][i] * (e ? rs1 : rs0);
                                    const float a = __expf(-fabsf(x)), r = fast_rcp(1.0f + a);
                                    const float sneg = x >= 0.f ? a * r : r;
                                    const float em = x >= 0.f ? a : fminf(fast_rcp(a), 1.0686475e13f);
                                    g[e] = (fminf(x, 0.f) - __logf(1.0f + a)) + __logf(1.0f + lbv * em);
                                    kk[e] = (1.0f - lbv) * sneg;
                                    qq[e] = siluf_(za);
                                }
                                const float blo = rowscan16(g[0]), ref = bcast15(blo, fq * 16 + fr), bhi = ref + rowscan16(g[1]), blast = bcast15(bhi, fq * 16 + fr);
                                qsv[0][n][i] = qq[0] * expc(blo - ref); qsv[1][n][i] = qq[1] * expc(bhi - ref);
                                ksv[0][n][i] = kk[0] * expc(ref - blo); ksv[1][n][i] = kk[1] * expc(ref - bhi);
                                ktv[0][n][i] = kk[0] * __expf(blast - blo); ktv[1][n][i] = kk[1] * __expf(blast - bhi);
                                erv[n][i] = __expf(ref); dcv[n][i] = __expf(blast);
                            }
                        GAS bf16_t* zlo = (GAS bf16_t*)Z + (size_t)rlo * NIN + t * 256 + jl; GAS bf16_t* zhi = (GAS bf16_t*)Z + (size_t)rhi * NIN + t * 256 + jl;
                        *(GAS u32x4*)zlo = pack8(qsv[0][0], qsv[0][1]); *(GAS u32x4*)(zlo + 128) = pack8(ksv[0][0], ksv[0][1]);
                        *(GAS u32x4*)zhi = pack8(qsv[1][0], qsv[1][1]); *(GAS u32x4*)(zhi + 128) = pack8(ksv[1][0], ksv[1][1]);
                        *(GAS u32x4*)((GAS bf16_t*)KST + (size_t)rlo * MIXW + t * 128 + jl) = pack8(ktv[0][0], ktv[0][1]);
                        *(GAS u32x4*)((GAS bf16_t*)KST + (size_t)rhi * MIXW + t * 128 + jl) = pack8(ktv[1][0], ktv[1][1]);
                        if (fr == 15) { GAS float* ap = (GAS float*)AUX + ((size_t)((tok0 >> 11) * NH + t) * 64 + ((tok0 & 2047) >> 5)) * 256 + jl;
                            *(GAS f32x4*)ap = erv[0]; *(GAS f32x4*)(ap + 4) = erv[1]; *(GAS f32x4*)(ap + 128) = dcv[0]; *(GAS f32x4*)(ap + 132) = dcv[1]; }
                    }
            } else {
                const float lg = __log2f(1.0f - exp2f(-5.0f - (float)t));
#pragma unroll
                for (int ai = 0; ai < 2; ++ai)
#pragma unroll
                    for (int m = 0; m < 4; ++m) { const int row = row0 + ai * 128 + m * 16; const float rs = tl[ai * 128 + m * 16];
                        const f32x4 cs = *(const GAS f32x4*)((const GAS float*)cosT + (size_t)row * 64 + (jl >> 1)), sn = *(const GAS f32x4*)((const GAS float*)sinT + (size_t)row * 64 + (jl >> 1));
                        const float cp1 = (float)(16 * (m & 1) + fr + 1), pw = exp2f(cp1 * lg), ipw = exp2f(-cp1 * lg);
                        const float qsc = rs * pw, ksc = rs * 0.08838834764831845f * ipw;
                        f32x4 q0, q1, k0, k1;
#pragma unroll
                        for (int i = 0; i < 4; ++i) {
                            const float a1 = acc[ai][0][m][0][i] * qsc, a2 = acc[ai][0][m][1][i] * qsc; q0[i] = a1 * cs[i] - a2 * sn[i]; q1[i] = a1 * sn[i] + a2 * cs[i];
                            const float b1 = acc[ai][1][m][0][i] * ksc, b2 = acc[ai][1][m][1][i] * ksc; k0[i] = b1 * cs[i] - b2 * sn[i]; k1[i] = b1 * sn[i] + b2 * cs[i];
                        }
                        GAS bf16_t* zp = (GAS bf16_t*)Z + (size_t)row * NIN + t * 256 + jl; *(GAS u32x4*)zp = pack8(q0, q1); *(GAS u32x4*)(zp + 128) = pack8(k0, k1); }
            }
        } else {
            const int mode = (t >= 9 && t < 12) ? (is_ret ? 2 : 1) : 0;
#pragma unroll
            for (int ai = 0; ai < 2; ++ai)
#pragma unroll
                for (int m = 0; m < 4; ++m) { const int row = row0 + ai * 128 + m * 16; const float rs = tl[ai * 128 + m * 16];
                    GAS bf16_t* zp = (GAS bf16_t*)Z + (size_t)row * NIN + t * 256 + jl;
#pragma unroll
                    for (int bj = 0; bj < 2; ++bj) { f32x4 v0 = acc[ai][bj][m][0] * rs, v1 = acc[ai][bj][m][1] * rs;
                        if (mode == 1) {
#pragma unroll
                            for (int i = 0; i < 4; ++i) { v0[i] = sigmoidf_(v0[i]); v1[i] = sigmoidf_(v1[i]); } }
                        else if (mode == 2) {
#pragma unroll
                            for (int i = 0; i < 4; ++i) { v0[i] = siluf_(v0[i]); v1[i] = siluf_(v1[i]); } }
                        *(GAS u32x4*)(zp + bj * 128) = pack8(v0, v1); } }
        }
    }
};
struct EpiRes {
    static constexpr bool PERM = true; static constexpr int MID_T = 0;
    const bf16_t* xin; bf16_t* xb; float* ssq;
    __device__ __forceinline__ void operator()(const f32x4 (&acc)[2][2][4][2], const Unit& u, int wr, int wc, int fr, int fq) const {
        const int row0 = u.pm * 256 + wr * 64 + fr, col0 = u.pn * 256 + wc * 32 + 8 * fq;
#pragma unroll
        for (int ai = 0; ai < 2; ++ai)
#pragma unroll
            for (int m = 0; m < 4; ++m) { const int row = row0 + ai * 128 + m * 16; const size_t off = (size_t)row * D + col0; float s = 0.f;
#pragma unroll
                for (int bj = 0; bj < 2; ++bj) {
                    const u32x4 r = *(const GAS u32x4*)((const GAS bf16_t*)xin + off + bj * 128);
                    f32x4 v0, v1;
                    v0[0] = bf2f(r.x & 0xffffu); v0[1] = bf2f(r.x >> 16); v0[2] = bf2f(r.y & 0xffffu); v0[3] = bf2f(r.y >> 16);
                    v1[0] = bf2f(r.z & 0xffffu); v1[1] = bf2f(r.z >> 16); v1[2] = bf2f(r.w & 0xffffu); v1[3] = bf2f(r.w >> 16);
                    v0 = v0 + acc[ai][bj][m][0]; v1 = v1 + acc[ai][bj][m][1];
                    *(GAS u32x4*)((GAS bf16_t*)xb + off + bj * 128) = pack8(v0, v1);
                    s += (v0[0] * v0[0] + v0[1] * v0[1]) + (v0[2] * v0[2] + v0[3] * v0[3]) + (v1[0] * v1[0] + v1[1] * v1[1]) + (v1[2] * v1[2] + v1[3] * v1[3]);
                }
                s += shfl_xor_l(s, fq * 16 + fr, 16); s += shfl_xor_l(s, fq * 16 + fr, 32);
                if (fq == 0) ((GAS float*)ssq)[(size_t)row * 16 + u.pn * 4 + wc] = s; }
    }
};
struct EpiResC {
    static constexpr bool PERM = true; static constexpr int MID_T = 12;
    EpiRes base; const float* ssqo;
    __device__ __forceinline__ void mid(f32x4 (&acc)[2][2][4][2], const Unit& u, int wr, int wc, int fr, int fq) const {
        if (!ssqo) return;
        const int row0 = u.pm * 256 + wr * 64 + fr;
#pragma unroll
        for (int ai = 0; ai < 2; ++ai)
#pragma unroll
            for (int m = 0; m < 4; ++m) { const int row = row0 + ai * 128 + m * 16;
                const GAS f32x4* sp = (const GAS f32x4*)((const GAS float*)ssqo + (size_t)row * 16); float tot = 0.f;
#pragma unroll
                for (int q4 = 0; q4 < (NH * NVS + 3) / 4; ++q4) { const f32x4 a = sp[q4];
#pragma unroll
                    for (int e = 0; e < 4; ++e) if (4 * q4 + e < NH * NVS) tot += a[e]; }
                const float rs = rsqrtf(tot * (1.0f / MIXW) + EPS);
#pragma unroll
                for (int bj = 0; bj < 2; ++bj)
#pragma unroll
                    for (int n = 0; n < 2; ++n) acc[ai][bj][m][n] = acc[ai][bj][m][n] * rs;
                asm volatile("" ::: "memory"); }
    }
    __device__ __forceinline__ void operator()(const f32x4 (&acc)[2][2][4][2], const Unit& u, int wr, int wc, int fr, int fq) const { base(acc, u, wr, wc, fr, fq); }
};
struct EpiFfn {
    static constexpr bool PERM = true; static constexpr int MID_T = 0;
    bf16_t* act; const float* ssq; LAS float* tab;
    __device__ __forceinline__ void operator()(const f32x4 (&acc)[2][2][4][2], const Unit& u, int wr, int wc, int fr, int fq) const {
        const int row0 = u.pm * 256 + wr * 64 + fr, jl = wc * 32 + 8 * fq;
        rstd_table(ssq, u.pm, tab, wr, wc, fr, fq);
        const LAS float* tl = tab + wr * 64 + fr;
#pragma unroll
        for (int ai = 0; ai < 2; ++ai)
#pragma unroll
            for (int m = 0; m < 4; ++m) { const int row = row0 + ai * 128 + m * 16; const float rs = tl[ai * 128 + m * 16];
                f32x4 v0, v1;
#pragma unroll
                for (int i = 0; i < 4; ++i) { v0[i] = siluf_(acc[ai][0][m][0][i] * rs) * (acc[ai][1][m][0][i] * rs); v1[i] = siluf_(acc[ai][0][m][1][i] * rs) * (acc[ai][1][m][1][i] * rs); }
                *(GAS u32x4*)((GAS bf16_t*)act + (size_t)row * DFF + u.pn * 128 + jl) = pack8(v0, v1); }
    }
};

#define XB_TMO      128
#define XB_XCNT(j)  (256  + 64 * (j))
#define XB_XSUB(j)  (1280 + 64 * (j))
#define XB_XGEN(j)  (2304 + 64 * (j))
#define XB_TOP      3328
#define XB_TOPGEN   3392
#define XCD_BAR_WORDS 3456
#define XB_SPIN_CAP (1u << 18)
__device__ __forceinline__ unsigned xb_ld(unsigned* p)              { return __hip_atomic_load(p, __ATOMIC_RELAXED, __HIP_MEMORY_SCOPE_AGENT); }
__device__ __forceinline__ unsigned xb_add(unsigned* p, unsigned v) { return __hip_atomic_fetch_add(p, v, __ATOMIC_RELAXED, __HIP_MEMORY_SCOPE_AGENT); }
__device__ __forceinline__ unsigned xb_xcc_id() { return (unsigned)__builtin_amdgcn_s_getreg((3 << 11) | 20) & 0xFu; }
#define XB_SPIN(cond, bar) do { unsigned _sp = 0; while (cond) { __builtin_amdgcn_s_sleep(1); \
    if ((++_sp & 255u) == 0u) { if (xb_ld(&(bar)[XB_TMO])) break; if (_sp > XB_SPIN_CAP) { atomicAdd(&(bar)[XB_TMO], 1u); break; } } } } while (0)
struct XcdBarrier { unsigned* bar; unsigned x; volatile LAS unsigned* st; };
__device__ __forceinline__ XcdBarrier xcd_barrier_post(unsigned* bar, volatile LAS unsigned* st) {
    XcdBarrier b; b.bar = bar; b.x = xb_xcc_id(); b.st = st;
    if (threadIdx.x == 0) st[2] = xb_add(&bar[XB_XCNT(b.x)], 1u);
    return b;
}
#define XB_LOC(j) (3456 + 64 * (j))
__device__ __forceinline__ void xcc_barrier(const XcdBarrier& b, unsigned n, bool leader) {
    asm volatile("s_waitcnt vmcnt(0)" ::: "memory");
    __syncthreads();
    if (leader) {
        unsigned* bar = b.bar; unsigned* cnt = &bar[XB_LOC(b.x)];
        __builtin_amdgcn_s_waitcnt(0);
        const unsigned old = xb_add(cnt, 1u), target = (old / n + 1u) * n;
        XB_SPIN(xb_ld(cnt) < target, bar);
        __builtin_amdgcn_fence(__ATOMIC_ACQUIRE, "agent");
        asm volatile("s_waitcnt vmcnt(0)" ::: "memory");
    }
    __syncthreads();
}
__device__ __forceinline__ void xcd_barrier_complete(unsigned* bar, unsigned x, unsigned& nloc, unsigned& nx) {
    const unsigned G = gridDim.x * gridDim.y * gridDim.z;
    unsigned sum, cnt, mine, sp = 0u;
    for (;;) {
        sum = 0u; cnt = 0u; mine = 0u;
#pragma unroll
        for (unsigned j = 0; j < 16; ++j) { const unsigned c = xb_ld(&bar[XB_XCNT(j)]); sum += c; cnt += (c > 0u) ? 1u : 0u; mine = (j == x) ? c : mine; }
        if (sum == G) break;
        __builtin_amdgcn_s_sleep(1);
        if ((++sp & 255u) == 0u) { if (xb_ld(&bar[XB_TMO])) break; if (sp > XB_SPIN_CAP) { atomicAdd(&bar[XB_TMO], 1u); break; } }
    }
    nloc = mine > 0u ? mine : 1u; nx = cnt > 0u ? cnt : 1u;
}
__device__ __forceinline__ void xcd_barrier(const XcdBarrier& b, bool leader) {
    asm volatile("s_waitcnt vmcnt(0)" ::: "memory");
    __syncthreads();
    if (leader) {
        unsigned* bar = b.bar;
        __builtin_amdgcn_s_waitcnt(0);
        unsigned nloc = b.st[0], nx = b.st[1];
        if (nloc == 0u) { xcd_barrier_complete(bar, b.x, nloc, nx); b.st[0] = nloc; b.st[1] = nx; }
        const unsigned old = xb_add(&bar[XB_XSUB(b.x)], 1u);
        const unsigned gen = old / nloc;
        if (old + 1u == (gen + 1u) * nloc) {
            __builtin_amdgcn_fence(__ATOMIC_RELEASE, "agent");
            asm volatile("s_waitcnt vmcnt(0)" ::: "memory");
            const unsigned og = xb_add(&bar[XB_TOP], 1u);
            const unsigned tg = og / nx;
            if (og + 1u == (tg + 1u) * nx) xb_add(&bar[XB_TOPGEN], 1u);
            else XB_SPIN(xb_ld(&bar[XB_TOPGEN]) == tg, bar);
            __builtin_amdgcn_fence(__ATOMIC_ACQUIRE, "agent");
            xb_add(&bar[XB_XGEN(b.x)], 1u);
            asm volatile("s_waitcnt vmcnt(0)" ::: "memory");
        } else {
            XB_SPIN(xb_ld(&bar[XB_XGEN(b.x)]) == gen, bar);
            __builtin_amdgcn_fence(__ATOMIC_ACQUIRE, "agent");
            asm volatile("s_waitcnt vmcnt(0)" ::: "memory");
        }
    }
    __syncthreads();
}

constexpr int RING_BYTES = 131072, LDSCTL_OFF = RING_BYTES, MISC_OFF = LDSCTL_OFF + 320, LDS_BYTES = 147456;
constexpr int NWAVES = 8;

__device__ __forceinline__ int misc_rd(LAS unsigned char* lds, int idx) { unsigned off = (unsigned)(MISC_OFF + 4 * idx); asm volatile("" : "+v"(off)); return __builtin_amdgcn_readfirstlane((int)*(volatile LAS unsigned*)(lds + off)); }
struct Args { const float* in[15]; float* out; unsigned char* ws; int ph_lo, ph_hi; };

__device__ __forceinline__ int win_srccol(int j) {
    const int t = j >> 8;
    if (t >= 6) return j;
    const int jj = j & 255, half = jj >> 7, p = jj & 127, d = 4 * (p >> 3) + (p & 3) + 64 * ((p >> 2) & 1);
    return half * MIXW + t * 128 + d;
}
__device__ __forceinline__ int wfi_srccol(int j) { const int t = j >> 8, jj = j & 255; return (jj < 128 ? 0 : DFF) + t * 128 + (jj & 127); }
struct TItem { const GAS float* W; GAS bf16_t* WT; const GAS float* kscale; int K, N, ndst, kind, nscale, item; };
__device__ __forceinline__ TItem titem_decode(const Args& a, unsigned char* ws, int it) {
    constexpr int I0 = 16 * (NIN / 32), I1 = 16 * 32, I2 = 16 * (NFI / 32), I3 = (DFF / 64) * 32, I4 = 16 * 16, IL = I0 + I1 + I2 + I3 + I4;
    const int l = it / IL; int r = it % IL; TItem t;
    if (r < I0) { t.W = (const GAS float*)a.in[4] + (size_t)l * D * NIN; t.WT = (GAS bf16_t*)(ws + WS_WIN) + (size_t)l * NIN * D; t.kscale = (const GAS float*)a.in[3] + l * D; t.K = D; t.N = NIN; t.ndst = NIN; t.kind = 0; t.nscale = D; t.item = r; return t; } r -= I0;
    if (r < I1) { t.W = (const GAS float*)a.in[5] + (size_t)l * D * D; t.WT = (GAS bf16_t*)(ws + WS_WOUT) + (size_t)l * D * D; t.kscale = (const GAS float*)((l & 1) ? a.in[10] : a.in[9]) + (l >> 1) * MIXW; t.K = D; t.N = D; t.ndst = D; t.kind = 1; t.nscale = MIXW; t.item = r; return t; } r -= I1;
    if (r < I2) { t.W = (const GAS float*)a.in[12] + (size_t)l * D * NFI; t.WT = (GAS bf16_t*)(ws + WS_WFI) + (size_t)l * NFI * D; t.kscale = (const GAS float*)a.in[11] + l * D; t.K = D; t.N = NFI; t.ndst = NFI; t.kind = 2; t.nscale = D; t.item = r; return t; } r -= I2;
    if (r < I3) { t.W = (const GAS float*)a.in[13] + (size_t)l * DFF * D; t.WT = (GAS bf16_t*)(ws + WS_WFO) + (size_t)l * D * DFF; t.kscale = (const GAS float*)a.in[13]; t.K = DFF; t.N = D; t.ndst = D; t.kind = 3; t.nscale = 0; t.item = r; return t; } r -= I3;
    t.W = (const GAS float*)a.in[7] + (size_t)l * D * 512; t.WT = (GAS bf16_t*)(ws + WS_WM) + (size_t)l * 512 * D; t.kscale = (const GAS float*)a.in[6] + l * D; t.K = D; t.N = 512; t.ndst = 512; t.kind = 4; t.nscale = D; t.item = r; return t;
}
__device__ __forceinline__ void titem_load(const TItem& t, f32x4 (&v)[8], int lane) {
    const int nblk = t.ndst / 32, kb = t.item / nblk, nb = t.item % nblk, k0 = 64 * kb, n0 = 32 * nb, kq = lane >> 3, jd = n0 + 4 * (lane & 7);
    const int sc = t.kind == 0 ? win_srccol(jd) : (t.kind == 2 ? wfi_srccol(jd) : jd);
#pragma unroll
    for (int i = 0; i < 8; ++i) v[i] = *(const GAS f32x4*)(t.W + (size_t)(k0 + 8 * i + kq) * t.N + sc);
}
__device__ __forceinline__ void titem_store(const TItem& t, const f32x4 (&v)[8], LAS float* scr, int lane) {
    const int nblk = t.ndst / 32, kb = t.item / nblk, nb = t.item % nblk, k0 = 64 * kb, n0 = 32 * nb, kq = lane >> 3, nq = lane & 7;
#pragma unroll
    for (int i = 0; i < 8; ++i)
#pragma unroll
        for (int e = 0; e < 4; ++e) scr[(8 * i + kq) * 33 + 4 * nq + e] = v[i][e];
    const int c = lane & 7;
    f32x4 s0 = (f32x4){1.f, 1.f, 1.f, 1.f}, s1 = s0;
    if (k0 + 8 * c < t.nscale) { s0 = *(const GAS f32x4*)(t.kscale + k0 + 8 * c); s1 = *(const GAS f32x4*)(t.kscale + k0 + 8 * c + 4); }
    asm volatile("s_waitcnt lgkmcnt(0)" ::: "memory");
#pragma unroll
    for (int j = 0; j < 4; ++j) { const int n = (lane >> 3) + 8 * j; const LAS float* s = scr + (8 * c) * 33 + n;
        u32x4 o; o.x = pk2(s[0 * 33] * s0[0], s[1 * 33] * s0[1]); o.y = pk2(s[2 * 33] * s0[2], s[3 * 33] * s0[3]); o.z = pk2(s[4 * 33] * s1[0], s[5 * 33] * s1[1]); o.w = pk2(s[6 * 33] * s1[2], s[7 * 33] * s1[3]);
        *(GAS u32x4*)(t.WT + (size_t)(n0 + n) * t.K + k0 + 8 * c) = o; }
    asm volatile("s_waitcnt lgkmcnt(0)" ::: "memory");
}

constexpr int TITEMS_PER_LAYER = 16 * (NIN / 32) + 16 * 32 + 16 * (NFI / 32) + (DFF / 64) * 32 + 16 * 16;
__device__ __forceinline__ void convert_weights(const Args& a, unsigned char* ws, LAS float* scr, int it0, int it1, int w, int nw, int lane, int off = 0, int mul = 1) {
    f32x4 va[8], vb[8];
    nw *= mul;
    int it = it0 + off + mul * w;
    if (it < it1) { const TItem t = titem_decode(a, ws, it); titem_load(t, va, lane); }
    while (it < it1) {
        const int itn = it + nw;
        if (itn < it1) { const TItem t = titem_decode(a, ws, itn); titem_load(t, vb, lane); }
        { const TItem t = titem_decode(a, ws, it); titem_store(t, va, scr, lane); }
        it = itn;
        if (it >= it1) break;
        const int itn2 = it + nw;
        if (itn2 < it1) { const TItem t = titem_decode(a, ws, itn2); titem_load(t, va, lane); }
        { const TItem t = titem_decode(a, ws, it); titem_store(t, vb, scr, lane); }
        it = itn2;
    }
}

__device__ __forceinline__ void p0_prologue(const Args& a, unsigned char* ws, LAS unsigned char* lds, int gw, int NGW, int wave, int lane) {
    LAS float* scr = (LAS float*)(lds + wave * 16384);
    convert_weights(a, ws, scr, 0, 16 * (NIN / 32), gw, NGW, lane);
    for (int l = 0; l < DEPTH; ++l) convert_weights(a, ws, scr, l * TITEMS_PER_LAYER + TITEMS_PER_LAYER - 256, (l + 1) * TITEMS_PER_LAYER, gw, NGW, lane);
    for (int m = gw; m < M; m += NGW) {
        const f32x4* xr = (const f32x4*)(a.in[0] + (size_t)m * D) + lane; f32x4 v[4]; float s = 0.f;
#pragma unroll
        for (int j = 0; j < 4; ++j) { v[j] = xr[64 * j]; s += (v[j].x * v[j].x + v[j].y * v[j].y) + (v[j].z * v[j].z + v[j].w * v[j].w); }
        s = wave_sum(s, lane);
        u32x2* o8 = (u32x2*)((bf16_t*)(ws + WS_XB) + (size_t)m * D) + lane;
#pragma unroll
        for (int j = 0; j < 4; ++j) { u32x2 w; w.x = pk2(v[j].x, v[j].y); w.y = pk2(v[j].z, v[j].w); o8[64 * j] = w; }
        if (lane < 16) ((float*)(ws + WS_SSQA))[(size_t)m * 16 + lane] = lane == 0 ? s : 0.f;
    }
    for (int m = gw; m < MROWS; m += NGW) {
        const f32x4* xr = (const f32x4*)(a.in[1] + (size_t)m * D) + lane; f32x4 v[4]; float s = 0.f;
#pragma unroll
        for (int j = 0; j < 4; ++j) { v[j] = xr[64 * j]; s += (v[j].x * v[j].x + v[j].y * v[j].y) + (v[j].z * v[j].z + v[j].w * v[j].w); }
        const float rs = rsqrtf(wave_sum(s, lane) * (1.0f / D) + EPS);
        u32x2* o8 = (u32x2*)((bf16_t*)(ws + WS_MEMB) + (size_t)m * D) + lane;
#pragma unroll
        for (int j = 0; j < 4; ++j) { u32x2 w; w.x = pk2(v[j].x * rs, v[j].y * rs); w.y = pk2(v[j].z * rs, v[j].w * rs); o8[64 * j] = w; }
    }
    {   const double invf = exp(-9.210340371976184 * ((double)lane / 63.0));
        for (int m = gw; m < M; m += NGW) {
            const double ang = (double)((const GAS int*)a.in[2])[m] * invf;
            const double kr = rint(ang * 0.15915494309189535);
            const float r = (float)fma(-kr, 1.2246467991473532e-16 * 2.0, fma(-kr, 6.283185307179586, ang));
            float sn, cs; sincosf(r, &sn, &cs);
            ((GAS float*)(ws + WS_COS))[(size_t)m * 64 + lane] = cs;
            ((GAS float*)(ws + WS_SIN))[(size_t)m * 64 + lane] = sn;
        }
    }
    for (int c = gw * 64 + lane; c < MIXW; c += NGW * 64) {
        const float l0 = a.in[8][c], l1 = a.in[8][MIXW + c]; const float mx = fmaxf(l0, l1), e0 = expf(l0 - mx), e1 = expf(l1 - mx);
        ((float*)(ws + WS_LB))[c] = 0.f; ((float*)(ws + WS_LB))[MIXW + c] = e1 / (e0 + e1);
    }
}

typedef float f32x16 __attribute__((ext_vector_type(16)));
constexpr int SC_QS = 0, SC_KS = 8704, SC_KST = 17408, SC_V = 27648, SC_P = 37888, SC_AUX = 40448, SC_OUT = 41472, SC_SSQ = 50176, SC_GATE = 50688, SC_BUF = 50688 + 32 * VPR * 16;
constexpr int PQ = 272, PT = 320;
constexpr int NCHUNK = SEQ / 32;
typedef const GAS bf16_t* gbf;
struct HRegs { u32x4 x0[8], x1[8]; float aux[2]; };
__device__ __forceinline__ bf16x8 as_bf16x8(u32x4 v) { return __builtin_bit_cast(bf16x8, v); }

struct StLane { unsigned g0, g1, gg, ga, l0, l1, lg, la, sk; };
template <int IS_RET>
__device__ __forceinline__ void stager_load(HRegs& R, gbf Z, gbf KST, const GAS float* AUXG, int b, int h, int unit, int sw, const StLane& L, int chunk) {
    chunk = chunk < NCHUNK ? chunk : NCHUNK - 1;
    const size_t tok0 = (size_t)b * SEQ + chunk * 32;
    const int p0 = (sw == 0 || IS_RET) ? NIN : MIXW;
    const GAS char* s0 = (const GAS char*)(sw == 0 ? Z + h * 256 : (IS_RET ? Z + h * 256 + 128 : KST + h * 128)) + tok0 * p0 * 2;
    const GAS char* s1 = (const GAS char*)(sw == 0 ? Z + h * 256 + 128 : Z + 1536 + h * 128) + tok0 * NIN * 2;
#pragma unroll
    for (int i = 0; i < 8; ++i) R.x0[i] = *(const GAS u32x4*)(s0 + (size_t)(4 * i) * p0 * 2 + L.g0);
    if (sw == 0) {
#pragma unroll
        for (int i = 0; i < 8; ++i) R.x1[i] = *(const GAS u32x4*)(s1 + 32 * i + L.g1);
    } else {
#pragma unroll
        for (int i = 0; i < 8 / NVS; ++i) R.x1[i] = *(const GAS u32x4*)(s1 + (size_t)(4 * NVS * i) * NIN * 2 + L.g1);
    }
    if (!IS_RET) { const GAS char* ag = (const GAS char*)(AUXG + ((size_t)unit * 64 + chunk) * 256 + 128 * sw); R.aux[0] = *(const GAS float*)(ag + L.ga); R.aux[1] = *(const GAS float*)(ag + 256 + L.ga); }
}
template <int IS_RET>
__device__ __forceinline__ void stager_stage(const HRegs& R, LAS unsigned char* buf, LAS unsigned char* gbuf, int sw, const StLane& L) {
    const int o0 = sw == 0 ? SC_QS : SC_KST, o1 = sw == 0 ? SC_KS : SC_V, pit = sw == 0 ? PQ : PT;
    LAS unsigned char* d0 = buf + o0 + L.l0; LAS unsigned char* d1 = buf + o1 + L.l1;
#pragma unroll
    for (int i = 0; i < 8; ++i) *(LAS u32x4*)(d0 + 4 * i * pit) = R.x0[i];
    if (sw != 0) {
#pragma unroll
        for (int i = 0; i < 8 / NVS; ++i) *(LAS u32x4*)(d1 + 4 * NVS * i * PT) = R.x1[i];
    }
    if (!IS_RET) { LAS unsigned char* al = buf + SC_AUX + 512 * sw + L.la; *(LAS float*)al = R.aux[0]; *(LAS float*)(al + 256) = R.aux[1]; }
}
__device__ __forceinline__ void scores_stage(const HRegs& R, LAS unsigned char* buf, const StLane& L, int l31, int hh) {
    f32x16 d;
#pragma unroll
    for (int r = 0; r < 16; ++r) d[r] = 0.f;
    u32x4 qf[8];
    {   const unsigned aq = (unsigned)(size_t)(buf + SC_QS) + L.sk;
        asm volatile(
            "ds_read_b128 %0, %8 offset:0\n\tds_read_b128 %1, %8 offset:32\n\tds_read_b128 %2, %8 offset:64\n\tds_read_b128 %3, %8 offset:96\n\t"
            "ds_read_b128 %4, %8 offset:128\n\tds_read_b128 %5, %8 offset:160\n\tds_read_b128 %6, %8 offset:192\n\tds_read_b128 %7, %8 offset:224\n\t"
            "s_waitcnt lgkmcnt(0)"
            : "=&v"(qf[0]), "=&v"(qf[1]), "=&v"(qf[2]), "=&v"(qf[3]), "=&v"(qf[4]), "=&v"(qf[5]), "=&v"(qf[6]), "=&v"(qf[7])
            : "v"(aq) : "memory");
        __builtin_amdgcn_sched_barrier(0);
    }
#pragma unroll
    for (int kk = 0; kk < 8; ++kk) d = __builtin_amdgcn_mfma_f32_32x32x16_bf16(as_bf16x8(R.x1[kk]), as_bf16x8(qf[kk]), d, 0, 0, 0);
#pragma unroll
    for (int q = 0; q < 4; ++q) { float v4[4];
#pragma unroll
        for (int i = 0; i < 4; ++i) { const int srow = 8 * q + 4 * hh + i; v4[i] = (srow <= l31) ? d[4 * q + i] : 0.f; }
        u32x2 w; w.x = pg8::cvt_pk_bf16(v4[0], v4[1]); w.y = pg8::cvt_pk_bf16(v4[2], v4[3]);
        *(LAS u32x2*)(buf + SC_P + l31 * 80 + (8 * q + 4 * hh) * 2) = w; }
}
struct FinLane { unsigned lo, ls, go, gs, gz; };
constexpr int FPT = 32 * VPR / 64;
template <int IS_RET>
__device__ __forceinline__ void gate_load(u32x4 (&g)[FPT], gbf Z, int b, int h, const FinLane& L, int chunk) {
    chunk = chunk < NCHUNK ? chunk : NCHUNK - 1;
    const GAS char* sg = (const GAS char*)(Z + 2304 + h * 128) + ((size_t)b * SEQ + chunk * 32) * NIN * 2;
#pragma unroll
    for (int i = 0; i < FPT; ++i) g[i] = *(const GAS u32x4*)(sg + (size_t)(64 / VPR * i) * NIN * 2 + L.gz);
}
__device__ __forceinline__ void gate_stage(const u32x4 (&g)[FPT], LAS unsigned char* buf, int lane) {
#pragma unroll
    for (int i = 0; i < FPT; ++i) *(LAS u32x4*)(buf + SC_GATE + (lane + 64 * i) * 16) = g[i];
}
template <int IS_RET>
__device__ __forceinline__ void fin_store(LAS unsigned char* buf, GAS bf16_t* CAT, GAS float* SSQO, int b, int h, int vh, const FinLane& L, int lane, bool first, int chunk) {
    const size_t tok0 = (size_t)b * SEQ + chunk * 32;
    GAS char* cg = (GAS char*)(CAT + tok0 * D + h * 128); GAS char* sgp = (GAS char*)(SSQO + tok0 * 16 + h * NVS + vh);
#pragma unroll
    for (int i = 0; i < FPT; ++i) {
        const u32x2 lo = *(const LAS u32x2*)(buf + SC_OUT + (64 / VPR) * i * PQ + L.lo), hi = *(const LAS u32x2*)(buf + SC_OUT + (64 / VPR) * i * PQ + 8 + L.lo);
        const LAS unsigned char* sq = buf + SC_SSQ + (64 / VPR) * 4 * i + L.ls;
        float ssum = *(const LAS float*)sq;
#pragma unroll
        for (int w = 1; w < 4 / NVS; ++w) ssum += *(const LAS float*)(sq + 128 * w);
        const float sc = (IS_RET && NVS == 1) ? rsqrtf(ssum * (1.0f / HD) + EPS) : 1.0f;
        const u32x4 gt = *(const LAS u32x4*)(buf + SC_GATE + (lane + 64 * i) * 16);
        const unsigned ow[4] = {lo.x, lo.y, hi.x, hi.y}; u32x4 out;
#pragma unroll
        for (int j = 0; j < 4; ++j) out[j] = pg8::cvt_pk_bf16(__uint_as_float(ow[j] << 16) * sc * __uint_as_float(gt[j] << 16), __uint_as_float(ow[j] & 0xffff0000u) * sc * __uint_as_float(gt[j] & 0xffff0000u));
        *(GAS u32x4*)(cg + (size_t)(64 / VPR * i) * D * 2 + L.go) = out;
        if ((!IS_RET || NVS > 1) && first) *(GAS float*)(sgp + (size_t)(64 / VPR * i) * 64 + L.gs) = ssum; }
}
__device__ __forceinline__ void norm_rows(unsigned char* ws, int row0, int row1, int gw, int NGW, int lane) {
    GAS bf16_t* CAT = (GAS bf16_t*)(ws + WS_CAT); const GAS float* SSQO = (const GAS float*)(ws + WS_SSQO);
    for (int row = row0 + gw; row < row1; row += NGW) {
#pragma unroll
        for (int j = 0; j < 3; ++j) { const int e = lane * 4 + 256 * j, h = e >> 7;
            float ssum = 0.f;
#pragma unroll
            for (int q = 0; q < NVS; ++q) ssum += SSQO[(size_t)row * 16 + h * NVS + q];
            const float sc = rsqrtf(ssum * (1.0f / HD) + EPS);
            GAS u32x2* p = (GAS u32x2*)(CAT + (size_t)row * D + e); const u32x2 w = *p; u32x2 o;
            o.x = pg8::cvt_pk_bf16(__uint_as_float(w.x << 16) * sc, __uint_as_float(w.x & 0xffff0000u) * sc); o.y = pg8::cvt_pk_bf16(__uint_as_float(w.y << 16) * sc, __uint_as_float(w.y & 0xffff0000u) * sc);
            *p = o; }
    }
}
#define TRR(dst, areg, off) "ds_read_b64_tr_b16 " dst ", " areg " offset:" #off "\n\t"
struct MLane { unsigned av, ak, aq, aaux, ap, aout, assq; };
template <int IS_RET, int PAR>
__device__ __forceinline__ void mfma_step(f32x16 (&S)[4], const MLane& A, int lane, float g32) {
    constexpr unsigned PB = PAR * SC_BUF;
    u32x2 v00, v01, v10, v11, k[4][2][2]; u32x4 qf[4][2];
    const unsigned av = A.av + PB, ak = A.ak + PB, aq = A.aq + PB;
    asm volatile(
        "ds_read_b128 %0, %8 offset:0\n\tds_read_b128 %1, %8 offset:32\n\tds_read_b128 %2, %8 offset:64\n\tds_read_b128 %3, %8 offset:96\n\t"
        "ds_read_b128 %4, %8 offset:128\n\tds_read_b128 %5, %8 offset:160\n\tds_read_b128 %6, %8 offset:192\n\tds_read_b128 %7, %8 offset:224"
        : "=&v"(qf[0][0]), "=&v"(qf[0][1]), "=&v"(qf[1][0]), "=&v"(qf[1][1]), "=&v"(qf[2][0]), "=&v"(qf[2][1]), "=&v"(qf[3][0]), "=&v"(qf[3][1])
        : "v"(aq) : "memory");
    asm volatile(
        TRR("%0", "%12", 0) TRR("%1", "%12", 1280) TRR("%2", "%12", 5120) TRR("%3", "%12", 6400)
        TRR("%4", "%13", 0) TRR("%5", "%13", 1280) TRR("%6", "%13", 5120) TRR("%7", "%13", 6400)
        TRR("%8", "%13", 64) TRR("%9", "%13", 1344) TRR("%10", "%13", 5184) TRR("%11", "%13", 6464)
        : "=&v"(v00), "=&v"(v01), "=&v"(v10), "=&v"(v11),
          "=&v"(k[0][0][0]), "=&v"(k[0][0][1]), "=&v"(k[0][1][0]), "=&v"(k[0][1][1]), "=&v"(k[1][0][0]), "=&v"(k[1][0][1]), "=&v"(k[1][1][0]), "=&v"(k[1][1][1])
        : "v"(av), "v"(ak) : "memory");
    const LAS unsigned char* auxp = (const LAS unsigned char*)(size_t)(A.aaux + PB);
    bf16x8 sf[4][2];
#pragma unroll
    for (int kt = 0; kt < 4; ++kt) { f32x16 t = S[kt];
        if (!IS_RET) {
#pragma unroll
            for (int q = 0; q < 4; ++q) { const f32x4 e = *(const LAS f32x4*)(auxp + (32 * kt + 16 * (q >> 1) + 4 * (q & 1)) * 4);
#pragma unroll
                for (int i = 0; i < 4; ++i) t[4 * q + i] *= e[i]; } }
#pragma unroll
        for (int s2 = 0; s2 < 2; ++s2) { u32x4 pk;
#pragma unroll
            for (int j = 0; j < 4; ++j) pk[j] = pg8::cvt_pk_bf16(t[8 * s2 + 2 * j], t[8 * s2 + 2 * j + 1]);
            sf[kt][s2] = as_bf16x8(pk); } }
    asm volatile("s_waitcnt lgkmcnt(12)" : "+v"(qf[0][0]), "+v"(qf[0][1]), "+v"(qf[1][0]), "+v"(qf[1][1]), "+v"(qf[2][0]), "+v"(qf[2][1]), "+v"(qf[3][0]), "+v"(qf[3][1]) :: "memory");
    asm volatile(
        TRR("%0", "%8", 128) TRR("%1", "%8", 1408) TRR("%2", "%8", 5248) TRR("%3", "%8", 6528)
        TRR("%4", "%8", 192) TRR("%5", "%8", 1472) TRR("%6", "%8", 5312) TRR("%7", "%8", 6592)
        : "=&v"(k[2][0][0]), "=&v"(k[2][0][1]), "=&v"(k[2][1][0]), "=&v"(k[2][1][1]), "=&v"(k[3][0][0]), "=&v"(k[3][0][1]), "=&v"(k[3][1][0]), "=&v"(k[3][1][1])
        : "v"(ak) : "memory");
    __builtin_amdgcn_sched_barrier(0);
    f32x16 o;
#pragma unroll
    for (int r = 0; r < 16; ++r) o[r] = 0.f;
#pragma unroll
    for (int kt = 0; kt < 4; ++kt)
#pragma unroll
        for (int s2 = 0; s2 < 2; ++s2) o = __builtin_amdgcn_mfma_f32_32x32x16_bf16(sf[kt][s2], as_bf16x8(qf[kt][s2]), o, 0, 0, 0);
    __builtin_amdgcn_sched_barrier(0);
    asm volatile("s_waitcnt lgkmcnt(0)" : "+v"(v00), "+v"(v01), "+v"(v10), "+v"(v11),
          "+v"(k[0][0][0]), "+v"(k[0][0][1]), "+v"(k[0][1][0]), "+v"(k[0][1][1]), "+v"(k[1][0][0]), "+v"(k[1][0][1]), "+v"(k[1][1][0]), "+v"(k[1][1][1]),
          "+v"(k[2][0][0]), "+v"(k[2][0][1]), "+v"(k[2][1][0]), "+v"(k[2][1][1]), "+v"(k[3][0][0]), "+v"(k[3][0][1]), "+v"(k[3][1][0]), "+v"(k[3][1][1]) :: "memory");
    __builtin_amdgcn_sched_barrier(0);
    const bf16x8 vt[2] = {as_bf16x8((u32x4){v00.x, v00.y, v01.x, v01.y}), as_bf16x8((u32x4){v10.x, v10.y, v11.x, v11.y})};
    const LAS unsigned char* pp = (const LAS unsigned char*)(size_t)(A.ap + PB);
#pragma unroll
    for (int kk = 0; kk < 2; ++kk) { const bf16x8 pf = *(const LAS bf16x8*)(pp + 32 * kk);
        o = __builtin_amdgcn_mfma_f32_32x32x16_bf16(vt[kk], pf, o, 0, 0, 0); }
#pragma unroll
    for (int kt = 0; kt < 4; ++kt) {
        if (!IS_RET) {
#pragma unroll
            for (int q = 0; q < 4; ++q) { const f32x4 e = *(const LAS f32x4*)(auxp + 512 + (32 * kt + 16 * (q >> 1) + 4 * (q & 1)) * 4);
#pragma unroll
                for (int i = 0; i < 4; ++i) S[kt][4 * q + i] *= e[i]; } }
#pragma unroll
        for (int kk = 0; kk < 2; ++kk) S[kt] = __builtin_amdgcn_mfma_f32_32x32x16_bf16(as_bf16x8((u32x4){k[kt][kk][0].x, k[kt][kk][0].y, k[kt][kk][1].x, k[kt][kk][1].y}), vt[kk], S[kt], 0, 0, 0);
        if (IS_RET) S[kt] = S[kt] * g32;
    }
    float ss = 0.f;
#pragma unroll
    for (int r = 0; r < 16; ++r) ss += o[r] * o[r];
    ss += shfl_xor_l(ss, lane, 32);
    if (lane < 32) *(LAS float*)(size_t)(A.assq + PB) = ss;
    LAS unsigned char* op = (LAS unsigned char*)(size_t)(A.aout + PB);
#pragma unroll
    for (int q = 0; q < 4; ++q) { u32x2 wv; wv.x = pg8::cvt_pk_bf16(o[4 * q], o[4 * q + 1]); wv.y = pg8::cvt_pk_bf16(o[4 * q + 2], o[4 * q + 3]);
        *(LAS u32x2*)(op + 16 * q) = wv; }
}
template <int IS_RET, int VAR>
__device__ __forceinline__ void scan2_unit(unsigned char* ws, LAS unsigned char* lds, int unit, int tid) {
    constexpr bool MF_ON = VAR == 0 || ((VAR & 16) && (VAR & 1)), ST_ON = VAR == 0 || ((VAR & 16) && (VAR & 2)), FI_ON = VAR == 0 || ((VAR & 16) && (VAR & 4)), ST_LD = ST_ON && !(VAR & 64), ST_ST = ST_ON && !(VAR & 32);
    gbf Z = (gbf)(ws + WS_Z); gbf KST = (gbf)(ws + WS_KST); const GAS float* AUXG = (const GAS float*)(ws + WS_AUX);
    GAS bf16_t* CAT = (GAS bf16_t*)(ws + WS_CAT); GAS float* SSQO = (GAS float*)(ws + WS_SSQO);
    const int b = unit / (NH * NVS), h = (unit / NVS) % NH, vh = unit % NVS, hu = b * NH + h, wave = __builtin_amdgcn_readfirstlane(tid >> 6); int lane = tid & 63;
    const float g32 = exp2f(32.0f * __log2f(1.0f - exp2f(-5.0f - (float)h)));
    __syncthreads();
    static_assert(NVS == 2, "wave roles below are written for two value slices per head");
    if (wave >= 6) {
        __syncthreads();
        for (int n = 0; n < NCHUNK; ++n) __syncthreads();
    } else if (wave < 2) {
        asm volatile("" : "+v"(lane));
        const int l31 = lane & 31, hh = lane >> 5, vs = (128 / NVS) * vh + 32 * wave;
        const unsigned base = (unsigned)(size_t)lds, trl = (unsigned)((8 * hh + ((lane & 15) >> 2)) * PT + (16 * ((lane >> 4) & 1) + 4 * (lane & 3)) * 2);
        const int psw = ((lane & 3) == 1) ? 2 : (((lane & 3) == 2) ? 1 : (lane & 3));
        const unsigned trk = (unsigned)((8 * hh + ((lane & 15) >> 2)) * PT + (16 * ((lane >> 4) & 1) + 4 * psw) * 2);
        MLane A;
        A.av = base + SC_V + trl + vs * 2; A.ak = base + SC_KST + trk; A.aq = base + SC_QS + l31 * PQ + 16 * hh; A.aaux = base + SC_AUX + 32 * hh; A.ap = base + SC_P + l31 * 80 + 16 * hh;
        A.aout = base + SC_OUT + l31 * PQ + (vs + 4 * hh) * 2; A.assq = base + SC_SSQ + (wave * 32 + l31) * 4;
        asm volatile("" : "+v"(A.av), "+v"(A.ak), "+v"(A.aq), "+v"(A.aaux), "+v"(A.ap), "+v"(A.aout), "+v"(A.assq));
        f32x16 S[4];
#pragma unroll
        for (int kt = 0; kt < 4; ++kt)
#pragma unroll
            for (int r = 0; r < 16; ++r) S[kt][r] = 0.f;
        __syncthreads();
        for (int n = 0; n < NCHUNK; n += 2) {
            if (MF_ON) mfma_step<IS_RET, 0>(S, A, lane, g32);
            __syncthreads();
            if (MF_ON) mfma_step<IS_RET, 1>(S, A, lane, g32);
            __syncthreads();
        }
        if (!MF_ON) asm volatile("" :: "v"(S[0][0]));
    } else if (wave < 4) {
        const int sw = wave - 2;
        if (!ST_ON) { __syncthreads(); for (int n = 0; n < NCHUNK; ++n) __syncthreads(); }
        else {
        asm volatile("" : "+v"(lane));
        const int l31 = lane & 31, hh = lane >> 5, r4 = lane >> 4, c16 = lane & 15, p0 = (sw == 0 || IS_RET) ? NIN : MIXW;
        StLane L;
        L.g0 = (unsigned)((r4 * p0 + 8 * c16) * 2); L.gg = 0; L.ga = (unsigned)(lane * 4);
        L.l0 = (unsigned)(r4 * (sw == 0 ? PQ : PT) + 16 * c16); L.lg = (unsigned)(lane * 16); L.la = (unsigned)(lane * 4); L.sk = (unsigned)(l31 * PQ + 16 * hh);
        if (sw == 0) { L.g1 = (unsigned)((l31 * NIN + 8 * hh) * 2); L.l1 = 0; }
        else { const int rv = lane / VPR, cv = VPR * vh + lane % VPR; L.g1 = (unsigned)((rv * NIN + 8 * cv) * 2); L.l1 = (unsigned)(rv * PT + 16 * cv); }
        asm volatile("" : "+v"(L.g0), "+v"(L.g1), "+v"(L.gg), "+v"(L.ga), "+v"(L.l0), "+v"(L.l1), "+v"(L.lg), "+v"(L.la), "+v"(L.sk));
        HRegs RA, RB;
        stager_load<IS_RET>(RA, Z, KST, AUXG, b, h, hu, sw, L, 0);
        stager_stage<IS_RET>(RA, lds, lds + SC_BUF, sw, L);
        if (sw == 0) scores_stage(RA, lds, L, l31, hh);
        stager_load<IS_RET>(RB, Z, KST, AUXG, b, h, hu, sw, L, 1);
        __syncthreads();
        for (int n = 0; n < NCHUNK; n += 2) {
            if (ST_LD) stager_load<IS_RET>(RA, Z, KST, AUXG, b, h, hu, sw, L, n + 2);
            if (ST_ST) { stager_stage<IS_RET>(RB, lds + SC_BUF, lds, sw, L);
                if (sw == 0) scores_stage(RB, lds + SC_BUF, L, l31, hh); }
            else asm volatile("" :: "v"(RB.x0[0]), "v"(RB.x0[7]), "v"(RB.x1[0]), "v"(RB.aux[1]));
            __syncthreads();
            if (ST_LD) stager_load<IS_RET>(RB, Z, KST, AUXG, b, h, hu, sw, L, n + 3);
            if (ST_ST) { stager_stage<IS_RET>(RA, lds, lds + SC_BUF, sw, L);
                if (sw == 0) scores_stage(RA, lds, L, l31, hh); }
            else asm volatile("" :: "v"(RA.x0[0]), "v"(RA.x0[7]), "v"(RA.x1[0]), "v"(RA.aux[1]));
            __syncthreads();
        }
        }
    } else {
        asm volatile("" : "+v"(lane));
        FinLane L;
        {   const int c0 = lane / VPR, v0 = 8 * (VPR * vh + lane % VPR);
            L.lo = (unsigned)(c0 * PQ + v0 * 2); L.ls = (unsigned)(c0 * 4); L.go = (unsigned)((c0 * D + v0) * 2); L.gs = (unsigned)(c0 * 64); L.gz = (unsigned)((c0 * NIN + v0) * 2); }
        asm volatile("" : "+v"(L.lo), "+v"(L.ls), "+v"(L.go), "+v"(L.gs), "+v"(L.gz));
        if (wave == 4) {
            u32x4 gA[FPT], gB[FPT];
            gate_load<IS_RET>(gA, Z, b, h, L, 0); gate_load<IS_RET>(gB, Z, b, h, L, 1);
            __syncthreads();
            for (int n = 0; n < NCHUNK; n += 2) {
                if (FI_ON) { gate_stage(gA, lds, lane); gate_load<IS_RET>(gA, Z, b, h, L, n + 2); }
                __syncthreads();
                if (FI_ON) { gate_stage(gB, lds + SC_BUF, lane); gate_load<IS_RET>(gB, Z, b, h, L, n + 3); }
                __syncthreads();
            }
        } else {
            const bool first = (lane % VPR) == 0;
            __syncthreads();
            __syncthreads();
            for (int n = 1; n < NCHUNK; ++n) { if (FI_ON) fin_store<IS_RET>(lds + ((n - 1) & 1) * SC_BUF, CAT, SSQO, b, h, vh, L, lane, first, n - 1); __syncthreads(); }
            if (FI_ON) fin_store<IS_RET>(lds + ((NCHUNK - 1) & 1) * SC_BUF, CAT, SSQO, b, h, vh, L, lane, first, NCHUNK - 1);
        }
    }
}

constexpr int XA_K = 0, XA_KP = 144, XA_V = 256 * XA_KP, XA_VP = 192;
#define XRD(dst, areg, off) "ds_read_b128 " dst ", " areg " offset:" #off "\n\t"
__device__ __forceinline__ void xattn2_unit(unsigned char* ws, LAS unsigned char* lds, int unit, int layer, int tid) {
    gbf Z = (gbf)(ws + WS_Z); gbf MKV = (gbf)(ws + WS_MKV); GAS bf16_t* CAT = (GAS bf16_t*)(ws + WS_CAT);
    const int b = unit >> 5, hx = (unit >> 3) & 3, qb = unit & 7;
    const int wave = tid >> 6, lane = tid & 63, l31 = lane & 31, hh = lane >> 5;
    const size_t tok = (size_t)b * SEQ + qb * 256 + wave * 32 + l31;
    bf16x8 qf[4];
#pragma unroll
    for (int ks = 0; ks < 4; ++ks) qf[ks] = *(const GAS bf16x8*)(Z + tok * NIN + 3072 + hx * 64 + 16 * ks + 8 * hh);
    __syncthreads();
    {   gbf src = MKV + (size_t)(b * NMEM) * 2048 + layer * 512 + hx * 64;
        u32x4 kr[4], vr[4];
#pragma unroll
        for (int i = 0; i < 4; ++i) { const int piece = tid + 512 * i, key = piece >> 3, j = piece & 7;
            kr[i] = *(const GAS u32x4*)(src + (size_t)key * 2048 + 8 * j); vr[i] = *(const GAS u32x4*)(src + (size_t)key * 2048 + 256 + 8 * j); }
#pragma unroll
        for (int i = 0; i < 4; ++i) { const int piece = tid + 512 * i, key = piece >> 3, j = piece & 7;
            *(LAS u32x4*)(lds + XA_K + key * XA_KP + 16 * j) = kr[i]; *(LAS u32x4*)(lds + XA_V + key * XA_VP + 16 * j) = vr[i]; }
    }
    __syncthreads();
    f32x16 st[8];
    const unsigned ak = (unsigned)(size_t)(lds + XA_K) + (unsigned)(l31 * XA_KP + 16 * hh);
#define XBLK(T0, o0, o1, o2, o3, o4, o5, o6, o7) { u32x4 f0, f1, f2, f3, f4, f5, f6, f7; \
        asm volatile(XRD("%0", "%8", o0) XRD("%1", "%8", o1) XRD("%2", "%8", o2) XRD("%3", "%8", o3) XRD("%4", "%8", o4) XRD("%5", "%8", o5) XRD("%6", "%8", o6) XRD("%7", "%8", o7) "s_waitcnt lgkmcnt(0)" \
            : "=&v"(f0), "=&v"(f1), "=&v"(f2), "=&v"(f3), "=&v"(f4), "=&v"(f5), "=&v"(f6), "=&v"(f7) : "v"(ak) : "memory"); \
        __builtin_amdgcn_sched_barrier(0); \
        f32x16 a0, a1; _Pragma("unroll") for (int r = 0; r < 16; ++r) { a0[r] = 0.f; a1[r] = 0.f; } \
        a0 = __builtin_amdgcn_mfma_f32_32x32x16_bf16(as_bf16x8(f0), qf[0], a0, 0, 0, 0); a1 = __builtin_amdgcn_mfma_f32_32x32x16_bf16(as_bf16x8(f4), qf[0], a1, 0, 0, 0); \
        a0 = __builtin_amdgcn_mfma_f32_32x32x16_bf16(as_bf16x8(f1), qf[1], a0, 0, 0, 0); a1 = __builtin_amdgcn_mfma_f32_32x32x16_bf16(as_bf16x8(f5), qf[1], a1, 0, 0, 0); \
        a0 = __builtin_amdgcn_mfma_f32_32x32x16_bf16(as_bf16x8(f2), qf[2], a0, 0, 0, 0); a1 = __builtin_amdgcn_mfma_f32_32x32x16_bf16(as_bf16x8(f6), qf[2], a1, 0, 0, 0); \
        a0 = __builtin_amdgcn_mfma_f32_32x32x16_bf16(as_bf16x8(f3), qf[3], a0, 0, 0, 0); a1 = __builtin_amdgcn_mfma_f32_32x32x16_bf16(as_bf16x8(f7), qf[3], a1, 0, 0, 0); \
        st[T0] = a0; st[T0 + 1] = a1; }
    XBLK(0, 0, 32, 64, 96, 4608, 4640, 4672, 4704)
    XBLK(2, 9216, 9248, 9280, 9312, 13824, 13856, 13888, 13920)
    XBLK(4, 18432, 18464, 18496, 18528, 23040, 23072, 23104, 23136)
    XBLK(6, 27648, 27680, 27712, 27744, 32256, 32288, 32320, 32352)
#undef XBLK
    float mx = -1e30f;
#pragma unroll
    for (int T = 0; T < 8; ++T)
#pragma unroll
        for (int r = 0; r < 16; ++r) mx = fmaxf(mx, st[T][r]);
    mx = fmaxf(mx, shfl_xor_l(mx, lane, 32));
    const float c2 = 0.125f * 1.4426950408889634f, mc = mx * c2;
    float sum = 0.f;
#pragma unroll
    for (int T = 0; T < 8; ++T)
#pragma unroll
        for (int r = 0; r < 16; ++r) { const float p = exp2f(st[T][r] * c2 - mc); st[T][r] = p; sum += p; }
    sum += shfl_xor_l(sum, lane, 32);
    f32x16 ot[2];
#pragma unroll
    for (int dt = 0; dt < 2; ++dt)
#pragma unroll
        for (int r = 0; r < 16; ++r) ot[dt][r] = 0.f;
    const unsigned av = (unsigned)(size_t)(lds + XA_V) + (unsigned)((4 * hh + ((lane & 15) >> 2)) * XA_VP + (16 * ((lane >> 4) & 1) + 4 * (lane & 3)) * 2);
#define XTR(dst, off) "ds_read_b64_tr_b16 " dst ", %8 offset:" #off "\n\t"
#define VBLK(T, o00, o01, o10, o11, o20, o21, o30, o31) { u32x2 g0, g1, g2, g3, g4, g5, g6, g7; \
        asm volatile(XTR("%0", o00) XTR("%1", o01) XTR("%2", o10) XTR("%3", o11) XTR("%4", o20) XTR("%5", o21) XTR("%6", o30) XTR("%7", o31) "s_waitcnt lgkmcnt(0)" \
            : "=&v"(g0), "=&v"(g1), "=&v"(g2), "=&v"(g3), "=&v"(g4), "=&v"(g5), "=&v"(g6), "=&v"(g7) : "v"(av) : "memory"); \
        __builtin_amdgcn_sched_barrier(0); \
        u32x4 p0, p1; _Pragma("unroll") for (int j = 0; j < 4; ++j) { p0[j] = pg8::cvt_pk_bf16(st[T][2 * j], st[T][2 * j + 1]); p1[j] = pg8::cvt_pk_bf16(st[T][8 + 2 * j], st[T][8 + 2 * j + 1]); } \
        ot[0] = __builtin_amdgcn_mfma_f32_32x32x16_bf16(as_bf16x8((u32x4){g0.x, g0.y, g1.x, g1.y}), as_bf16x8(p0), ot[0], 0, 0, 0); \
        ot[1] = __builtin_amdgcn_mfma_f32_32x32x16_bf16(as_bf16x8((u32x4){g2.x, g2.y, g3.x, g3.y}), as_bf16x8(p0), ot[1], 0, 0, 0); \
        ot[0] = __builtin_amdgcn_mfma_f32_32x32x16_bf16(as_bf16x8((u32x4){g4.x, g4.y, g5.x, g5.y}), as_bf16x8(p1), ot[0], 0, 0, 0); \
        ot[1] = __builtin_amdgcn_mfma_f32_32x32x16_bf16(as_bf16x8((u32x4){g6.x, g6.y, g7.x, g7.y}), as_bf16x8(p1), ot[1], 0, 0, 0); }
    VBLK(0, 0, 1536, 64, 1600, 3072, 4608, 3136, 4672)
    VBLK(1, 6144, 7680, 6208, 7744, 9216, 10752, 9280, 10816)
    VBLK(2, 12288, 13824, 12352, 13888, 15360, 16896, 15424, 16960)
    VBLK(3, 18432, 19968, 18496, 20032, 21504, 23040, 21568, 23104)
    VBLK(4, 24576, 26112, 24640, 26176, 27648, 29184, 27712, 29248)
    VBLK(5, 30720, 32256, 30784, 32320, 33792, 35328, 33856, 35392)
    VBLK(6, 36864, 38400, 36928, 38464, 39936, 41472, 40000, 41536)
    VBLK(7, 43008, 44544, 43072, 44608, 46080, 47616, 46144, 47680)
#undef VBLK
#undef XTR
    const float il = 1.0f / sum;
    GAS bf16_t* op = CAT + tok * D + MIXW + hx * 64 + 4 * hh;
#pragma unroll
    for (int dt = 0; dt < 2; ++dt)
#pragma unroll
        for (int q = 0; q < 4; ++q) { u32x2 w; w.x = pg8::cvt_pk_bf16(ot[dt][4 * q] * il, ot[dt][4 * q + 1] * il); w.y = pg8::cvt_pk_bf16(ot[dt][4 * q + 2] * il, ot[dt][4 * q + 3] * il);
            *(GAS u32x2*)(op + 32 * dt + 8 * q) = w; }
}

__device__ __forceinline__ void final_rows(const unsigned char* ws, float* out, const float* nf, int row0, int row1, int gw, int NGW, int lane) {
    const GAS f32x4* wv = (const GAS f32x4*)nf + lane;
    for (int row = row0 + gw; row < row1; row += NGW) {
        const GAS u32x2* xr = (const GAS u32x2*)((const GAS bf16_t*)(ws + WS_XB) + (size_t)row * D) + lane; f32x4 v[4]; float s = 0.f;
#pragma unroll
        for (int j = 0; j < 4; ++j) { const u32x2 w = xr[64 * j]; v[j][0] = bf2f(w.x & 0xffffu); v[j][1] = bf2f(w.x >> 16); v[j][2] = bf2f(w.y & 0xffffu); v[j][3] = bf2f(w.y >> 16);
            s += (v[j].x * v[j].x + v[j].y * v[j].y) + (v[j].z * v[j].z + v[j].w * v[j].w); }
        const float rs = rsqrtf(wave_sum(s, lane) * (1.0f / D) + EPS);
        GAS f32x4* orow = (GAS f32x4*)(out + (size_t)row * D) + lane;
#pragma unroll
        for (int j = 0; j < 4; ++j) orow[64 * j] = v[j] * rs * wv[64 * j];
    }
}

__global__ void __launch_bounds__(NWAVES * 64, 2) mega_fwd(Args args) {
    extern __shared__ __attribute__((aligned(16))) unsigned char lds_raw[];
    LAS unsigned char* lds = (LAS unsigned char*)lds_raw;
    volatile LAS unsigned* MISC = (volatile LAS unsigned*)(lds + MISC_OFF);
    const int G = gridDim.x, bx = blockIdx.x;
    const int wave_s = __builtin_amdgcn_readfirstlane(threadIdx.x >> 6);
    unsigned char* ws = args.ws;
    for (int u = threadIdx.x; u < (LDS_BYTES - LDSCTL_OFF) / 4; u += NWAVES * 64) ((LAS unsigned*)(lds + LDSCTL_OFF))[u] = 0u;
    __syncthreads();
    XcdBarrier bar = xcd_barrier_post((unsigned*)(ws + WS_CTL) + CW_BAR, MISC + 8);
#define GBAR() xcd_barrier(bar, wave_s == 0 && lane_id_volatile() == 0)
#define OPAQ() unsigned char* wsp = ws; int Gp = G, bxp = bx, tidp = wave_s * 64 + lane_id_volatile(); asm volatile("" : "+s"(wsp), "+s"(Gp), "+s"(bxp), "+v"(tidp)); \
    const int lanep = tidp & 63, wavep = __builtin_amdgcn_readfirstlane(tidp >> 6), vcup = (Gp % 8 == 0) ? (bxp % 8) * (Gp / 8) + bxp / 8 : bxp, gwp = vcup * NWAVES + wavep, NGWp = Gp * NWAVES; \
    (void)lanep; (void)gwp; (void)NGWp
#define XPART() const int xn = misc_rd(lds, 8), xnx = misc_rd(lds, 9), xrank = misc_rd(lds, 10), xslot = misc_rd(lds, 11); \
    (void)xn; (void)xnx; (void)xrank; (void)xslot
#define LBAR() xcc_barrier(bar, (unsigned)misc_rd(lds, 8), wave_s == 0 && lane_id_volatile() == 0)

    { OPAQ(); p0_prologue(args, wsp, lds, gwp, NGWp, wavep, lanep); }
    GBAR();
    if (threadIdx.x == 0) {
        unsigned slot = 0;
        for (unsigned j = 0; j < 16; ++j) { const unsigned c = xb_ld(&bar.bar[XB_XCNT(j)]); if (j < bar.x && c > 0u) ++slot; }
        MISC[11] = slot;
    }
    __syncthreads();
    for (int l = 0; l < DEPTH; ++l) {
        const int is_ret = l & 1;
        { OPAQ(); XPART();
            if (l == 0) {
                pg8::Gemm g{(const bf16_t*)(wsp + WS_MEMB), (const bf16_t*)(wsp + WS_WM), MROWS, 2048, D}; pg8::XccOrderMem S{xrank, xn, xslot, xnx};
                EpiPlain E{(bf16_t*)(wsp + WS_MKV), 2048};
                pg8::gemm_phase<EpiPlain, pg8::XccOrderMem, true, true>(lds, g, S, E, tidp);
            }
            pg8::Gemm g{(const bf16_t*)(wsp + WS_XB), (const bf16_t*)(wsp + WS_WIN) + (size_t)l * NIN * D, M, NIN, D}; pg8::XccOrder S{xrank, xn, xslot, xnx, (NIN - XW) / 256};
            EpiIn E{(bf16_t*)(wsp + WS_Z), (bf16_t*)(wsp + WS_KST), (float*)(wsp + WS_AUX), (const float*)(wsp + WS_SSQA), (const float*)(wsp + WS_LB) + (l >> 1) * MIXW, (const float*)(wsp + WS_COS), (const float*)(wsp + WS_SIN), is_ret, (LAS float*)(lds + RSTD_TAB_OFF)};
            pg8::gemm_phase<EpiIn, pg8::XccOrder, true, true>(lds, g, S, E, tidp);
        }
        LBAR();
        { OPAQ(); XPART();
            constexpr int UB = NH * NVS + 8;
            const int nb = xslot < 8 ? (8 - xslot + xnx - 1) / xnx : 0;
            for (int u = xrank; u < UB * nb; u += xn) {
                const int b = xslot + (u / UB) * xnx, uu = u % UB;
                if (uu < NH * NVS) { if (is_ret) scan2_unit<1, 0>(wsp, lds, b * NH * NVS + uu, tidp); else scan2_unit<0, 0>(wsp, lds, b * NH * NVS + uu, tidp); }
                else { const int rb = 8 * b + (uu - NH * NVS);
                    {   pg8::Gemm g{(const bf16_t*)(wsp + WS_XB), (const bf16_t*)(wsp + WS_WIN) + (size_t)l * NIN * D, M, NIN, D}; pg8::OneUnit S{rb, 12};
                        EpiIn E{(bf16_t*)(wsp + WS_Z), (bf16_t*)(wsp + WS_KST), (float*)(wsp + WS_AUX), (const float*)(wsp + WS_SSQA), (const float*)(wsp + WS_LB) + (l >> 1) * MIXW, (const float*)(wsp + WS_COS), (const float*)(wsp + WS_SIN), is_ret, (LAS float*)(lds + RSTD_TAB_OFF)};
                        pg8::gemm_phase<EpiIn, pg8::OneUnit, true, true>(lds, g, S, E, tidp); }
                    asm volatile("s_waitcnt vmcnt(0)" ::: "memory"); __builtin_amdgcn_fence(__ATOMIC_RELEASE, "agent"); __syncthreads(); __builtin_amdgcn_fence(__ATOMIC_ACQUIRE, "agent");
                    for (int hx = 0; hx < NXH; ++hx) xattn2_unit(wsp, lds, (rb >> 3) * 32 + hx * 8 + (rb & 7), l, tidp);
                }
            }
            if (l == 0) {
                const int busy = UB * nb < xn ? UB * nb : 0, nidle = xn - busy;
                if (xrank >= busy) { const int wv = (xrank - busy) * NWAVES + wavep, nwv = nidle * NWAVES;
                    __syncthreads();
                    for (int l2 = 0; l2 < DEPTH; ++l2) convert_weights(args, wsp, (LAS float*)(lds + wavep * 16384), l2 * TITEMS_PER_LAYER + (l2 == 0 ? 16 * (NIN / 32) : 0), (l2 + 1) * TITEMS_PER_LAYER - 256, wv, nwv, lanep, xslot < xnx ? xslot : 0, xnx);
                }
            }
            __syncthreads();
        }
        if (l == 0) GBAR(); else LBAR();
        if (NVS > 1 && is_ret) {
            { OPAQ(); XPART(); for (int b = xslot; b < BATCH; b += xnx) norm_rows(wsp, b * SEQ, (b + 1) * SEQ, xrank * NWAVES + wavep, xn * NWAVES, lanep); }
            LBAR();
        }
        { OPAQ(); XPART();
            pg8::Gemm g{(const bf16_t*)(wsp + WS_CAT), (const bf16_t*)(wsp + WS_WOUT) + (size_t)l * D * D, M, D, D}; pg8::XccOrder S{xrank, xn, xslot, xnx, D / 256};
            EpiResC E{EpiRes{(const bf16_t*)(wsp + WS_XB), (bf16_t*)(wsp + WS_XB), (float*)(wsp + WS_SSQD)}, is_ret ? nullptr : (const float*)(wsp + WS_SSQO)};
            pg8::gemm_phase<EpiResC, pg8::XccOrder, true, true>(lds, g, S, E, tidp);
        }
        LBAR();
        { OPAQ(); XPART();
            pg8::Gemm g{(const bf16_t*)(wsp + WS_XB), (const bf16_t*)(wsp + WS_WFI) + (size_t)l * NFI * D, M, NFI, D}; pg8::XccOrder S{xrank, xn, xslot, xnx, NFI / 256};
            EpiFfn E{(bf16_t*)(wsp + WS_ACT), (const float*)(wsp + WS_SSQD), (LAS float*)(lds + RSTD_TAB_OFF)};
            pg8::gemm_phase<EpiFfn, pg8::XccOrder, true, true>(lds, g, S, E, tidp);
        }
        LBAR();
        { OPAQ(); XPART();
            pg8::Gemm g{(const bf16_t*)(wsp + WS_ACT), (const bf16_t*)(wsp + WS_WFO) + (size_t)l * D * DFF, M, D, DFF}; pg8::XccOrder S{xrank, xn, xslot, xnx, D / 256};
            EpiRes E{(const bf16_t*)(wsp + WS_XB), (bf16_t*)(wsp + WS_XB), (float*)(wsp + WS_SSQA)};
            pg8::gemm_phase<EpiRes, pg8::XccOrder, true, true>(lds, g, S, E, tidp);
        }
        LBAR();
    }
    { OPAQ(); XPART();
        for (int b = xslot; b < BATCH; b += xnx) final_rows(wsp, args.out, args.in[14], b * SEQ, (b + 1) * SEQ, xrank * NWAVES + wavep, xn * NWAVES, lanep);
    }
#undef OPAQ
#undef XPART
#undef GBAR
#undef LBAR
}

extern "C" void kernel_launch(void* const* d_in, const int* in_sizes, int n_in, void* d_out, int out_size, void* d_ws, size_t ws_size, hipStream_t stream) {
    static int grid = 0;
    if (grid == 0) {
        if (n_in != 15 || in_sizes[0] != M * D || out_size != M * D || ws_size < WS_END) {
            fprintf(stderr, "kernel_launch: unexpected shapes: n_in %d in0 %d out %d ws %zu (need %zu)\n", n_in, n_in > 0 ? in_sizes[0] : -1, out_size, ws_size, (size_t)WS_END); grid = -1; return; }
        int dev = 0, cus = 0, per_cu = 0;
        if (hipGetDevice(&dev) != hipSuccess || hipDeviceGetAttribute(&cus, hipDeviceAttributeMultiprocessorCount, dev) != hipSuccess) { grid = -1; return; }
        if (hipFuncSetAttribute((const void*)mega_fwd, hipFuncAttributeMaxDynamicSharedMemorySize, LDS_BYTES) != hipSuccess) { fprintf(stderr, "kernel_launch: hipFuncSetAttribute failed\n"); grid = -1; return; }
        if (hipOccupancyMaxActiveBlocksPerMultiprocessor(&per_cu, (const void*)mega_fwd, NWAVES * 64, LDS_BYTES) != hipSuccess || per_cu < 1)
            fprintf(stderr, "kernel_launch: occupancy query reports %d workgroups per CU\n", per_cu);
        (void)hipGetLastError();
        grid = cus;
        if (grid < 176) { fprintf(stderr, "kernel_launch: this kernel needs at least 176 CUs (found %d)\n", cus); grid = -1; return; }
    }
    if (grid < 0) return;
    if (hipMemsetAsync((char*)d_ws + WS_CTL, 0, CTL_ZERO_BYTES, stream) != hipSuccess) { fprintf(stderr, "kernel_launch: memset failed\n"); return; }
    Args a{};
    for (int i = 0; i < 15; ++i) a.in[i] = (const float*)d_in[i];
    a.out = (float*)d_out; a.ws = (unsigned char*)d_ws;
    a.ph_lo = 0; a.ph_hi = 0;
    hipLaunchKernelGGL(mega_fwd, dim3(grid), dim3(NWAVES * 64), LDS_BYTES, stream, a);
    const hipError_t le = hipPeekAtLastError();
    if (le != hipSuccess) fprintf(stderr, "kernel_launch: launch failed: %s\n", hipGetErrorName(le));
}
```

```cpp
#include <hip/hip_runtime.h>
#include <cstdio>
#include <cstdint>

#ifndef DBG_SKIP
#define DBG_SKIP 0
#endif
#ifndef PROBE_REP
#define PROBE_REP 0
#endif
#ifndef PROBE_VAR
#define PROBE_VAR 0
#endif
#ifndef MK_N_LAUNCHES
#define MK_N_LAUNCHES 1
#endif

#define GAS __attribute__((address_space(1)))
#define LAS __attribute__((address_space(3)))
typedef unsigned short bf16_t;
typedef short bf16x8 __attribute__((ext_vector_type(8)));
typedef float f32x4 __attribute__((ext_vector_type(4)));
typedef float f32x2 __attribute__((ext_vector_type(2)));
typedef unsigned u32x4 __attribute__((ext_vector_type(4)));
typedef unsigned u32x2 __attribute__((ext_vector_type(2)));

constexpr int BATCH = 8, SEQ = 2048, D = 1024, DEPTH = 4;
constexpr int M = BATCH * SEQ;
constexpr int NH = 6, HD = 128, MIXW = 768, XW = 256, NXH = 4, XHD = 64, NMEM = 256;
constexpr int NIN = 3328, DFF = 2816, NFI = 2 * DFF;
constexpr int MROWS = BATCH * NMEM;
constexpr float EPS = 1e-6f;
constexpr int NVS = 2;
constexpr int VPR = 16 / NVS;

constexpr size_t MiB = 1u << 20;
constexpr size_t WS_CTL = 0, CTL_ZERO_BYTES = 1 * MiB;
constexpr size_t WS_LB = 1 * MiB;
constexpr size_t WS_SSQA = 2 * MiB;
constexpr size_t WS_SSQD = 3 * MiB;
constexpr size_t WS_COS = 4 * MiB, WS_SIN = 8 * MiB;
constexpr size_t WS_MEMB = 12 * MiB;
constexpr size_t WS_MKV = 16 * MiB;
constexpr size_t WS_WIN = 24 * MiB;
constexpr size_t WS_WOUT = 50 * MiB;
constexpr size_t WS_WFI = 58 * MiB;
constexpr size_t WS_WFO = 102 * MiB;
constexpr size_t WS_WM = 124 * MiB;
constexpr size_t WS_XB = 128 * MiB;
constexpr size_t WS_CAT = 160 * MiB;
constexpr size_t WS_Z = 192 * MiB;
constexpr size_t WS_F = 296 * MiB;
constexpr size_t WS_KST = 296 * MiB;
constexpr size_t WS_AUX = 320 * MiB;
constexpr size_t WS_SSQO = 323 * MiB;
constexpr size_t WS_ACT = 192 * MiB;
constexpr size_t WS_END = 344 * MiB;
static_assert(WS_WIN + (size_t)DEPTH * NIN * D * 2 <= WS_WOUT && WS_WOUT + (size_t)DEPTH * D * D * 2 <= WS_WFI && WS_WFI + (size_t)DEPTH * NFI * D * 2 <= WS_WFO &&
              WS_WFO + (size_t)DEPTH * D * DFF * 2 <= WS_WM && WS_WM + (size_t)2048 * 1024 * 2 <= WS_XB && WS_Z + (size_t)M * NIN * 2 <= WS_F && WS_F + (size_t)M * MIXW * 4 <= WS_END &&
              WS_ACT + (size_t)M * DFF * 2 <= WS_F, "ws map");
constexpr int CW_BAR = 4096;

__device__ __forceinline__ int lane_id_volatile() { int l; asm volatile("v_mbcnt_lo_u32_b32 %0, -1, 0\n\tv_mbcnt_hi_u32_b32 %0, -1, %0" : "=v"(l)); return l; }
namespace pg8 {
constexpr int BM = 256, BK = 64, HALF = 128, HTB = HALF * BK * 2, STAGE_BYTES = 8 * HTB, NXCD = 8, WGM = 8;
__host__ __device__ __forceinline__ int lds_byte(int r, int c) { const int st = (r >> 4) * 2 + (c >> 5), rr = r & 15, cc = c & 31, ob = rr * 64 + cc * 2; return st * 1024 + (ob ^ (((ob >> 9) & 1) << 5)); }
__host__ __device__ __forceinline__ void stage_rc(int b, int& R, int& C) { const int st = b / 1024, sb = b % 1024, swz = sb ^ (((sb >> 9) & 1) << 5); R = (st >> 1) * 16 + swz / 64; C = (st & 1) * 32 + (swz % 64) / 2; }
__host__ __device__ __forceinline__ int perm32(int rho) { const int n = rho >> 4, i = rho & 15; return 8 * (i >> 2) + 4 * n + (i & 3); }
struct Unit { int pm, pn; };
struct Gemm { const bf16_t* A; const bf16_t* Bt; int M, N, K; };
struct StaticOrder {
    int nM, nN, nwg, G, c;
    __host__ __device__ void init(int M_, int N_, int G_, int c_) { nM = M_ / BM; nN = N_ / BM; nwg = nM * nN; G = G_; c = c_; }
    __host__ __device__ bool next(int i, Unit& u) const {
        const long L = (long)i * G + c; if (L >= nwg) return false;
        int wgid = (int)L; { const int q = nwg / NXCD, r = nwg % NXCD, xcd = wgid % NXCD, off = wgid / NXCD; wgid = (xcd < r ? xcd * (q + 1) : r * (q + 1) + (xcd - r) * q) + off; }
        const int nig = WGM * nN, gid = wgid / nig, fm = gid * WGM, gsz = (nM - fm) < WGM ? (nM - fm) : WGM;
        u.pm = fm + ((wgid % nig) % gsz); u.pn = (wgid % nig) / gsz; return true;
    }
    __device__ __forceinline__ void a_ready(const Unit&) const {}
    __device__ __forceinline__ void done(const Unit&) const {}
};
struct XccOrder {
    int rank, n, slot, nx, nN;
    __device__ __forceinline__ bool next(int i, Unit& u) const {
        const int per = 8 * nN, t = i * n + rank, nb = (8 - slot + nx - 1) / nx;
        if (slot >= 8 || t >= nb * per) return false;
        const int bi = t / per, tt = t - bi * per, g = tt / (4 * nN), r = tt - g * 4 * nN;
        u.pm = 8 * (slot + bi * nx) + 4 * g + (r & 3); u.pn = r >> 2; return true;
    }
    __device__ __forceinline__ void a_ready(const Unit&) const {}
};
struct XccOrderMem {
    int rank, n, slot, nx;
    __device__ __forceinline__ bool next(int i, Unit& u) const {
        const int t = i * n + rank, nb = (8 - slot + nx - 1) / nx;
        if (slot >= 8 || t >= nb * 8) return false;
        u.pm = slot + (t >> 3) * nx; u.pn = t & 7; return true;
    }
    __device__ __forceinline__ void a_ready(const Unit&) const {}
};
struct OneUnit {
    int pm, pn;
    __device__ __forceinline__ bool next(int i, Unit& u) const { if (i) return false; u.pm = pm; u.pn = pn; return true; }
    __device__ __forceinline__ void a_ready(const Unit&) const {}
};
__device__ __forceinline__ unsigned cvt_pk_bf16(float lo, float hi) { unsigned r; asm volatile("v_cvt_pk_bf16_f32 %0, %1, %2" : "=v"(r) : "v"(lo), "v"(hi)); return r; }

template <class Epi, class Sched, bool ALIGN_EPI = false, bool SP2 = false>
__device__ __forceinline__ void gemm_phase(LAS unsigned char* lds, const Gemm g, const Sched& S, const Epi& E, int tid) {
    asm volatile("" : "+v"(tid));
    const int wid = __builtin_amdgcn_readfirstlane(tid >> 6), lane = tid & 63, wr = wid >> 2, wc = wid & 3, fr = lane & 15, fq = lane >> 4;
    const int K = g.K, nt = K / BK;
    unsigned voffA[2], voffB[2];
#pragma unroll
    for (int i = 0; i < 2; ++i) { int R, C; stage_rc(tid * 16 + i * 8192, R, C); const int Rb = Epi::PERM ? ((R & ~31) + perm32(R & 31)) : R;
        voffA[i] = (unsigned)(R * K + C) * 2u; voffB[i] = (unsigned)(Rb * K + C) * 2u; }
    asm volatile("" : "+v"(voffA[0]), "+v"(voffA[1]), "+v"(voffB[0]), "+v"(voffB[1]));
    const size_t kstep = (size_t)(BK * 2);
    const size_t hstep = (size_t)HALF * K * 2;
    const size_t tstep = 2 * hstep;
    const unsigned ldsw = (unsigned)wid * 1024u;
    const int aoff = lds_byte(wr * 64 + fr, fq * 8), boff = lds_byte(wc * 32 + fr, fq * 8);
#define PG8_SA(b, h) (((b) * 2 + (h)) * HTB)
#define PG8_SB(b, h) ((4 + (b) * 2 + (h)) * HTB)
#define PG8_STAGE(bufoff, gbase, voff) do { _Pragma("unroll") for (int _i = 0; _i < 2; ++_i) \
        __builtin_amdgcn_global_load_lds((const unsigned*)((const char*)(gbase) + (voff)[_i]), (LAS unsigned*)(lds + (bufoff) + ldsw + _i * 8192), 16, 0, 0); } while (0)
#define PG8_LDA(dst, b, h) do { _Pragma("unroll") for (int m = 0; m < 4; ++m) _Pragma("unroll") for (int k = 0; k < 2; ++k) dst[m][k] = *(const LAS bf16x8*)(lds + PG8_SA(b, h) + aoff + m * 2048 + k * 1024); } while (0)
#define PG8_LDB(dst, b, h) do { _Pragma("unroll") for (int n = 0; n < 2; ++n) _Pragma("unroll") for (int k = 0; k < 2; ++k) dst[n][k] = *(const LAS bf16x8*)(lds + PG8_SB(b, h) + boff + n * 2048 + k * 1024); } while (0)
#define PG8_MMA(ai, bj, At, Bt) do { __builtin_amdgcn_s_setprio(1); _Pragma("unroll") for (int m = 0; m < 4; ++m) _Pragma("unroll") for (int n = 0; n < 2; ++n) _Pragma("unroll") for (int k = 0; k < 2; ++k) \
        acc[ai][bj][m][n] = __builtin_amdgcn_mfma_f32_16x16x32_bf16(Bt[n][k], At[m][k], acc[ai][bj][m][n], 0, 0, 0); __builtin_amdgcn_s_setprio(0); } while (0)
#define PG8_WAIT_V(n) asm volatile("s_waitcnt vmcnt(" #n ")" ::: "memory")
#define PG8_WAIT_L(n) asm volatile("s_waitcnt lgkmcnt(" #n ")" ::: "memory")
#define PG8_BAR __builtin_amdgcn_s_barrier()
#define PG8_SCHED __builtin_amdgcn_sched_barrier(0)
    Unit cur, nxt; int ui = 0;
    if (!S.next(0, cur)) return;
    f32x4 acc[2][2][4][2];
#pragma unroll
    for (int a = 0; a < 2; ++a)
#pragma unroll
        for (int b = 0; b < 2; ++b)
#pragma unroll
            for (int m = 0; m < 4; ++m)
#pragma unroll
                for (int n = 0; n < 2; ++n) acc[a][b][m][n] = (f32x4){0.f, 0.f, 0.f, 0.f};
    bf16x8 At[4][2], B0[2][2], B1[2][2];
    const char* cA = (const char*)g.A + (size_t)cur.pm * tstep; const char* cB = (const char*)g.Bt + (size_t)cur.pn * tstep;
    S.a_ready(cur);
    if constexpr (SP2) {
        PG8_STAGE(PG8_SB(0, 0), cB, voffB); PG8_STAGE(PG8_SB(0, 1), cB + hstep, voffB); PG8_STAGE(PG8_SA(0, 0), cA, voffA); PG8_STAGE(PG8_SA(0, 1), cA + hstep, voffA);
        if (wr == 1) PG8_BAR;
        PG8_WAIT_V(2); PG8_BAR;
        PG8_STAGE(PG8_SB(1, 0), cB + kstep, voffB); PG8_STAGE(PG8_SA(1, 0), cA + kstep, voffA); PG8_STAGE(PG8_SB(1, 1), cB + hstep + kstep, voffB);
        PG8_WAIT_V(6); PG8_BAR;
    } else {
        PG8_STAGE(PG8_SB(0, 0), cB, voffB); PG8_STAGE(PG8_SA(0, 0), cA, voffA); PG8_STAGE(PG8_SB(0, 1), cB + hstep, voffB); PG8_STAGE(PG8_SA(0, 1), cA + hstep, voffA);
        if (wr == 1) PG8_BAR;
        PG8_WAIT_V(4); PG8_BAR;
        PG8_STAGE(PG8_SB(1, 0), cB + kstep, voffB); PG8_STAGE(PG8_SA(1, 0), cA + kstep, voffA); PG8_STAGE(PG8_SB(1, 1), cB + hstep + kstep, voffB);
        PG8_WAIT_V(6); PG8_BAR;
    }
    for (;;) {
        const bool has_next = S.next(ui + 1, nxt);
        const char* nA = has_next ? (const char*)g.A + (size_t)nxt.pm * tstep : cA; const char* nB = has_next ? (const char*)g.Bt + (size_t)nxt.pn * tstep : cB;
        for (int t = 0; t < nt; t += 2) {
            const bool last = (t == nt - 2);
            const char* a1 = cA + (size_t)(t + 1) * kstep;
            const char* a2 = last ? nA : cA + (size_t)(t + 2) * kstep; const char* b2 = last ? nB : cB + (size_t)(t + 2) * kstep;
            const char* a3 = a2 + kstep; const char* b3 = b2 + kstep;
            if (last && has_next) S.a_ready(nxt);
            if constexpr (Epi::MID_T > 0) { if (t == Epi::MID_T) { const int l2 = lane_id_volatile(); E.mid(acc, cur, wr, wc, l2 & 15, l2 >> 4); } }
            if constexpr (SP2) {
            PG8_LDB(B0, 0, 0); PG8_LDB(B1, 0, 1); PG8_SCHED; PG8_LDA(At, 0, 0); PG8_STAGE(PG8_SA(1, 1), a1 + hstep, voffA);
            PG8_WAIT_V(8); PG8_WAIT_L(0); PG8_BAR; PG8_MMA(0, 0, At, B0); PG8_MMA(0, 1, At, B1); PG8_BAR; PG8_SCHED;
            PG8_LDA(At, 0, 1); PG8_STAGE(PG8_SB(0, 0), b2, voffB); PG8_STAGE(PG8_SB(0, 1), b2 + hstep, voffB); PG8_STAGE(PG8_SA(0, 0), a2, voffA);
            PG8_WAIT_V(8); PG8_WAIT_L(0); PG8_BAR; PG8_MMA(1, 0, At, B0); PG8_MMA(1, 1, At, B1); PG8_BAR; PG8_SCHED;
            PG8_LDB(B0, 1, 0); PG8_LDB(B1, 1, 1); PG8_SCHED; PG8_LDA(At, 1, 0); PG8_STAGE(PG8_SA(0, 1), a2 + hstep, voffA);
            PG8_WAIT_V(8); PG8_WAIT_L(0); PG8_BAR; PG8_MMA(0, 0, At, B0); PG8_MMA(0, 1, At, B1); PG8_BAR; PG8_SCHED;
            PG8_LDA(At, 1, 1); PG8_STAGE(PG8_SB(1, 0), b3, voffB); PG8_STAGE(PG8_SB(1, 1), b3 + hstep, voffB); PG8_STAGE(PG8_SA(1, 0), a3, voffA);
            PG8_WAIT_V(8); PG8_WAIT_L(0); PG8_BAR; PG8_MMA(1, 0, At, B0); PG8_MMA(1, 1, At, B1); PG8_BAR; PG8_SCHED;
            } else {
            PG8_LDB(B0, 0, 0); PG8_SCHED; PG8_LDA(At, 0, 0); PG8_STAGE(PG8_SA(1, 1), a1 + hstep, voffA);
            PG8_WAIT_L(8); PG8_BAR; PG8_WAIT_L(0); PG8_MMA(0, 0, At, B0); PG8_BAR; PG8_SCHED;
            PG8_LDB(B1, 0, 1); PG8_STAGE(PG8_SB(0, 0), b2, voffB);
            PG8_BAR; PG8_WAIT_L(0); PG8_MMA(0, 1, At, B1); PG8_BAR;
            PG8_LDA(At, 0, 1); PG8_STAGE(PG8_SA(0, 0), a2, voffA);
            PG8_BAR; PG8_WAIT_L(0); PG8_MMA(1, 0, At, B0); PG8_BAR; PG8_SCHED;
            PG8_STAGE(PG8_SB(0, 1), b2 + hstep, voffB);
            PG8_WAIT_V(6); PG8_BAR; PG8_MMA(1, 1, At, B1); PG8_BAR;
            PG8_LDB(B0, 1, 0); PG8_SCHED; PG8_LDA(At, 1, 0); PG8_STAGE(PG8_SA(0, 1), a2 + hstep, voffA);
            PG8_WAIT_L(8); PG8_BAR; PG8_WAIT_L(0); PG8_MMA(0, 0, At, B0); PG8_BAR; PG8_SCHED;
            PG8_LDB(B1, 1, 1); PG8_STAGE(PG8_SB(1, 0), b3, voffB);
            PG8_BAR; PG8_WAIT_L(0); PG8_MMA(0, 1, At, B1); PG8_BAR;
            PG8_LDA(At, 1, 1); PG8_STAGE(PG8_SA(1, 0), a3, voffA);
            PG8_BAR; PG8_WAIT_L(0); PG8_MMA(1, 0, At, B0); PG8_BAR; PG8_SCHED;
            PG8_STAGE(PG8_SB(1, 1), b3 + hstep, voffB);
            PG8_WAIT_V(6); PG8_BAR; PG8_MMA(1, 1, At, B1); PG8_BAR;
            }
        }
        if constexpr (ALIGN_EPI) { if (wr == 0) PG8_BAR; }
        { const int l2 = lane_id_volatile(); E(acc, cur, wr, wc, l2 & 15, l2 >> 4); }
        if (!has_next) break;
#pragma unroll
        for (int a = 0; a < 2; ++a)
#pragma unroll
            for (int b = 0; b < 2; ++b)
#pragma unroll
                for (int m = 0; m < 4; ++m)
#pragma unroll
                    for (int n = 0; n < 2; ++n) acc[a][b][m][n] = (f32x4){0.f, 0.f, 0.f, 0.f};
        cur = nxt; cA = nA; cB = nB; ++ui;
        if constexpr (ALIGN_EPI) { if (wr == 1) PG8_BAR; }
    }
    PG8_WAIT_V(0);
    if constexpr (!ALIGN_EPI) { if (wr == 0) PG8_BAR; }
    PG8_BAR;
#undef PG8_SA
#undef PG8_SB
#undef PG8_STAGE
#undef PG8_LDA
#undef PG8_LDB
#undef PG8_MMA
#undef PG8_WAIT_V
#undef PG8_WAIT_L
#undef PG8_BAR
#undef PG8_SCHED
}
}

__device__ __forceinline__ float bf2f(unsigned h) { return __uint_as_float(h << 16); }
__device__ __forceinline__ unsigned f2bf(float f) { unsigned u = __float_as_uint(f); return (u + 0x7fffu + ((u >> 16) & 1u)) >> 16; }
__device__ __forceinline__ unsigned pk2(float lo, float hi) { return f2bf(lo) | (f2bf(hi) << 16); }
__device__ __forceinline__ float fast_rcp(float x) { return __builtin_amdgcn_rcpf(x); }
__device__ __forceinline__ float sigmoidf_(float x) { return fast_rcp(1.0f + __expf(-x)); }
__device__ __forceinline__ float siluf_(float x) { return x * sigmoidf_(x); }
__device__ __forceinline__ float shfl_xor_l(float v, int lane, int mask) { return __int_as_float(__builtin_amdgcn_ds_bpermute((lane ^ mask) << 2, __float_as_int(v))); }
__device__ __forceinline__ float wave_sum(float v, int lane) {
#pragma unroll
    for (int o = 1; o < 64; o <<= 1) v += shfl_xor_l(v, lane, o);
    return v;
}
__device__ __forceinline__ float rstd_from_partials(const float* ssq, int row, float invn) {
    const f32x4* p = (const f32x4*)(ssq + (size_t)row * 16);
    const f32x4 a = p[0], b = p[1], c = p[2], d = p[3];
    const f32x4 s = (a + b) + (c + d);
    return rsqrtf(((s[0] + s[1]) + (s[2] + s[3])) * invn + EPS);
}
constexpr int RSTD_TAB_OFF = 132096;
__device__ __forceinline__ void rstd_table(const float* ssq, int pm, LAS float* tab, int wr, int wc, int fr, int fq) {
    const int t = (wr * 4 + wc) * 64 + fq * 16 + fr;
    if (t < 256) { const GAS f32x4* p = (const GAS f32x4*)((const GAS float*)ssq + (size_t)(pm * 256 + t) * 16);
        const f32x4 a = p[0], b = p[1], c = p[2], d = p[3]; const f32x4 sm = (a + b) + (c + d);
        tab[t] = rsqrtf(((sm[0] + sm[1]) + (sm[2] + sm[3])) * (1.0f / D) + EPS); }
    asm volatile("s_waitcnt lgkmcnt(0)" ::: "memory"); __builtin_amdgcn_s_barrier(); asm volatile("" ::: "memory");
}
__device__ __forceinline__ u32x4 pack8(const f32x4 v0, const f32x4 v1) {
    u32x4 w; w.x = pg8::cvt_pk_bf16(v0[0], v0[1]); w.y = pg8::cvt_pk_bf16(v0[2], v0[3]); w.z = pg8::cvt_pk_bf16(v1[0], v1[1]); w.w = pg8::cvt_pk_bf16(v1[2], v1[3]); return w;
}

#define DPP_SHR(x, n) __int_as_float(__builtin_amdgcn_update_dpp(0, __float_as_int(x), 0x110 + (n), 0xf, 0xf, false))
__device__ __forceinline__ float rowscan16(float x) {
    x += DPP_SHR(x, 1); x += DPP_SHR(x, 2); x += DPP_SHR(x, 4); x += DPP_SHR(x, 8); return x;
}
__device__ __forceinline__ float bcast15(float x, int lane) { return __int_as_float(__builtin_amdgcn_ds_bpermute((lane | 15) << 2, __float_as_int(x))); }
__device__ __forceinline__ float expc(float x) { return __expf(fminf(x, 80.0f)); }
using pg8::Unit;
struct EpiPlain {
    static constexpr bool PERM = true; static constexpr int MID_T = 0;
    bf16_t* O; int ldc;
    __device__ __forceinline__ void operator()(const f32x4 (&acc)[2][2][4][2], const Unit& u, int wr, int wc, int fr, int fq) const {
        const int row0 = u.pm * 256 + wr * 64 + fr, col0 = u.pn * 256 + wc * 32 + 8 * fq;
#pragma unroll
        for (int ai = 0; ai < 2; ++ai)
#pragma unroll
            for (int m = 0; m < 4; ++m) { bf16_t* rowp = O + (size_t)(row0 + ai * 128 + m * 16) * ldc + col0;
#pragma unroll
                for (int bj = 0; bj < 2; ++bj) *(GAS u32x4*)((GAS bf16_t*)rowp + bj * 128) = pack8(acc[ai][bj][m][0], acc[ai][bj][m][1]); }
    }
};
struct EpiIn {
    static constexpr bool PERM = true; static constexpr int MID_T = 0;
    bf16_t* Z; bf16_t* KST; float* AUX; const float* ssq; const float* lb; const float* cosT; const float* sinT; int is_ret; LAS float* tab;
    __device__ __forceinline__ void operator()(const f32x4 (&acc)[2][2][4][2], const Unit& u, int wr, int wc, int fr, int fq) const {
        const int row0 = u.pm * 256 + wr * 64 + fr, jl = wc * 32 + 8 * fq, t = u.pn;
        rstd_table(ssq, u.pm, tab, wr, wc, fr, fq);
        const LAS float* tl = tab + wr * 64 + fr;
        if (t < 6) {
            if (!is_ret) {
                const f32x4 lb0 = *(const GAS f32x4*)((const GAS float*)lb + t * 128 + (jl >> 1)), lb1 = *(const GAS f32x4*)((const GAS float*)lb + t * 128 + (jl >> 1) + 64);
#pragma unroll
                for (int ai = 0; ai < 2; ++ai)
#pragma unroll
                    for (int mp = 0; mp < 2; ++mp) {
                        const int tok0 = u.pm * 256 + ai * 128 + wr * 64 + mp * 32, rlo = tok0 + fr, rhi = rlo + 16;
                        const float rs0 = tl[ai * 128 + mp * 32], rs1 = tl[ai * 128 + mp * 32 + 16];
                        f32x4 qsv[2][2], ksv[2][2], ktv[2][2], erv[2], dcv[2];
#pragma unroll
                        for (int n = 0; n < 2; ++n)
#pragma unroll
                            for (int i = 0; i < 4; ++i) {
                                const float lbv = n ? lb1[i] : lb0[i];
                                float g[2], kk[2], qq[2];
#pragma unroll
                                for (int e = 0; e < 2; ++e) {
                                    const float x = acc[ai][1][2 * mp + e][n][i] * (e ? rs1 : rs0), za = acc[ai][0][2 * mp + e][n][i] * (e ? rs1 : rs0);
                                    const float a = __expf(-fabsf(x)), r = fast_rcp(1.0f + a);
                                    const float sneg = x >= 0.f ? a * r : r;
                                    const float em = x >= 0.f ? a : fminf(fast_rcp(a), 1.0686475e13f);
                                    g[e] = (fminf(x, 0.f) - __logf(1.0f + a)) + __logf(1.0f + lbv * em);
                                    kk[e] = (1.0f - lbv) * sneg;
                                    qq[e] = siluf_(za);
                                }
                                const float blo = rowscan16(g[0]), ref = bcast15(blo, fq * 16 + fr), bhi = ref + rowscan16(g[1]), blast = bcast15(bhi, fq * 16 + fr);
                                qsv[0][n][i] = qq[0] * expc(blo - ref); qsv[1][n][i] = qq[1] * expc(bhi - ref);
                                ksv[0][n][i] = kk[0] * expc(ref - blo); ksv[1][n][i] = kk[1] * expc(ref - bhi);
                                ktv[0][n][i] = kk[0] * __expf(blast - blo); ktv[1][n][i] = kk[1] * __expf(blast - bhi);
                                erv[n][i] = __expf(ref); dcv[n][i] = __expf(blast);
                            }
                        GAS bf16_t* zlo = (GAS bf16_t*)Z + (size_t)rlo * NIN + t * 256 + jl; GAS bf16_t* zhi = (GAS bf16_t*)Z + (size_t)rhi * NIN + t * 256 + jl;
                        *(GAS u32x4*)zlo = pack8(qsv[0][0], qsv[0][1]); *(GAS u32x4*)(zlo + 128) = pack8(ksv[0][0], ksv[0][1]);
                        *(GAS u32x4*)zhi = pack8(qsv[1][0], qsv[1][1]); *(GAS u32x4*)(zhi + 128) = pack8(ksv[1][0], ksv[1][1]);
                        *(GAS u32x4*)((GAS bf16_t*)KST + (size_t)rlo * MIXW + t * 128 + jl) = pack8(ktv[0][0], ktv[0][1]);
                        *(GAS u32x4*)((GAS bf16_t*)KST + (size_t)rhi * MIXW + t * 128 + jl) = pack8(ktv[1][0], ktv[1][1]);
                        if (fr == 15) { GAS float* ap = (GAS float*)AUX + ((size_t)((tok0 >> 11) * NH + t) * 64 + ((tok0 & 2047) >> 5)) * 256 + jl;
                            *(GAS f32x4*)ap = erv[0]; *(GAS f32x4*)(ap + 4) = erv[1]; *(GAS f32x4*)(ap + 128) = dcv[0]; *(GAS f32x4*)(ap + 132) = dcv[1]; }
                    }
            } else {
                const float lg = __log2f(1.0f - exp2f(-5.0f - (float)t));
#pragma unroll
                for (int ai = 0; ai < 2; ++ai)
#pragma unroll
                    for (int m = 0; m < 4; ++m) { const int row = row0 + ai * 128 + m * 16; const float rs = tl[ai * 128 + m * 16];
                        const f32x4 cs = *(const GAS f32x4*)((const GAS float*)cosT + (size_t)row * 64 + (jl >> 1)), sn = *(const GAS f32x4*)((const GAS float*)sinT + (size_t)row * 64 + (jl >> 1));
                        const float cp1 = (float)(16 * (m & 1) + fr + 1), pw = exp2f(cp1 * lg), ipw = exp2f(-cp1 * lg);
                        const float qsc = rs * pw, ksc = rs * 0.08838834764831845f * ipw;
                        f32x4 q0, q1, k0, k1;
#pragma unroll
                        for (int i = 0; i < 4; ++i) {
                            const float a1 = acc[ai][0][m][0][i] * qsc, a2 = acc[ai][0][m][1][i] * qsc; q0[i] = a1 * cs[i] - a2 * sn[i]; q1[i] = a1 * sn[i] + a2 * cs[i];
                            const float b1 = acc[ai][1][m][0][i] * ksc, b2 = acc[ai][1][m][1][i] * ksc; k0[i] = b1 * cs[i] - b2 * sn[i]; k1[i] = b1 * sn[i] + b2 * cs[i];
                        }
                        GAS bf16_t* zp = (GAS bf16_t*)Z + (size_t)row * NIN + t * 256 + jl; *(GAS u32x4*)zp = pack8(q0, q1); *(GAS u32x4*)(zp + 128) = pack8(k0, k1); }
            }
        } else {
            const int mode = (t >= 9 && t < 12) ? (is_ret ? 2 : 1) : 0;
#pragma unroll
            for (int ai = 0; ai < 2; ++ai)
#pragma unroll
                for (int m = 0; m < 4; ++m) { const int row = row0 + ai * 128 + m * 16; const float rs = tl[ai * 128 + m * 16];
                    GAS bf16_t* zp = (GAS bf16_t*)Z + (size_t)row * NIN + t * 256 + jl;
#pragma unroll
                    for (int bj = 0; bj < 2; ++bj) { f32x4 v0 = acc[ai][bj][m][0] * rs, v1 = acc[ai][bj][m][1] * rs;
                        if (mode == 1) {
#pragma unroll
                            for (int i = 0; i < 4; ++i) { v0[i] = sigmoidf_(v0[i]); v1[i] = sigmoidf_(v1[i]); } }
                        else if (mode == 2) {
#pragma unroll
                            for (int i = 0; i < 4; ++i) { v0[i] = siluf_(v0[i]); v1[i] = siluf_(v1[i]); } }
                        *(GAS u32x4*)(zp + bj * 128) = pack8(v0, v1); } }
        }
    }
};
struct EpiRes {
    static constexpr bool PERM = true; static constexpr int MID_T = 0;
    const bf16_t* xin; bf16_t* xb; float* ssq;
    __device__ __forceinline__ void operator()(const f32x4 (&acc)[2][2][4][2], const Unit& u, int wr, int wc, int fr, int fq) const {
        const int row0 = u.pm * 256 + wr * 64 + fr, col0 = u.pn * 256 + wc * 32 + 8 * fq;
#pragma unroll
        for (int ai = 0; ai < 2; ++ai)
#pragma unroll
            for (int m = 0; m < 4; ++m) { const int row = row0 + ai * 128 + m * 16; const size_t off = (size_t)row * D + col0; float s = 0.f;
#pragma unroll
                for (int bj = 0; bj < 2; ++bj) {
                    const u32x4 r = *(const GAS u32x4*)((const GAS bf16_t*)xin + off + bj * 128);
                    f32x4 v0, v1;
                    v0[0] = bf2f(r.x & 0xffffu); v0[1] = bf2f(r.x >> 16); v0[2] = bf2f(r.y & 0xffffu); v0[3] = bf2f(r.y >> 16);
                    v1[0] = bf2f(r.z & 0xffffu); v1[1] = bf2f(r.z >> 16); v1[2] = bf2f(r.w & 0xffffu); v1[3] = bf2f(r.w >> 16);
                    v0 = v0 + acc[ai][bj][m][0]; v1 = v1 + acc[ai][bj][m][1];
                    *(GAS u32x4*)((GAS bf16_t*)xb + off + bj * 128) = pack8(v0, v1);
                    s += (v0[0] * v0[0] + v0[1] * v0[1]) + (v0[2] * v0[2] + v0[3] * v0[3]) + (v1[0] * v1[0] + v1[1] * v1[1]) + (v1[2] * v1[2] + v1[3] * v1[3]);
                }
                s += shfl_xor_l(s, fq * 16 + fr, 16); s += shfl_xor_l(s, fq * 16 + fr, 32);
                if (fq == 0) ((GAS float*)ssq)[(size_t)row * 16 + u.pn * 4 + wc] = s; }
    }
};
struct EpiResC {
    static constexpr bool PERM = true; static constexpr int MID_T = 12;
    EpiRes base; const float* ssqo;
    __device__ __forceinline__ void mid(f32x4 (&acc)[2][2][4][2], const Unit& u, int wr, int wc, int fr, int fq) const {
        if (!ssqo) return;
        const int row0 = u.pm * 256 + wr * 64 + fr;
#pragma unroll
        for (int ai = 0; ai < 2; ++ai)
#pragma unroll
            for (int m = 0; m < 4; ++m) { const int row = row0 + ai * 128 + m * 16;
                const GAS f32x4* sp = (const GAS f32x4*)((const GAS float*)ssqo + (size_t)row * 16); float tot = 0.f;
#pragma unroll
                for (int q4 = 0; q4 < (NH * NVS + 3) / 4; ++q4) { const f32x4 a = sp[q4];
#pragma unroll
                    for (int e = 0; e < 4; ++e) if (4 * q4 + e < NH * NVS) tot += a[e]; }
                const float rs = rsqrtf(tot * (1.0f / MIXW) + EPS);
#pragma unroll
                for (int bj = 0; bj < 2; ++bj)
#pragma unroll
                    for (int n = 0; n < 2; ++n) acc[ai][bj][m][n] = acc[ai][bj][m][n] * rs;
                asm volatile("" ::: "memory"); }
    }
    __device__ __forceinline__ void operator()(const f32x4 (&acc)[2][2][4][2], const Unit& u, int wr, int wc, int fr, int fq) const { base(acc, u, wr, wc, fr, fq); }
};
struct EpiFfn {
    static constexpr bool PERM = true; static constexpr int MID_T = 0;
    bf16_t* act; const float* ssq; LAS float* tab;
    __device__ __forceinline__ void operator()(const f32x4 (&acc)[2][2][4][2], const Unit& u, int wr, int wc, int fr, int fq) const {
        const int row0 = u.pm * 256 + wr * 64 + fr, jl = wc * 32 + 8 * fq;
        rstd_table(ssq, u.pm, tab, wr, wc, fr, fq);
        const LAS float* tl = tab + wr * 64 + fr;
#pragma unroll
        for (int ai = 0; ai < 2; ++ai)
#pragma unroll
            for (int m = 0; m < 4; ++m) { const int row = row0 + ai * 128 + m * 16; const float rs = tl[ai * 128 + m * 16];
                f32x4 v0, v1;
#pragma unroll
                for (int i = 0; i < 4; ++i) { v0[i] = siluf_(acc[ai][0][m][0][i] * rs) * (acc[ai][1][m][0][i] * rs); v1[i] = siluf_(acc[ai][0][m][1][i] * rs) * (acc[ai][1][m][1][i] * rs); }
                *(GAS u32x4*)((GAS bf16_t*)act + (size_t)row * DFF + u.pn * 128 + jl) = pack8(v0, v1); }
    }
};

#define XB_TMO      128
#define XB_XCNT(j)  (256  + 64 * (j))
#define XB_XSUB(j)  (1280 + 64 * (j))
#define XB_XGEN(j)  (2304 + 64 * (j))
#define XB_TOP      3328
#define XB_TOPGEN   3392
#define XCD_BAR_WORDS 3456
#define XB_SPIN_CAP (1u << 18)
__device__ __forceinline__ unsigned xb_ld(unsigned* p)              { return __hip_atomic_load(p, __ATOMIC_RELAXED, __HIP_MEMORY_SCOPE_AGENT); }
__device__ __forceinline__ unsigned xb_add(unsigned* p, unsigned v) { return __hip_atomic_fetch_add(p, v, __ATOMIC_RELAXED, __HIP_MEMORY_SCOPE_AGENT); }
__device__ __forceinline__ unsigned xb_xcc_id() { return (unsigned)__builtin_amdgcn_s_getreg((3 << 11) | 20) & 0xFu; }
#define XB_SPIN(cond, bar) do { unsigned _sp = 0; while (cond) { __builtin_amdgcn_s_sleep(1); \
    if ((++_sp & 255u) == 0u) { if (xb_ld(&(bar)[XB_TMO])) break; if (_sp > XB_SPIN_CAP) { atomicAdd(&(bar)[XB_TMO], 1u); break; } } } } while (0)
struct XcdBarrier { unsigned* bar; unsigned x; volatile LAS unsigned* st; };
__device__ __forceinline__ XcdBarrier xcd_barrier_post(unsigned* bar, volatile LAS unsigned* st) {
    XcdBarrier b; b.bar = bar; b.x = xb_xcc_id(); b.st = st;
    if (threadIdx.x == 0) st[2] = xb_add(&bar[XB_XCNT(b.x)], 1u);
    return b;
}
#define XB_LOC(j) (3456 + 64 * (j))
__device__ __forceinline__ void xcc_barrier(const XcdBarrier& b, unsigned n, bool leader) {
    asm volatile("s_waitcnt vmcnt(0)" ::: "memory");
    __syncthreads();
    if (leader) {
        unsigned* bar = b.bar; unsigned* cnt = &bar[XB_LOC(b.x)];
        __builtin_amdgcn_s_waitcnt(0);
        const unsigned old = xb_add(cnt, 1u), target = (old / n + 1u) * n;
        XB_SPIN(xb_ld(cnt) < target, bar);
        __builtin_amdgcn_fence(__ATOMIC_ACQUIRE, "agent");
        asm volatile("s_waitcnt vmcnt(0)" ::: "memory");
    }
    __syncthreads();
}
__device__ __forceinline__ void xcd_barrier_complete(unsigned* bar, unsigned x, unsigned& nloc, unsigned& nx) {
    const unsigned G = gridDim.x * gridDim.y * gridDim.z;
    unsigned sum, cnt, mine, sp = 0u;
    for (;;) {
        sum = 0u; cnt = 0u; mine = 0u;
#pragma unroll
        for (unsigned j = 0; j < 16; ++j) { const unsigned c = xb_ld(&bar[XB_XCNT(j)]); sum += c; cnt += (c > 0u) ? 1u : 0u; mine = (j == x) ? c : mine; }
        if (sum == G) break;
        __builtin_amdgcn_s_sleep(1);
        if ((++sp & 255u) == 0u) { if (xb_ld(&bar[XB_TMO])) break; if (sp > XB_SPIN_CAP) { atomicAdd(&bar[XB_TMO], 1u); break; } }
    }
    nloc = mine > 0u ? mine : 1u; nx = cnt > 0u ? cnt : 1u;
}
__device__ __forceinline__ void xcd_barrier(const XcdBarrier& b, bool leader) {
    asm volatile("s_waitcnt vmcnt(0)" ::: "memory");
    __syncthreads();
    if (leader) {
        unsigned* bar = b.bar;
        __builtin_amdgcn_s_waitcnt(0);
        unsigned nloc = b.st[0], nx = b.st[1];
        if (nloc == 0u) { xcd_barrier_complete(bar, b.x, nloc, nx); b.st[0] = nloc; b.st[1] = nx; }
        const unsigned old = xb_add(&bar[XB_XSUB(b.x)], 1u);
        const unsigned gen = old / nloc;
        if (old + 1u == (gen + 1u) * nloc) {
            __builtin_amdgcn_fence(__ATOMIC_RELEASE, "agent");
            asm volatile("s_waitcnt vmcnt(0)" ::: "memory");
            const unsigned og = xb_add(&bar[XB_TOP], 1u);
            const unsigned tg = og / nx;
            if (og + 1u == (tg + 1u) * nx) xb_add(&bar[XB_TOPGEN], 1u);
            else XB_SPIN(xb_ld(&bar[XB_TOPGEN]) == tg, bar);
            __builtin_amdgcn_fence(__ATOMIC_ACQUIRE, "agent");
            xb_add(&bar[XB_XGEN(b.x)], 1u);
            asm volatile("s_waitcnt vmcnt(0)" ::: "memory");
        } else {
            XB_SPIN(xb_ld(&bar[XB_XGEN(b.x)]) == gen, bar);
            __builtin_amdgcn_fence(__ATOMIC_ACQUIRE, "agent");
            asm volatile("s_waitcnt vmcnt(0)" ::: "memory");
        }
    }
    __syncthreads();
}

constexpr int RING_BYTES = 131072, LDSCTL_OFF = RING_BYTES, MISC_OFF = LDSCTL_OFF + 320, LDS_BYTES = 147456;
constexpr int NWAVES = 8;

__device__ __forceinline__ int misc_rd(LAS unsigned char* lds, int idx) { unsigned off = (unsigned)(MISC_OFF + 4 * idx); asm volatile("" : "+v"(off)); return __builtin_amdgcn_readfirstlane((int)*(volatile LAS unsigned*)(lds + off)); }
struct Args { const float* in[15]; float* out; unsigned char* ws; int ph_lo, ph_hi; };

__device__ __forceinline__ int win_srccol(int j) {
    const int t = j >> 8;
    if (t >= 6) return j;
    const int jj = j & 255, half = jj >> 7, p = jj & 127, d = 4 * (p >> 3) + (p & 3) + 64 * ((p >> 2) & 1);
    return half * MIXW + t * 128 + d;
}
__device__ __forceinline__ int wfi_srccol(int j) { const int t = j >> 8, jj = j & 255; return (jj < 128 ? 0 : DFF) + t * 128 + (jj & 127); }
struct TItem { const GAS float* W; GAS bf16_t* WT; const GAS float* kscale; int K, N, ndst, kind, nscale, item; };
__device__ __forceinline__ TItem titem_decode(const Args& a, unsigned char* ws, int it) {
    constexpr int I0 = 16 * (NIN / 32), I1 = 16 * 32, I2 = 16 * (NFI / 32), I3 = (DFF / 64) * 32, I4 = 16 * 16, IL = I0 + I1 + I2 + I3 + I4;
    const int l = it / IL; int r = it % IL; TItem t;
    if (r < I0) { t.W = (const GAS float*)a.in[4] + (size_t)l * D * NIN; t.WT = (GAS bf16_t*)(ws + WS_WIN) + (size_t)l * NIN * D; t.kscale = (const GAS float*)a.in[3] + l * D; t.K = D; t.N = NIN; t.ndst = NIN; t.kind = 0; t.nscale = D; t.item = r; return t; } r -= I0;
    if (r < I1) { t.W = (const GAS float*)a.in[5] + (size_t)l * D * D; t.WT = (GAS bf16_t*)(ws + WS_WOUT) + (size_t)l * D * D; t.kscale = (const GAS float*)((l & 1) ? a.in[10] : a.in[9]) + (l >> 1) * MIXW; t.K = D; t.N = D; t.ndst = D; t.kind = 1; t.nscale = MIXW; t.item = r; return t; } r -= I1;
    if (r < I2) { t.W = (const GAS float*)a.in[12] + (size_t)l * D * NFI; t.WT = (GAS bf16_t*)(ws + WS_WFI) + (size_t)l * NFI * D; t.kscale = (const GAS float*)a.in[11] + l * D; t.K = D; t.N = NFI; t.ndst = NFI; t.kind = 2; t.nscale = D; t.item = r; return t; } r -= I2;
    if (r < I3) { t.W = (const GAS float*)a.in[13] + (size_t)l * DFF * D; t.WT = (GAS bf16_t*)(ws + WS_WFO) + (size_t)l * D * DFF; t.kscale = (const GAS float*)a.in[13]; t.K = DFF; t.N = D; t.ndst = D; t.kind = 3; t.nscale = 0; t.item = r; return t; } r -= I3;
    t.W = (const GAS float*)a.in[7] + (size_t)l * D * 512; t.WT = (GAS bf16_t*)(ws + WS_WM) + (size_t)l * 512 * D; t.kscale = (const GAS float*)a.in[6] + l * D; t.K = D; t.N = 512; t.ndst = 512; t.kind = 4; t.nscale = D; t.item = r; return t;
}
__device__ __forceinline__ void titem_load(const TItem& t, f32x4 (&v)[8], int lane) {
    const int nblk = t.ndst / 32, kb = t.item / nblk, nb = t.item % nblk, k0 = 64 * kb, n0 = 32 * nb, kq = lane >> 3, jd = n0 + 4 * (lane & 7);
    const int sc = t.kind == 0 ? win_srccol(jd) : (t.kind == 2 ? wfi_srccol(jd) : jd);
#pragma unroll
    for (int i = 0; i < 8; ++i) v[i] = *(const GAS f32x4*)(t.W + (size_t)(k0 + 8 * i + kq) * t.N + sc);
}
__device__ __forceinline__ void titem_store(const TItem& t, const f32x4 (&v)[8], LAS float* scr, int lane) {
    const int nblk = t.ndst / 32, kb = t.item / nblk, nb = t.item % nblk, k0 = 64 * kb, n0 = 32 * nb, kq = lane >> 3, nq = lane & 7;
#pragma unroll
    for (int i = 0; i < 8; ++i)
#pragma unroll
        for (int e = 0; e < 4; ++e) scr[(8 * i + kq) * 33 + 4 * nq + e] = v[i][e];
    const int c = lane & 7;
    f32x4 s0 = (f32x4){1.f, 1.f, 1.f, 1.f}, s1 = s0;
    if (k0 + 8 * c < t.nscale) { s0 = *(const GAS f32x4*)(t.kscale + k0 + 8 * c); s1 = *(const GAS f32x4*)(t.kscale + k0 + 8 * c + 4); }
    asm volatile("s_waitcnt lgkmcnt(0)" ::: "memory");
#pragma unroll
    for (int j = 0; j < 4; ++j) { const int n = (lane >> 3) + 8 * j; const LAS float* s = scr + (8 * c) * 33 + n;
        u32x4 o; o.x = pk2(s[0 * 33] * s0[0], s[1 * 33] * s0[1]); o.y = pk2(s[2 * 33] * s0[2], s[3 * 33] * s0[3]); o.z = pk2(s[4 * 33] * s1[0], s[5 * 33] * s1[1]); o.w = pk2(s[6 * 33] * s1[2], s[7 * 33] * s1[3]);
        *(GAS u32x4*)(t.WT + (size_t)(n0 + n) * t.K + k0 + 8 * c) = o; }
    asm volatile("s_waitcnt lgkmcnt(0)" ::: "memory");
}

constexpr int TITEMS_PER_LAYER = 16 * (NIN / 32) + 16 * 32 + 16 * (NFI / 32) + (DFF / 64) * 32 + 16 * 16;
__device__ __forceinline__ void convert_weights(const Args& a, unsigned char* ws, LAS float* scr, int it0, int it1, int w, int nw, int lane, int off = 0, int mul = 1) {
    f32x4 va[8], vb[8];
    nw *= mul;
    int it = it0 + off + mul * w;
    if (it < it1) { const TItem t = titem_decode(a, ws, it); titem_load(t, va, lane); }
    while (it < it1) {
        const int itn = it + nw;
        if (itn < it1) { const TItem t = titem_decode(a, ws, itn); titem_load(t, vb, lane); }
        { const TItem t = titem_decode(a, ws, it); titem_store(t, va, scr, lane); }
        it = itn;
        if (it >= it1) break;
        const int itn2 = it + nw;
        if (itn2 < it1) { const TItem t = titem_decode(a, ws, itn2); titem_load(t, va, lane); }
        { const TItem t = titem_decode(a, ws, it); titem_store(t, vb, scr, lane); }
        it = itn2;
    }
}

__device__ __forceinline__ void p0_prologue(const Args& a, unsigned char* ws, LAS unsigned char* lds, int gw, int NGW, int wave, int lane) {
    LAS float* scr = (LAS float*)(lds + wave * 16384);
    convert_weights(a, ws, scr, 0, 16 * (NIN / 32), gw, NGW, lane);
    for (int l = 0; l < DEPTH; ++l) convert_weights(a, ws, scr, l * TITEMS_PER_LAYER + TITEMS_PER_LAYER - 256, (l + 1) * TITEMS_PER_LAYER, gw, NGW, lane);
    for (int m = gw; m < M; m += NGW) {
        const f32x4* xr = (const f32x4*)(a.in[0] + (size_t)m * D) + lane; f32x4 v[4]; float s = 0.f;
#pragma unroll
        for (int j = 0; j < 4; ++j) { v[j] = xr[64 * j]; s += (v[j].x * v[j].x + v[j].y * v[j].y) + (v[j].z * v[j].z + v[j].w * v[j].w); }
        s = wave_sum(s, lane);
        u32x2* o8 = (u32x2*)((bf16_t*)(ws + WS_XB) + (size_t)m * D) + lane;
#pragma unroll
        for (int j = 0; j < 4; ++j) { u32x2 w; w.x = pk2(v[j].x, v[j].y); w.y = pk2(v[j].z, v[j].w); o8[64 * j] = w; }
        if (lane < 16) ((float*)(ws + WS_SSQA))[(size_t)m * 16 + lane] = lane == 0 ? s : 0.f;
    }
    for (int m = gw; m < MROWS; m += NGW) {
        const f32x4* xr = (const f32x4*)(a.in[1] + (size_t)m * D) + lane; f32x4 v[4]; float s = 0.f;
#pragma unroll
        for (int j = 0; j < 4; ++j) { v[j] = xr[64 * j]; s += (v[j].x * v[j].x + v[j].y * v[j].y) + (v[j].z * v[j].z + v[j].w * v[j].w); }
        const float rs = rsqrtf(wave_sum(s, lane) * (1.0f / D) + EPS);
        u32x2* o8 = (u32x2*)((bf16_t*)(ws + WS_MEMB) + (size_t)m * D) + lane;
#pragma unroll
        for (int j = 0; j < 4; ++j) { u32x2 w; w.x = pk2(v[j].x * rs, v[j].y * rs); w.y = pk2(v[j].z * rs, v[j].w * rs); o8[64 * j] = w; }
    }
    {   const double invf = exp(-9.210340371976184 * ((double)lane / 63.0));
        for (int m = gw; m < M; m += NGW) {
            const double ang = (double)((const GAS int*)a.in[2])[m] * invf;
            const double kr = rint(ang * 0.15915494309189535);
            const float r = (float)fma(-kr, 1.2246467991473532e-16 * 2.0, fma(-kr, 6.283185307179586, ang));
            float sn, cs; sincosf(r, &sn, &cs);
            ((GAS float*)(ws + WS_COS))[(size_t)m * 64 + lane] = cs;
            ((GAS float*)(ws + WS_SIN))[(size_t)m * 64 + lane] = sn;
        }
    }
    for (int c = gw * 64 + lane; c < MIXW; c += NGW * 64) {
        const float l0 = a.in[8][c], l1 = a.in[8][MIXW + c]; const float mx = fmaxf(l0, l1), e0 = expf(l0 - mx), e1 = expf(l1 - mx);
        ((float*)(ws + WS_LB))[c] = 0.f; ((float*)(ws + WS_LB))[MIXW + c] = e1 / (e0 + e1);
    }
}

typedef float f32x16 __attribute__((ext_vector_type(16)));
constexpr int SC_QS = 0, SC_KS = 8704, SC_KST = 17408, SC_V = 27648, SC_P = 37888, SC_AUX = 40448, SC_OUT = 41472, SC_SSQ = 50176, SC_GATE = 50688, SC_BUF = 50688 + 32 * VPR * 16;
constexpr int PQ = 272, PT = 320;
constexpr int NCHUNK = SEQ / 32;
typedef const GAS bf16_t* gbf;
struct HRegs { u32x4 x0[8], x1[8]; float aux[2]; };
__device__ __forceinline__ bf16x8 as_bf16x8(u32x4 v) { return __builtin_bit_cast(bf16x8, v); }

struct StLane { unsigned g0, g1, gg, ga, l0, l1, lg, la, sk; };
template <int IS_RET>
__device__ __forceinline__ void stager_load(HRegs& R, gbf Z, gbf KST, const GAS float* AUXG, int b, int h, int unit, int sw, const StLane& L, int chunk) {
    chunk = chunk < NCHUNK ? chunk : NCHUNK - 1;
    const size_t tok0 = (size_t)b * SEQ + chunk * 32;
    const int p0 = (sw == 0 || IS_RET) ? NIN : MIXW;
    const GAS char* s0 = (const GAS char*)(sw == 0 ? Z + h * 256 : (IS_RET ? Z + h * 256 + 128 : KST + h * 128)) + tok0 * p0 * 2;
    const GAS char* s1 = (const GAS char*)(sw == 0 ? Z + h * 256 + 128 : Z + 1536 + h * 128) + tok0 * NIN * 2;
#pragma unroll
    for (int i = 0; i < 8; ++i) R.x0[i] = *(const GAS u32x4*)(s0 + (size_t)(4 * i) * p0 * 2 + L.g0);
    if (sw == 0) {
#pragma unroll
        for (int i = 0; i < 8; ++i) R.x1[i] = *(const GAS u32x4*)(s1 + 32 * i + L.g1);
    } else {
#pragma unroll
        for (int i = 0; i < 8 / NVS; ++i) R.x1[i] = *(const GAS u32x4*)(s1 + (size_t)(4 * NVS * i) * NIN * 2 + L.g1);
    }
    if (!IS_RET) { const GAS char* ag = (const GAS char*)(AUXG + ((size_t)unit * 64 + chunk) * 256 + 128 * sw); R.aux[0] = *(const GAS float*)(ag + L.ga); R.aux[1] = *(const GAS float*)(ag + 256 + L.ga); }
}
template <int IS_RET>
__device__ __forceinline__ void stager_stage(const HRegs& R, LAS unsigned char* buf, LAS unsigned char* gbuf, int sw, const StLane& L) {
    const int o0 = sw == 0 ? SC_QS : SC_KST, o1 = sw == 0 ? SC_KS : SC_V, pit = sw == 0 ? PQ : PT;
    LAS unsigned char* d0 = buf + o0 + L.l0; LAS unsigned char* d1 = buf + o1 + L.l1;
#pragma unroll
    for (int i = 0; i < 8; ++i) *(LAS u32x4*)(d0 + 4 * i * pit) = R.x0[i];
    if (sw != 0) {
#pragma unroll
        for (int i = 0; i < 8 / NVS; ++i) *(LAS u32x4*)(d1 + 4 * NVS * i * PT) = R.x1[i];
    }
    if (!IS_RET) { LAS unsigned char* al = buf + SC_AUX + 512 * sw + L.la; *(LAS float*)al = R.aux[0]; *(LAS float*)(al + 256) = R.aux[1]; }
}
__device__ __forceinline__ void scores_stage(const HRegs& R, LAS unsigned char* buf, const StLane& L, int l31, int hh) {
    f32x16 d;
#pragma unroll
    for (int r = 0; r < 16; ++r) d[r] = 0.f;
    u32x4 qf[8];
    {   const unsigned aq = (unsigned)(size_t)(buf + SC_QS) + L.sk;
        asm volatile(
            "ds_read_b128 %0, %8 offset:0\n\tds_read_b128 %1, %8 offset:32\n\tds_read_b128 %2, %8 offset:64\n\tds_read_b128 %3, %8 offset:96\n\t"
            "ds_read_b128 %4, %8 offset:128\n\tds_read_b128 %5, %8 offset:160\n\tds_read_b128 %6, %8 offset:192\n\tds_read_b128 %7, %8 offset:224\n\t"
            "s_waitcnt lgkmcnt(0)"
            : "=&v"(qf[0]), "=&v"(qf[1]), "=&v"(qf[2]), "=&v"(qf[3]), "=&v"(qf[4]), "=&v"(qf[5]), "=&v"(qf[6]), "=&v"(qf[7])
            : "v"(aq) : "memory");
        __builtin_amdgcn_sched_barrier(0);
    }
#pragma unroll
    for (int kk = 0; kk < 8; ++kk) d = __builtin_amdgcn_mfma_f32_32x32x16_bf16(as_bf16x8(R.x1[kk]), as_bf16x8(qf[kk]), d, 0, 0, 0);
#pragma unroll
    for (int q = 0; q < 4; ++q) { float v4[4];
#pragma unroll
        for (int i = 0; i < 4; ++i) { const int srow = 8 * q + 4 * hh + i; v4[i] = (srow <= l31) ? d[4 * q + i] : 0.f; }
        u32x2 w; w.x = pg8::cvt_pk_bf16(v4[0], v4[1]); w.y = pg8::cvt_pk_bf16(v4[2], v4[3]);
        *(LAS u32x2*)(buf + SC_P + l31 * 80 + (8 * q + 4 * hh) * 2) = w; }
}
struct FinLane { unsigned lo, ls, go, gs, gz; };
constexpr int FPT = 32 * VPR / 64;
template <int IS_RET>
__device__ __forceinline__ void gate_load(u32x4 (&g)[FPT], gbf Z, int b, int h, const FinLane& L, int chunk) {
    chunk = chunk < NCHUNK ? chunk : NCHUNK - 1;
    const GAS char* sg = (const GAS char*)(Z + 2304 + h * 128) + ((size_t)b * SEQ + chunk * 32) * NIN * 2;
#pragma unroll
    for (int i = 0; i < FPT; ++i) g[i] = *(const GAS u32x4*)(sg + (size_t)(64 / VPR * i) * NIN * 2 + L.gz);
}
__device__ __forceinline__ void gate_stage(const u32x4 (&g)[FPT], LAS unsigned char* buf, int lane) {
#pragma unroll
    for (int i = 0; i < FPT; ++i) *(LAS u32x4*)(buf + SC_GATE + (lane + 64 * i) * 16) = g[i];
}
template <int IS_RET>
__device__ __forceinline__ void fin_store(LAS unsigned char* buf, GAS bf16_t* CAT, GAS float* SSQO, int b, int h, int vh, const FinLane& L, int lane, bool first, int chunk) {
    const size_t tok0 = (size_t)b * SEQ + chunk * 32;
    GAS char* cg = (GAS char*)(CAT + tok0 * D + h * 128); GAS char* sgp = (GAS char*)(SSQO + tok0 * 16 + h * NVS + vh);
#pragma unroll
    for (int i = 0; i < FPT; ++i) {
        const u32x2 lo = *(const LAS u32x2*)(buf + SC_OUT + (64 / VPR) * i * PQ + L.lo), hi = *(const LAS u32x2*)(buf + SC_OUT + (64 / VPR) * i * PQ + 8 + L.lo);
        const LAS unsigned char* sq = buf + SC_SSQ + (64 / VPR) * 4 * i + L.ls;
        float ssum = *(const LAS float*)sq;
#pragma unroll
        for (int w = 1; w < 4 / NVS; ++w) ssum += *(const LAS float*)(sq + 128 * w);
        const float sc = (IS_RET && NVS == 1) ? rsqrtf(ssum * (1.0f / HD) + EPS) : 1.0f;
        const u32x4 gt = *(const LAS u32x4*)(buf + SC_GATE + (lane + 64 * i) * 16);
        const unsigned ow[4] = {lo.x, lo.y, hi.x, hi.y}; u32x4 out;
#pragma unroll
        for (int j = 0; j < 4; ++j) out[j] = pg8::cvt_pk_bf16(__uint_as_float(ow[j] << 16) * sc * __uint_as_float(gt[j] << 16), __uint_as_float(ow[j] & 0xffff0000u) * sc * __uint_as_float(gt[j] & 0xffff0000u));
        *(GAS u32x4*)(cg + (size_t)(64 / VPR * i) * D * 2 + L.go) = out;
        if ((!IS_RET || NVS > 1) && first) *(GAS float*)(sgp + (size_t)(64 / VPR * i) * 64 + L.gs) = ssum; }
}
__device__ __forceinline__ void norm_rows(unsigned char* ws, int row0, int row1, int gw, int NGW, int lane) {
    GAS bf16_t* CAT = (GAS bf16_t*)(ws + WS_CAT); const GAS float* SSQO = (const GAS float*)(ws + WS_SSQO);
    for (int row = row0 + gw; row < row1; row += NGW) {
#pragma unroll
        for (int j = 0; j < 3; ++j) { const int e = lane * 4 + 256 * j, h = e >> 7;
            float ssum = 0.f;
#pragma unroll
            for (int q = 0; q < NVS; ++q) ssum += SSQO[(size_t)row * 16 + h * NVS + q];
            const float sc = rsqrtf(ssum * (1.0f / HD) + EPS);
            GAS u32x2* p = (GAS u32x2*)(CAT + (size_t)row * D + e); const u32x2 w = *p; u32x2 o;
            o.x = pg8::cvt_pk_bf16(__uint_as_float(w.x << 16) * sc, __uint_as_float(w.x & 0xffff0000u) * sc); o.y = pg8::cvt_pk_bf16(__uint_as_float(w.y << 16) * sc, __uint_as_float(w.y & 0xffff0000u) * sc);
            *p = o; }
    }
}
#define TRR(dst, areg, off) "ds_read_b64_tr_b16 " dst ", " areg " offset:" #off "\n\t"
struct MLane { unsigned av, ak, aq, aaux, ap, aout, assq; };
template <int IS_RET, int PAR>
__device__ __forceinline__ void mfma_step(f32x16 (&S)[4], const MLane& A, int lane, float g32) {
    constexpr unsigned PB = PAR * SC_BUF;
    u32x2 v00, v01, v10, v11, k[4][2][2]; u32x4 qf[4][2];
    const unsigned av = A.av + PB, ak = A.ak + PB, aq = A.aq + PB;
    asm volatile(
        "ds_read_b128 %0, %8 offset:0\n\tds_read_b128 %1, %8 offset:32\n\tds_read_b128 %2, %8 offset:64\n\tds_read_b128 %3, %8 offset:96\n\t"
        "ds_read_b128 %4, %8 offset:128\n\tds_read_b128 %5, %8 offset:160\n\tds_read_b128 %6, %8 offset:192\n\tds_read_b128 %7, %8 offset:224"
        : "=&v"(qf[0][0]), "=&v"(qf[0][1]), "=&v"(qf[1][0]), "=&v"(qf[1][1]), "=&v"(qf[2][0]), "=&v"(qf[2][1]), "=&v"(qf[3][0]), "=&v"(qf[3][1])
        : "v"(aq) : "memory");
    asm volatile(
        TRR("%0", "%12", 0) TRR("%1", "%12", 1280) TRR("%2", "%12", 5120) TRR("%3", "%12", 6400)
        TRR("%4", "%13", 0) TRR("%5", "%13", 1280) TRR("%6", "%13", 5120) TRR("%7", "%13", 6400)
        TRR("%8", "%13", 64) TRR("%9", "%13", 1344) TRR("%10", "%13", 5184) TRR("%11", "%13", 6464)
        : "=&v"(v00), "=&v"(v01), "=&v"(v10), "=&v"(v11),
          "=&v"(k[0][0][0]), "=&v"(k[0][0][1]), "=&v"(k[0][1][0]), "=&v"(k[0][1][1]), "=&v"(k[1][0][0]), "=&v"(k[1][0][1]), "=&v"(k[1][1][0]), "=&v"(k[1][1][1])
        : "v"(av), "v"(ak) : "memory");
    const LAS unsigned char* auxp = (const LAS unsigned char*)(size_t)(A.aaux + PB);
    bf16x8 sf[4][2];
#pragma unroll
    for (int kt = 0; kt < 4; ++kt) { f32x16 t = S[kt];
        if (!IS_RET) {
#pragma unroll
            for (int q = 0; q < 4; ++q) { const f32x4 e = *(const LAS f32x4*)(auxp + (32 * kt + 16 * (q >> 1) + 4 * (q & 1)) * 4);
#pragma unroll
                for (int i = 0; i < 4; ++i) t[4 * q + i] *= e[i]; } }
#pragma unroll
        for (int s2 = 0; s2 < 2; ++s2) { u32x4 pk;
#pragma unroll
            for (int j = 0; j < 4; ++j) pk[j] = pg8::cvt_pk_bf16(t[8 * s2 + 2 * j], t[8 * s2 + 2 * j + 1]);
            sf[kt][s2] = as_bf16x8(pk); } }
    asm volatile("s_waitcnt lgkmcnt(12)" : "+v"(qf[0][0]), "+v"(qf[0][1]), "+v"(qf[1][0]), "+v"(qf[1][1]), "+v"(qf[2][0]), "+v"(qf[2][1]), "+v"(qf[3][0]), "+v"(qf[3][1]) :: "memory");
    asm volatile(
        TRR("%0", "%8", 128) TRR("%1", "%8", 1408) TRR("%2", "%8", 5248) TRR("%3", "%8", 6528)
        TRR("%4", "%8", 192) TRR("%5", "%8", 1472) TRR("%6", "%8", 5312) TRR("%7", "%8", 6592)
        : "=&v"(k[2][0][0]), "=&v"(k[2][0][1]), "=&v"(k[2][1][0]), "=&v"(k[2][1][1]), "=&v"(k[3][0][0]), "=&v"(k[3][0][1]), "=&v"(k[3][1][0]), "=&v"(k[3][1][1])
        : "v"(ak) : "memory");
    __builtin_amdgcn_sched_barrier(0);
    f32x16 o;
#pragma unroll
    for (int r = 0; r < 16; ++r) o[r] = 0.f;
#pragma unroll
    for (int kt = 0; kt < 4; ++kt)
#pragma unroll
        for (int s2 = 0; s2 < 2; ++s2) o = __builtin_amdgcn_mfma_f32_32x32x16_bf16(sf[kt][s2], as_bf16x8(qf[kt][s2]), o, 0, 0, 0);
    __builtin_amdgcn_sched_barrier(0);
    asm volatile("s_waitcnt lgkmcnt(0)" : "+v"(v00), "+v"(v01), "+v"(v10), "+v"(v11),
          "+v"(k[0][0][0]), "+v"(k[0][0][1]), "+v"(k[0][1][0]), "+v"(k[0][1][1]), "+v"(k[1][0][0]), "+v"(k[1][0][1]), "+v"(k[1][1][0]), "+v"(k[1][1][1]),
          "+v"(k[2][0][0]), "+v"(k[2][0][1]), "+v"(k[2][1][0]), "+v"(k[2][1][1]), "+v"(k[3][0][0]), "+v"(k[3][0][1]), "+v"(k[3][1][0]), "+v"(k[3][1][1]) :: "memory");
    __builtin_amdgcn_sched_barrier(0);
    const bf16x8 vt[2] = {as_bf16x8((u32x4){v00.x, v00.y, v01.x, v01.y}), as_bf16x8((u32x4){v10.x, v10.y, v11.x, v11.y})};
    const LAS unsigned char* pp = (const LAS unsigned char*)(size_t)(A.ap + PB);
#pragma unroll
    for (int kk = 0; kk < 2; ++kk) { const bf16x8 pf = *(const LAS bf16x8*)(pp + 32 * kk);
        o = __builtin_amdgcn_mfma_f32_32x32x16_bf16(vt[kk], pf, o, 0, 0, 0); }
#pragma unroll
    for (int kt = 0; kt < 4; ++kt) {
        if (!IS_RET) {
#pragma unroll
            for (int q = 0; q < 4; ++q) { const f32x4 e = *(const LAS f32x4*)(auxp + 512 + (32 * kt + 16 * (q >> 1) + 4 * (q & 1)) * 4);
#pragma unroll
                for (int i = 0; i < 4; ++i) S[kt][4 * q + i] *= e[i]; } }
#pragma unroll
        for (int kk = 0; kk < 2; ++kk) S[kt] = __builtin_amdgcn_mfma_f32_32x32x16_bf16(as_bf16x8((u32x4){k[kt][kk][0].x, k[kt][kk][0].y, k[kt][kk][1].x, k[kt][kk][1].y}), vt[kk], S[kt], 0, 0, 0);
        if (IS_RET) S[kt] = S[kt] * g32;
    }
    float ss = 0.f;
#pragma unroll
    for (int r = 0; r < 16; ++r) ss += o[r] * o[r];
    ss += shfl_xor_l(ss, lane, 32);
    if (lane < 32) *(LAS float*)(size_t)(A.assq + PB) = ss;
    LAS unsigned char* op = (LAS unsigned char*)(size_t)(A.aout + PB);
#pragma unroll
    for (int q = 0; q < 4; ++q) { u32x2 wv; wv.x = pg8::cvt_pk_bf16(o[4 * q], o[4 * q + 1]); wv.y = pg8::cvt_pk_bf16(o[4 * q + 2], o[4 * q + 3]);
        *(LAS u32x2*)(op + 16 * q) = wv; }
}
template <int IS_RET, int VAR>
__device__ __forceinline__ void scan2_unit(unsigned char* ws, LAS unsigned char* lds, int unit, int tid) {
    constexpr bool MF_ON = VAR == 0 || ((VAR & 16) && (VAR & 1)), ST_ON = VAR == 0 || ((VAR & 16) && (VAR & 2)), FI_ON = VAR == 0 || ((VAR & 16) && (VAR & 4)), ST_LD = ST_ON && !(VAR & 64), ST_ST = ST_ON && !(VAR & 32);
    gbf Z = (gbf)(ws + WS_Z); gbf KST = (gbf)(ws + WS_KST); const GAS float* AUXG = (const GAS float*)(ws + WS_AUX);
    GAS bf16_t* CAT = (GAS bf16_t*)(ws + WS_CAT); GAS float* SSQO = (GAS float*)(ws + WS_SSQO);
    const int b = unit / (NH * NVS), h = (unit / NVS) % NH, vh = unit % NVS, hu = b * NH + h, wave = __builtin_amdgcn_readfirstlane(tid >> 6); int lane = tid & 63;
    const float g32 = exp2f(32.0f * __log2f(1.0f - exp2f(-5.0f - (float)h)));
    __syncthreads();
    static_assert(NVS == 2, "wave roles below are written for two value slices per head");
    if (wave >= 6) {
        __syncthreads();
        for (int n = 0; n < NCHUNK; ++n) __syncthreads();
    } else if (wave < 2) {
        asm volatile("" : "+v"(lane));
        const int l31 = lane & 31, hh = lane >> 5, vs = (128 / NVS) * vh + 32 * wave;
        const unsigned base = (unsigned)(size_t)lds, trl = (unsigned)((8 * hh + ((lane & 15) >> 2)) * PT + (16 * ((lane >> 4) & 1) + 4 * (lane & 3)) * 2);
        const int psw = ((lane & 3) == 1) ? 2 : (((lane & 3) == 2) ? 1 : (lane & 3));
        const unsigned trk = (unsigned)((8 * hh + ((lane & 15) >> 2)) * PT + (16 * ((lane >> 4) & 1) + 4 * psw) * 2);
        MLane A;
        A.av = base + SC_V + trl + vs * 2; A.ak = base + SC_KST + trk; A.aq = base + SC_QS + l31 * PQ + 16 * hh; A.aaux = base + SC_AUX + 32 * hh; A.ap = base + SC_P + l31 * 80 + 16 * hh;
        A.aout = base + SC_OUT + l31 * PQ + (vs + 4 * hh) * 2; A.assq = base + SC_SSQ + (wave * 32 + l31) * 4;
        asm volatile("" : "+v"(A.av), "+v"(A.ak), "+v"(A.aq), "+v"(A.aaux), "+v"(A.ap), "+v"(A.aout), "+v"(A.assq));
        f32x16 S[4];
#pragma unroll
        for (int kt = 0; kt < 4; ++kt)
#pragma unroll
            for (int r = 0; r < 16; ++r) S[kt][r] = 0.f;
        __syncthreads();
        for (int n = 0; n < NCHUNK; n += 2) {
            if (MF_ON) mfma_step<IS_RET, 0>(S, A, lane, g32);
            __syncthreads();
            if (MF_ON) mfma_step<IS_RET, 1>(S, A, lane, g32);
            __syncthreads();
        }
        if (!MF_ON) asm volatile("" :: "v"(S[0][0]));
    } else if (wave < 4) {
        const int sw = wave - 2;
        if (!ST_ON) { __syncthreads(); for (int n = 0; n < NCHUNK; ++n) __syncthreads(); }
        else {
        asm volatile("" : "+v"(lane));
        const int l31 = lane & 31, hh = lane >> 5, r4 = lane >> 4, c16 = lane & 15, p0 = (sw == 0 || IS_RET) ? NIN : MIXW;
        StLane L;
        L.g0 = (unsigned)((r4 * p0 + 8 * c16) * 2); L.gg = 0; L.ga = (unsigned)(lane * 4);
        L.l0 = (unsigned)(r4 * (sw == 0 ? PQ : PT) + 16 * c16); L.lg = (unsigned)(lane * 16); L.la = (unsigned)(lane * 4); L.sk = (unsigned)(l31 * PQ + 16 * hh);
        if (sw == 0) { L.g1 = (unsigned)((l31 * NIN + 8 * hh) * 2); L.l1 = 0; }
        else { const int rv = lane / VPR, cv = VPR * vh + lane % VPR; L.g1 = (unsigned)((rv * NIN + 8 * cv) * 2); L.l1 = (unsigned)(rv * PT + 16 * cv); }
        asm volatile("" : "+v"(L.g0), "+v"(L.g1), "+v"(L.gg), "+v"(L.ga), "+v"(L.l0), "+v"(L.l1), "+v"(L.lg), "+v"(L.la), "+v"(L.sk));
        HRegs RA, RB;
        stager_load<IS_RET>(RA, Z, KST, AUXG, b, h, hu, sw, L, 0);
        stager_stage<IS_RET>(RA, lds, lds + SC_BUF, sw, L);
        if (sw == 0) scores_stage(RA, lds, L, l31, hh);
        stager_load<IS_RET>(RB, Z, KST, AUXG, b, h, hu, sw, L, 1);
        __syncthreads();
        for (int n = 0; n < NCHUNK; n += 2) {
            if (ST_LD) stager_load<IS_RET>(RA, Z, KST, AUXG, b, h, hu, sw, L, n + 2);
            if (ST_ST) { stager_stage<IS_RET>(RB, lds + SC_BUF, lds, sw, L);
                if (sw == 0) scores_stage(RB, lds + SC_BUF, L, l31, hh); }
            else asm volatile("" :: "v"(RB.x0[0]), "v"(RB.x0[7]), "v"(RB.x1[0]), "v"(RB.aux[1]));
            __syncthreads();
            if (ST_LD) stager_load<IS_RET>(RB, Z, KST, AUXG, b, h, hu, sw, L, n + 3);
            if (ST_ST) { stager_stage<IS_RET>(RA, lds, lds + SC_BUF, sw, L);
                if (sw == 0) scores_stage(RA, lds, L, l31, hh); }
            else asm volatile("" :: "v"(RA.x0[0]), "v"(RA.x0[7]), "v"(RA.x1[0]), "v"(RA.aux[1]));
            __syncthreads();
        }
        }
    } else {
        asm volatile("" : "+v"(lane));
        FinLane L;
        {   const int c0 = lane / VPR, v0 = 8 * (VPR * vh + lane % VPR);
            L.lo = (unsigned)(c0 * PQ + v0 * 2); L.ls = (unsigned)(c0 * 4); L.go = (unsigned)((c0 * D + v0) * 2); L.gs = (unsigned)(c0 * 64); L.gz = (unsigned)((c0 * NIN + v0) * 2); }
        asm volatile("" : "+v"(L.lo), "+v"(L.ls), "+v"(L.go), "+v"(L.gs), "+v"(L.gz));
        if (wave == 4) {
            u32x4 gA[FPT], gB[FPT];
            gate_load<IS_RET>(gA, Z, b, h, L, 0); gate_load<IS_RET>(gB, Z, b, h, L, 1);
            __syncthreads();
            for (int n = 0; n < NCHUNK; n += 2) {
                if (FI_ON) { gate_stage(gA, lds, lane); gate_load<IS_RET>(gA, Z, b, h, L, n + 2); }
                __syncthreads();
                if (FI_ON) { gate_stage(gB, lds + SC_BUF, lane); gate_load<IS_RET>(gB, Z, b, h, L, n + 3); }
                __syncthreads();
            }
        } else {
            const bool first = (lane % VPR) == 0;
            __syncthreads();
            __syncthreads();
            for (int n = 1; n < NCHUNK; ++n) { if (FI_ON) fin_store<IS_RET>(lds + ((n - 1) & 1) * SC_BUF, CAT, SSQO, b, h, vh, L, lane, first, n - 1); __syncthreads(); }
            if (FI_ON) fin_store<IS_RET>(lds + ((NCHUNK - 1) & 1) * SC_BUF, CAT, SSQO, b, h, vh, L, lane, first, NCHUNK - 1);
        }
    }
}

constexpr int XA_K = 0, XA_KP = 144, XA_V = 256 * XA_KP, XA_VP = 192;
#define XRD(dst, areg, off) "ds_read_b128 " dst ", " areg " offset:" #off "\n\t"
__device__ __forceinline__ void xattn2_unit(unsigned char* ws, LAS unsigned char* lds, int unit, int layer, int tid) {
    gbf Z = (gbf)(ws + WS_Z); gbf MKV = (gbf)(ws + WS_MKV); GAS bf16_t* CAT = (GAS bf16_t*)(ws + WS_CAT);
    const int b = unit >> 5, hx = (unit >> 3) & 3, qb = unit & 7;
    const int wave = tid >> 6, lane = tid & 63, l31 = lane & 31, hh = lane >> 5;
    const size_t tok = (size_t)b * SEQ + qb * 256 + wave * 32 + l31;
    bf16x8 qf[4];
#pragma unroll
    for (int ks = 0; ks < 4; ++ks) qf[ks] = *(const GAS bf16x8*)(Z + tok * NIN + 3072 + hx * 64 + 16 * ks + 8 * hh);
    __syncthreads();
    {   gbf src = MKV + (size_t)(b * NMEM) * 2048 + layer * 512 + hx * 64;
        u32x4 kr[4], vr[4];
#pragma unroll
        for (int i = 0; i < 4; ++i) { const int piece = tid + 512 * i, key = piece >> 3, j = piece & 7;
            kr[i] = *(const GAS u32x4*)(src + (size_t)key * 2048 + 8 * j); vr[i] = *(const GAS u32x4*)(src + (size_t)key * 2048 + 256 + 8 * j); }
#pragma unroll
        for (int i = 0; i < 4; ++i) { const int piece = tid + 512 * i, key = piece >> 3, j = piece & 7;
            *(LAS u32x4*)(lds + XA_K + key * XA_KP + 16 * j) = kr[i]; *(LAS u32x4*)(lds + XA_V + key * XA_VP + 16 * j) = vr[i]; }
    }
    __syncthreads();
    f32x16 st[8];
    const unsigned ak = (unsigned)(size_t)(lds + XA_K) + (unsigned)(l31 * XA_KP + 16 * hh);
#define XBLK(T0, o0, o1, o2, o3, o4, o5, o6, o7) { u32x4 f0, f1, f2, f3, f4, f5, f6, f7; \
        asm volatile(XRD("%0", "%8", o0) XRD("%1", "%8", o1) XRD("%2", "%8", o2) XRD("%3", "%8", o3) XRD("%4", "%8", o4) XRD("%5", "%8", o5) XRD("%6", "%8", o6) XRD("%7", "%8", o7) "s_waitcnt lgkmcnt(0)" \
            : "=&v"(f0), "=&v"(f1), "=&v"(f2), "=&v"(f3), "=&v"(f4), "=&v"(f5), "=&v"(f6), "=&v"(f7) : "v"(ak) : "memory"); \
        __builtin_amdgcn_sched_barrier(0); \
        f32x16 a0, a1; _Pragma("unroll") for (int r = 0; r < 16; ++r) { a0[r] = 0.f; a1[r] = 0.f; } \
        a0 = __builtin_amdgcn_mfma_f32_32x32x16_bf16(as_bf16x8(f0), qf[0], a0, 0, 0, 0); a1 = __builtin_amdgcn_mfma_f32_32x32x16_bf16(as_bf16x8(f4), qf[0], a1, 0, 0, 0); \
        a0 = __builtin_amdgcn_mfma_f32_32x32x16_bf16(as_bf16x8(f1), qf[1], a0, 0, 0, 0); a1 = __builtin_amdgcn_mfma_f32_32x32x16_bf16(as_bf16x8(f5), qf[1], a1, 0, 0, 0); \
        a0 = __builtin_amdgcn_mfma_f32_32x32x16_bf16(as_bf16x8(f2), qf[2], a0, 0, 0, 0); a1 = __builtin_amdgcn_mfma_f32_32x32x16_bf16(as_bf16x8(f6), qf[2], a1, 0, 0, 0); \
        a0 = __builtin_amdgcn_mfma_f32_32x32x16_bf16(as_bf16x8(f3), qf[3], a0, 0, 0, 0); a1 = __builtin_amdgcn_mfma_f32_32x32x16_bf16(as_bf16x8(f7), qf[3], a1, 0, 0, 0); \
        st[T0] = a0; st[T0 + 1] = a1; }
    XBLK(0, 0, 32, 64, 96, 4608, 4640, 4672, 4704)
    XBLK(2, 9216, 9248, 9280, 9312, 13824, 13856, 13888, 13920)
    XBLK(4, 18432, 18464, 18496, 18528, 23040, 23072, 23104, 23136)
    XBLK(6, 27648, 27680, 27712, 27744, 32256, 32288, 32320, 32352)
#undef XBLK
    float mx = -1e30f;
#pragma unroll
    for (int T = 0; T < 8; ++T)
#pragma unroll
        for (int r = 0; r < 16; ++r) mx = fmaxf(mx, st[T][r]);
    mx = fmaxf(mx, shfl_xor_l(mx, lane, 32));
    const float c2 = 0.125f * 1.4426950408889634f, mc = mx * c2;
    float sum = 0.f;
#pragma unroll
    for (int T = 0; T < 8; ++T)
#pragma unroll
        for (int r = 0; r < 16; ++r) { const float p = exp2f(st[T][r] * c2 - mc); st[T][r] = p; sum += p; }
    sum += shfl_xor_l(sum, lane, 32);
    f32x16 ot[2];
#pragma unroll
    for (int dt = 0; dt < 2; ++dt)
#pragma unroll
        for (int r = 0; r < 16; ++r) ot[dt][r] = 0.f;
    const unsigned av = (unsigned)(size_t)(lds + XA_V) + (unsigned)((4 * hh + ((lane & 15) >> 2)) * XA_VP + (16 * ((lane >> 4) & 1) + 4 * (lane & 3)) * 2);
#define XTR(dst, off) "ds_read_b64_tr_b16 " dst ", %8 offset:" #off "\n\t"
#define VBLK(T, o00, o01, o10, o11, o20, o21, o30, o31) { u32x2 g0, g1, g2, g3, g4, g5, g6, g7; \
        asm volatile(XTR("%0", o00) XTR("%1", o01) XTR("%2", o10) XTR("%3", o11) XTR("%4", o20) XTR("%5", o21) XTR("%6", o30) XTR("%7", o31) "s_waitcnt lgkmcnt(0)" \
            : "=&v"(g0), "=&v"(g1), "=&v"(g2), "=&v"(g3), "=&v"(g4), "=&v"(g5), "=&v"(g6), "=&v"(g7) : "v"(av) : "memory"); \
        __builtin_amdgcn_sched_barrier(0); \
        u32x4 p0, p1; _Pragma("unroll") for (int j = 0; j < 4; ++j) { p0[j] = pg8::cvt_pk_bf16(st[T][2 * j], st[T][2 * j + 1]); p1[j] = pg8::cvt_pk_bf16(st[T][8 + 2 * j], st[T][8 + 2 * j + 1]); } \
        ot[0] = __builtin_amdgcn_mfma_f32_32x32x16_bf16(as_bf16x8((u32x4){g0.x, g0.y, g1.x, g1.y}), as_bf16x8(p0), ot[0], 0, 0, 0); \
        ot[1] = __builtin_amdgcn_mfma_f32_32x32x16_bf16(as_bf16x8((u32x4){g2.x, g2.y, g3.x, g3.y}), as_bf16x8(p0), ot[1], 0, 0, 0); \
        ot[0] = __builtin_amdgcn_mfma_f32_32x32x16_bf16(as_bf16x8((u32x4){g4.x, g4.y, g5.x, g5.y}), as_bf16x8(p1), ot[0], 0, 0, 0); \
        ot[1] = __builtin_amdgcn_mfma_f32_32x32x16_bf16(as_bf16x8((u32x4){g6.x, g6.y, g7.x, g7.y}), as_bf16x8(p1), ot[1], 0, 0, 0); }
    VBLK(0, 0, 1536, 64, 1600, 3072, 4608, 3136, 4672)
    VBLK(1, 6144, 7680, 6208, 7744, 9216, 10752, 9280, 10816)
    VBLK(2, 12288, 13824, 12352, 13888, 15360, 16896, 15424, 16960)
    VBLK(3, 18432, 19968, 18496, 20032, 21504, 23040, 21568, 23104)
    VBLK(4, 24576, 26112, 24640, 26176, 27648, 29184, 27712, 29248)
    VBLK(5, 30720, 32256, 30784, 32320, 33792, 35328, 33856, 35392)
    VBLK(6, 36864, 38400, 36928, 38464, 39936, 41472, 40000, 41536)
    VBLK(7, 43008, 44544, 43072, 44608, 46080, 47616, 46144, 47680)
#undef VBLK
#undef XTR
    const float il = 1.0f / sum;
    GAS bf16_t* op = CAT + tok * D + MIXW + hx * 64 + 4 * hh;
#pragma unroll
    for (int dt = 0; dt < 2; ++dt)
#pragma unroll
        for (int q = 0; q < 4; ++q) { u32x2 w; w.x = pg8::cvt_pk_bf16(ot[dt][4 * q] * il, ot[dt][4 * q + 1] * il); w.y = pg8::cvt_pk_bf16(ot[dt][4 * q + 2] * il, ot[dt][4 * q + 3] * il);
            *(GAS u32x2*)(op + 32 * dt + 8 * q) = w; }
}

__device__ __forceinline__ void final_rows(const unsigned char* ws, float* out, const float* nf, int row0, int row1, int gw, int NGW, int lane) {
    const GAS f32x4* wv = (const GAS f32x4*)nf + lane;
    for (int row = row0 + gw; row < row1; row += NGW) {
        const GAS u32x2* xr = (const GAS u32x2*)((const GAS bf16_t*)(ws + WS_XB) + (size_t)row * D) + lane; f32x4 v[4]; float s = 0.f;
#pragma unroll
        for (int j = 0; j < 4; ++j) { const u32x2 w = xr[64 * j]; v[j][0] = bf2f(w.x & 0xffffu); v[j][1] = bf2f(w.x >> 16); v[j][2] = bf2f(w.y & 0xffffu); v[j][3] = bf2f(w.y >> 16);
            s += (v[j].x * v[j].x + v[j].y * v[j].y) + (v[j].z * v[j].z + v[j].w * v[j].w); }
        const float rs = rsqrtf(wave_sum(s, lane) * (1.0f / D) + EPS);
        GAS f32x4* orow = (GAS f32x4*)(out + (size_t)row * D) + lane;
#pragma unroll
        for (int j = 0; j < 4; ++j) orow[64 * j] = v[j] * rs * wv[64 * j];
    }
}

__global__ void __launch_bounds__(NWAVES * 64, 2) mega_fwd(Args args) {
    extern __shared__ __attribute__((aligned(16))) unsigned char lds_raw[];
    LAS unsigned char* lds = (LAS unsigned char*)lds_raw;
    volatile LAS unsigned* MISC = (volatile LAS unsigned*)(lds + MISC_OFF);
    const int G = gridDim.x, bx = blockIdx.x;
    const int wave_s = __builtin_amdgcn_readfirstlane(threadIdx.x >> 6);
    unsigned char* ws = args.ws;
    for (int u = threadIdx.x; u < (LDS_BYTES - LDSCTL_OFF) / 4; u += NWAVES * 64) ((LAS unsigned*)(lds + LDSCTL_OFF))[u] = 0u;
    __syncthreads();
    XcdBarrier bar = xcd_barrier_post((unsigned*)(ws + WS_CTL) + CW_BAR, MISC + 8);
#define GBAR() xcd_barrier(bar, wave_s == 0 && lane_id_volatile() == 0)
#define OPAQ() unsigned char* wsp = ws; int Gp = G, bxp = bx, tidp = wave_s * 64 + lane_id_volatile(); asm volatile("" : "+s"(wsp), "+s"(Gp), "+s"(bxp), "+v"(tidp)); \
    const int lanep = tidp & 63, wavep = __builtin_amdgcn_readfirstlane(tidp >> 6), vcup = (Gp % 8 == 0) ? (bxp % 8) * (Gp / 8) + bxp / 8 : bxp, gwp = vcup * NWAVES + wavep, NGWp = Gp * NWAVES; \
    (void)lanep; (void)gwp; (void)NGWp
#define XPART() const int xn = misc_rd(lds, 8), xnx = misc_rd(lds, 9), xrank = misc_rd(lds, 10), xslot = misc_rd(lds, 11); \
    (void)xn; (void)xnx; (void)xrank; (void)xslot
#define LBAR() xcc_barrier(bar, (unsigned)misc_rd(lds, 8), wave_s == 0 && lane_id_volatile() == 0)

    { OPAQ(); p0_prologue(args, wsp, lds, gwp, NGWp, wavep, lanep); }
    GBAR();
    if (threadIdx.x == 0) {
        unsigned slot = 0;
        for (unsigned j = 0; j < 16; ++j) { const unsigned c = xb_ld(&bar.bar[XB_XCNT(j)]); if (j < bar.x && c > 0u) ++slot; }
        MISC[11] = slot;
    }
    __syncthreads();
    for (int l = 0; l < DEPTH; ++l) {
        const int is_ret = l & 1;
        { OPAQ(); XPART();
            if (l == 0) {
                pg8::Gemm g{(const bf16_t*)(wsp + WS_MEMB), (const bf16_t*)(wsp + WS_WM), MROWS, 2048, D}; pg8::XccOrderMem S{xrank, xn, xslot, xnx};
                EpiPlain E{(bf16_t*)(wsp + WS_MKV), 2048};
                pg8::gemm_phase<EpiPlain, pg8::XccOrderMem, true, true>(lds, g, S, E, tidp);
            }
            pg8::Gemm g{(const bf16_t*)(wsp + WS_XB), (const bf16_t*)(wsp + WS_WIN) + (size_t)l * NIN * D, M, NIN, D}; pg8::XccOrder S{xrank, xn, xslot, xnx, (NIN - XW) / 256};
            EpiIn E{(bf16_t*)(wsp + WS_Z), (bf16_t*)(wsp + WS_KST), (float*)(wsp + WS_AUX), (const float*)(wsp + WS_SSQA), (const float*)(wsp + WS_LB) + (l >> 1) * MIXW, (const float*)(wsp + WS_COS), (const float*)(wsp + WS_SIN), is_ret, (LAS float*)(lds + RSTD_TAB_OFF)};
            pg8::gemm_phase<EpiIn, pg8::XccOrder, true, true>(lds, g, S, E, tidp);
        }
        LBAR();
        { OPAQ(); XPART();
            constexpr int UB = NH * NVS + 8;
            const int nb = xslot < 8 ? (8 - xslot + xnx - 1) / xnx : 0;
            for (int u = xrank; u < UB * nb; u += xn) {
                const int b = xslot + (u / UB) * xnx, uu = u % UB;
                if (uu < NH * NVS) { if (is_ret) scan2_unit<1, 0>(wsp, lds, b * NH * NVS + uu, tidp); else scan2_unit<0, 0>(wsp, lds, b * NH * NVS + uu, tidp); }
                else { const int rb = 8 * b + (uu - NH * NVS);
                    {   pg8::Gemm g{(const bf16_t*)(wsp + WS_XB), (const bf16_t*)(wsp + WS_WIN) + (size_t)l * NIN * D, M, NIN, D}; pg8::OneUnit S{rb, 12};
                        EpiIn E{(bf16_t*)(wsp + WS_Z), (bf16_t*)(wsp + WS_KST), (float*)(wsp + WS_AUX), (const float*)(wsp + WS_SSQA), (const float*)(wsp + WS_LB) + (l >> 1) * MIXW, (const float*)(wsp + WS_COS), (const float*)(wsp + WS_SIN), is_ret, (LAS float*)(lds + RSTD_TAB_OFF)};
                        pg8::gemm_phase<EpiIn, pg8::OneUnit, true, true>(lds, g, S, E, tidp); }
                    asm volatile("s_waitcnt vmcnt(0)" ::: "memory"); __builtin_amdgcn_fence(__ATOMIC_RELEASE, "agent"); __syncthreads(); __builtin_amdgcn_fence(__ATOMIC_ACQUIRE, "agent");
                    for (int hx = 0; hx < NXH; ++hx) xattn2_unit(wsp, lds, (rb >> 3) * 32 + hx * 8 + (rb & 7), l, tidp);
                }
            }
            if (l == 0) {
                const int busy = UB * nb < xn ? UB * nb : 0, nidle = xn - busy;
                if (xrank >= busy) { const int wv = (xrank - busy) * NWAVES + wavep, nwv = nidle * NWAVES;
                    __syncthreads();
                    for (int l2 = 0; l2 < DEPTH; ++l2) convert_weights(args, wsp, (LAS float*)(lds + wavep * 16384), l2 * TITEMS_PER_LAYER + (l2 == 0 ? 16 * (NIN / 32) : 0), (l2 + 1) * TITEMS_PER_LAYER - 256, wv, nwv, lanep, xslot < xnx ? xslot : 0, xnx);
                }
            }
            __syncthreads();
        }
        if (l == 0) GBAR(); else LBAR();
        if (NVS > 1 && is_ret) {
            { OPAQ(); XPART(); for (int b = xslot; b < BATCH; b += xnx) norm_rows(wsp, b * SEQ, (b + 1) * SEQ, xrank * NWAVES + wavep, xn * NWAVES, lanep); }
            LBAR();
        }
        { OPAQ(); XPART();
            pg8::Gemm g{(const bf16_t*)(wsp + WS_CAT), (const bf16_t*)(wsp + WS_WOUT) + (size_t)l * D * D, M, D, D}; pg8::XccOrder S{xrank, xn, xslot, xnx, D / 256};
            EpiResC E{EpiRes{(const bf16_t*)(wsp + WS_XB), (bf16_t*)(wsp + WS_XB), (float*)(wsp + WS_SSQD)}, is_ret ? nullptr : (const float*)(wsp + WS_SSQO)};
            pg8::gemm_phase<EpiResC, pg8::XccOrder, true, true>(lds, g, S, E, tidp);
        }
        LBAR();
        { OPAQ(); XPART();
            pg8::Gemm g{(const bf16_t*)(wsp + WS_XB), (const bf16_t*)(wsp + WS_WFI) + (size_t)l * NFI * D, M, NFI, D}; pg8::XccOrder S{xrank, xn, xslot, xnx, NFI / 256};
            EpiFfn E{(bf16_t*)(wsp + WS_ACT), (const float*)(wsp + WS_SSQD), (LAS float*)(lds + RSTD_TAB_OFF)};
            pg8::gemm_phase<EpiFfn, pg8::XccOrder, true, true>(lds, g, S, E, tidp);
        }
        LBAR();
        { OPAQ(); XPART();
            pg8::Gemm g{(const bf16_t*)(wsp + WS_ACT), (const bf16_t*)(wsp + WS_WFO) + (size_t)l * D * DFF, M, D, DFF}; pg8::XccOrder S{xrank, xn, xslot, xnx, D / 256};
            EpiRes E{(const bf16_t*)(wsp + WS_XB), (bf16_t*)(wsp + WS_XB), (float*)(wsp + WS_SSQA)};
            pg8::gemm_phase<EpiRes, pg8::XccOrder, true, true>(lds, g, S, E, tidp);
        }
        LBAR();
    }
    { OPAQ(); XPART();
        for (int b = xslot; b < BATCH; b += xnx) final_rows(wsp, args.out, args.in[14], b * SEQ, (b + 1) * SEQ, xrank * NWAVES + wavep, xn * NWAVES, lanep);
    }
#undef OPAQ
#undef XPART
#undef GBAR
#undef LBAR
}

extern "C" void kernel_launch(void* const* d_in, const int* in_sizes, int n_in, void* d_out, int out_size, void* d_ws, size_t ws_size, hipStream_t stream) {
    static int grid = 0;
    if (grid == 0) {
        if (n_in != 15 || in_sizes[0] != M * D || out_size != M * D || ws_size < WS_END) {
            fprintf(stderr, "kernel_launch: unexpected shapes: n_in %d in0 %d out %d ws %zu (need %zu)\n", n_in, n_in > 0 ? in_sizes[0] : -1, out_size, ws_size, (size_t)WS_END); grid = -1; return; }
        int dev = 0, cus = 0, per_cu = 0;
        if (hipGetDevice(&dev) != hipSuccess || hipDeviceGetAttribute(&cus, hipDeviceAttributeMultiprocessorCount, dev) != hipSuccess) { grid = -1; return; }
        if (hipFuncSetAttribute((const void*)mega_fwd, hipFuncAttributeMaxDynamicSharedMemorySize, LDS_BYTES) != hipSuccess) { fprintf(stderr, "kernel_launch: hipFuncSetAttribute failed\n"); grid = -1; return; }
        if (hipOccupancyMaxActiveBlocksPerMultiprocessor(&per_cu, (const void*)mega_fwd, NWAVES * 64, LDS_BYTES) != hipSuccess || per_cu < 1)
            fprintf(stderr, "kernel_launch: occupancy query reports %d workgroups per CU\n", per_cu);
        (void)hipGetLastError();
        grid = cus;
        if (grid < 176) { fprintf(stderr, "kernel_launch: this kernel needs at least 176 CUs (found %d)\n", cus); grid = -1; return; }
    }
    if (grid < 0) return;
    if (hipMemsetAsync((char*)d_ws + WS_CTL, 0, CTL_ZERO_BYTES, stream) != hipSuccess) { fprintf(stderr, "kernel_launch: memset failed\n"); return; }
    Args a{};
    for (int i = 0; i < 15; ++i) a.in[i] = (const float*)d_in[i];
    a.out = (float*)d_out; a.ws = (unsigned char*)d_ws;
    a.ph_lo = 0; a.ph_hi = 0;
    hipLaunchKernelGGL(mega_fwd, dim3(grid), dim3(NWAVES * 64), LDS_BYTES, stream, a);
    const hipError_t le = hipPeekAtLastError();
    if (le != hipSuccess) fprintf(stderr, "kernel_launch: launch failed: %s\n", hipGetErrorName(le));
}
```

```cpp
#include <hip/hip_runtime.h>
#include <cstdio>
#include <cstdint>

#ifndef DBG_SKIP
#define DBG_SKIP 0
#endif
#ifndef PROBE_REP
#define PROBE_REP 0
#endif
#ifndef RBG_A
#define RBG_A 4
#endif
#ifndef RBG_D
#define RBG_D 4
#endif
#ifndef PROBE_VAR
#define PROBE_VAR 0
#endif
#ifndef MK_N_LAUNCHES
#define MK_N_LAUNCHES 1
#endif

#define GAS __attribute__((address_space(1)))
#define LAS __attribute__((address_space(3)))
typedef unsigned short bf16_t;
typedef short bf16x8 __attribute__((ext_vector_type(8)));
typedef float f32x4 __attribute__((ext_vector_type(4)));
typedef float f32x2 __attribute__((ext_vector_type(2)));
typedef unsigned u32x4 __attribute__((ext_vector_type(4)));
typedef unsigned u32x2 __attribute__((ext_vector_type(2)));

constexpr int BATCH = 8, SEQ = 2048, D = 1024, DEPTH = 4;
constexpr int M = BATCH * SEQ;
constexpr int NH = 6, HD = 128, MIXW = 768, XW = 256, NXH = 4, XHD = 64, NMEM = 256;
constexpr int NIN = 3328, DFF = 2816, NFI = 2 * DFF;
constexpr int MROWS = BATCH * NMEM;
constexpr float EPS = 1e-6f;
constexpr int NVS = 2;
constexpr int VPR = 16 / NVS;

constexpr size_t MiB = 1u << 20;
constexpr size_t WS_CTL = 0, CTL_ZERO_BYTES = 1 * MiB;
constexpr size_t WS_LB = 1 * MiB;
constexpr size_t WS_SSQA = 2 * MiB;
constexpr size_t WS_SSQD = 3 * MiB;
constexpr size_t WS_COS = 4 * MiB, WS_SIN = 8 * MiB;
constexpr size_t WS_MEMB = 12 * MiB;
constexpr size_t WS_MKV = 16 * MiB;
constexpr size_t WS_WIN = 24 * MiB;
constexpr size_t WS_WOUT = 50 * MiB;
constexpr size_t WS_WFI = 58 * MiB;
constexpr size_t WS_WFO = 102 * MiB;
constexpr size_t WS_WM = 124 * MiB;
constexpr size_t WS_XB = 128 * MiB;
constexpr size_t WS_CAT = 160 * MiB;
constexpr size_t WS_Z = 192 * MiB;
constexpr size_t WS_F = 296 * MiB;
constexpr size_t WS_KST = 296 * MiB;
constexpr size_t WS_AUX = 320 * MiB;
constexpr size_t WS_SSQO = 323 * MiB;
constexpr size_t WS_ACT = 192 * MiB;
constexpr size_t WS_END = 344 * MiB;
static_assert(WS_WIN + (size_t)DEPTH * NIN * D * 2 <= WS_WOUT && WS_WOUT + (size_t)DEPTH * D * D * 2 <= WS_WFI && WS_WFI + (size_t)DEPTH * NFI * D * 2 <= WS_WFO &&
              WS_WFO + (size_t)DEPTH * D * DFF * 2 <= WS_WM && WS_WM + (size_t)2048 * 1024 * 2 <= WS_XB && WS_Z + (size_t)M * NIN * 2 <= WS_F && WS_F + (size_t)M * MIXW * 4 <= WS_END &&
              WS_ACT + (size_t)M * DFF * 2 <= WS_F, "ws map");
constexpr int CW_BAR = 4096;

__device__ __forceinline__ int lane_id_volatile() { int l; asm volatile("v_mbcnt_lo_u32_b32 %0, -1, 0\n\tv_mbcnt_hi_u32_b32 %0, -1, %0" : "=v"(l)); return l; }
namespace pg8 {
constexpr int BM = 256, BK = 64, HALF = 128, HTB = HALF * BK * 2, STAGE_BYTES = 8 * HTB, NXCD = 8, WGM = 8;
__host__ __device__ __forceinline__ int lds_byte(int r, int c) { const int st = (r >> 4) * 2 + (c >> 5), rr = r & 15, cc = c & 31, ob = rr * 64 + cc * 2; return st * 1024 + (ob ^ (((ob >> 9) & 1) << 5)); }
__host__ __device__ __forceinline__ void stage_rc(int b, int& R, int& C) { const int st = b / 1024, sb = b % 1024, swz = sb ^ (((sb >> 9) & 1) << 5); R = (st >> 1) * 16 + swz / 64; C = (st & 1) * 32 + (swz % 64) / 2; }
__host__ __device__ __forceinline__ int perm32(int rho) { const int n = rho >> 4, i = rho & 15; return 8 * (i >> 2) + 4 * n + (i & 3); }
struct Unit { int pm, pn; };
struct Gemm { const bf16_t* A; const bf16_t* Bt; int M, N, K; };
struct StaticOrder {
    int nM, nN, nwg, G, c;
    __host__ __device__ void init(int M_, int N_, int G_, int c_) { nM = M_ / BM; nN = N_ / BM; nwg = nM * nN; G = G_; c = c_; }
    __host__ __device__ bool next(int i, Unit& u) const {
        const long L = (long)i * G + c; if (L >= nwg) return false;
        int wgid = (int)L; { const int q = nwg / NXCD, r = nwg % NXCD, xcd = wgid % NXCD, off = wgid / NXCD; wgid = (xcd < r ? xcd * (q + 1) : r * (q + 1) + (xcd - r) * q) + off; }
        const int nig = WGM * nN, gid = wgid / nig, fm = gid * WGM, gsz = (nM - fm) < WGM ? (nM - fm) : WGM;
        u.pm = fm + ((wgid % nig) % gsz); u.pn = (wgid % nig) / gsz; return true;
    }
    __device__ __forceinline__ void a_ready(const Unit&) const {}
    __device__ __forceinline__ void done(const Unit&) const {}
};
struct XccOrder {
    int rank, n, slot, nx, nN, rbg, tlim;
    __device__ __forceinline__ bool next(int i, Unit& u) const {
        const int t = i * n + rank, nb = (8 - slot + nx - 1) / nx;
        if (slot >= 8 || t >= nb * 8 * nN || t >= tlim) return false;
        decode(t, u); return true;
    }
    __device__ __forceinline__ void decode(int t, Unit& u) const {
        const int per = 8 * nN;
        const int bi = t / per, tt = t - bi * per, g = tt / (rbg * nN), r = tt - g * rbg * nN;
        u.pm = 8 * (slot + bi * nx) + rbg * g + (r % rbg); u.pn = r / rbg;
    }
    __device__ __forceinline__ void a_ready(const Unit&) const {}
};
struct XccOrderMem {
    int rank, n, slot, nx;
    __device__ __forceinline__ bool next(int i, Unit& u) const {
        const int t = i * n + rank, nb = (8 - slot + nx - 1) / nx;
        if (slot >= 8 || t >= nb * 8) return false;
        u.pm = slot + (t >> 3) * nx; u.pn = t & 7; return true;
    }
    __device__ __forceinline__ void a_ready(const Unit&) const {}
};
struct OneUnit {
    int pm, pn;
    __device__ __forceinline__ bool next(int i, Unit& u) const { if (i) return false; u.pm = pm; u.pn = pn; return true; }
    __device__ __forceinline__ void a_ready(const Unit&) const {}
};
struct HalfUnit {
    int pm, pn, half;
    __device__ __forceinline__ bool next(int i, Unit& u) const { if (i) return false; u.pm = pm; u.pn = pn; return true; }
    __device__ __forceinline__ void a_ready(const Unit&) const {}
};
__device__ __forceinline__ unsigned cvt_pk_bf16(float lo, float hi) { unsigned r; asm volatile("v_cvt_pk_bf16_f32 %0, %1, %2" : "=v"(r) : "v"(lo), "v"(hi)); return r; }

template <class Epi, class Sched, bool ALIGN_EPI = false, bool SP2 = false, bool HM = false>
__device__ __forceinline__ void gemm_phase(LAS unsigned char* lds, const Gemm g, const Sched& S, const Epi& E, int tid) {
    asm volatile("" : "+v"(tid));
    const int wid = __builtin_amdgcn_readfirstlane(tid >> 6), lane = tid & 63, wr = wid >> 2, wc = wid & 3, fr = lane & 15, fq = lane >> 4;
    const int K = g.K, nt = K / BK;
    unsigned voffA[2], voffB[2];
#pragma unroll
    for (int i = 0; i < 2; ++i) { int R, C; stage_rc(tid * 16 + i * 8192, R, C); const int Rb = Epi::PERM ? ((R & ~31) + perm32(R & 31)) : R;
        voffA[i] = (unsigned)(R * K + C) * 2u; voffB[i] = (unsigned)(Rb * K + C) * 2u; }
    asm volatile("" : "+v"(voffA[0]), "+v"(voffA[1]), "+v"(voffB[0]), "+v"(voffB[1]));
    const size_t kstep = (size_t)(BK * 2);
    const size_t hstep = (size_t)HALF * K * 2;
    const size_t tstep = 2 * hstep;
    static_assert(!HM || SP2, "half tiles use the SP2 body");
    const size_t ahs = HM ? (size_t)0 : hstep;
    const unsigned ldsw = (unsigned)wid * 1024u;
    const int aoff = lds_byte(wr * 64 + fr, fq * 8), boff = lds_byte(wc * 32 + fr, fq * 8);
#define PG8_SA(b, h) (((b) * 2 + (h)) * HTB)
#define PG8_SB(b, h) ((4 + (b) * 2 + (h)) * HTB)
#define PG8_STAGE(bufoff, gbase, voff) do { _Pragma("unroll") for (int _i = 0; _i < 2; ++_i) \
        __builtin_amdgcn_global_load_lds((const unsigned*)((const char*)(gbase) + (voff)[_i]), (LAS unsigned*)(lds + (bufoff) + ldsw + _i * 8192), 16, 0, 0); } while (0)
#define PG8_LDA(dst, b, h) do { _Pragma("unroll") for (int m = 0; m < 4; ++m) _Pragma("unroll") for (int k = 0; k < 2; ++k) dst[m][k] = *(const LAS bf16x8*)(lds + PG8_SA(b, h) + aoff + m * 2048 + k * 1024); } while (0)
#define PG8_LDB(dst, b, h) do { _Pragma("unroll") for (int n = 0; n < 2; ++n) _Pragma("unroll") for (int k = 0; k < 2; ++k) dst[n][k] = *(const LAS bf16x8*)(lds + PG8_SB(b, h) + boff + n * 2048 + k * 1024); } while (0)
#define PG8_MMA(ai, bj, At, Bt) do { __builtin_amdgcn_s_setprio(1); _Pragma("unroll") for (int m = 0; m < 4; ++m) _Pragma("unroll") for (int n = 0; n < 2; ++n) _Pragma("unroll") for (int k = 0; k < 2; ++k) \
        acc[ai][bj][m][n] = __builtin_amdgcn_mfma_f32_16x16x32_bf16(Bt[n][k], At[m][k], acc[ai][bj][m][n], 0, 0, 0); __builtin_amdgcn_s_setprio(0); } while (0)
#define PG8_WAIT_V(n) asm volatile("s_waitcnt vmcnt(" #n ")" ::: "memory")
#define PG8_WAIT_L(n) asm volatile("s_waitcnt lgkmcnt(" #n ")" ::: "memory")
#define PG8_BAR __builtin_amdgcn_s_barrier()
#define PG8_SCHED __builtin_amdgcn_sched_barrier(0)
    Unit cur, nxt; int ui = 0;
    if (!S.next(0, cur)) return;
    f32x4 acc[2][2][4][2];
#pragma unroll
    for (int a = 0; a < 2; ++a)
#pragma unroll
        for (int b = 0; b < 2; ++b)
#pragma unroll
            for (int m = 0; m < 4; ++m)
#pragma unroll
                for (int n = 0; n < 2; ++n) acc[a][b][m][n] = (f32x4){0.f, 0.f, 0.f, 0.f};
    bf16x8 At[4][2], B0[2][2], B1[2][2];
    const char* cA = (const char*)g.A + (size_t)cur.pm * tstep; if constexpr (HM) cA += (size_t)S.half * hstep;
    const char* cB = (const char*)g.Bt + (size_t)cur.pn * tstep;
    S.a_ready(cur);
    if constexpr (SP2) {
        PG8_STAGE(PG8_SB(0, 0), cB, voffB); PG8_STAGE(PG8_SB(0, 1), cB + hstep, voffB); PG8_STAGE(PG8_SA(0, 0), cA, voffA); PG8_STAGE(PG8_SA(0, 1), cA + ahs, voffA);
        if (wr == 1) PG8_BAR;
        PG8_WAIT_V(2); PG8_BAR;
        PG8_STAGE(PG8_SB(1, 0), cB + kstep, voffB); PG8_STAGE(PG8_SA(1, 0), cA + kstep, voffA); PG8_STAGE(PG8_SB(1, 1), cB + hstep + kstep, voffB);
        PG8_WAIT_V(6); PG8_BAR;
    } else {
        PG8_STAGE(PG8_SB(0, 0), cB, voffB); PG8_STAGE(PG8_SA(0, 0), cA, voffA); PG8_STAGE(PG8_SB(0, 1), cB + hstep, voffB); PG8_STAGE(PG8_SA(0, 1), cA + hstep, voffA);
        if (wr == 1) PG8_BAR;
        PG8_WAIT_V(4); PG8_BAR;
        PG8_STAGE(PG8_SB(1, 0), cB + kstep, voffB); PG8_STAGE(PG8_SA(1, 0), cA + kstep, voffA); PG8_STAGE(PG8_SB(1, 1), cB + hstep + kstep, voffB);
        PG8_WAIT_V(6); PG8_BAR;
    }
    for (;;) {
        const bool has_next = S.next(ui + 1, nxt);
        const char* nA = has_next ? (const char*)g.A + (size_t)nxt.pm * tstep : cA; const char* nB = has_next ? (const char*)g.Bt + (size_t)nxt.pn * tstep : cB;
        for (int t = 0; t < nt; t += 2) {
            const bool last = (t == nt - 2);
            const char* a1 = cA + (size_t)(t + 1) * kstep;
            const char* a2 = last ? nA : cA + (size_t)(t + 2) * kstep; const char* b2 = last ? nB : cB + (size_t)(t + 2) * kstep;
            const char* a3 = a2 + kstep; const char* b3 = b2 + kstep;
            if (last && has_next) S.a_ready(nxt);
            if constexpr (Epi::MID_T > 0) { if (t == Epi::MID_T) { const int l2 = lane_id_volatile(); E.mid(acc, cur, wr, wc, l2 & 15, l2 >> 4); } }
            if constexpr (SP2) {
            PG8_LDB(B0, 0, 0); PG8_LDB(B1, 0, 1); PG8_SCHED; PG8_LDA(At, 0, 0); PG8_STAGE(PG8_SA(1, 1), a1 + ahs, voffA);
            PG8_WAIT_V(8); PG8_WAIT_L(0); PG8_BAR; PG8_MMA(0, 0, At, B0); PG8_MMA(0, 1, At, B1); PG8_BAR; PG8_SCHED;
            if constexpr (!HM) PG8_LDA(At, 0, 1);
            PG8_STAGE(PG8_SB(0, 0), b2, voffB); PG8_STAGE(PG8_SB(0, 1), b2 + hstep, voffB); PG8_STAGE(PG8_SA(0, 0), a2, voffA);
            PG8_WAIT_V(8); PG8_WAIT_L(0); PG8_BAR; if constexpr (!HM) { PG8_MMA(1, 0, At, B0); PG8_MMA(1, 1, At, B1); } PG8_BAR; PG8_SCHED;
            PG8_LDB(B0, 1, 0); PG8_LDB(B1, 1, 1); PG8_SCHED; PG8_LDA(At, 1, 0); PG8_STAGE(PG8_SA(0, 1), a2 + ahs, voffA);
            PG8_WAIT_V(8); PG8_WAIT_L(0); PG8_BAR; PG8_MMA(0, 0, At, B0); PG8_MMA(0, 1, At, B1); PG8_BAR; PG8_SCHED;
            if constexpr (!HM) PG8_LDA(At, 1, 1);
            PG8_STAGE(PG8_SB(1, 0), b3, voffB); PG8_STAGE(PG8_SB(1, 1), b3 + hstep, voffB); PG8_STAGE(PG8_SA(1, 0), a3, voffA);
            PG8_WAIT_V(8); PG8_WAIT_L(0); PG8_BAR; if constexpr (!HM) { PG8_MMA(1, 0, At, B0); PG8_MMA(1, 1, At, B1); } PG8_BAR; PG8_SCHED;
            } else {
            PG8_LDB(B0, 0, 0); PG8_SCHED; PG8_LDA(At, 0, 0); PG8_STAGE(PG8_SA(1, 1), a1 + hstep, voffA);
            PG8_WAIT_L(8); PG8_BAR; PG8_WAIT_L(0); PG8_MMA(0, 0, At, B0); PG8_BAR; PG8_SCHED;
            PG8_LDB(B1, 0, 1); PG8_STAGE(PG8_SB(0, 0), b2, voffB);
            PG8_BAR; PG8_WAIT_L(0); PG8_MMA(0, 1, At, B1); PG8_BAR;
            PG8_LDA(At, 0, 1); PG8_STAGE(PG8_SA(0, 0), a2, voffA);
            PG8_BAR; PG8_WAIT_L(0); PG8_MMA(1, 0, At, B0); PG8_BAR; PG8_SCHED;
            PG8_STAGE(PG8_SB(0, 1), b2 + hstep, voffB);
            PG8_WAIT_V(6); PG8_BAR; PG8_MMA(1, 1, At, B1); PG8_BAR;
            PG8_LDB(B0, 1, 0); PG8_SCHED; PG8_LDA(At, 1, 0); PG8_STAGE(PG8_SA(0, 1), a2 + hstep, voffA);
            PG8_WAIT_L(8); PG8_BAR; PG8_WAIT_L(0); PG8_MMA(0, 0, At, B0); PG8_BAR; PG8_SCHED;
            PG8_LDB(B1, 1, 1); PG8_STAGE(PG8_SB(1, 0), b3, voffB);
            PG8_BAR; PG8_WAIT_L(0); PG8_MMA(0, 1, At, B1); PG8_BAR;
            PG8_LDA(At, 1, 1); PG8_STAGE(PG8_SA(1, 0), a3, voffA);
            PG8_BAR; PG8_WAIT_L(0); PG8_MMA(1, 0, At, B0); PG8_BAR; PG8_SCHED;
            PG8_STAGE(PG8_SB(1, 1), b3 + hstep, voffB);
            PG8_WAIT_V(6); PG8_BAR; PG8_MMA(1, 1, At, B1); PG8_BAR;
            }
        }
        if constexpr (ALIGN_EPI) { if (wr == 0) PG8_BAR; }
        { const int l2 = lane_id_volatile(); E(acc, cur, wr, wc, l2 & 15, l2 >> 4); }
        if (!has_next) break;
#pragma unroll
        for (int a = 0; a < 2; ++a)
#pragma unroll
            for (int b = 0; b < 2; ++b)
#pragma unroll
                for (int m = 0; m < 4; ++m)
#pragma unroll
                    for (int n = 0; n < 2; ++n) acc[a][b][m][n] = (f32x4){0.f, 0.f, 0.f, 0.f};
        cur = nxt; cA = nA; cB = nB; ++ui;
        if constexpr (ALIGN_EPI) { if (wr == 1) PG8_BAR; }
    }
    PG8_WAIT_V(0);
    if constexpr (!ALIGN_EPI) { if (wr == 0) PG8_BAR; }
    PG8_BAR;
#undef PG8_SA
#undef PG8_SB
#undef PG8_STAGE
#undef PG8_LDA
#undef PG8_LDB
#undef PG8_MMA
#undef PG8_WAIT_V
#undef PG8_WAIT_L
#undef PG8_BAR
#undef PG8_SCHED
}
}

__device__ __forceinline__ float bf2f(unsigned h) { return __uint_as_float(h << 16); }
__device__ __forceinline__ unsigned f2bf(float f) { unsigned u = __float_as_uint(f); return (u + 0x7fffu + ((u >> 16) & 1u)) >> 16; }
__device__ __forceinline__ unsigned pk2(float lo, float hi) { return f2bf(lo) | (f2bf(hi) << 16); }
__device__ __forceinline__ float fast_rcp(float x) { return __builtin_amdgcn_rcpf(x); }
__device__ __forceinline__ float sigmoidf_(float x) { return fast_rcp(1.0f + __expf(-x)); }
__device__ __forceinline__ float siluf_(float x) { return x * sigmoidf_(x); }
__device__ __forceinline__ float shfl_xor_l(float v, int lane, int mask) { return __int_as_float(__builtin_amdgcn_ds_bpermute((lane ^ mask) << 2, __float_as_int(v))); }
__device__ __forceinline__ float wave_sum(float v, int lane) {
#pragma unroll
    for (int o = 1; o < 64; o <<= 1) v += shfl_xor_l(v, lane, o);
    return v;
}
__device__ __forceinline__ float rstd_from_partials(const float* ssq, int row, float invn) {
    const f32x4* p = (const f32x4*)(ssq + (size_t)row * 16);
    const f32x4 a = p[0], b = p[1], c = p[2], d = p[3];
    const f32x4 s = (a + b) + (c + d);
    return rsqrtf(((s[0] + s[1]) + (s[2] + s[3])) * invn + EPS);
}
constexpr int RSTD_TAB_OFF = 132096;
__device__ __forceinline__ void rstd_table(const float* ssq, int pm, LAS float* tab, int wr, int wc, int fr, int fq) {
    const int t = (wr * 4 + wc) * 64 + fq * 16 + fr;
    if (t < 256) { const GAS f32x4* p = (const GAS f32x4*)((const GAS float*)ssq + (size_t)(pm * 256 + t) * 16);
        const f32x4 a = p[0], b = p[1], c = p[2], d = p[3]; const f32x4 sm = (a + b) + (c + d);
        tab[t] = rsqrtf(((sm[0] + sm[1]) + (sm[2] + sm[3])) * (1.0f / D) + EPS); }
    asm volatile("s_waitcnt lgkmcnt(0)" ::: "memory"); __builtin_amdgcn_s_barrier(); asm volatile("" ::: "memory");
}
__device__ __forceinline__ u32x4 pack8(const f32x4 v0, const f32x4 v1) {
    u32x4 w; w.x = pg8::cvt_pk_bf16(v0[0], v0[1]); w.y = pg8::cvt_pk_bf16(v0[2], v0[3]); w.z = pg8::cvt_pk_bf16(v1[0], v1[1]); w.w = pg8::cvt_pk_bf16(v1[2], v1[3]); return w;
}

#define DPP_SHR(x, n) __int_as_float(__builtin_amdgcn_update_dpp(0, __float_as_int(x), 0x110 + (n), 0xf, 0xf, false))
__device__ __forceinline__ float rowscan16(float x) {
    x += DPP_SHR(x, 1); x += DPP_SHR(x, 2); x += DPP_SHR(x, 4); x += DPP_SHR(x, 8); return x;
}
__device__ __forceinline__ float bcast15(float x, int lane) { return __int_as_float(__builtin_amdgcn_ds_bpermute((lane | 15) << 2, __float_as_int(x))); }
__device__ __forceinline__ float expc(float x) { return __expf(fminf(x, 80.0f)); }
using pg8::Unit;
struct EpiPlain {
    static constexpr bool PERM = true; static constexpr int MID_T = 0;
    bf16_t* O; int ldc;
    __device__ __forceinline__ void operator()(const f32x4 (&acc)[2][2][4][2], const Unit& u, int wr, int wc, int fr, int fq) const {
        const int row0 = u.pm * 256 + wr * 64 + fr, col0 = u.pn * 256 + wc * 32 + 8 * fq;
#pragma unroll
        for (int ai = 0; ai < 2; ++ai)
#pragma unroll
            for (int m = 0; m < 4; ++m) { bf16_t* rowp = O + (size_t)(row0 + ai * 128 + m * 16) * ldc + col0;
#pragma unroll
                for (int bj = 0; bj < 2; ++bj) *(GAS u32x4*)((GAS bf16_t*)rowp + bj * 128) = pack8(acc[ai][bj][m][0], acc[ai][bj][m][1]); }
    }
};
struct EpiIn {
    static constexpr bool PERM = true; static constexpr int MID_T = 0;
    bf16_t* Z; bf16_t* KST; float* AUX; const float* ssq; const float* lb; const float* cosT; const float* sinT; int is_ret; LAS float* tab;
    __device__ __forceinline__ void operator()(const f32x4 (&acc)[2][2][4][2], const Unit& u, int wr, int wc, int fr, int fq) const {
        const int row0 = u.pm * 256 + wr * 64 + fr, jl = wc * 32 + 8 * fq, t = u.pn;
        rstd_table(ssq, u.pm, tab, wr, wc, fr, fq);
        const LAS float* tl = tab + wr * 64 + fr;
        if (t < 6) {
            if (!is_ret) {
                const f32x4 lb0 = *(const GAS f32x4*)((const GAS float*)lb + t * 128 + (jl >> 1)), lb1 = *(const GAS f32x4*)((const GAS float*)lb + t * 128 + (jl >> 1) + 64);
#pragma unroll
                for (int ai = 0; ai < 2; ++ai)
#pragma unroll
                    for (int mp = 0; mp < 2; ++mp) {
                        const int tok0 = u.pm * 256 + ai * 128 + wr * 64 + mp * 32, rlo = tok0 + fr, rhi = rlo + 16;
                        const float rs0 = tl[ai * 128 + mp * 32], rs1 = tl[ai * 128 + mp * 32 + 16];
                        f32x4 qsv[2][2], ksv[2][2], ktv[2][2], erv[2], dcv[2];
#pragma unroll
                        for (int n = 0; n < 2; ++n)
#pragma unroll
                            for (int i = 0; i < 4; ++i) {
                                const float lbv = n ? lb1[i] : lb0[i];
                                float g[2], kk[2], qq[2];
#pragma unroll
                                for (int e = 0; e < 2; ++e) {
                                    const float x = acc[ai][1][2 * mp + e][n][i] * (e ? rs1 : rs0), za = acc[ai][0][2 * mp + e][n][i] * (e ? rs1 : rs0);
                                    const float a = __expf(-fabsf(x)), r = fast_rcp(1.0f + a);
                                    const float sneg = x >= 0.f ? a * r : r;
                                    const float em = x >= 0.f ? a : fminf(fast_rcp(a), 1.0686475e13f);
                                    g[e] = (fminf(x, 0.f) - __logf(1.0f + a)) + __logf(1.0f + lbv * em);
                                    kk[e] = (1.0f - lbv) * sneg;
                                    qq[e] = siluf_(za);
                                }
                                const float blo = rowscan16(g[0]), ref = bcast15(blo, fq * 16 + fr), bhi = ref + rowscan16(g[1]), blast = bcast15(bhi, fq * 16 + fr);
                                qsv[0][n][i] = qq[0] * expc(blo - ref); qsv[1][n][i] = qq[1] * expc(bhi - ref);
                                ksv[0][n][i] = kk[0] * expc(ref - blo); ksv[1][n][i] = kk[1] * expc(ref - bhi);
                                ktv[0][n][i] = kk[0] * __expf(blast - blo); ktv[1][n][i] = kk[1] * __expf(blast - bhi);
                                erv[n][i] = __expf(ref); dcv[n][i] = __expf(blast);
                            }
                        GAS bf16_t* zlo = (GAS bf16_t*)Z + (size_t)rlo * NIN + t * 256 + jl; GAS bf16_t* zhi = (GAS bf16_t*)Z + (size_t)rhi * NIN + t * 256 + jl;
                        *(GAS u32x4*)zlo = pack8(qsv[0][0], qsv[0][1]); *(GAS u32x4*)(zlo + 128) = pack8(ksv[0][0], ksv[0][1]);
                        *(GAS u32x4*)zhi = pack8(qsv[1][0], qsv[1][1]); *(GAS u32x4*)(zhi + 128) = pack8(ksv[1][0], ksv[1][1]);
                        *(GAS u32x4*)((GAS bf16_t*)KST + (size_t)rlo * MIXW + t * 128 + jl) = pack8(ktv[0][0], ktv[0][1]);
                        *(GAS u32x4*)((GAS bf16_t*)KST + (size_t)rhi * MIXW + t * 128 + jl) = pack8(ktv[1][0], ktv[1][1]);
                        if (fr == 15) { GAS float* ap = (GAS float*)AUX + ((size_t)((tok0 >> 11) * NH + t) * 64 + ((tok0 & 2047) >> 5)) * 256 + jl;
                            *(GAS f32x4*)ap = erv[0]; *(GAS f32x4*)(ap + 4) = erv[1]; *(GAS f32x4*)(ap + 128) = dcv[0]; *(GAS f32x4*)(ap + 132) = dcv[1]; }
                    }
            } else {
                const float lg = __log2f(1.0f - exp2f(-5.0f - (float)t));
#pragma unroll
                for (int ai = 0; ai < 2; ++ai)
#pragma unroll
                    for (int m = 0; m < 4; ++m) { const int row = row0 + ai * 128 + m * 16; const float rs = tl[ai * 128 + m * 16];
                        const f32x4 cs = *(const GAS f32x4*)((const GAS float*)cosT + (size_t)row * 64 + (jl >> 1)), sn = *(const GAS f32x4*)((const GAS float*)sinT + (size_t)row * 64 + (jl >> 1));
                        const float cp1 = (float)(16 * (m & 1) + fr + 1), pw = exp2f(cp1 * lg), ipw = exp2f(-cp1 * lg);
                        const float qsc = rs * pw, ksc = rs * 0.08838834764831845f * ipw;
                        f32x4 q0, q1, k0, k1;
#pragma unroll
                        for (int i = 0; i < 4; ++i) {
                            const float a1 = acc[ai][0][m][0][i] * qsc, a2 = acc[ai][0][m][1][i] * qsc; q0[i] = a1 * cs[i] - a2 * sn[i]; q1[i] = a1 * sn[i] + a2 * cs[i];
                            const float b1 = acc[ai][1][m][0][i] * ksc, b2 = acc[ai][1][m][1][i] * ksc; k0[i] = b1 * cs[i] - b2 * sn[i]; k1[i] = b1 * sn[i] + b2 * cs[i];
                        }
                        GAS bf16_t* zp = (GAS bf16_t*)Z + (size_t)row * NIN + t * 256 + jl; *(GAS u32x4*)zp = pack8(q0, q1); *(GAS u32x4*)(zp + 128) = pack8(k0, k1); }
            }
        } else {
            const int mode = (t >= 9 && t < 12) ? (is_ret ? 2 : 1) : 0;
#pragma unroll
            for (int ai = 0; ai < 2; ++ai)
#pragma unroll
                for (int m = 0; m < 4; ++m) { const int row = row0 + ai * 128 + m * 16; const float rs = tl[ai * 128 + m * 16];
                    GAS bf16_t* zp = (GAS bf16_t*)Z + (size_t)row * NIN + t * 256 + jl;
#pragma unroll
                    for (int bj = 0; bj < 2; ++bj) { f32x4 v0 = acc[ai][bj][m][0] * rs, v1 = acc[ai][bj][m][1] * rs;
                        if (mode == 1) {
#pragma unroll
                            for (int i = 0; i < 4; ++i) { v0[i] = sigmoidf_(v0[i]); v1[i] = sigmoidf_(v1[i]); } }
                        else if (mode == 2) {
#pragma unroll
                            for (int i = 0; i < 4; ++i) { v0[i] = siluf_(v0[i]); v1[i] = siluf_(v1[i]); } }
                        *(GAS u32x4*)(zp + bj * 128) = pack8(v0, v1); } }
        }
    }
};
struct EpiRes {
    static constexpr bool PERM = true; static constexpr int MID_T = 0;
    const bf16_t* xin; bf16_t* xb; float* ssq;
    __device__ __forceinline__ void operator()(const f32x4 (&acc)[2][2][4][2], const Unit& u, int wr, int wc, int fr, int fq) const {
        const int row0 = u.pm * 256 + wr * 64 + fr, col0 = u.pn * 256 + wc * 32 + 8 * fq;
#pragma unroll
        for (int ai = 0; ai < 2; ++ai)
#pragma unroll
            for (int m = 0; m < 4; ++m) { const int row = row0 + ai * 128 + m * 16; const size_t off = (size_t)row * D + col0; float s = 0.f;
#pragma unroll
                for (int bj = 0; bj < 2; ++bj) {
                    const u32x4 r = *(const GAS u32x4*)((const GAS bf16_t*)xin + off + bj * 128);
                    f32x4 v0, v1;
                    v0[0] = bf2f(r.x & 0xffffu); v0[1] = bf2f(r.x >> 16); v0[2] = bf2f(r.y & 0xffffu); v0[3] = bf2f(r.y >> 16);
                    v1[0] = bf2f(r.z & 0xffffu); v1[1] = bf2f(r.z >> 16); v1[2] = bf2f(r.w & 0xffffu); v1[3] = bf2f(r.w >> 16);
                    v0 = v0 + acc[ai][bj][m][0]; v1 = v1 + acc[ai][bj][m][1];
                    *(GAS u32x4*)((GAS bf16_t*)xb + off + bj * 128) = pack8(v0, v1);
                    s += (v0[0] * v0[0] + v0[1] * v0[1]) + (v0[2] * v0[2] + v0[3] * v0[3]) + (v1[0] * v1[0] + v1[1] * v1[1]) + (v1[2] * v1[2] + v1[3] * v1[3]);
                }
                s += shfl_xor_l(s, fq * 16 + fr, 16); s += shfl_xor_l(s, fq * 16 + fr, 32);
                if (fq == 0) ((GAS float*)ssq)[(size_t)row * 16 + u.pn * 4 + wc] = s; }
    }
};
struct EpiResC {
    static constexpr bool PERM = true; static constexpr int MID_T = 12;
    EpiRes base; const float* ssqo;
    __device__ __forceinline__ void mid(f32x4 (&acc)[2][2][4][2], const Unit& u, int wr, int wc, int fr, int fq) const {
        if (!ssqo) return;
        const int row0 = u.pm * 256 + wr * 64 + fr;
#pragma unroll
        for (int ai = 0; ai < 2; ++ai)
#pragma unroll
            for (int m = 0; m < 4; ++m) { const int row = row0 + ai * 128 + m * 16;
                const GAS f32x4* sp = (const GAS f32x4*)((const GAS float*)ssqo + (size_t)row * 16); float tot = 0.f;
#pragma unroll
                for (int q4 = 0; q4 < (NH * NVS + 3) / 4; ++q4) { const f32x4 a = sp[q4];
#pragma unroll
                    for (int e = 0; e < 4; ++e) if (4 * q4 + e < NH * NVS) tot += a[e]; }
                const float rs = rsqrtf(tot * (1.0f / MIXW) + EPS);
#pragma unroll
                for (int bj = 0; bj < 2; ++bj)
#pragma unroll
                    for (int n = 0; n < 2; ++n) acc[ai][bj][m][n] = acc[ai][bj][m][n] * rs;
                asm volatile("" ::: "memory"); }
    }
    __device__ __forceinline__ void operator()(const f32x4 (&acc)[2][2][4][2], const Unit& u, int wr, int wc, int fr, int fq) const { base(acc, u, wr, wc, fr, fq); }
};
struct EpiFfn {
    static constexpr bool PERM = true; static constexpr int MID_T = 0;
    bf16_t* act; const float* ssq; LAS float* tab; int half;
    __device__ __forceinline__ void operator()(const f32x4 (&acc)[2][2][4][2], const Unit& u, int wr, int wc, int fr, int fq) const {
        const int hb = half < 0 ? 0 : 128 * half;
        const int row0 = u.pm * 256 + hb + wr * 64 + fr, jl = wc * 32 + 8 * fq;
        rstd_table(ssq, u.pm, tab, wr, wc, fr, fq);
        const LAS float* tl = tab + hb + wr * 64 + fr;
#pragma unroll
        for (int ai = 0; ai < 2; ++ai)
#pragma unroll
            for (int m = 0; m < 4; ++m) { if (ai == 1 && half >= 0) break; const int row = row0 + ai * 128 + m * 16; const float rs = tl[ai * 128 + m * 16];
                f32x4 v0, v1;
#pragma unroll
                for (int i = 0; i < 4; ++i) { v0[i] = siluf_(acc[ai][0][m][0][i] * rs) * (acc[ai][1][m][0][i] * rs); v1[i] = siluf_(acc[ai][0][m][1][i] * rs) * (acc[ai][1][m][1][i] * rs); }
                *(GAS u32x4*)((GAS bf16_t*)act + (size_t)row * DFF + u.pn * 128 + jl) = pack8(v0, v1); }
    }
};

#define XB_TMO      128
#define XB_XCNT(j)  (256  + 64 * (j))
#define XB_XSUB(j)  (1280 + 64 * (j))
#define XB_XGEN(j)  (2304 + 64 * (j))
#define XB_TOP      3328
#define XB_TOPGEN   3392
#define XCD_BAR_WORDS 3456
#define XB_SPIN_CAP (1u << 18)
__device__ __forceinline__ unsigned xb_ld(unsigned* p)              { return __hip_atomic_load(p, __ATOMIC_RELAXED, __HIP_MEMORY_SCOPE_AGENT); }
__device__ __forceinline__ unsigned xb_add(unsigned* p, unsigned v) { return __hip_atomic_fetch_add(p, v, __ATOMIC_RELAXED, __HIP_MEMORY_SCOPE_AGENT); }
__device__ __forceinline__ unsigned xb_xcc_id() { return (unsigned)__builtin_amdgcn_s_getreg((3 << 11) | 20) & 0xFu; }
#define XB_SPIN(cond, bar) do { unsigned _sp = 0; while (cond) { __builtin_amdgcn_s_sleep(1); \
    if ((++_sp & 255u) == 0u) { if (xb_ld(&(bar)[XB_TMO])) break; if (_sp > XB_SPIN_CAP) { atomicAdd(&(bar)[XB_TMO], 1u); break; } } } } while (0)
struct XcdBarrier { unsigned* bar; unsigned x; volatile LAS unsigned* st; };
__device__ __forceinline__ XcdBarrier xcd_barrier_post(unsigned* bar, volatile LAS unsigned* st) {
    XcdBarrier b; b.bar = bar; b.x = xb_xcc_id(); b.st = st;
    if (threadIdx.x == 0) st[2] = xb_add(&bar[XB_XCNT(b.x)], 1u);
    return b;
}
#define XB_LOC(j) (3456 + 64 * (j))
__device__ __forceinline__ void xcc_barrier(const XcdBarrier& b, unsigned n, bool leader) {
    asm volatile("s_waitcnt vmcnt(0)" ::: "memory");
    __syncthreads();
    if (leader) {
        unsigned* bar = b.bar; unsigned* cnt = &bar[XB_LOC(b.x)];
        __builtin_amdgcn_s_waitcnt(0);
        const unsigned old = xb_add(cnt, 1u), target = (old / n + 1u) * n;
        XB_SPIN(xb_ld(cnt) < target, bar);
        __builtin_amdgcn_fence(__ATOMIC_ACQUIRE, "agent");
        asm volatile("s_waitcnt vmcnt(0)" ::: "memory");
    }
    __syncthreads();
}
__device__ __forceinline__ void xcd_barrier_complete(unsigned* bar, unsigned x, unsigned& nloc, unsigned& nx) {
    const unsigned G = gridDim.x * gridDim.y * gridDim.z;
    unsigned sum, cnt, mine, sp = 0u;
    for (;;) {
        sum = 0u; cnt = 0u; mine = 0u;
#pragma unroll
        for (unsigned j = 0; j < 16; ++j) { const unsigned c = xb_ld(&bar[XB_XCNT(j)]); sum += c; cnt += (c > 0u) ? 1u : 0u; mine = (j == x) ? c : mine; }
        if (sum == G) break;
        __builtin_amdgcn_s_sleep(1);
        if ((++sp & 255u) == 0u) { if (xb_ld(&bar[XB_TMO])) break; if (sp > XB_SPIN_CAP) { atomicAdd(&bar[XB_TMO], 1u); break; } }
    }
    nloc = mine > 0u ? mine : 1u; nx = cnt > 0u ? cnt : 1u;
}
__device__ __forceinline__ void xcd_barrier(const XcdBarrier& b, bool leader) {
    asm volatile("s_waitcnt vmcnt(0)" ::: "memory");
    __syncthreads();
    if (leader) {
        unsigned* bar = b.bar;
        __builtin_amdgcn_s_waitcnt(0);
        unsigned nloc = b.st[0], nx = b.st[1];
        if (nloc == 0u) { xcd_barrier_complete(bar, b.x, nloc, nx); b.st[0] = nloc; b.st[1] = nx; }
        const unsigned old = xb_add(&bar[XB_XSUB(b.x)], 1u);
        const unsigned gen = old / nloc;
        if (old + 1u == (gen + 1u) * nloc) {
            __builtin_amdgcn_fence(__ATOMIC_RELEASE, "agent");
            asm volatile("s_waitcnt vmcnt(0)" ::: "memory");
            const unsigned og = xb_add(&bar[XB_TOP], 1u);
            const unsigned tg = og / nx;
            if (og + 1u == (tg + 1u) * nx) xb_add(&bar[XB_TOPGEN], 1u);
            else XB_SPIN(xb_ld(&bar[XB_TOPGEN]) == tg, bar);
            __builtin_amdgcn_fence(__ATOMIC_ACQUIRE, "agent");
            xb_add(&bar[XB_XGEN(b.x)], 1u);
            asm volatile("s_waitcnt vmcnt(0)" ::: "memory");
        } else {
            XB_SPIN(xb_ld(&bar[XB_XGEN(b.x)]) == gen, bar);
            __builtin_amdgcn_fence(__ATOMIC_ACQUIRE, "agent");
            asm volatile("s_waitcnt vmcnt(0)" ::: "memory");
        }
    }
    __syncthreads();
}

constexpr int RING_BYTES = 131072, LDSCTL_OFF = RING_BYTES, MISC_OFF = LDSCTL_OFF + 320, LDS_BYTES = 147456;
constexpr int NWAVES = 8;

__device__ __forceinline__ int misc_rd(LAS unsigned char* lds, int idx) { unsigned off = (unsigned)(MISC_OFF + 4 * idx); asm volatile("" : "+v"(off)); return __builtin_amdgcn_readfirstlane((int)*(volatile LAS unsigned*)(lds + off)); }
struct Args { const float* in[15]; float* out; unsigned char* ws; int ph_lo, ph_hi; };

__device__ __forceinline__ int win_srccol(int j) {
    const int t = j >> 8;
    if (t >= 6) return j;
    const int jj = j & 255, half = jj >> 7, p = jj & 127, d = 4 * (p >> 3) + (p & 3) + 64 * ((p >> 2) & 1);
    return half * MIXW + t * 128 + d;
}
__device__ __forceinline__ int wfi_srccol(int j) { const int t = j >> 8, jj = j & 255; return (jj < 128 ? 0 : DFF) + t * 128 + (jj & 127); }
struct TItem { const GAS float* W; GAS bf16_t* WT; const GAS float* kscale; int K, N, ndst, kind, nscale, item; };
__device__ __forceinline__ TItem titem_decode(const Args& a, unsigned char* ws, int it) {
    constexpr int I0 = 16 * (NIN / 32), I1 = 16 * 32, I2 = 16 * (NFI / 32), I3 = (DFF / 64) * 32, I4 = 16 * 16, IL = I0 + I1 + I2 + I3 + I4;
    const int l = it / IL; int r = it % IL; TItem t;
    if (r < I0) { t.W = (const GAS float*)a.in[4] + (size_t)l * D * NIN; t.WT = (GAS bf16_t*)(ws + WS_WIN) + (size_t)l * NIN * D; t.kscale = (const GAS float*)a.in[3] + l * D; t.K = D; t.N = NIN; t.ndst = NIN; t.kind = 0; t.nscale = D; t.item = r; return t; } r -= I0;
    if (r < I1) { t.W = (const GAS float*)a.in[5] + (size_t)l * D * D; t.WT = (GAS bf16_t*)(ws + WS_WOUT) + (size_t)l * D * D; t.kscale = (const GAS float*)((l & 1) ? a.in[10] : a.in[9]) + (l >> 1) * MIXW; t.K = D; t.N = D; t.ndst = D; t.kind = 1; t.nscale = MIXW; t.item = r; return t; } r -= I1;
    if (r < I2) { t.W = (const GAS float*)a.in[12] + (size_t)l * D * NFI; t.WT = (GAS bf16_t*)(ws + WS_WFI) + (size_t)l * NFI * D; t.kscale = (const GAS float*)a.in[11] + l * D; t.K = D; t.N = NFI; t.ndst = NFI; t.kind = 2; t.nscale = D; t.item = r; return t; } r -= I2;
    if (r < I3) { t.W = (const GAS float*)a.in[13] + (size_t)l * DFF * D; t.WT = (GAS bf16_t*)(ws + WS_WFO) + (size_t)l * D * DFF; t.kscale = (const GAS float*)a.in[13]; t.K = DFF; t.N = D; t.ndst = D; t.kind = 3; t.nscale = 0; t.item = r; return t; } r -= I3;
    t.W = (const GAS float*)a.in[7] + (size_t)l * D * 512; t.WT = (GAS bf16_t*)(ws + WS_WM) + (size_t)l * 512 * D; t.kscale = (const GAS float*)a.in[6] + l * D; t.K = D; t.N = 512; t.ndst = 512; t.kind = 4; t.nscale = D; t.item = r; return t;
}
__device__ __forceinline__ void titem_load(const TItem& t, f32x4 (&v)[8], int lane) {
    const int nblk = t.ndst / 32, kb = t.item / nblk, nb = t.item % nblk, k0 = 64 * kb, n0 = 32 * nb, kq = lane >> 3, jd = n0 + 4 * (lane & 7);
    const int sc = t.kind == 0 ? win_srccol(jd) : (t.kind == 2 ? wfi_srccol(jd) : jd);
#pragma unroll
    for (int i = 0; i < 8; ++i) v[i] = *(const GAS f32x4*)(t.W + (size_t)(k0 + 8 * i + kq) * t.N + sc);
}
__device__ __forceinline__ void titem_store(const TItem& t, const f32x4 (&v)[8], LAS float* scr, int lane) {
    const int nblk = t.ndst / 32, kb = t.item / nblk, nb = t.item % nblk, k0 = 64 * kb, n0 = 32 * nb, kq = lane >> 3, nq = lane & 7;
#pragma unroll
    for (int i = 0; i < 8; ++i)
#pragma unroll
        for (int e = 0; e < 4; ++e) scr[(8 * i + kq) * 33 + 4 * nq + e] = v[i][e];
    const int c = lane & 7;
    f32x4 s0 = (f32x4){1.f, 1.f, 1.f, 1.f}, s1 = s0;
    if (k0 + 8 * c < t.nscale) { s0 = *(const GAS f32x4*)(t.kscale + k0 + 8 * c); s1 = *(const GAS f32x4*)(t.kscale + k0 + 8 * c + 4); }
    asm volatile("s_waitcnt lgkmcnt(0)" ::: "memory");
#pragma unroll
    for (int j = 0; j < 4; ++j) { const int n = (lane >> 3) + 8 * j; const LAS float* s = scr + (8 * c) * 33 + n;
        u32x4 o; o.x = pk2(s[0 * 33] * s0[0], s[1 * 33] * s0[1]); o.y = pk2(s[2 * 33] * s0[2], s[3 * 33] * s0[3]); o.z = pk2(s[4 * 33] * s1[0], s[5 * 33] * s1[1]); o.w = pk2(s[6 * 33] * s1[2], s[7 * 33] * s1[3]);
        *(GAS u32x4*)(t.WT + (size_t)(n0 + n) * t.K + k0 + 8 * c) = o; }
    asm volatile("s_waitcnt lgkmcnt(0)" ::: "memory");
}

constexpr int TITEMS_PER_LAYER = 16 * (NIN / 32) + 16 * 32 + 16 * (NFI / 32) + (DFF / 64) * 32 + 16 * 16;
__device__ __forceinline__ void convert_weights(const Args& a, unsigned char* ws, LAS float* scr, int it0, int it1, int w, int nw, int lane, int off = 0, int mul = 1) {
    f32x4 va[8], vb[8];
    nw *= mul;
    int it = it0 + off + mul * w;
    if (it < it1) { const TItem t = titem_decode(a, ws, it); titem_load(t, va, lane); }
    while (it < it1) {
        const int itn = it + nw;
        if (itn < it1) { const TItem t = titem_decode(a, ws, itn); titem_load(t, vb, lane); }
        { const TItem t = titem_decode(a, ws, it); titem_store(t, va, scr, lane); }
        it = itn;
        if (it >= it1) break;
        const int itn2 = it + nw;
        if (itn2 < it1) { const TItem t = titem_decode(a, ws, itn2); titem_load(t, va, lane); }
        { const TItem t = titem_decode(a, ws, it); titem_store(t, vb, scr, lane); }
        it = itn2;
    }
}

__device__ __forceinline__ void p0_prologue(const Args& a, unsigned char* ws, LAS unsigned char* lds, int gw, int NGW, int wave, int lane) {
    LAS float* scr = (LAS float*)(lds + wave * 16384);
    convert_weights(a, ws, scr, 0, 16 * (NIN / 32), gw, NGW, lane);
    for (int l = 0; l < DEPTH; ++l) convert_weights(a, ws, scr, l * TITEMS_PER_LAYER + TITEMS_PER_LAYER - 256, (l + 1) * TITEMS_PER_LAYER, gw, NGW, lane);
    for (int m = gw; m < M; m += NGW) {
        const f32x4* xr = (const f32x4*)(a.in[0] + (size_t)m * D) + lane; f32x4 v[4]; float s = 0.f;
#pragma unroll
        for (int j = 0; j < 4; ++j) { v[j] = xr[64 * j]; s += (v[j].x * v[j].x + v[j].y * v[j].y) + (v[j].z * v[j].z + v[j].w * v[j].w); }
        s = wave_sum(s, lane);
        u32x2* o8 = (u32x2*)((bf16_t*)(ws + WS_XB) + (size_t)m * D) + lane;
#pragma unroll
        for (int j = 0; j < 4; ++j) { u32x2 w; w.x = pk2(v[j].x, v[j].y); w.y = pk2(v[j].z, v[j].w); o8[64 * j] = w; }
        if (lane < 16) ((float*)(ws + WS_SSQA))[(size_t)m * 16 + lane] = lane == 0 ? s : 0.f;
    }
    for (int m = gw; m < MROWS; m += NGW) {
        const f32x4* xr = (const f32x4*)(a.in[1] + (size_t)m * D) + lane; f32x4 v[4]; float s = 0.f;
#pragma unroll
        for (int j = 0; j < 4; ++j) { v[j] = xr[64 * j]; s += (v[j].x * v[j].x + v[j].y * v[j].y) + (v[j].z * v[j].z + v[j].w * v[j].w); }
        const float rs = rsqrtf(wave_sum(s, lane) * (1.0f / D) + EPS);
        u32x2* o8 = (u32x2*)((bf16_t*)(ws + WS_MEMB) + (size_t)m * D) + lane;
#pragma unroll
        for (int j = 0; j < 4; ++j) { u32x2 w; w.x = pk2(v[j].x * rs, v[j].y * rs); w.y = pk2(v[j].z * rs, v[j].w * rs); o8[64 * j] = w; }
    }
    {   const double invf = exp(-9.210340371976184 * ((double)lane / 63.0));
        for (int m = gw; m < M; m += NGW) {
            const double ang = (double)((const GAS int*)a.in[2])[m] * invf;
            const double kr = rint(ang * 0.15915494309189535);
            const float r = (float)fma(-kr, 1.2246467991473532e-16 * 2.0, fma(-kr, 6.283185307179586, ang));
            float sn, cs; sincosf(r, &sn, &cs);
            ((GAS float*)(ws + WS_COS))[(size_t)m * 64 + lane] = cs;
            ((GAS float*)(ws + WS_SIN))[(size_t)m * 64 + lane] = sn;
        }
    }
    for (int c = gw * 64 + lane; c < MIXW; c += NGW * 64) {
        const float l0 = a.in[8][c], l1 = a.in[8][MIXW + c]; const float mx = fmaxf(l0, l1), e0 = expf(l0 - mx), e1 = expf(l1 - mx);
        ((float*)(ws + WS_LB))[c] = 0.f; ((float*)(ws + WS_LB))[MIXW + c] = e1 / (e0 + e1);
    }
}

typedef float f32x16 __attribute__((ext_vector_type(16)));
constexpr int SC_QS = 0, SC_KS = 8704, SC_KST = 17408, SC_V = 27648, SC_P = 37888, SC_AUX = 40448, SC_OUT = 41472, SC_SSQ = 50176, SC_GATE = 50688, SC_BUF = 50688 + 32 * VPR * 16;
constexpr int PQ = 272, PT = 320;
constexpr int NCHUNK = SEQ / 32;
typedef const GAS bf16_t* gbf;
struct HRegs { u32x4 x0[8], x1[8]; float aux[2]; };
__device__ __forceinline__ bf16x8 as_bf16x8(u32x4 v) { return __builtin_bit_cast(bf16x8, v); }

struct StLane { unsigned g0, g1, gg, ga, l0, l1, lg, la, sk; };
template <int IS_RET>
__device__ __forceinline__ void stager_load(HRegs& R, gbf Z, gbf KST, const GAS float* AUXG, int b, int h, int unit, int sw, const StLane& L, int chunk) {
    chunk = chunk < NCHUNK ? chunk : NCHUNK - 1;
    const size_t tok0 = (size_t)b * SEQ + chunk * 32;
    const int p0 = (sw == 0 || IS_RET) ? NIN : MIXW;
    const GAS char* s0 = (const GAS char*)(sw == 0 ? Z + h * 256 : (IS_RET ? Z + h * 256 + 128 : KST + h * 128)) + tok0 * p0 * 2;
    const GAS char* s1 = (const GAS char*)(sw == 0 ? Z + h * 256 + 128 : Z + 1536 + h * 128) + tok0 * NIN * 2;
#pragma unroll
    for (int i = 0; i < 8; ++i) R.x0[i] = *(const GAS u32x4*)(s0 + (size_t)(4 * i) * p0 * 2 + L.g0);
    if (sw == 0) {
#pragma unroll
        for (int i = 0; i < 8; ++i) R.x1[i] = *(const GAS u32x4*)(s1 + 32 * i + L.g1);
    } else {
#pragma unroll
        for (int i = 0; i < 8 / NVS; ++i) R.x1[i] = *(const GAS u32x4*)(s1 + (size_t)(4 * NVS * i) * NIN * 2 + L.g1);
    }
    if (!IS_RET) { const GAS char* ag = (const GAS char*)(AUXG + ((size_t)unit * 64 + chunk) * 256 + 128 * sw); R.aux[0] = *(const GAS float*)(ag + L.ga); R.aux[1] = *(const GAS float*)(ag + 256 + L.ga); }
}
template <int IS_RET>
__device__ __forceinline__ void stager_stage(const HRegs& R, LAS unsigned char* buf, LAS unsigned char* gbuf, int sw, const StLane& L) {
    const int o0 = sw == 0 ? SC_QS : SC_KST, o1 = sw == 0 ? SC_KS : SC_V, pit = sw == 0 ? PQ : PT;
    LAS unsigned char* d0 = buf + o0 + L.l0; LAS unsigned char* d1 = buf + o1 + L.l1;
#pragma unroll
    for (int i = 0; i < 8; ++i) *(LAS u32x4*)(d0 + 4 * i * pit) = R.x0[i];
    if (sw != 0) {
#pragma unroll
        for (int i = 0; i < 8 / NVS; ++i) *(LAS u32x4*)(d1 + 4 * NVS * i * PT) = R.x1[i];
    }
    if (!IS_RET) { LAS unsigned char* al = buf + SC_AUX + 512 * sw + L.la; *(LAS float*)al = R.aux[0]; *(LAS float*)(al + 256) = R.aux[1]; }
}
__device__ __forceinline__ void scores_stage(const HRegs& R, LAS unsigned char* buf, const StLane& L, int l31, int hh) {
    f32x16 d;
#pragma unroll
    for (int r = 0; r < 16; ++r) d[r] = 0.f;
    u32x4 qf[8];
    {   const unsigned aq = (unsigned)(size_t)(buf + SC_QS) + L.sk;
        asm volatile(
            "ds_read_b128 %0, %8 offset:0\n\tds_read_b128 %1, %8 offset:32\n\tds_read_b128 %2, %8 offset:64\n\tds_read_b128 %3, %8 offset:96\n\t"
            "ds_read_b128 %4, %8 offset:128\n\tds_read_b128 %5, %8 offset:160\n\tds_read_b128 %6, %8 offset:192\n\tds_read_b128 %7, %8 offset:224\n\t"
            "s_waitcnt lgkmcnt(0)"
            : "=&v"(qf[0]), "=&v"(qf[1]), "=&v"(qf[2]), "=&v"(qf[3]), "=&v"(qf[4]), "=&v"(qf[5]), "=&v"(qf[6]), "=&v"(qf[7])
            : "v"(aq) : "memory");
        __builtin_amdgcn_sched_barrier(0);
    }
#pragma unroll
    for (int kk = 0; kk < 8; ++kk) d = __builtin_amdgcn_mfma_f32_32x32x16_bf16(as_bf16x8(R.x1[kk]), as_bf16x8(qf[kk]), d, 0, 0, 0);
#pragma unroll
    for (int q = 0; q < 4; ++q) { float v4[4];
#pragma unroll
        for (int i = 0; i < 4; ++i) { const int srow = 8 * q + 4 * hh + i; v4[i] = (srow <= l31) ? d[4 * q + i] : 0.f; }
        u32x2 w; w.x = pg8::cvt_pk_bf16(v4[0], v4[1]); w.y = pg8::cvt_pk_bf16(v4[2], v4[3]);
        *(LAS u32x2*)(buf + SC_P + l31 * 80 + (8 * q + 4 * hh) * 2) = w; }
}
struct FinLane { unsigned lo, ls, go, gs, gz; };
constexpr int FPT = 32 * VPR / 64;
template <int IS_RET>
__device__ __forceinline__ void gate_load(u32x4 (&g)[FPT], gbf Z, int b, int h, const FinLane& L, int chunk) {
    chunk = chunk < NCHUNK ? chunk : NCHUNK - 1;
    const GAS char* sg = (const GAS char*)(Z + 2304 + h * 128) + ((size_t)b * SEQ + chunk * 32) * NIN * 2;
#pragma unroll
    for (int i = 0; i < FPT; ++i) g[i] = *(const GAS u32x4*)(sg + (size_t)(64 / VPR * i) * NIN * 2 + L.gz);
}
__device__ __forceinline__ void gate_stage(const u32x4 (&g)[FPT], LAS unsigned char* buf, int lane) {
#pragma unroll
    for (int i = 0; i < FPT; ++i) *(LAS u32x4*)(buf + SC_GATE + (lane + 64 * i) * 16) = g[i];
}
template <int IS_RET>
__device__ __forceinline__ void fin_store(LAS unsigned char* buf, GAS bf16_t* CAT, GAS float* SSQO, int b, int h, int vh, const FinLane& L, int lane, bool first, int chunk) {
    const size_t tok0 = (size_t)b * SEQ + chunk * 32;
    GAS char* cg = (GAS char*)(CAT + tok0 * D + h * 128); GAS char* sgp = (GAS char*)(SSQO + tok0 * 16 + h * NVS + vh);
#pragma unroll
    for (int i = 0; i < FPT; ++i) {
        const u32x2 lo = *(const LAS u32x2*)(buf + SC_OUT + (64 / VPR) * i * PQ + L.lo), hi = *(const LAS u32x2*)(buf + SC_OUT + (64 / VPR) * i * PQ + 8 + L.lo);
        const LAS unsigned char* sq = buf + SC_SSQ + (64 / VPR) * 4 * i + L.ls;
        float ssum = *(const LAS float*)sq;
#pragma unroll
        for (int w = 1; w < 4 / NVS; ++w) ssum += *(const LAS float*)(sq + 128 * w);
        const float sc = (IS_RET && NVS == 1) ? rsqrtf(ssum * (1.0f / HD) + EPS) : 1.0f;
        const u32x4 gt = *(const LAS u32x4*)(buf + SC_GATE + (lane + 64 * i) * 16);
        const unsigned ow[4] = {lo.x, lo.y, hi.x, hi.y}; u32x4 out;
#pragma unroll
        for (int j = 0; j < 4; ++j) out[j] = pg8::cvt_pk_bf16(__uint_as_float(ow[j] << 16) * sc * __uint_as_float(gt[j] << 16), __uint_as_float(ow[j] & 0xffff0000u) * sc * __uint_as_float(gt[j] & 0xffff0000u));
        *(GAS u32x4*)(cg + (size_t)(64 / VPR * i) * D * 2 + L.go) = out;
        if ((!IS_RET || NVS > 1) && first) *(GAS float*)(sgp + (size_t)(64 / VPR * i) * 64 + L.gs) = ssum; }
}
__device__ __forceinline__ void norm_rows(unsigned char* ws, int row0, int row1, int gw, int NGW, int lane) {
    GAS bf16_t* CAT = (GAS bf16_t*)(ws + WS_CAT); const GAS float* SSQO = (const GAS float*)(ws + WS_SSQO);
    for (int row = row0 + gw; row < row1; row += NGW) {
#pragma unroll
        for (int j = 0; j < 3; ++j) { const int e = lane * 4 + 256 * j, h = e >> 7;
            float ssum = 0.f;
#pragma unroll
            for (int q = 0; q < NVS; ++q) ssum += SSQO[(size_t)row * 16 + h * NVS + q];
            const float sc = rsqrtf(ssum * (1.0f / HD) + EPS);
            GAS u32x2* p = (GAS u32x2*)(CAT + (size_t)row * D + e); const u32x2 w = *p; u32x2 o;
            o.x = pg8::cvt_pk_bf16(__uint_as_float(w.x << 16) * sc, __uint_as_float(w.x & 0xffff0000u) * sc); o.y = pg8::cvt_pk_bf16(__uint_as_float(w.y << 16) * sc, __uint_as_float(w.y & 0xffff0000u) * sc);
            *p = o; }
    }
}
#define TRR(dst, areg, off) "ds_read_b64_tr_b16 " dst ", " areg " offset:" #off "\n\t"
struct MLane { unsigned av, ak, aq, aaux, ap, aout, assq; };
template <int IS_RET, int PAR>
__device__ __forceinline__ void mfma_step(f32x16 (&S)[4], const MLane& A, int lane, float g32) {
    constexpr unsigned PB = PAR * SC_BUF;
    u32x2 v00, v01, v10, v11, k[4][2][2]; u32x4 qf[4][2];
    const unsigned av = A.av + PB, ak = A.ak + PB, aq = A.aq + PB;
    asm volatile(
        "ds_read_b128 %0, %8 offset:0\n\tds_read_b128 %1, %8 offset:32\n\tds_read_b128 %2, %8 offset:64\n\tds_read_b128 %3, %8 offset:96\n\t"
        "ds_read_b128 %4, %8 offset:128\n\tds_read_b128 %5, %8 offset:160\n\tds_read_b128 %6, %8 offset:192\n\tds_read_b128 %7, %8 offset:224"
        : "=&v"(qf[0][0]), "=&v"(qf[0][1]), "=&v"(qf[1][0]), "=&v"(qf[1][1]), "=&v"(qf[2][0]), "=&v"(qf[2][1]), "=&v"(qf[3][0]), "=&v"(qf[3][1])
        : "v"(aq) : "memory");
    asm volatile(
        TRR("%0", "%12", 0) TRR("%1", "%12", 1280) TRR("%2", "%12", 5120) TRR("%3", "%12", 6400)
        TRR("%4", "%13", 0) TRR("%5", "%13", 1280) TRR("%6", "%13", 5120) TRR("%7", "%13", 6400)
        TRR("%8", "%13", 64) TRR("%9", "%13", 1344) TRR("%10", "%13", 5184) TRR("%11", "%13", 6464)
        : "=&v"(v00), "=&v"(v01), "=&v"(v10), "=&v"(v11),
          "=&v"(k[0][0][0]), "=&v"(k[0][0][1]), "=&v"(k[0][1][0]), "=&v"(k[0][1][1]), "=&v"(k[1][0][0]), "=&v"(k[1][0][1]), "=&v"(k[1][1][0]), "=&v"(k[1][1][1])
        : "v"(av), "v"(ak) : "memory");
    const LAS unsigned char* auxp = (const LAS unsigned char*)(size_t)(A.aaux + PB);
    bf16x8 sf[4][2];
#pragma unroll
    for (int kt = 0; kt < 4; ++kt) { f32x16 t = S[kt];
        if (!IS_RET) {
#pragma unroll
            for (int q = 0; q < 4; ++q) { const f32x4 e = *(const LAS f32x4*)(auxp + (32 * kt + 16 * (q >> 1) + 4 * (q & 1)) * 4);
#pragma unroll
                for (int i = 0; i < 4; ++i) t[4 * q + i] *= e[i]; } }
#pragma unroll
        for (int s2 = 0; s2 < 2; ++s2) { u32x4 pk;
#pragma unroll
            for (int j = 0; j < 4; ++j) pk[j] = pg8::cvt_pk_bf16(t[8 * s2 + 2 * j], t[8 * s2 + 2 * j + 1]);
            sf[kt][s2] = as_bf16x8(pk); } }
    asm volatile("s_waitcnt lgkmcnt(12)" : "+v"(qf[0][0]), "+v"(qf[0][1]), "+v"(qf[1][0]), "+v"(qf[1][1]), "+v"(qf[2][0]), "+v"(qf[2][1]), "+v"(qf[3][0]), "+v"(qf[3][1]) :: "memory");
    asm volatile(
        TRR("%0", "%8", 128) TRR("%1", "%8", 1408) TRR("%2", "%8", 5248) TRR("%3", "%8", 6528)
        TRR("%4", "%8", 192) TRR("%5", "%8", 1472) TRR("%6", "%8", 5312) TRR("%7", "%8", 6592)
        : "=&v"(k[2][0][0]), "=&v"(k[2][0][1]), "=&v"(k[2][1][0]), "=&v"(k[2][1][1]), "=&v"(k[3][0][0]), "=&v"(k[3][0][1]), "=&v"(k[3][1][0]), "=&v"(k[3][1][1])
        : "v"(ak) : "memory");
    __builtin_amdgcn_sched_barrier(0);
    f32x16 o;
#pragma unroll
    for (int r = 0; r < 16; ++r) o[r] = 0.f;
#pragma unroll
    for (int kt = 0; kt < 4; ++kt)
#pragma unroll
        for (int s2 = 0; s2 < 2; ++s2) o = __builtin_amdgcn_mfma_f32_32x32x16_bf16(sf[kt][s2], as_bf16x8(qf[kt][s2]), o, 0, 0, 0);
    __builtin_amdgcn_sched_barrier(0);
    asm volatile("s_waitcnt lgkmcnt(0)" : "+v"(v00), "+v"(v01), "+v"(v10), "+v"(v11),
          "+v"(k[0][0][0]), "+v"(k[0][0][1]), "+v"(k[0][1][0]), "+v"(k[0][1][1]), "+v"(k[1][0][0]), "+v"(k[1][0][1]), "+v"(k[1][1][0]), "+v"(k[1][1][1]),
          "+v"(k[2][0][0]), "+v"(k[2][0][1]), "+v"(k[2][1][0]), "+v"(k[2][1][1]), "+v"(k[3][0][0]), "+v"(k[3][0][1]), "+v"(k[3][1][0]), "+v"(k[3][1][1]) :: "memory");
    __builtin_amdgcn_sched_barrier(0);
    const bf16x8 vt[2] = {as_bf16x8((u32x4){v00.x, v00.y, v01.x, v01.y}), as_bf16x8((u32x4){v10.x, v10.y, v11.x, v11.y})};
    const LAS unsigned char* pp = (const LAS unsigned char*)(size_t)(A.ap + PB);
#pragma unroll
    for (int kk = 0; kk < 2; ++kk) { const bf16x8 pf = *(const LAS bf16x8*)(pp + 32 * kk);
        o = __builtin_amdgcn_mfma_f32_32x32x16_bf16(vt[kk], pf, o, 0, 0, 0); }
#pragma unroll
    for (int kt = 0; kt < 4; ++kt) {
        if (!IS_RET) {
#pragma unroll
            for (int q = 0; q < 4; ++q) { const f32x4 e = *(const LAS f32x4*)(auxp + 512 + (32 * kt + 16 * (q >> 1) + 4 * (q & 1)) * 4);
#pragma unroll
                for (int i = 0; i < 4; ++i) S[kt][4 * q + i] *= e[i]; } }
#pragma unroll
        for (int kk = 0; kk < 2; ++kk) S[kt] = __builtin_amdgcn_mfma_f32_32x32x16_bf16(as_bf16x8((u32x4){k[kt][kk][0].x, k[kt][kk][0].y, k[kt][kk][1].x, k[kt][kk][1].y}), vt[kk], S[kt], 0, 0, 0);
        if (IS_RET) S[kt] = S[kt] * g32;
    }
    float ss = 0.f;
#pragma unroll
    for (int r = 0; r < 16; ++r) ss += o[r] * o[r];
    ss += shfl_xor_l(ss, lane, 32);
    if (lane < 32) *(LAS float*)(size_t)(A.assq + PB) = ss;
    LAS unsigned char* op = (LAS unsigned char*)(size_t)(A.aout + PB);
#pragma unroll
    for (int q = 0; q < 4; ++q) { u32x2 wv; wv.x = pg8::cvt_pk_bf16(o[4 * q], o[4 * q + 1]); wv.y = pg8::cvt_pk_bf16(o[4 * q + 2], o[4 * q + 3]);
        *(LAS u32x2*)(op + 16 * q) = wv; }
}
template <int IS_RET, int VAR>
__device__ __forceinline__ void scan2_unit(unsigned char* ws, LAS unsigned char* lds, int unit, int tid) {
    constexpr bool MF_ON = VAR == 0 || ((VAR & 16) && (VAR & 1)), ST_ON = VAR == 0 || ((VAR & 16) && (VAR & 2)), FI_ON = VAR == 0 || ((VAR & 16) && (VAR & 4)), ST_LD = ST_ON && !(VAR & 64), ST_ST = ST_ON && !(VAR & 32);
    gbf Z = (gbf)(ws + WS_Z); gbf KST = (gbf)(ws + WS_KST); const GAS float* AUXG = (const GAS float*)(ws + WS_AUX);
    GAS bf16_t* CAT = (GAS bf16_t*)(ws + WS_CAT); GAS float* SSQO = (GAS float*)(ws + WS_SSQO);
    const int b = unit / (NH * NVS), h = (unit / NVS) % NH, vh = unit % NVS, hu = b * NH + h, wave = __builtin_amdgcn_readfirstlane(tid >> 6); int lane = tid & 63;
    const float g32 = exp2f(32.0f * __log2f(1.0f - exp2f(-5.0f - (float)h)));
    __syncthreads();
    static_assert(NVS == 2, "wave roles below are written for two value slices per head");
    if (wave >= 6) {
        __syncthreads();
        for (int n = 0; n < NCHUNK; ++n) __syncthreads();
    } else if (wave < 2) {
        asm volatile("" : "+v"(lane));
        const int l31 = lane & 31, hh = lane >> 5, vs = (128 / NVS) * vh + 32 * wave;
        const unsigned base = (unsigned)(size_t)lds, trl = (unsigned)((8 * hh + ((lane & 15) >> 2)) * PT + (16 * ((lane >> 4) & 1) + 4 * (lane & 3)) * 2);
        const int psw = ((lane & 3) == 1) ? 2 : (((lane & 3) == 2) ? 1 : (lane & 3));
        const unsigned trk = (unsigned)((8 * hh + ((lane & 15) >> 2)) * PT + (16 * ((lane >> 4) & 1) + 4 * psw) * 2);
        MLane A;
        A.av = base + SC_V + trl + vs * 2; A.ak = base + SC_KST + trk; A.aq = base + SC_QS + l31 * PQ + 16 * hh; A.aaux = base + SC_AUX + 32 * hh; A.ap = base + SC_P + l31 * 80 + 16 * hh;
        A.aout = base + SC_OUT + l31 * PQ + (vs + 4 * hh) * 2; A.assq = base + SC_SSQ + (wave * 32 + l31) * 4;
        asm volatile("" : "+v"(A.av), "+v"(A.ak), "+v"(A.aq), "+v"(A.aaux), "+v"(A.ap), "+v"(A.aout), "+v"(A.assq));
        f32x16 S[4];
#pragma unroll
        for (int kt = 0; kt < 4; ++kt)
#pragma unroll
            for (int r = 0; r < 16; ++r) S[kt][r] = 0.f;
        __syncthreads();
        for (int n = 0; n < NCHUNK; n += 2) {
            if (MF_ON) mfma_step<IS_RET, 0>(S, A, lane, g32);
            __syncthreads();
            if (MF_ON) mfma_step<IS_RET, 1>(S, A, lane, g32);
            __syncthreads();
        }
        if (!MF_ON) asm volatile("" :: "v"(S[0][0]));
    } else if (wave < 4) {
        const int sw = wave - 2;
        if (!ST_ON) { __syncthreads(); for (int n = 0; n < NCHUNK; ++n) __syncthreads(); }
        else {
        asm volatile("" : "+v"(lane));
        const int l31 = lane & 31, hh = lane >> 5, r4 = lane >> 4, c16 = lane & 15, p0 = (sw == 0 || IS_RET) ? NIN : MIXW;
        StLane L;
        L.g0 = (unsigned)((r4 * p0 + 8 * c16) * 2); L.gg = 0; L.ga = (unsigned)(lane * 4);
        L.l0 = (unsigned)(r4 * (sw == 0 ? PQ : PT) + 16 * c16); L.lg = (unsigned)(lane * 16); L.la = (unsigned)(lane * 4); L.sk = (unsigned)(l31 * PQ + 16 * hh);
        if (sw == 0) { L.g1 = (unsigned)((l31 * NIN + 8 * hh) * 2); L.l1 = 0; }
        else { const int rv = lane / VPR, cv = VPR * vh + lane % VPR; L.g1 = (unsigned)((rv * NIN + 8 * cv) * 2); L.l1 = (unsigned)(rv * PT + 16 * cv); }
        asm volatile("" : "+v"(L.g0), "+v"(L.g1), "+v"(L.gg), "+v"(L.ga), "+v"(L.l0), "+v"(L.l1), "+v"(L.lg), "+v"(L.la), "+v"(L.sk));
        HRegs RA, RB;
        stager_load<IS_RET>(RA, Z, KST, AUXG, b, h, hu, sw, L, 0);
        stager_stage<IS_RET>(RA, lds, lds + SC_BUF, sw, L);
        if (sw == 0) scores_stage(RA, lds, L, l31, hh);
        stager_load<IS_RET>(RB, Z, KST, AUXG, b, h, hu, sw, L, 1);
        __syncthreads();
        for (int n = 0; n < NCHUNK; n += 2) {
            if (ST_LD) stager_load<IS_RET>(RA, Z, KST, AUXG, b, h, hu, sw, L, n + 2);
            if (ST_ST) { stager_stage<IS_RET>(RB, lds + SC_BUF, lds, sw, L);
                if (sw == 0) scores_stage(RB, lds + SC_BUF, L, l31, hh); }
            else asm volatile("" :: "v"(RB.x0[0]), "v"(RB.x0[7]), "v"(RB.x1[0]), "v"(RB.aux[1]));
            __syncthreads();
            if (ST_LD) stager_load<IS_RET>(RB, Z, KST, AUXG, b, h, hu, sw, L, n + 3);
            if (ST_ST) { stager_stage<IS_RET>(RA, lds, lds + SC_BUF, sw, L);
                if (sw == 0) scores_stage(RA, lds, L, l31, hh); }
            else asm volatile("" :: "v"(RA.x0[0]), "v"(RA.x0[7]), "v"(RA.x1[0]), "v"(RA.aux[1]));
            __syncthreads();
        }
        }
    } else {
        asm volatile("" : "+v"(lane));
        FinLane L;
        {   const int c0 = lane / VPR, v0 = 8 * (VPR * vh + lane % VPR);
            L.lo = (unsigned)(c0 * PQ + v0 * 2); L.ls = (unsigned)(c0 * 4); L.go = (unsigned)((c0 * D + v0) * 2); L.gs = (unsigned)(c0 * 64); L.gz = (unsigned)((c0 * NIN + v0) * 2); }
        asm volatile("" : "+v"(L.lo), "+v"(L.ls), "+v"(L.go), "+v"(L.gs), "+v"(L.gz));
        if (wave == 4) {
            u32x4 gA[FPT], gB[FPT];
            gate_load<IS_RET>(gA, Z, b, h, L, 0); gate_load<IS_RET>(gB, Z, b, h, L, 1);
            __syncthreads();
            for (int n = 0; n < NCHUNK; n += 2) {
                if (FI_ON) { gate_stage(gA, lds, lane); gate_load<IS_RET>(gA, Z, b, h, L, n + 2); }
                __syncthreads();
                if (FI_ON) { gate_stage(gB, lds + SC_BUF, lane); gate_load<IS_RET>(gB, Z, b, h, L, n + 3); }
                __syncthreads();
            }
        } else {
            const bool first = (lane % VPR) == 0;
            __syncthreads();
            __syncthreads();
            for (int n = 1; n < NCHUNK; ++n) { if (FI_ON) fin_store<IS_RET>(lds + ((n - 1) & 1) * SC_BUF, CAT, SSQO, b, h, vh, L, lane, first, n - 1); __syncthreads(); }
            if (FI_ON) fin_store<IS_RET>(lds + ((NCHUNK - 1) & 1) * SC_BUF, CAT, SSQO, b, h, vh, L, lane, first, NCHUNK - 1);
        }
    }
}

constexpr int XA_K = 0, XA_KP = 144, XA_V = 256 * XA_KP, XA_VP = 192;
#define XRD(dst, areg, off) "ds_read_b128 " dst ", " areg " offset:" #off "\n\t"
__device__ __forceinline__ void xattn2_unit(unsigned char* ws, LAS unsigned char* lds, int unit, int layer, int tid) {
    gbf Z = (gbf)(ws + WS_Z); gbf MKV = (gbf)(ws + WS_MKV); GAS bf16_t* CAT = (GAS bf16_t*)(ws + WS_CAT);
    const int b = unit >> 5, hx = (unit >> 3) & 3, qb = unit & 7;
    const int wave = tid >> 6, lane = tid & 63, l31 = lane & 31, hh = lane >> 5;
    const size_t tok = (size_t)b * SEQ + qb * 256 + wave * 32 + l31;
    bf16x8 qf[4];
#pragma unroll
    for (int ks = 0; ks < 4; ++ks) qf[ks] = *(const GAS bf16x8*)(Z + tok * NIN + 3072 + hx * 64 + 16 * ks + 8 * hh);
    __syncthreads();
    {   gbf src = MKV + (size_t)(b * NMEM) * 2048 + layer * 512 + hx * 64;
        u32x4 kr[4], vr[4];
#pragma unroll
        for (int i = 0; i < 4; ++i) { const int piece = tid + 512 * i, key = piece >> 3, j = piece & 7;
            kr[i] = *(const GAS u32x4*)(src + (size_t)key * 2048 + 8 * j); vr[i] = *(const GAS u32x4*)(src + (size_t)key * 2048 + 256 + 8 * j); }
#pragma unroll
        for (int i = 0; i < 4; ++i) { const int piece = tid + 512 * i, key = piece >> 3, j = piece & 7;
            *(LAS u32x4*)(lds + XA_K + key * XA_KP + 16 * j) = kr[i]; *(LAS u32x4*)(lds + XA_V + key * XA_VP + 16 * j) = vr[i]; }
    }
    __syncthreads();
    f32x16 st[8];
    const unsigned ak = (unsigned)(size_t)(lds + XA_K) + (unsigned)(l31 * XA_KP + 16 * hh);
#define XBLK(T0, o0, o1, o2, o3, o4, o5, o6, o7) { u32x4 f0, f1, f2, f3, f4, f5, f6, f7; \
        asm volatile(XRD("%0", "%8", o0) XRD("%1", "%8", o1) XRD("%2", "%8", o2) XRD("%3", "%8", o3) XRD("%4", "%8", o4) XRD("%5", "%8", o5) XRD("%6", "%8", o6) XRD("%7", "%8", o7) "s_waitcnt lgkmcnt(0)" \
            : "=&v"(f0), "=&v"(f1), "=&v"(f2), "=&v"(f3), "=&v"(f4), "=&v"(f5), "=&v"(f6), "=&v"(f7) : "v"(ak) : "memory"); \
        __builtin_amdgcn_sched_barrier(0); \
        f32x16 a0, a1; _Pragma("unroll") for (int r = 0; r < 16; ++r) { a0[r] = 0.f; a1[r] = 0.f; } \
        a0 = __builtin_amdgcn_mfma_f32_32x32x16_bf16(as_bf16x8(f0), qf[0], a0, 0, 0, 0); a1 = __builtin_amdgcn_mfma_f32_32x32x16_bf16(as_bf16x8(f4), qf[0], a1, 0, 0, 0); \
        a0 = __builtin_amdgcn_mfma_f32_32x32x16_bf16(as_bf16x8(f1), qf[1], a0, 0, 0, 0); a1 = __builtin_amdgcn_mfma_f32_32x32x16_bf16(as_bf16x8(f5), qf[1], a1, 0, 0, 0); \
        a0 = __builtin_amdgcn_mfma_f32_32x32x16_bf16(as_bf16x8(f2), qf[2], a0, 0, 0, 0); a1 = __builtin_amdgcn_mfma_f32_32x32x16_bf16(as_bf16x8(f6), qf[2], a1, 0, 0, 0); \
        a0 = __builtin_amdgcn_mfma_f32_32x32x16_bf16(as_bf16x8(f3), qf[3], a0, 0, 0, 0); a1 = __builtin_amdgcn_mfma_f32_32x32x16_bf16(as_bf16x8(f7), qf[3], a1, 0, 0, 0); \
        st[T0] = a0; st[T0 + 1] = a1; }
    XBLK(0, 0, 32, 64, 96, 4608, 4640, 4672, 4704)
    XBLK(2, 9216, 9248, 9280, 9312, 13824, 13856, 13888, 13920)
    XBLK(4, 18432, 18464, 18496, 18528, 23040, 23072, 23104, 23136)
    XBLK(6, 27648, 27680, 27712, 27744, 32256, 32288, 32320, 32352)
#undef XBLK
    float mx = -1e30f;
#pragma unroll
    for (int T = 0; T < 8; ++T)
#pragma unroll
        for (int r = 0; r < 16; ++r) mx = fmaxf(mx, st[T][r]);
    mx = fmaxf(mx, shfl_xor_l(mx, lane, 32));
    const float c2 = 0.125f * 1.4426950408889634f, mc = mx * c2;
    float sum = 0.f;
#pragma unroll
    for (int T = 0; T < 8; ++T)
#pragma unroll
        for (int r = 0; r < 16; ++r) { const float p = exp2f(st[T][r] * c2 - mc); st[T][r] = p; sum += p; }
    sum += shfl_xor_l(sum, lane, 32);
    f32x16 ot[2];
#pragma unroll
    for (int dt = 0; dt < 2; ++dt)
#pragma unroll
        for (int r = 0; r < 16; ++r) ot[dt][r] = 0.f;
    const unsigned av = (unsigned)(size_t)(lds + XA_V) + (unsigned)((4 * hh + ((lane & 15) >> 2)) * XA_VP + (16 * ((lane >> 4) & 1) + 4 * (lane & 3)) * 2);
#define XTR(dst, off) "ds_read_b64_tr_b16 " dst ", %8 offset:" #off "\n\t"
#define VBLK(T, o00, o01, o10, o11, o20, o21, o30, o31) { u32x2 g0, g1, g2, g3, g4, g5, g6, g7; \
        asm volatile(XTR("%0", o00) XTR("%1", o01) XTR("%2", o10) XTR("%3", o11) XTR("%4", o20) XTR("%5", o21) XTR("%6", o30) XTR("%7", o31) "s_waitcnt lgkmcnt(0)" \
            : "=&v"(g0), "=&v"(g1), "=&v"(g2), "=&v"(g3), "=&v"(g4), "=&v"(g5), "=&v"(g6), "=&v"(g7) : "v"(av) : "memory"); \
        __builtin_amdgcn_sched_barrier(0); \
        u32x4 p0, p1; _Pragma("unroll") for (int j = 0; j < 4; ++j) { p0[j] = pg8::cvt_pk_bf16(st[T][2 * j], st[T][2 * j + 1]); p1[j] = pg8::cvt_pk_bf16(st[T][8 + 2 * j], st[T][8 + 2 * j + 1]); } \
        ot[0] = __builtin_amdgcn_mfma_f32_32x32x16_bf16(as_bf16x8((u32x4){g0.x, g0.y, g1.x, g1.y}), as_bf16x8(p0), ot[0], 0, 0, 0); \
        ot[1] = __builtin_amdgcn_mfma_f32_32x32x16_bf16(as_bf16x8((u32x4){g2.x, g2.y, g3.x, g3.y}), as_bf16x8(p0), ot[1], 0, 0, 0); \
        ot[0] = __builtin_amdgcn_mfma_f32_32x32x16_bf16(as_bf16x8((u32x4){g4.x, g4.y, g5.x, g5.y}), as_bf16x8(p1), ot[0], 0, 0, 0); \
        ot[1] = __builtin_amdgcn_mfma_f32_32x32x16_bf16(as_bf16x8((u32x4){g6.x, g6.y, g7.x, g7.y}), as_bf16x8(p1), ot[1], 0, 0, 0); }
    VBLK(0, 0, 1536, 64, 1600, 3072, 4608, 3136, 4672)
    VBLK(1, 6144, 7680, 6208, 7744, 9216, 10752, 9280, 10816)
    VBLK(2, 12288, 13824, 12352, 13888, 15360, 16896, 15424, 16960)
    VBLK(3, 18432, 19968, 18496, 20032, 21504, 23040, 21568, 23104)
    VBLK(4, 24576, 26112, 24640, 26176, 27648, 29184, 27712, 29248)
    VBLK(5, 30720, 32256, 30784, 32320, 33792, 35328, 33856, 35392)
    VBLK(6, 36864, 38400, 36928, 38464, 39936, 41472, 40000, 41536)
    VBLK(7, 43008, 44544, 43072, 44608, 46080, 47616, 46144, 47680)
#undef VBLK
#undef XTR
    const float il = 1.0f / sum;
    GAS bf16_t* op = CAT + tok * D + MIXW + hx * 64 + 4 * hh;
#pragma unroll
    for (int dt = 0; dt < 2; ++dt)
#pragma unroll
        for (int q = 0; q < 4; ++q) { u32x2 w; w.x = pg8::cvt_pk_bf16(ot[dt][4 * q] * il, ot[dt][4 * q + 1] * il); w.y = pg8::cvt_pk_bf16(ot[dt][4 * q + 2] * il, ot[dt][4 * q + 3] * il);
            *(GAS u32x2*)(op + 32 * dt + 8 * q) = w; }
}

__device__ __forceinline__ void final_rows(const unsigned char* ws, float* out, const float* nf, int row0, int row1, int gw, int NGW, int lane) {
    const GAS f32x4* wv = (const GAS f32x4*)nf + lane;
    for (int row = row0 + gw; row < row1; row += NGW) {
        const GAS u32x2* xr = (const GAS u32x2*)((const GAS bf16_t*)(ws + WS_XB) + (size_t)row * D) + lane; f32x4 v[4]; float s = 0.f;
#pragma unroll
        for (int j = 0; j < 4; ++j) { const u32x2 w = xr[64 * j]; v[j][0] = bf2f(w.x & 0xffffu); v[j][1] = bf2f(w.x >> 16); v[j][2] = bf2f(w.y & 0xffffu); v[j][3] = bf2f(w.y >> 16);
            s += (v[j].x * v[j].x + v[j].y * v[j].y) + (v[j].z * v[j].z + v[j].w * v[j].w); }
        const float rs = rsqrtf(wave_sum(s, lane) * (1.0f / D) + EPS);
        GAS f32x4* orow = (GAS f32x4*)(out + (size_t)row * D) + lane;
#pragma unroll
        for (int j = 0; j < 4; ++j) orow[64 * j] = v[j] * rs * wv[64 * j];
    }
}

__global__ void __launch_bounds__(NWAVES * 64, 2) mega_fwd(Args args) {
    extern __shared__ __attribute__((aligned(16))) unsigned char lds_raw[];
    LAS unsigned char* lds = (LAS unsigned char*)lds_raw;
    volatile LAS unsigned* MISC = (volatile LAS unsigned*)(lds + MISC_OFF);
    const int G = gridDim.x, bx = blockIdx.x;
    const int wave_s = __builtin_amdgcn_readfirstlane(threadIdx.x >> 6);
    unsigned char* ws = args.ws;
    for (int u = threadIdx.x; u < (LDS_BYTES - LDSCTL_OFF) / 4; u += NWAVES * 64) ((LAS unsigned*)(lds + LDSCTL_OFF))[u] = 0u;
    __syncthreads();
    XcdBarrier bar = xcd_barrier_post((unsigned*)(ws + WS_CTL) + CW_BAR, MISC + 8);
#define GBAR() xcd_barrier(bar, wave_s == 0 && lane_id_volatile() == 0)
#define OPAQ() unsigned char* wsp = ws; int Gp = G, bxp = bx, tidp = wave_s * 64 + lane_id_volatile(); asm volatile("" : "+s"(wsp), "+s"(Gp), "+s"(bxp), "+v"(tidp)); \
    const int lanep = tidp & 63, wavep = __builtin_amdgcn_readfirstlane(tidp >> 6), vcup = (Gp % 8 == 0) ? (bxp % 8) * (Gp / 8) + bxp / 8 : bxp, gwp = vcup * NWAVES + wavep, NGWp = Gp * NWAVES; \
    (void)lanep; (void)gwp; (void)NGWp
#define XPART() const int xn = misc_rd(lds, 8), xnx = misc_rd(lds, 9), xrank = misc_rd(lds, 10), xslot = misc_rd(lds, 11); \
    (void)xn; (void)xnx; (void)xrank; (void)xslot
#define LBAR() xcc_barrier(bar, (unsigned)misc_rd(lds, 8), wave_s == 0 && lane_id_volatile() == 0)

    { OPAQ(); p0_prologue(args, wsp, lds, gwp, NGWp, wavep, lanep); }
    GBAR();
    if (threadIdx.x == 0) {
        unsigned slot = 0;
        for (unsigned j = 0; j < 16; ++j) { const unsigned c = xb_ld(&bar.bar[XB_XCNT(j)]); if (j < bar.x && c > 0u) ++slot; }
        MISC[11] = slot;
    }
    __syncthreads();
    for (int l = 0; l < DEPTH; ++l) {
        const int is_ret = l & 1;
        { OPAQ(); XPART();
            if (l == 0) {
                pg8::Gemm g{(const bf16_t*)(wsp + WS_MEMB), (const bf16_t*)(wsp + WS_WM), MROWS, 2048, D}; pg8::XccOrderMem S{xrank, xn, xslot, xnx};
                EpiPlain E{(bf16_t*)(wsp + WS_MKV), 2048};
                pg8::gemm_phase<EpiPlain, pg8::XccOrderMem, true, true>(lds, g, S, E, tidp);
            }
            pg8::Gemm g{(const bf16_t*)(wsp + WS_XB), (const bf16_t*)(wsp + WS_WIN) + (size_t)l * NIN * D, M, NIN, D}; pg8::XccOrder S{xrank, xn, xslot, xnx, (NIN - XW) / 256, RBG_A, 1 << 30};
            EpiIn E{(bf16_t*)(wsp + WS_Z), (bf16_t*)(wsp + WS_KST), (float*)(wsp + WS_AUX), (const float*)(wsp + WS_SSQA), (const float*)(wsp + WS_LB) + (l >> 1) * MIXW, (const float*)(wsp + WS_COS), (const float*)(wsp + WS_SIN), is_ret, (LAS float*)(lds + RSTD_TAB_OFF)};
            pg8::gemm_phase<EpiIn, pg8::XccOrder, true, true>(lds, g, S, E, tidp);
        }
        LBAR();
        { OPAQ(); XPART();
            constexpr int UB = NH * NVS + 8;
            const int nb = xslot < 8 ? (8 - xslot + xnx - 1) / xnx : 0;
            for (int u = xrank; u < UB * nb; u += xn) {
                const int b = xslot + (u / UB) * xnx, uu = u % UB;
                if (uu < NH * NVS) { if (is_ret) scan2_unit<1, 0>(wsp, lds, b * NH * NVS + uu, tidp); else scan2_unit<0, 0>(wsp, lds, b * NH * NVS + uu, tidp); }
                else { const int rb = 8 * b + (uu - NH * NVS);
                    {   pg8::Gemm g{(const bf16_t*)(wsp + WS_XB), (const bf16_t*)(wsp + WS_WIN) + (size_t)l * NIN * D, M, NIN, D}; pg8::OneUnit S{rb, 12};
                        EpiIn E{(bf16_t*)(wsp + WS_Z), (bf16_t*)(wsp + WS_KST), (float*)(wsp + WS_AUX), (const float*)(wsp + WS_SSQA), (const float*)(wsp + WS_LB) + (l >> 1) * MIXW, (const float*)(wsp + WS_COS), (const float*)(wsp + WS_SIN), is_ret, (LAS float*)(lds + RSTD_TAB_OFF)};
                        pg8::gemm_phase<EpiIn, pg8::OneUnit, true, true>(lds, g, S, E, tidp); }
                    asm volatile("s_waitcnt vmcnt(0)" ::: "memory"); __builtin_amdgcn_fence(__ATOMIC_RELEASE, "agent"); __syncthreads(); __builtin_amdgcn_fence(__ATOMIC_ACQUIRE, "agent");
                    for (int hx = 0; hx < NXH; ++hx) xattn2_unit(wsp, lds, (rb >> 3) * 32 + hx * 8 + (rb & 7), l, tidp);
                }
            }
            if (l == 0) {
                const int busy = UB * nb < xn ? UB * nb : 0, nidle = xn - busy;
                if (xrank >= busy) { const int wv = (xrank - busy) * NWAVES + wavep, nwv = nidle * NWAVES;
                    __syncthreads();
                    for (int l2 = 0; l2 < DEPTH; ++l2) convert_weights(args, wsp, (LAS float*)(lds + wavep * 16384), l2 * TITEMS_PER_LAYER + (l2 == 0 ? 16 * (NIN / 32) : 0), (l2 + 1) * TITEMS_PER_LAYER - 256, wv, nwv, lanep, xslot < xnx ? xslot : 0, xnx);
                }
            }
            __syncthreads();
        }
        if (l == 0) GBAR(); else LBAR();
        if (NVS > 1 && is_ret) {
            { OPAQ(); XPART(); for (int b = xslot; b < BATCH; b += xnx) norm_rows(wsp, b * SEQ, (b + 1) * SEQ, xrank * NWAVES + wavep, xn * NWAVES, lanep); }
            LBAR();
        }
        { OPAQ(); XPART();
            pg8::Gemm g{(const bf16_t*)(wsp + WS_CAT), (const bf16_t*)(wsp + WS_WOUT) + (size_t)l * D * D, M, D, D}; pg8::XccOrder S{xrank, xn, xslot, xnx, D / 256, 4, 1 << 30};
            EpiResC E{EpiRes{(const bf16_t*)(wsp + WS_XB), (bf16_t*)(wsp + WS_XB), (float*)(wsp + WS_SSQD)}, is_ret ? nullptr : (const float*)(wsp + WS_SSQO)};
            pg8::gemm_phase<EpiResC, pg8::XccOrder, true, true>(lds, g, S, E, tidp);
        }
        LBAR();
        { OPAQ(); XPART();
            pg8::Gemm g{(const bf16_t*)(wsp + WS_XB), (const bf16_t*)(wsp + WS_WFI) + (size_t)l * NFI * D, M, NFI, D};
            const int totD = (xslot < 8 ? (8 - xslot + xnx - 1) / xnx : 0) * 8 * (NFI / 256), fullD = (totD / xn) * xn, leftD = totD - fullD; const bool halves = leftD > 0 && 2 * leftD <= xn;
            pg8::XccOrder S{xrank, xn, xslot, xnx, NFI / 256, RBG_D, halves ? fullD : (1 << 30)};
            EpiFfn E{(bf16_t*)(wsp + WS_ACT), (const float*)(wsp + WS_SSQD), (LAS float*)(lds + RSTD_TAB_OFF), -1};
            pg8::gemm_phase<EpiFfn, pg8::XccOrder, true, true>(lds, g, S, E, tidp);
            if (halves && xrank < 2 * leftD) { pg8::Unit hu; S.decode(fullD + xrank % leftD, hu);
                pg8::HalfUnit SH{hu.pm, hu.pn, xrank / leftD}; EpiFfn EH{(bf16_t*)(wsp + WS_ACT), (const float*)(wsp + WS_SSQD), (LAS float*)(lds + RSTD_TAB_OFF), xrank / leftD};
                pg8::gemm_phase<EpiFfn, pg8::HalfUnit, true, true, true>(lds, g, SH, EH, tidp); }
        }
        LBAR();
        { OPAQ(); XPART();
            pg8::Gemm g{(const bf16_t*)(wsp + WS_ACT), (const bf16_t*)(wsp + WS_WFO) + (size_t)l * D * DFF, M, D, DFF}; pg8::XccOrder S{xrank, xn, xslot, xnx, D / 256, 4, 1 << 30};
            EpiRes E{(const bf16_t*)(wsp + WS_XB), (bf16_t*)(wsp + WS_XB), (float*)(wsp + WS_SSQA)};
            pg8::gemm_phase<EpiRes, pg8::XccOrder, true, true>(lds, g, S, E, tidp);
        }
        LBAR();
    }
    { OPAQ(); XPART();
        for (int b = xslot; b < BATCH; b += xnx) final_rows(wsp, args.out, args.in[14], b * SEQ, (b + 1) * SEQ, xrank * NWAVES + wavep, xn * NWAVES, lanep);
    }
#undef OPAQ
#undef XPART
#undef GBAR
#undef LBAR
}

extern "C" void kernel_launch(void* const* d_in, const int* in_sizes, int n_in, void* d_out, int out_size, void* d_ws, size_t ws_size, hipStream_t stream) {
    static int grid = 0;
    if (grid == 0) {
        if (n_in != 15 || in_sizes[0] != M * D || out_size != M * D || ws_size < WS_END) {
            fprintf(stderr, "kernel_launch: unexpected shapes: n_in %d in0 %d out %d ws %zu (need %zu)\n", n_in, n_in > 0 ? in_sizes[0] : -1, out_size, ws_size, (size_t)WS_END); grid = -1; return; }
        int dev = 0, cus = 0, per_cu = 0;
        if (hipGetDevice(&dev) != hipSuccess || hipDeviceGetAttribute(&cus, hipDeviceAttributeMultiprocessorCount, dev) != hipSuccess) { grid = -1; return; }
        if (hipFuncSetAttribute((const void*)mega_fwd, hipFuncAttributeMaxDynamicSharedMemorySize, LDS_BYTES) != hipSuccess) { fprintf(stderr, "kernel_launch: hipFuncSetAttribute failed\n"); grid = -1; return; }
        if (hipOccupancyMaxActiveBlocksPerMultiprocessor(&per_cu, (const void*)mega_fwd, NWAVES * 64, LDS_BYTES) != hipSuccess || per_cu < 1)
            fprintf(stderr, "kernel_launch: occupancy query reports %d workgroups per CU\n", per_cu);
        (void)hipGetLastError();
        grid = cus;
        if (grid < 176) { fprintf(stderr, "kernel_launch: this kernel needs at least 176 CUs (found %d)\n", cus); grid = -1; return; }
    }
    if (grid < 0) return;
    if (hipMemsetAsync((char*)d_ws + WS_CTL, 0, CTL_ZERO_BYTES, stream) != hipSuccess) { fprintf(stderr, "kernel_launch: memset failed\n"); return; }
    Args a{};
    for (int i = 0; i < 15; ++i) a.in[i] = (const float*)d_in[i];
    a.out = (float*)d_out; a.ws = (unsigned char*)d_ws;
    a.ph_lo = 0; a.ph_hi = 0;
    hipLaunchKernelGGL(mega_fwd, dim3(grid), dim3(NWAVES * 64), LDS_BYTES, stream, a);
    const hipError_t le = hipPeekAtLastError();
    if (le != hipSuccess) fprintf(stderr, "kernel_launch: launch failed: %s\n", hipGetErrorName(le));
}
```

```cpp
#include <hip/hip_runtime.h>
#include <cstdio>
#include <cstdint>

#ifndef DBG_SKIP
#define DBG_SKIP 0
#endif
#ifndef PROBE_REP
#define PROBE_REP 0
#endif
#ifndef RBG_A
#define RBG_A 4
#endif
#ifndef RBG_D
#define RBG_D 4
#endif
#ifndef PROBE_VAR
#define PROBE_VAR 0
#endif
#ifndef MK_N_LAUNCHES
#define MK_N_LAUNCHES 1
#endif

#define GAS __attribute__((address_space(1)))
#define LAS __attribute__((address_space(3)))
typedef unsigned short bf16_t;
typedef short bf16x8 __attribute__((ext_vector_type(8)));
typedef float f32x4 __attribute__((ext_vector_type(4)));
typedef float f32x2 __attribute__((ext_vector_type(2)));
typedef unsigned u32x4 __attribute__((ext_vector_type(4)));
typedef unsigned u32x2 __attribute__((ext_vector_type(2)));

constexpr int BATCH = 8, SEQ = 2048, D = 1024, DEPTH = 4;
constexpr int M = BATCH * SEQ;
constexpr int NH = 6, HD = 128, MIXW = 768, XW = 256, NXH = 4, XHD = 64, NMEM = 256;
constexpr int NIN = 3328, DFF = 2816, NFI = 2 * DFF;
constexpr int MROWS = BATCH * NMEM;
constexpr float EPS = 1e-6f;
constexpr int NVS = 2;
constexpr int VPR = 16 / NVS;

constexpr size_t MiB = 1u << 20;
constexpr size_t WS_CTL = 0, CTL_ZERO_BYTES = 1 * MiB;
constexpr size_t WS_LB = 1 * MiB;
constexpr size_t WS_SSQA = 2 * MiB;
constexpr size_t WS_SSQD = 3 * MiB;
constexpr size_t WS_COS = 4 * MiB, WS_SIN = 8 * MiB;
constexpr size_t WS_MEMB = 12 * MiB;
constexpr size_t WS_MKV = 16 * MiB;
constexpr size_t WS_WIN = 24 * MiB;
constexpr size_t WS_WOUT = 50 * MiB;
constexpr size_t WS_WFI = 58 * MiB;
constexpr size_t WS_WFO = 102 * MiB;
constexpr size_t WS_WM = 124 * MiB;
constexpr size_t WS_XB = 128 * MiB;
constexpr size_t WS_CAT = 160 * MiB;
constexpr size_t WS_Z = 192 * MiB;
constexpr size_t WS_F = 296 * MiB;
constexpr size_t WS_KST = 296 * MiB;
constexpr size_t WS_AUX = 320 * MiB;
constexpr size_t WS_SSQO = 323 * MiB;
constexpr size_t WS_ACT = 192 * MiB;
constexpr size_t WS_END = 344 * MiB;
static_assert(WS_WIN + (size_t)DEPTH * NIN * D * 2 <= WS_WOUT && WS_WOUT + (size_t)DEPTH * D * D * 2 <= WS_WFI && WS_WFI + (size_t)DEPTH * NFI * D * 2 <= WS_WFO &&
              WS_WFO + (size_t)DEPTH * D * DFF * 2 <= WS_WM && WS_WM + (size_t)2048 * 1024 * 2 <= WS_XB && WS_Z + (size_t)M * NIN * 2 <= WS_F && WS_F + (size_t)M * MIXW * 4 <= WS_END &&
              WS_ACT + (size_t)M * DFF * 2 <= WS_F, "ws map");
constexpr int CW_BAR = 4096;

__device__ __forceinline__ int lane_id_volatile() { int l; asm volatile("v_mbcnt_lo_u32_b32 %0, -1, 0\n\tv_mbcnt_hi_u32_b32 %0, -1, %0" : "=v"(l)); return l; }
namespace pg8 {
constexpr int BM = 256, BK = 64, HALF = 128, HTB = HALF * BK * 2, STAGE_BYTES = 8 * HTB, NXCD = 8, WGM = 8;
__host__ __device__ __forceinline__ int lds_byte(int r, int c) { const int st = (r >> 4) * 2 + (c >> 5), rr = r & 15, cc = c & 31, ob = rr * 64 + cc * 2; return st * 1024 + (ob ^ (((ob >> 9) & 1) << 5)); }
__host__ __device__ __forceinline__ void stage_rc(int b, int& R, int& C) { const int st = b / 1024, sb = b % 1024, swz = sb ^ (((sb >> 9) & 1) << 5); R = (st >> 1) * 16 + swz / 64; C = (st & 1) * 32 + (swz % 64) / 2; }
__host__ __device__ __forceinline__ int perm32(int rho) { const int n = rho >> 4, i = rho & 15; return 8 * (i >> 2) + 4 * n + (i & 3); }
struct Unit { int pm, pn; };
struct Gemm { const bf16_t* A; const bf16_t* Bt; int M, N, K; };
struct StaticOrder {
    int nM, nN, nwg, G, c;
    __host__ __device__ void init(int M_, int N_, int G_, int c_) { nM = M_ / BM; nN = N_ / BM; nwg = nM * nN; G = G_; c = c_; }
    __host__ __device__ bool next(int i, Unit& u) const {
        const long L = (long)i * G + c; if (L >= nwg) return false;
        int wgid = (int)L; { const int q = nwg / NXCD, r = nwg % NXCD, xcd = wgid % NXCD, off = wgid / NXCD; wgid = (xcd < r ? xcd * (q + 1) : r * (q + 1) + (xcd - r) * q) + off; }
        const int nig = WGM * nN, gid = wgid / nig, fm = gid * WGM, gsz = (nM - fm) < WGM ? (nM - fm) : WGM;
        u.pm = fm + ((wgid % nig) % gsz); u.pn = (wgid % nig) / gsz; return true;
    }
    __device__ __forceinline__ void a_ready(const Unit&) const {}
    __device__ __forceinline__ void done(const Unit&) const {}
};
struct XccOrder {
    int rank, n, slot, nx, nN, rbg, tlim;
    __device__ __forceinline__ bool next(int i, Unit& u) const {
        const int t = i * n + rank, nb = (8 - slot + nx - 1) / nx;
        if (slot >= 8 || t >= nb * 8 * nN || t >= tlim) return false;
        decode(t, u); return true;
    }
    __device__ __forceinline__ void decode(int t, Unit& u) const {
        const int per = 8 * nN;
        const int bi = t / per, tt = t - bi * per, g = tt / (rbg * nN), r = tt - g * rbg * nN;
        u.pm = 8 * (slot + bi * nx) + rbg * g + (r % rbg); u.pn = r / rbg;
    }
    __device__ __forceinline__ void a_ready(const Unit&) const {}
};
struct XccOrderMem {
    int rank, n, slot, nx;
    __device__ __forceinline__ bool next(int i, Unit& u) const {
        const int t = i * n + rank, nb = (8 - slot + nx - 1) / nx;
        if (slot >= 8 || t >= nb * 8) return false;
        u.pm = slot + (t >> 3) * nx; u.pn = t & 7; return true;
    }
    __device__ __forceinline__ void a_ready(const Unit&) const {}
};
struct OneUnit {
    int pm, pn;
    __device__ __forceinline__ bool next(int i, Unit& u) const { if (i) return false; u.pm = pm; u.pn = pn; return true; }
    __device__ __forceinline__ void a_ready(const Unit&) const {}
};
struct HalfUnit {
    int pm, pn, half;
    __device__ __forceinline__ bool next(int i, Unit& u) const { if (i) return false; u.pm = pm; u.pn = pn; return true; }
    __device__ __forceinline__ void a_ready(const Unit&) const {}
};
__device__ __forceinline__ unsigned cvt_pk_bf16(float lo, float hi) { unsigned r; asm volatile("v_cvt_pk_bf16_f32 %0, %1, %2" : "=v"(r) : "v"(lo), "v"(hi)); return r; }

template <class Epi, class Sched, bool ALIGN_EPI = false, bool SP2 = false, bool HM = false>
__device__ __forceinline__ void gemm_phase(LAS unsigned char* lds, const Gemm g, const Sched& S, const Epi& E, int tid) {
    asm volatile("" : "+v"(tid));
    const int wid = __builtin_amdgcn_readfirstlane(tid >> 6), lane = tid & 63, wr = wid >> 2, wc = wid & 3, fr = lane & 15, fq = lane >> 4;
    const int K = g.K, nt = K / BK;
    unsigned voffA[2], voffB[2];
#pragma unroll
    for (int i = 0; i < 2; ++i) { int R, C; stage_rc(tid * 16 + i * 8192, R, C); const int Rb = Epi::PERM ? ((R & ~31) + perm32(R & 31)) : R;
        voffA[i] = (unsigned)(R * K + C) * 2u; voffB[i] = (unsigned)(Rb * K + C) * 2u; }
    asm volatile("" : "+v"(voffA[0]), "+v"(voffA[1]), "+v"(voffB[0]), "+v"(voffB[1]));
    const size_t kstep = (size_t)(BK * 2);
    const size_t hstep = (size_t)HALF * K * 2;
    const size_t tstep = 2 * hstep;
    static_assert(!HM || SP2, "half tiles use the SP2 body");
    const size_t ahs = HM ? (size_t)0 : hstep;
    const unsigned ldsw = (unsigned)wid * 1024u;
    const int aoff = lds_byte(wr * 64 + fr, fq * 8), boff = lds_byte(wc * 32 + fr, fq * 8);
#define PG8_SA(b, h) (((b) * 2 + (h)) * HTB)
#define PG8_SB(b, h) ((4 + (b) * 2 + (h)) * HTB)
#define PG8_STAGE(bufoff, gbase, voff) do { _Pragma("unroll") for (int _i = 0; _i < 2; ++_i) \
        __builtin_amdgcn_global_load_lds((const unsigned*)((const char*)(gbase) + (voff)[_i]), (LAS unsigned*)(lds + (bufoff) + ldsw + _i * 8192), 16, 0, 0); } while (0)
#define PG8_LDA(dst, b, h) do { _Pragma("unroll") for (int m = 0; m < 4; ++m) _Pragma("unroll") for (int k = 0; k < 2; ++k) dst[m][k] = *(const LAS bf16x8*)(lds + PG8_SA(b, h) + aoff + m * 2048 + k * 1024); } while (0)
#define PG8_LDB(dst, b, h) do { _Pragma("unroll") for (int n = 0; n < 2; ++n) _Pragma("unroll") for (int k = 0; k < 2; ++k) dst[n][k] = *(const LAS bf16x8*)(lds + PG8_SB(b, h) + boff + n * 2048 + k * 1024); } while (0)
#define PG8_MMA(ai, bj, At, Bt) do { __builtin_amdgcn_s_setprio(1); _Pragma("unroll") for (int m = 0; m < 4; ++m) _Pragma("unroll") for (int n = 0; n < 2; ++n) _Pragma("unroll") for (int k = 0; k < 2; ++k) \
        acc[ai][bj][m][n] = __builtin_amdgcn_mfma_f32_16x16x32_bf16(Bt[n][k], At[m][k], acc[ai][bj][m][n], 0, 0, 0); __builtin_amdgcn_s_setprio(0); } while (0)
#define PG8_WAIT_V(n) asm volatile("s_waitcnt vmcnt(" #n ")" ::: "memory")
#define PG8_WAIT_L(n) asm volatile("s_waitcnt lgkmcnt(" #n ")" ::: "memory")
#define PG8_BAR __builtin_amdgcn_s_barrier()
#define PG8_SCHED __builtin_amdgcn_sched_barrier(0)
    Unit cur, nxt; int ui = 0;
    if (!S.next(0, cur)) return;
    f32x4 acc[2][2][4][2];
#pragma unroll
    for (int a = 0; a < 2; ++a)
#pragma unroll
        for (int b = 0; b < 2; ++b)
#pragma unroll
            for (int m = 0; m < 4; ++m)
#pragma unroll
                for (int n = 0; n < 2; ++n) acc[a][b][m][n] = (f32x4){0.f, 0.f, 0.f, 0.f};
    bf16x8 At[4][2], B0[2][2], B1[2][2];
    const char* cA = (const char*)g.A + (size_t)cur.pm * tstep; if constexpr (HM) cA += (size_t)S.half * hstep;
    const char* cB = (const char*)g.Bt + (size_t)cur.pn * tstep;
    S.a_ready(cur);
    if constexpr (SP2) {
        PG8_STAGE(PG8_SB(0, 0), cB, voffB); PG8_STAGE(PG8_SB(0, 1), cB + hstep, voffB); PG8_STAGE(PG8_SA(0, 0), cA, voffA); PG8_STAGE(PG8_SA(0, 1), cA + ahs, voffA);
        if (wr == 1) PG8_BAR;
        PG8_WAIT_V(2); PG8_BAR;
        PG8_STAGE(PG8_SB(1, 0), cB + kstep, voffB); PG8_STAGE(PG8_SA(1, 0), cA + kstep, voffA); PG8_STAGE(PG8_SB(1, 1), cB + hstep + kstep, voffB);
        PG8_WAIT_V(6); PG8_BAR;
    } else {
        PG8_STAGE(PG8_SB(0, 0), cB, voffB); PG8_STAGE(PG8_SA(0, 0), cA, voffA); PG8_STAGE(PG8_SB(0, 1), cB + hstep, voffB); PG8_STAGE(PG8_SA(0, 1), cA + hstep, voffA);
        if (wr == 1) PG8_BAR;
        PG8_WAIT_V(4); PG8_BAR;
        PG8_STAGE(PG8_SB(1, 0), cB + kstep, voffB); PG8_STAGE(PG8_SA(1, 0), cA + kstep, voffA); PG8_STAGE(PG8_SB(1, 1), cB + hstep + kstep, voffB);
        PG8_WAIT_V(6); PG8_BAR;
    }
    for (;;) {
        const bool has_next = S.next(ui + 1, nxt);
        const char* nA = has_next ? (const char*)g.A + (size_t)nxt.pm * tstep : cA; const char* nB = has_next ? (const char*)g.Bt + (size_t)nxt.pn * tstep : cB;
        for (int t = 0; t < nt; t += 2) {
            const bool last = (t == nt - 2);
            const char* a1 = cA + (size_t)(t + 1) * kstep;
            const char* a2 = last ? nA : cA + (size_t)(t + 2) * kstep; const char* b2 = last ? nB : cB + (size_t)(t + 2) * kstep;
            const char* a3 = a2 + kstep; const char* b3 = b2 + kstep;
            if (last && has_next) S.a_ready(nxt);
            if constexpr (Epi::MID_T > 0) { if (t == Epi::MID_T) { const int l2 = lane_id_volatile(); E.mid(acc, cur, wr, wc, l2 & 15, l2 >> 4); } }
            if constexpr (SP2) {
            PG8_LDB(B0, 0, 0); PG8_LDB(B1, 0, 1); PG8_SCHED; PG8_LDA(At, 0, 0); PG8_STAGE(PG8_SA(1, 1), a1 + ahs, voffA);
            PG8_WAIT_V(8); PG8_WAIT_L(0); PG8_BAR; PG8_MMA(0, 0, At, B0); PG8_MMA(0, 1, At, B1); PG8_BAR; PG8_SCHED;
            if constexpr (!HM) PG8_LDA(At, 0, 1);
            PG8_STAGE(PG8_SB(0, 0), b2, voffB); PG8_STAGE(PG8_SB(0, 1), b2 + hstep, voffB); PG8_STAGE(PG8_SA(0, 0), a2, voffA);
            PG8_WAIT_V(8); PG8_WAIT_L(0); PG8_BAR; if constexpr (!HM) { PG8_MMA(1, 0, At, B0); PG8_MMA(1, 1, At, B1); } PG8_BAR; PG8_SCHED;
            PG8_LDB(B0, 1, 0); PG8_LDB(B1, 1, 1); PG8_SCHED; PG8_LDA(At, 1, 0); PG8_STAGE(PG8_SA(0, 1), a2 + ahs, voffA);
            PG8_WAIT_V(8); PG8_WAIT_L(0); PG8_BAR; PG8_MMA(0, 0, At, B0); PG8_MMA(0, 1, At, B1); PG8_BAR; PG8_SCHED;
            if constexpr (!HM) PG8_LDA(At, 1, 1);
            PG8_STAGE(PG8_SB(1, 0), b3, voffB); PG8_STAGE(PG8_SB(1, 1), b3 + hstep, voffB); PG8_STAGE(PG8_SA(1, 0), a3, voffA);
            PG8_WAIT_V(8); PG8_WAIT_L(0); PG8_BAR; if constexpr (!HM) { PG8_MMA(1, 0, At, B0); PG8_MMA(1, 1, At, B1); } PG8_BAR; PG8_SCHED;
            } else {
            PG8_LDB(B0, 0, 0); PG8_SCHED; PG8_LDA(At, 0, 0); PG8_STAGE(PG8_SA(1, 1), a1 + hstep, voffA);
            PG8_WAIT_L(8); PG8_BAR; PG8_WAIT_L(0); PG8_MMA(0, 0, At, B0); PG8_BAR; PG8_SCHED;
            PG8_LDB(B1, 0, 1); PG8_STAGE(PG8_SB(0, 0), b2, voffB);
            PG8_BAR; PG8_WAIT_L(0); PG8_MMA(0, 1, At, B1); PG8_BAR;
            PG8_LDA(At, 0, 1); PG8_STAGE(PG8_SA(0, 0), a2, voffA);
            PG8_BAR; PG8_WAIT_L(0); PG8_MMA(1, 0, At, B0); PG8_BAR; PG8_SCHED;
            PG8_STAGE(PG8_SB(0, 1), b2 + hstep, voffB);
            PG8_WAIT_V(6); PG8_BAR; PG8_MMA(1, 1, At, B1); PG8_BAR;
            PG8_LDB(B0, 1, 0); PG8_SCHED; PG8_LDA(At, 1, 0); PG8_STAGE(PG8_SA(0, 1), a2 + hstep, voffA);
            PG8_WAIT_L(8); PG8_BAR; PG8_WAIT_L(0); PG8_MMA(0, 0, At, B0); PG8_BAR; PG8_SCHED;
            PG8_LDB(B1, 1, 1); PG8_STAGE(PG8_SB(1, 0), b3, voffB);
            PG8_BAR; PG8_WAIT_L(0); PG8_MMA(0, 1, At, B1); PG8_BAR;
            PG8_LDA(At, 1, 1); PG8_STAGE(PG8_SA(1, 0), a3, voffA);
            PG8_BAR; PG8_WAIT_L(0); PG8_MMA(1, 0, At, B0); PG8_BAR; PG8_SCHED;
            PG8_STAGE(PG8_SB(1, 1), b3 + hstep, voffB);
            PG8_WAIT_V(6); PG8_BAR; PG8_MMA(1, 1, At, B1); PG8_BAR;
            }
        }
        if constexpr (ALIGN_EPI) { if (wr == 0) PG8_BAR; }
        { const int l2 = lane_id_volatile(); E(acc, cur, wr, wc, l2 & 15, l2 >> 4); }
        if (!has_next) break;
#pragma unroll
        for (int a = 0; a < 2; ++a)
#pragma unroll
            for (int b = 0; b < 2; ++b)
#pragma unroll
                for (int m = 0; m < 4; ++m)
#pragma unroll
                    for (int n = 0; n < 2; ++n) acc[a][b][m][n] = (f32x4){0.f, 0.f, 0.f, 0.f};
        cur = nxt; cA = nA; cB = nB; ++ui;
        if constexpr (ALIGN_EPI) { if (wr == 1) PG8_BAR; }
    }
    PG8_WAIT_V(0);
    if constexpr (!ALIGN_EPI) { if (wr == 0) PG8_BAR; }
    PG8_BAR;
#undef PG8_SA
#undef PG8_SB
#undef PG8_STAGE
#undef PG8_LDA
#undef PG8_LDB
#undef PG8_MMA
#undef PG8_WAIT_V
#undef PG8_WAIT_L
#undef PG8_BAR
#undef PG8_SCHED
}
}

__device__ __forceinline__ float bf2f(unsigned h) { return __uint_as_float(h << 16); }
__device__ __forceinline__ unsigned f2bf(float f) { unsigned u = __float_as_uint(f); return (u + 0x7fffu + ((u >> 16) & 1u)) >> 16; }
__device__ __forceinline__ unsigned pk2(float lo, float hi) { return f2bf(lo) | (f2bf(hi) << 16); }
__device__ __forceinline__ float fast_rcp(float x) { return __builtin_amdgcn_rcpf(x); }
__device__ __forceinline__ float sigmoidf_(float x) { return fast_rcp(1.0f + __expf(-x)); }
__device__ __forceinline__ float siluf_(float x) { return x * sigmoidf_(x); }
__device__ __forceinline__ float shfl_xor_l(float v, int lane, int mask) { return __int_as_float(__builtin_amdgcn_ds_bpermute((lane ^ mask) << 2, __float_as_int(v))); }
__device__ __forceinline__ float wave_sum(float v, int lane) {
#pragma unroll
    for (int o = 1; o < 64; o <<= 1) v += shfl_xor_l(v, lane, o);
    return v;
}
__device__ __forceinline__ float rstd_from_partials(const float* ssq, int row, float invn) {
    const f32x4* p = (const f32x4*)(ssq + (size_t)row * 16);
    const f32x4 a = p[0], b = p[1], c = p[2], d = p[3];
    const f32x4 s = (a + b) + (c + d);
    return rsqrtf(((s[0] + s[1]) + (s[2] + s[3])) * invn + EPS);
}
constexpr int RSTD_TAB_OFF = 132096;
__device__ __forceinline__ void rstd_table(const float* ssq, int pm, LAS float* tab, int wr, int wc, int fr, int fq) {
    const int t = (wr * 4 + wc) * 64 + fq * 16 + fr;
    if (t < 256) { const GAS f32x4* p = (const GAS f32x4*)((const GAS float*)ssq + (size_t)(pm * 256 + t) * 16);
        const f32x4 a = p[0], b = p[1], c = p[2], d = p[3]; const f32x4 sm = (a + b) + (c + d);
        tab[t] = rsqrtf(((sm[0] + sm[1]) + (sm[2] + sm[3])) * (1.0f / D) + EPS); }
    asm volatile("s_waitcnt lgkmcnt(0)" ::: "memory"); __builtin_amdgcn_s_barrier(); asm volatile("" ::: "memory");
}
__device__ __forceinline__ u32x4 pack8(const f32x4 v0, const f32x4 v1) {
    u32x4 w; w.x = pg8::cvt_pk_bf16(v0[0], v0[1]); w.y = pg8::cvt_pk_bf16(v0[2], v0[3]); w.z = pg8::cvt_pk_bf16(v1[0], v1[1]); w.w = pg8::cvt_pk_bf16(v1[2], v1[3]); return w;
}

#define DPP_SHR(x, n) __int_as_float(__builtin_amdgcn_update_dpp(0, __float_as_int(x), 0x110 + (n), 0xf, 0xf, false))
__device__ __forceinline__ float rowscan16(float x) {
    x += DPP_SHR(x, 1); x += DPP_SHR(x, 2); x += DPP_SHR(x, 4); x += DPP_SHR(x, 8); return x;
}
__device__ __forceinline__ float bcast15(float x, int lane) { return __int_as_float(__builtin_amdgcn_ds_bpermute((lane | 15) << 2, __float_as_int(x))); }
__device__ __forceinline__ float expc(float x) { return __expf(fminf(x, 80.0f)); }
using pg8::Unit;
struct EpiPlain {
    static constexpr bool PERM = true; static constexpr int MID_T = 0;
    bf16_t* O; int ldc;
    __device__ __forceinline__ void operator()(const f32x4 (&acc)[2][2][4][2], const Unit& u, int wr, int wc, int fr, int fq) const {
        const int row0 = u.pm * 256 + wr * 64 + fr, col0 = u.pn * 256 + wc * 32 + 8 * fq;
#pragma unroll
        for (int ai = 0; ai < 2; ++ai)
#pragma unroll
            for (int m = 0; m < 4; ++m) { bf16_t* rowp = O + (size_t)(row0 + ai * 128 + m * 16) * ldc + col0;
#pragma unroll
                for (int bj = 0; bj < 2; ++bj) *(GAS u32x4*)((GAS bf16_t*)rowp + bj * 128) = pack8(acc[ai][bj][m][0], acc[ai][bj][m][1]); }
    }
};
struct EpiIn {
    static constexpr bool PERM = true; static constexpr int MID_T = 0;
    bf16_t* Z; bf16_t* KST; float* AUX; const float* ssq; const float* lb; const float* cosT; const float* sinT; int is_ret; LAS float* tab;
    __device__ __forceinline__ void operator()(const f32x4 (&acc)[2][2][4][2], const Unit& u, int wr, int wc, int fr, int fq) const {
        const int row0 = u.pm * 256 + wr * 64 + fr, jl = wc * 32 + 8 * fq, t = u.pn;
        rstd_table(ssq, u.pm, tab, wr, wc, fr, fq);
        const LAS float* tl = tab + wr * 64 + fr;
        if (t < 6) {
            if (!is_ret) {
                const f32x4 lb0 = *(const GAS f32x4*)((const GAS float*)lb + t * 128 + (jl >> 1)), lb1 = *(const GAS f32x4*)((const GAS float*)lb + t * 128 + (jl >> 1) + 64);
#pragma unroll
                for (int ai = 0; ai < 2; ++ai)
#pragma unroll
                    for (int mp = 0; mp < 2; ++mp) {
                        const int tok0 = u.pm * 256 + ai * 128 + wr * 64 + mp * 32, rlo = tok0 + fr, rhi = rlo + 16;
                        const float rs0 = tl[ai * 128 + mp * 32], rs1 = tl[ai * 128 + mp * 32 + 16];
                        f32x4 qsv[2][2], ksv[2][2], ktv[2][2], erv[2], dcv[2];
#pragma unroll
                        for (int n = 0; n < 2; ++n)
#pragma unroll
                            for (int i = 0; i < 4; ++i) {
                                const float lbv = n ? lb1[i] : lb0[i];
                                float g[2], kk[2], qq[2];
#pragma unroll
                                for (int e = 0; e < 2; ++e) {
                                    const float x = acc[ai][1][2 * mp + e][n][i] * (e ? rs1 : rs0), za = acc[ai][0][2 * mp + e][n][i] * (e ? rs1 : rs0);
                                    const float a = __expf(-fabsf(x)), r = fast_rcp(1.0f + a);
                                    const float sneg = x >= 0.f ? a * r : r;
                                    const float em = x >= 0.f ? a : fminf(fast_rcp(a), 1.0686475e13f);
                                    g[e] = (fminf(x, 0.f) - __logf(1.0f + a)) + __logf(1.0f + lbv * em);
                                    kk[e] = (1.0f - lbv) * sneg;
                                    qq[e] = siluf_(za);
                                }
                                const float blo = rowscan16(g[0]), ref = bcast15(blo, fq * 16 + fr), bhi = ref + rowscan16(g[1]), blast = bcast15(bhi, fq * 16 + fr);
                                qsv[0][n][i] = qq[0] * expc(blo - ref); qsv[1][n][i] = qq[1] * expc(bhi - ref);
                                ksv[0][n][i] = kk[0] * expc(ref - blo); ksv[1][n][i] = kk[1] * expc(ref - bhi);
                                ktv[0][n][i] = kk[0] * __expf(blast - blo); ktv[1][n][i] = kk[1] * __expf(blast - bhi);
                                erv[n][i] = __expf(ref); dcv[n][i] = __expf(blast);
                            }
                        GAS bf16_t* zlo = (GAS bf16_t*)Z + (size_t)rlo * NIN + t * 256 + jl; GAS bf16_t* zhi = (GAS bf16_t*)Z + (size_t)rhi * NIN + t * 256 + jl;
                        *(GAS u32x4*)zlo = pack8(qsv[0][0], qsv[0][1]); *(GAS u32x4*)(zlo + 128) = pack8(ksv[0][0], ksv[0][1]);
                        *(GAS u32x4*)zhi = pack8(qsv[1][0], qsv[1][1]); *(GAS u32x4*)(zhi + 128) = pack8(ksv[1][0], ksv[1][1]);
                        *(GAS u32x4*)((GAS bf16_t*)KST + (size_t)rlo * MIXW + t * 128 + jl) = pack8(ktv[0][0], ktv[0][1]);
                        *(GAS u32x4*)((GAS bf16_t*)KST + (size_t)rhi * MIXW + t * 128 + jl) = pack8(ktv[1][0], ktv[1][1]);
                        if (fr == 15) { GAS float* ap = (GAS float*)AUX + ((size_t)((tok0 >> 11) * NH + t) * 64 + ((tok0 & 2047) >> 5)) * 256 + jl;
                            *(GAS f32x4*)ap = erv[0]; *(GAS f32x4*)(ap + 4) = erv[1]; *(GAS f32x4*)(ap + 128) = dcv[0]; *(GAS f32x4*)(ap + 132) = dcv[1]; }
                    }
            } else {
                const float lg = __log2f(1.0f - exp2f(-5.0f - (float)t));
#pragma unroll
                for (int ai = 0; ai < 2; ++ai)
#pragma unroll
                    for (int m = 0; m < 4; ++m) { const int row = row0 + ai * 128 + m * 16; const float rs = tl[ai * 128 + m * 16];
                        const f32x4 cs = *(const GAS f32x4*)((const GAS float*)cosT + (size_t)row * 64 + (jl >> 1)), sn = *(const GAS f32x4*)((const GAS float*)sinT + (size_t)row * 64 + (jl >> 1));
                        const float cp1 = (float)(16 * (m & 1) + fr + 1), pw = exp2f(cp1 * lg), ipw = exp2f(-cp1 * lg);
                        const float qsc = rs * pw, ksc = rs * 0.08838834764831845f * ipw;
                        f32x4 q0, q1, k0, k1;
#pragma unroll
                        for (int i = 0; i < 4; ++i) {
                            const float a1 = acc[ai][0][m][0][i] * qsc, a2 = acc[ai][0][m][1][i] * qsc; q0[i] = a1 * cs[i] - a2 * sn[i]; q1[i] = a1 * sn[i] + a2 * cs[i];
                            const float b1 = acc[ai][1][m][0][i] * ksc, b2 = acc[ai][1][m][1][i] * ksc; k0[i] = b1 * cs[i] - b2 * sn[i]; k1[i] = b1 * sn[i] + b2 * cs[i];
                        }
                        GAS bf16_t* zp = (GAS bf16_t*)Z + (size_t)row * NIN + t * 256 + jl; *(GAS u32x4*)zp = pack8(q0, q1); *(GAS u32x4*)(zp + 128) = pack8(k0, k1); }
            }
        } else {
            const int mode = (t >= 9 && t < 12) ? (is_ret ? 2 : 1) : 0;
#pragma unroll
            for (int ai = 0; ai < 2; ++ai)
#pragma unroll
                for (int m = 0; m < 4; ++m) { const int row = row0 + ai * 128 + m * 16; const float rs = tl[ai * 128 + m * 16];
                    GAS bf16_t* zp = (GAS bf16_t*)Z + (size_t)row * NIN + t * 256 + jl;
#pragma unroll
                    for (int bj = 0; bj < 2; ++bj) { f32x4 v0 = acc[ai][bj][m][0] * rs, v1 = acc[ai][bj][m][1] * rs;
                        if (mode == 1) {
#pragma unroll
                            for (int i = 0; i < 4; ++i) { v0[i] = sigmoidf_(v0[i]); v1[i] = sigmoidf_(v1[i]); } }
                        else if (mode == 2) {
#pragma unroll
                            for (int i = 0; i < 4; ++i) { v0[i] = siluf_(v0[i]); v1[i] = siluf_(v1[i]); } }
                        *(GAS u32x4*)(zp + bj * 128) = pack8(v0, v1); } }
        }
    }
};
struct EpiRes {
    static constexpr bool PERM = true; static constexpr int MID_T = 0;
    const bf16_t* xin; bf16_t* xb; float* ssq;
    __device__ __forceinline__ void operator()(const f32x4 (&acc)[2][2][4][2], const Unit& u, int wr, int wc, int fr, int fq) const {
        const int row0 = u.pm * 256 + wr * 64 + fr, col0 = u.pn * 256 + wc * 32 + 8 * fq;
#pragma unroll
        for (int ai = 0; ai < 2; ++ai)
#pragma unroll
            for (int m = 0; m < 4; ++m) { const int row = row0 + ai * 128 + m * 16; const size_t off = (size_t)row * D + col0; float s = 0.f;
#pragma unroll
                for (int bj = 0; bj < 2; ++bj) {
                    const u32x4 r = *(const GAS u32x4*)((const GAS bf16_t*)xin + off + bj * 128);
                    f32x4 v0, v1;
                    v0[0] = bf2f(r.x & 0xffffu); v0[1] = bf2f(r.x >> 16); v0[2] = bf2f(r.y & 0xffffu); v0[3] = bf2f(r.y >> 16);
                    v1[0] = bf2f(r.z & 0xffffu); v1[1] = bf2f(r.z >> 16); v1[2] = bf2f(r.w & 0xffffu); v1[3] = bf2f(r.w >> 16);
                    v0 = v0 + acc[ai][bj][m][0]; v1 = v1 + acc[ai][bj][m][1];
                    *(GAS u32x4*)((GAS bf16_t*)xb + off + bj * 128) = pack8(v0, v1);
                    s += (v0[0] * v0[0] + v0[1] * v0[1]) + (v0[2] * v0[2] + v0[3] * v0[3]) + (v1[0] * v1[0] + v1[1] * v1[1]) + (v1[2] * v1[2] + v1[3] * v1[3]);
                }
                s += shfl_xor_l(s, fq * 16 + fr, 16); s += shfl_xor_l(s, fq * 16 + fr, 32);
                if (fq == 0) ((GAS float*)ssq)[(size_t)row * 16 + u.pn * 4 + wc] = s; }
    }
};
struct EpiResC {
    static constexpr bool PERM = true; static constexpr int MID_T = 12;
    EpiRes base; const float* ssqo;
    __device__ __forceinline__ void mid(f32x4 (&acc)[2][2][4][2], const Unit& u, int wr, int wc, int fr, int fq) const {
        if (!ssqo) return;
        const int row0 = u.pm * 256 + wr * 64 + fr;
#pragma unroll
        for (int ai = 0; ai < 2; ++ai)
#pragma unroll
            for (int m = 0; m < 4; ++m) { const int row = row0 + ai * 128 + m * 16;
                const GAS f32x4* sp = (const GAS f32x4*)((const GAS float*)ssqo + (size_t)row * 16); float tot = 0.f;
#pragma unroll
                for (int q4 = 0; q4 < (NH * NVS + 3) / 4; ++q4) { const f32x4 a = sp[q4];
#pragma unroll
                    for (int e = 0; e < 4; ++e) if (4 * q4 + e < NH * NVS) tot += a[e]; }
                const float rs = rsqrtf(tot * (1.0f / MIXW) + EPS);
#pragma unroll
                for (int bj = 0; bj < 2; ++bj)
#pragma unroll
                    for (int n = 0; n < 2; ++n) acc[ai][bj][m][n] = acc[ai][bj][m][n] * rs;
                asm volatile("" ::: "memory"); }
    }
    __device__ __forceinline__ void operator()(const f32x4 (&acc)[2][2][4][2], const Unit& u, int wr, int wc, int fr, int fq) const { base(acc, u, wr, wc, fr, fq); }
};
struct EpiFfn {
    static constexpr bool PERM = true; static constexpr int MID_T = 0;
    bf16_t* act; const float* ssq; LAS float* tab; int half;
    __device__ __forceinline__ void operator()(const f32x4 (&acc)[2][2][4][2], const Unit& u, int wr, int wc, int fr, int fq) const {
        const int hb = half < 0 ? 0 : 128 * half;
        const int row0 = u.pm * 256 + hb + wr * 64 + fr, jl = wc * 32 + 8 * fq;
        rstd_table(ssq, u.pm, tab, wr, wc, fr, fq);
        const LAS float* tl = tab + hb + wr * 64 + fr;
#pragma unroll
        for (int ai = 0; ai < 2; ++ai)
#pragma unroll
            for (int m = 0; m < 4; ++m) { if (ai == 1 && half >= 0) break; const int row = row0 + ai * 128 + m * 16; const float rs = tl[ai * 128 + m * 16];
                f32x4 v0, v1;
#pragma unroll
                for (int i = 0; i < 4; ++i) { v0[i] = siluf_(acc[ai][0][m][0][i] * rs) * (acc[ai][1][m][0][i] * rs); v1[i] = siluf_(acc[ai][0][m][1][i] * rs) * (acc[ai][1][m][1][i] * rs); }
                *(GAS u32x4*)((GAS bf16_t*)act + (size_t)row * DFF + u.pn * 128 + jl) = pack8(v0, v1); }
    }
};

#define XB_TMO      128
#define XB_XCNT(j)  (256  + 64 * (j))
#define XB_XSUB(j)  (1280 + 64 * (j))
#define XB_XGEN(j)  (2304 + 64 * (j))
#define XB_TOP      3328
#define XB_TOPGEN   3392
#define XCD_BAR_WORDS 3456
#define XB_SPIN_CAP (1u << 18)
__device__ __forceinline__ unsigned xb_ld(unsigned* p)              { return __hip_atomic_load(p, __ATOMIC_RELAXED, __HIP_MEMORY_SCOPE_AGENT); }
__device__ __forceinline__ unsigned xb_add(unsigned* p, unsigned v) { return __hip_atomic_fetch_add(p, v, __ATOMIC_RELAXED, __HIP_MEMORY_SCOPE_AGENT); }
__device__ __forceinline__ unsigned xb_xcc_id() { return (unsigned)__builtin_amdgcn_s_getreg((3 << 11) | 20) & 0xFu; }
#define XB_SPIN(cond, bar) do { unsigned _sp = 0; while (cond) { __builtin_amdgcn_s_sleep(1); \
    if ((++_sp & 255u) == 0u) { if (xb_ld(&(bar)[XB_TMO])) break; if (_sp > XB_SPIN_CAP) { atomicAdd(&(bar)[XB_TMO], 1u); break; } } } } while (0)
struct XcdBarrier { unsigned* bar; unsigned x; volatile LAS unsigned* st; };
__device__ __forceinline__ XcdBarrier xcd_barrier_post(unsigned* bar, volatile LAS unsigned* st) {
    XcdBarrier b; b.bar = bar; b.x = xb_xcc_id(); b.st = st;
    if (threadIdx.x == 0) st[2] = xb_add(&bar[XB_XCNT(b.x)], 1u);
    return b;
}
#define XB_LOC(j) (3456 + 64 * (j))
__device__ __forceinline__ void xcc_barrier(const XcdBarrier& b, unsigned n, bool leader) {
    asm volatile("s_waitcnt vmcnt(0)" ::: "memory");
    __syncthreads();
    if (leader) {
        unsigned* bar = b.bar; unsigned* cnt = &bar[XB_LOC(b.x)];
        __builtin_amdgcn_s_waitcnt(0);
        const unsigned old = xb_add(cnt, 1u), target = (old / n + 1u) * n;
        XB_SPIN(xb_ld(cnt) < target, bar);
        __builtin_amdgcn_fence(__ATOMIC_ACQUIRE, "agent");
        asm volatile("s_waitcnt vmcnt(0)" ::: "memory");
    }
    __syncthreads();
}
#define XB_CVX(k, j) (4608 + 64 * (16 * (k) + (j)))
#define XB_CVG(k)    (6656 + 64 * (k))
__device__ __forceinline__ void cv_signal(const XcdBarrier& b, int k, unsigned nconv, bool leader) {
    asm volatile("s_waitcnt vmcnt(0)" ::: "memory");
    __syncthreads();
    if (leader) {
        __builtin_amdgcn_s_waitcnt(0);
        if (xb_add(&b.bar[XB_CVX(k, b.x)], 1u) + 1u == nconv) {
            __builtin_amdgcn_fence(__ATOMIC_RELEASE, "agent");
            asm volatile("s_waitcnt vmcnt(0)" ::: "memory");
            xb_add(&b.bar[XB_CVG(k)], 1u);
        }
    }
}
__device__ __forceinline__ void cv_wait(const XcdBarrier& b, int k, unsigned nx, bool leader) {
    if (leader) {
        unsigned* bar = b.bar;
        XB_SPIN(xb_ld(&bar[XB_CVG(k)]) < nx, bar);
        __builtin_amdgcn_fence(__ATOMIC_ACQUIRE, "agent");
        asm volatile("s_waitcnt vmcnt(0)" ::: "memory");
    }
    __syncthreads();
}
__device__ __forceinline__ void xcd_barrier_complete(unsigned* bar, unsigned x, unsigned& nloc, unsigned& nx) {
    const unsigned G = gridDim.x * gridDim.y * gridDim.z;
    unsigned sum, cnt, mine, sp = 0u;
    for (;;) {
        sum = 0u; cnt = 0u; mine = 0u;
#pragma unroll
        for (unsigned j = 0; j < 16; ++j) { const unsigned c = xb_ld(&bar[XB_XCNT(j)]); sum += c; cnt += (c > 0u) ? 1u : 0u; mine = (j == x) ? c : mine; }
        if (sum == G) break;
        __builtin_amdgcn_s_sleep(1);
        if ((++sp & 255u) == 0u) { if (xb_ld(&bar[XB_TMO])) break; if (sp > XB_SPIN_CAP) { atomicAdd(&bar[XB_TMO], 1u); break; } }
    }
    nloc = mine > 0u ? mine : 1u; nx = cnt > 0u ? cnt : 1u;
}
__device__ __forceinline__ void xcd_barrier(const XcdBarrier& b, bool leader) {
    asm volatile("s_waitcnt vmcnt(0)" ::: "memory");
    __syncthreads();
    if (leader) {
        unsigned* bar = b.bar;
        __builtin_amdgcn_s_waitcnt(0);
        unsigned nloc = b.st[0], nx = b.st[1];
        if (nloc == 0u) { xcd_barrier_complete(bar, b.x, nloc, nx); b.st[0] = nloc; b.st[1] = nx; }
        const unsigned old = xb_add(&bar[XB_XSUB(b.x)], 1u);
        const unsigned gen = old / nloc;
        if (old + 1u == (gen + 1u) * nloc) {
            __builtin_amdgcn_fence(__ATOMIC_RELEASE, "agent");
            asm volatile("s_waitcnt vmcnt(0)" ::: "memory");
            const unsigned og = xb_add(&bar[XB_TOP], 1u);
            const unsigned tg = og / nx;
            if (og + 1u == (tg + 1u) * nx) xb_add(&bar[XB_TOPGEN], 1u);
            else XB_SPIN(xb_ld(&bar[XB_TOPGEN]) == tg, bar);
            __builtin_amdgcn_fence(__ATOMIC_ACQUIRE, "agent");
            xb_add(&bar[XB_XGEN(b.x)], 1u);
            asm volatile("s_waitcnt vmcnt(0)" ::: "memory");
        } else {
            XB_SPIN(xb_ld(&bar[XB_XGEN(b.x)]) == gen, bar);
            __builtin_amdgcn_fence(__ATOMIC_ACQUIRE, "agent");
            asm volatile("s_waitcnt vmcnt(0)" ::: "memory");
        }
    }
    __syncthreads();
}

constexpr int RING_BYTES = 131072, LDSCTL_OFF = RING_BYTES, MISC_OFF = LDSCTL_OFF + 320, LDS_BYTES = 147456;
constexpr int NWAVES = 8;

__device__ __forceinline__ int misc_rd(LAS unsigned char* lds, int idx) { unsigned off = (unsigned)(MISC_OFF + 4 * idx); asm volatile("" : "+v"(off)); return __builtin_amdgcn_readfirstlane((int)*(volatile LAS unsigned*)(lds + off)); }
struct Args { const float* in[15]; float* out; unsigned char* ws; int ph_lo, ph_hi; };

__device__ __forceinline__ int win_srccol(int j) {
    const int t = j >> 8;
    if (t >= 6) return j;
    const int jj = j & 255, half = jj >> 7, p = jj & 127, d = 4 * (p >> 3) + (p & 3) + 64 * ((p >> 2) & 1);
    return half * MIXW + t * 128 + d;
}
__device__ __forceinline__ int wfi_srccol(int j) { const int t = j >> 8, jj = j & 255; return (jj < 128 ? 0 : DFF) + t * 128 + (jj & 127); }
struct TItem { const GAS float* W; GAS bf16_t* WT; const GAS float* kscale; int K, N, ndst, kind, nscale, item; };
__device__ __forceinline__ TItem titem_decode(const Args& a, unsigned char* ws, int it) {
    constexpr int I0 = 16 * (NIN / 32), I1 = 16 * 32, I2 = 16 * (NFI / 32), I3 = (DFF / 64) * 32, I4 = 16 * 16, IL = I0 + I1 + I2 + I3 + I4;
    const int l = it / IL; int r = it % IL; TItem t;
    if (r < I0) { t.W = (const GAS float*)a.in[4] + (size_t)l * D * NIN; t.WT = (GAS bf16_t*)(ws + WS_WIN) + (size_t)l * NIN * D; t.kscale = (const GAS float*)a.in[3] + l * D; t.K = D; t.N = NIN; t.ndst = NIN; t.kind = 0; t.nscale = D; t.item = r; return t; } r -= I0;
    if (r < I1) { t.W = (const GAS float*)a.in[5] + (size_t)l * D * D; t.WT = (GAS bf16_t*)(ws + WS_WOUT) + (size_t)l * D * D; t.kscale = (const GAS float*)((l & 1) ? a.in[10] : a.in[9]) + (l >> 1) * MIXW; t.K = D; t.N = D; t.ndst = D; t.kind = 1; t.nscale = MIXW; t.item = r; return t; } r -= I1;
    if (r < I2) { t.W = (const GAS float*)a.in[12] + (size_t)l * D * NFI; t.WT = (GAS bf16_t*)(ws + WS_WFI) + (size_t)l * NFI * D; t.kscale = (const GAS float*)a.in[11] + l * D; t.K = D; t.N = NFI; t.ndst = NFI; t.kind = 2; t.nscale = D; t.item = r; return t; } r -= I2;
    if (r < I3) { t.W = (const GAS float*)a.in[13] + (size_t)l * DFF * D; t.WT = (GAS bf16_t*)(ws + WS_WFO) + (size_t)l * D * DFF; t.kscale = (const GAS float*)a.in[13]; t.K = DFF; t.N = D; t.ndst = D; t.kind = 3; t.nscale = 0; t.item = r; return t; } r -= I3;
    t.W = (const GAS float*)a.in[7] + (size_t)l * D * 512; t.WT = (GAS bf16_t*)(ws + WS_WM) + (size_t)l * 512 * D; t.kscale = (const GAS float*)a.in[6] + l * D; t.K = D; t.N = 512; t.ndst = 512; t.kind = 4; t.nscale = D; t.item = r; return t;
}
__device__ __forceinline__ void titem_load(const TItem& t, f32x4 (&v)[8], int lane) {
    const int nblk = t.ndst / 32, kb = t.item / nblk, nb = t.item % nblk, k0 = 64 * kb, n0 = 32 * nb, kq = lane >> 3, jd = n0 + 4 * (lane & 7);
    const int sc = t.kind == 0 ? win_srccol(jd) : (t.kind == 2 ? wfi_srccol(jd) : jd);
#pragma unroll
    for (int i = 0; i < 8; ++i) v[i] = *(const GAS f32x4*)(t.W + (size_t)(k0 + 8 * i + kq) * t.N + sc);
}
__device__ __forceinline__ void titem_store(const TItem& t, const f32x4 (&v)[8], LAS float* scr, int lane) {
    const int nblk = t.ndst / 32, kb = t.item / nblk, nb = t.item % nblk, k0 = 64 * kb, n0 = 32 * nb, kq = lane >> 3, nq = lane & 7;
#pragma unroll
    for (int i = 0; i < 8; ++i)
#pragma unroll
        for (int e = 0; e < 4; ++e) scr[(8 * i + kq) * 33 + 4 * nq + e] = v[i][e];
    const int c = lane & 7;
    f32x4 s0 = (f32x4){1.f, 1.f, 1.f, 1.f}, s1 = s0;
    if (k0 + 8 * c < t.nscale) { s0 = *(const GAS f32x4*)(t.kscale + k0 + 8 * c); s1 = *(const GAS f32x4*)(t.kscale + k0 + 8 * c + 4); }
    asm volatile("s_waitcnt lgkmcnt(0)" ::: "memory");
#pragma unroll
    for (int j = 0; j < 4; ++j) { const int n = (lane >> 3) + 8 * j; const LAS float* s = scr + (8 * c) * 33 + n;
        u32x4 o; o.x = pk2(s[0 * 33] * s0[0], s[1 * 33] * s0[1]); o.y = pk2(s[2 * 33] * s0[2], s[3 * 33] * s0[3]); o.z = pk2(s[4 * 33] * s1[0], s[5 * 33] * s1[1]); o.w = pk2(s[6 * 33] * s1[2], s[7 * 33] * s1[3]);
        *(GAS u32x4*)(t.WT + (size_t)(n0 + n) * t.K + k0 + 8 * c) = o; }
    asm volatile("s_waitcnt lgkmcnt(0)" ::: "memory");
}

constexpr int TITEMS_PER_LAYER = 16 * (NIN / 32) + 16 * 32 + 16 * (NFI / 32) + (DFF / 64) * 32 + 16 * 16;
__device__ __forceinline__ void convert_weights(const Args& a, unsigned char* ws, LAS float* scr, int it0, int it1, int w, int nw, int lane, int off = 0, int mul = 1) {
    f32x4 va[8], vb[8];
    nw *= mul;
    int it = it0 + off + mul * w;
    if (it < it1) { const TItem t = titem_decode(a, ws, it); titem_load(t, va, lane); }
    while (it < it1) {
        const int itn = it + nw;
        if (itn < it1) { const TItem t = titem_decode(a, ws, itn); titem_load(t, vb, lane); }
        { const TItem t = titem_decode(a, ws, it); titem_store(t, va, scr, lane); }
        it = itn;
        if (it >= it1) break;
        const int itn2 = it + nw;
        if (itn2 < it1) { const TItem t = titem_decode(a, ws, itn2); titem_load(t, va, lane); }
        { const TItem t = titem_decode(a, ws, it); titem_store(t, vb, scr, lane); }
        it = itn2;
    }
}

__device__ __forceinline__ void p0_prologue(const Args& a, unsigned char* ws, LAS unsigned char* lds, int gw, int NGW, int wave, int lane) {
    LAS float* scr = (LAS float*)(lds + wave * 16384);
    convert_weights(a, ws, scr, 0, 16 * (NIN / 32), gw, NGW, lane);
    for (int l = 0; l < DEPTH; ++l) convert_weights(a, ws, scr, l * TITEMS_PER_LAYER + TITEMS_PER_LAYER - 256, (l + 1) * TITEMS_PER_LAYER, gw, NGW, lane);
    for (int m = gw; m < M; m += NGW) {
        const f32x4* xr = (const f32x4*)(a.in[0] + (size_t)m * D) + lane; f32x4 v[4]; float s = 0.f;
#pragma unroll
        for (int j = 0; j < 4; ++j) { v[j] = xr[64 * j]; s += (v[j].x * v[j].x + v[j].y * v[j].y) + (v[j].z * v[j].z + v[j].w * v[j].w); }
        s = wave_sum(s, lane);
        u32x2* o8 = (u32x2*)((bf16_t*)(ws + WS_XB) + (size_t)m * D) + lane;
#pragma unroll
        for (int j = 0; j < 4; ++j) { u32x2 w; w.x = pk2(v[j].x, v[j].y); w.y = pk2(v[j].z, v[j].w); o8[64 * j] = w; }
        if (lane < 16) ((float*)(ws + WS_SSQA))[(size_t)m * 16 + lane] = lane == 0 ? s : 0.f;
    }
    for (int m = gw; m < MROWS; m += NGW) {
        const f32x4* xr = (const f32x4*)(a.in[1] + (size_t)m * D) + lane; f32x4 v[4]; float s = 0.f;
#pragma unroll
        for (int j = 0; j < 4; ++j) { v[j] = xr[64 * j]; s += (v[j].x * v[j].x + v[j].y * v[j].y) + (v[j].z * v[j].z + v[j].w * v[j].w); }
        const float rs = rsqrtf(wave_sum(s, lane) * (1.0f / D) + EPS);
        u32x2* o8 = (u32x2*)((bf16_t*)(ws + WS_MEMB) + (size_t)m * D) + lane;
#pragma unroll
        for (int j = 0; j < 4; ++j) { u32x2 w; w.x = pk2(v[j].x * rs, v[j].y * rs); w.y = pk2(v[j].z * rs, v[j].w * rs); o8[64 * j] = w; }
    }
    {   const double invf = exp(-9.210340371976184 * ((double)lane / 63.0));
        for (int m = gw; m < M; m += NGW) {
            const double ang = (double)((const GAS int*)a.in[2])[m] * invf;
            const double kr = rint(ang * 0.15915494309189535);
            const float r = (float)fma(-kr, 1.2246467991473532e-16 * 2.0, fma(-kr, 6.283185307179586, ang));
            float sn, cs; sincosf(r, &sn, &cs);
            ((GAS float*)(ws + WS_COS))[(size_t)m * 64 + lane] = cs;
            ((GAS float*)(ws + WS_SIN))[(size_t)m * 64 + lane] = sn;
        }
    }
    for (int c = gw * 64 + lane; c < MIXW; c += NGW * 64) {
        const float l0 = a.in[8][c], l1 = a.in[8][MIXW + c]; const float mx = fmaxf(l0, l1), e0 = expf(l0 - mx), e1 = expf(l1 - mx);
        ((float*)(ws + WS_LB))[c] = 0.f; ((float*)(ws + WS_LB))[MIXW + c] = e1 / (e0 + e1);
    }
}

typedef float f32x16 __attribute__((ext_vector_type(16)));
constexpr int SC_QS = 0, SC_KS = 8704, SC_KST = 17408, SC_V = 27648, SC_P = 37888, SC_AUX = 40448, SC_OUT = 41472, SC_SSQ = 50176, SC_GATE = 50688, SC_BUF = 50688 + 32 * VPR * 16;
constexpr int PQ = 272, PT = 320;
constexpr int NCHUNK = SEQ / 32;
typedef const GAS bf16_t* gbf;
struct HRegs { u32x4 x0[8], x1[8]; float aux[2]; };
__device__ __forceinline__ bf16x8 as_bf16x8(u32x4 v) { return __builtin_bit_cast(bf16x8, v); }

struct StLane { unsigned g0, g1, gg, ga, l0, l1, lg, la, sk; };
template <int IS_RET>
__device__ __forceinline__ void stager_load(HRegs& R, gbf Z, gbf KST, const GAS float* AUXG, int b, int h, int unit, int sw, const StLane& L, int chunk) {
    chunk = chunk < NCHUNK ? chunk : NCHUNK - 1;
    const size_t tok0 = (size_t)b * SEQ + chunk * 32;
    const int p0 = (sw == 0 || IS_RET) ? NIN : MIXW;
    const GAS char* s0 = (const GAS char*)(sw == 0 ? Z + h * 256 : (IS_RET ? Z + h * 256 + 128 : KST + h * 128)) + tok0 * p0 * 2;
    const GAS char* s1 = (const GAS char*)(sw == 0 ? Z + h * 256 + 128 : Z + 1536 + h * 128) + tok0 * NIN * 2;
#pragma unroll
    for (int i = 0; i < 8; ++i) R.x0[i] = *(const GAS u32x4*)(s0 + (size_t)(4 * i) * p0 * 2 + L.g0);
    if (sw == 0) {
#pragma unroll
        for (int i = 0; i < 8; ++i) R.x1[i] = *(const GAS u32x4*)(s1 + 32 * i + L.g1);
    } else {
#pragma unroll
        for (int i = 0; i < 8 / NVS; ++i) R.x1[i] = *(const GAS u32x4*)(s1 + (size_t)(4 * NVS * i) * NIN * 2 + L.g1);
    }
    if (!IS_RET) { const GAS char* ag = (const GAS char*)(AUXG + ((size_t)unit * 64 + chunk) * 256 + 128 * sw); R.aux[0] = *(const GAS float*)(ag + L.ga); R.aux[1] = *(const GAS float*)(ag + 256 + L.ga); }
}
template <int IS_RET>
__device__ __forceinline__ void stager_stage(const HRegs& R, LAS unsigned char* buf, LAS unsigned char* gbuf, int sw, const StLane& L) {
    const int o0 = sw == 0 ? SC_QS : SC_KST, o1 = sw == 0 ? SC_KS : SC_V, pit = sw == 0 ? PQ : PT;
    LAS unsigned char* d0 = buf + o0 + L.l0; LAS unsigned char* d1 = buf + o1 + L.l1;
#pragma unroll
    for (int i = 0; i < 8; ++i) *(LAS u32x4*)(d0 + 4 * i * pit) = R.x0[i];
    if (sw != 0) {
#pragma unroll
        for (int i = 0; i < 8 / NVS; ++i) *(LAS u32x4*)(d1 + 4 * NVS * i * PT) = R.x1[i];
    }
    if (!IS_RET) { LAS unsigned char* al = buf + SC_AUX + 512 * sw + L.la; *(LAS float*)al = R.aux[0]; *(LAS float*)(al + 256) = R.aux[1]; }
}
__device__ __forceinline__ void scores_stage(const HRegs& R, LAS unsigned char* buf, const StLane& L, int l31, int hh) {
    f32x16 d;
#pragma unroll
    for (int r = 0; r < 16; ++r) d[r] = 0.f;
    u32x4 qf[8];
    {   const unsigned aq = (unsigned)(size_t)(buf + SC_QS) + L.sk;
        asm volatile(
            "ds_read_b128 %0, %8 offset:0\n\tds_read_b128 %1, %8 offset:32\n\tds_read_b128 %2, %8 offset:64\n\tds_read_b128 %3, %8 offset:96\n\t"
            "ds_read_b128 %4, %8 offset:128\n\tds_read_b128 %5, %8 offset:160\n\tds_read_b128 %6, %8 offset:192\n\tds_read_b128 %7, %8 offset:224\n\t"
            "s_waitcnt lgkmcnt(0)"
            : "=&v"(qf[0]), "=&v"(qf[1]), "=&v"(qf[2]), "=&v"(qf[3]), "=&v"(qf[4]), "=&v"(qf[5]), "=&v"(qf[6]), "=&v"(qf[7])
            : "v"(aq) : "memory");
        __builtin_amdgcn_sched_barrier(0);
    }
#pragma unroll
    for (int kk = 0; kk < 8; ++kk) d = __builtin_amdgcn_mfma_f32_32x32x16_bf16(as_bf16x8(R.x1[kk]), as_bf16x8(qf[kk]), d, 0, 0, 0);
#pragma unroll
    for (int q = 0; q < 4; ++q) { float v4[4];
#pragma unroll
        for (int i = 0; i < 4; ++i) { const int srow = 8 * q + 4 * hh + i; v4[i] = (srow <= l31) ? d[4 * q + i] : 0.f; }
        u32x2 w; w.x = pg8::cvt_pk_bf16(v4[0], v4[1]); w.y = pg8::cvt_pk_bf16(v4[2], v4[3]);
        *(LAS u32x2*)(buf + SC_P + l31 * 80 + (8 * q + 4 * hh) * 2) = w; }
}
struct FinLane { unsigned lo, ls, go, gs, gz; };
constexpr int FPT = 32 * VPR / 64;
template <int IS_RET>
__device__ __forceinline__ void gate_load(u32x4 (&g)[FPT], gbf Z, int b, int h, const FinLane& L, int chunk) {
    chunk = chunk < NCHUNK ? chunk : NCHUNK - 1;
    const GAS char* sg = (const GAS char*)(Z + 2304 + h * 128) + ((size_t)b * SEQ + chunk * 32) * NIN * 2;
#pragma unroll
    for (int i = 0; i < FPT; ++i) g[i] = *(const GAS u32x4*)(sg + (size_t)(64 / VPR * i) * NIN * 2 + L.gz);
}
__device__ __forceinline__ void gate_stage(const u32x4 (&g)[FPT], LAS unsigned char* buf, int lane) {
#pragma unroll
    for (int i = 0; i < FPT; ++i) *(LAS u32x4*)(buf + SC_GATE + (lane + 64 * i) * 16) = g[i];
}
template <int IS_RET>
__device__ __forceinline__ void fin_store(LAS unsigned char* buf, GAS bf16_t* CAT, GAS float* SSQO, int b, int h, int vh, const FinLane& L, int lane, bool first, int chunk) {
    const size_t tok0 = (size_t)b * SEQ + chunk * 32;
    GAS char* cg = (GAS char*)(CAT + tok0 * D + h * 128); GAS char* sgp = (GAS char*)(SSQO + tok0 * 16 + h * NVS + vh);
#pragma unroll
    for (int i = 0; i < FPT; ++i) {
        const u32x2 lo = *(const LAS u32x2*)(buf + SC_OUT + (64 / VPR) * i * PQ + L.lo), hi = *(const LAS u32x2*)(buf + SC_OUT + (64 / VPR) * i * PQ + 8 + L.lo);
        const LAS unsigned char* sq = buf + SC_SSQ + (64 / VPR) * 4 * i + L.ls;
        float ssum = *(const LAS float*)sq;
#pragma unroll
        for (int w = 1; w < 4 / NVS; ++w) ssum += *(const LAS float*)(sq + 128 * w);
        const float sc = (IS_RET && NVS == 1) ? rsqrtf(ssum * (1.0f / HD) + EPS) : 1.0f;
        const u32x4 gt = *(const LAS u32x4*)(buf + SC_GATE + (lane + 64 * i) * 16);
        const unsigned ow[4] = {lo.x, lo.y, hi.x, hi.y}; u32x4 out;
#pragma unroll
        for (int j = 0; j < 4; ++j) out[j] = pg8::cvt_pk_bf16(__uint_as_float(ow[j] << 16) * sc * __uint_as_float(gt[j] << 16), __uint_as_float(ow[j] & 0xffff0000u) * sc * __uint_as_float(gt[j] & 0xffff0000u));
        *(GAS u32x4*)(cg + (size_t)(64 / VPR * i) * D * 2 + L.go) = out;
        if ((!IS_RET || NVS > 1) && first) *(GAS float*)(sgp + (size_t)(64 / VPR * i) * 64 + L.gs) = ssum; }
}
__device__ __forceinline__ void norm_rows(unsigned char* ws, int row0, int row1, int gw, int NGW, int lane) {
    GAS bf16_t* CAT = (GAS bf16_t*)(ws + WS_CAT); const GAS float* SSQO = (const GAS float*)(ws + WS_SSQO);
    for (int row = row0 + gw; row < row1; row += NGW) {
#pragma unroll
        for (int j = 0; j < 3; ++j) { const int e = lane * 4 + 256 * j, h = e >> 7;
            float ssum = 0.f;
#pragma unroll
            for (int q = 0; q < NVS; ++q) ssum += SSQO[(size_t)row * 16 + h * NVS + q];
            const float sc = rsqrtf(ssum * (1.0f / HD) + EPS);
            GAS u32x2* p = (GAS u32x2*)(CAT + (size_t)row * D + e); const u32x2 w = *p; u32x2 o;
            o.x = pg8::cvt_pk_bf16(__uint_as_float(w.x << 16) * sc, __uint_as_float(w.x & 0xffff0000u) * sc); o.y = pg8::cvt_pk_bf16(__uint_as_float(w.y << 16) * sc, __uint_as_float(w.y & 0xffff0000u) * sc);
            *p = o; }
    }
}
#define TRR(dst, areg, off) "ds_read_b64_tr_b16 " dst ", " areg " offset:" #off "\n\t"
struct MLane { unsigned av, ak, aq, aaux, ap, aout, assq; };
template <int IS_RET, int PAR>
__device__ __forceinline__ void mfma_step(f32x16 (&S)[4], const MLane& A, int lane, float g32) {
    constexpr unsigned PB = PAR * SC_BUF;
    u32x2 v00, v01, v10, v11, k[4][2][2]; u32x4 qf[4][2];
    const unsigned av = A.av + PB, ak = A.ak + PB, aq = A.aq + PB;
    asm volatile(
        "ds_read_b128 %0, %8 offset:0\n\tds_read_b128 %1, %8 offset:32\n\tds_read_b128 %2, %8 offset:64\n\tds_read_b128 %3, %8 offset:96\n\t"
        "ds_read_b128 %4, %8 offset:128\n\tds_read_b128 %5, %8 offset:160\n\tds_read_b128 %6, %8 offset:192\n\tds_read_b128 %7, %8 offset:224"
        : "=&v"(qf[0][0]), "=&v"(qf[0][1]), "=&v"(qf[1][0]), "=&v"(qf[1][1]), "=&v"(qf[2][0]), "=&v"(qf[2][1]), "=&v"(qf[3][0]), "=&v"(qf[3][1])
        : "v"(aq) : "memory");
    asm volatile(
        TRR("%0", "%12", 0) TRR("%1", "%12", 1280) TRR("%2", "%12", 5120) TRR("%3", "%12", 6400)
        TRR("%4", "%13", 0) TRR("%5", "%13", 1280) TRR("%6", "%13", 5120) TRR("%7", "%13", 6400)
        TRR("%8", "%13", 64) TRR("%9", "%13", 1344) TRR("%10", "%13", 5184) TRR("%11", "%13", 6464)
        : "=&v"(v00), "=&v"(v01), "=&v"(v10), "=&v"(v11),
          "=&v"(k[0][0][0]), "=&v"(k[0][0][1]), "=&v"(k[0][1][0]), "=&v"(k[0][1][1]), "=&v"(k[1][0][0]), "=&v"(k[1][0][1]), "=&v"(k[1][1][0]), "=&v"(k[1][1][1])
        : "v"(av), "v"(ak) : "memory");
    const LAS unsigned char* auxp = (const LAS unsigned char*)(size_t)(A.aaux + PB);
    bf16x8 sf[4][2];
#pragma unroll
    for (int kt = 0; kt < 4; ++kt) { f32x16 t = S[kt];
        if (!IS_RET) {
#pragma unroll
            for (int q = 0; q < 4; ++q) { const f32x4 e = *(const LAS f32x4*)(auxp + (32 * kt + 16 * (q >> 1) + 4 * (q & 1)) * 4);
#pragma unroll
                for (int i = 0; i < 4; ++i) t[4 * q + i] *= e[i]; } }
#pragma unroll
        for (int s2 = 0; s2 < 2; ++s2) { u32x4 pk;
#pragma unroll
            for (int j = 0; j < 4; ++j) pk[j] = pg8::cvt_pk_bf16(t[8 * s2 + 2 * j], t[8 * s2 + 2 * j + 1]);
            sf[kt][s2] = as_bf16x8(pk); } }
    asm volatile("s_waitcnt lgkmcnt(12)" : "+v"(qf[0][0]), "+v"(qf[0][1]), "+v"(qf[1][0]), "+v"(qf[1][1]), "+v"(qf[2][0]), "+v"(qf[2][1]), "+v"(qf[3][0]), "+v"(qf[3][1]) :: "memory");
    asm volatile(
        TRR("%0", "%8", 128) TRR("%1", "%8", 1408) TRR("%2", "%8", 5248) TRR("%3", "%8", 6528)
        TRR("%4", "%8", 192) TRR("%5", "%8", 1472) TRR("%6", "%8", 5312) TRR("%7", "%8", 6592)
        : "=&v"(k[2][0][0]), "=&v"(k[2][0][1]), "=&v"(k[2][1][0]), "=&v"(k[2][1][1]), "=&v"(k[3][0][0]), "=&v"(k[3][0][1]), "=&v"(k[3][1][0]), "=&v"(k[3][1][1])
        : "v"(ak) : "memory");
    __builtin_amdgcn_sched_barrier(0);
    f32x16 o;
#pragma unroll
    for (int r = 0; r < 16; ++r) o[r] = 0.f;
#pragma unroll
    for (int kt = 0; kt < 4; ++kt)
#pragma unroll
        for (int s2 = 0; s2 < 2; ++s2) o = __builtin_amdgcn_mfma_f32_32x32x16_bf16(sf[kt][s2], as_bf16x8(qf[kt][s2]), o, 0, 0, 0);
    __builtin_amdgcn_sched_barrier(0);
    asm volatile("s_waitcnt lgkmcnt(0)" : "+v"(v00), "+v"(v01), "+v"(v10), "+v"(v11),
          "+v"(k[0][0][0]), "+v"(k[0][0][1]), "+v"(k[0][1][0]), "+v"(k[0][1][1]), "+v"(k[1][0][0]), "+v"(k[1][0][1]), "+v"(k[1][1][0]), "+v"(k[1][1][1]),
          "+v"(k[2][0][0]), "+v"(k[2][0][1]), "+v"(k[2][1][0]), "+v"(k[2][1][1]), "+v"(k[3][0][0]), "+v"(k[3][0][1]), "+v"(k[3][1][0]), "+v"(k[3][1][1]) :: "memory");
    __builtin_amdgcn_sched_barrier(0);
    const bf16x8 vt[2] = {as_bf16x8((u32x4){v00.x, v00.y, v01.x, v01.y}), as_bf16x8((u32x4){v10.x, v10.y, v11.x, v11.y})};
    const LAS unsigned char* pp = (const LAS unsigned char*)(size_t)(A.ap + PB);
#pragma unroll
    for (int kk = 0; kk < 2; ++kk) { const bf16x8 pf = *(const LAS bf16x8*)(pp + 32 * kk);
        o = __builtin_amdgcn_mfma_f32_32x32x16_bf16(vt[kk], pf, o, 0, 0, 0); }
#pragma unroll
    for (int kt = 0; kt < 4; ++kt) {
        if (!IS_RET) {
#pragma unroll
            for (int q = 0; q < 4; ++q) { const f32x4 e = *(const LAS f32x4*)(auxp + 512 + (32 * kt + 16 * (q >> 1) + 4 * (q & 1)) * 4);
#pragma unroll
                for (int i = 0; i < 4; ++i) S[kt][4 * q + i] *= e[i]; } }
#pragma unroll
        for (int kk = 0; kk < 2; ++kk) S[kt] = __builtin_amdgcn_mfma_f32_32x32x16_bf16(as_bf16x8((u32x4){k[kt][kk][0].x, k[kt][kk][0].y, k[kt][kk][1].x, k[kt][kk][1].y}), vt[kk], S[kt], 0, 0, 0);
        if (IS_RET) S[kt] = S[kt] * g32;
    }
    float ss = 0.f;
#pragma unroll
    for (int r = 0; r < 16; ++r) ss += o[r] * o[r];
    ss += shfl_xor_l(ss, lane, 32);
    if (lane < 32) *(LAS float*)(size_t)(A.assq + PB) = ss;
    LAS unsigned char* op = (LAS unsigned char*)(size_t)(A.aout + PB);
#pragma unroll
    for (int q = 0; q < 4; ++q) { u32x2 wv; wv.x = pg8::cvt_pk_bf16(o[4 * q], o[4 * q + 1]); wv.y = pg8::cvt_pk_bf16(o[4 * q + 2], o[4 * q + 3]);
        *(LAS u32x2*)(op + 16 * q) = wv; }
}
template <int IS_RET, int VAR>
__device__ __forceinline__ void scan2_unit(unsigned char* ws, LAS unsigned char* lds, int unit, int tid) {
    constexpr bool MF_ON = VAR == 0 || ((VAR & 16) && (VAR & 1)), ST_ON = VAR == 0 || ((VAR & 16) && (VAR & 2)), FI_ON = VAR == 0 || ((VAR & 16) && (VAR & 4)), ST_LD = ST_ON && !(VAR & 64), ST_ST = ST_ON && !(VAR & 32);
    gbf Z = (gbf)(ws + WS_Z); gbf KST = (gbf)(ws + WS_KST); const GAS float* AUXG = (const GAS float*)(ws + WS_AUX);
    GAS bf16_t* CAT = (GAS bf16_t*)(ws + WS_CAT); GAS float* SSQO = (GAS float*)(ws + WS_SSQO);
    const int b = unit / (NH * NVS), h = (unit / NVS) % NH, vh = unit % NVS, hu = b * NH + h, wave = __builtin_amdgcn_readfirstlane(tid >> 6); int lane = tid & 63;
    const float g32 = exp2f(32.0f * __log2f(1.0f - exp2f(-5.0f - (float)h)));
    __syncthreads();
    static_assert(NVS == 2, "wave roles below are written for two value slices per head");
    if (wave >= 6) {
        __syncthreads();
        for (int n = 0; n < NCHUNK; ++n) __syncthreads();
    } else if (wave < 2) {
        asm volatile("" : "+v"(lane));
        const int l31 = lane & 31, hh = lane >> 5, vs = (128 / NVS) * vh + 32 * wave;
        const unsigned base = (unsigned)(size_t)lds, trl = (unsigned)((8 * hh + ((lane & 15) >> 2)) * PT + (16 * ((lane >> 4) & 1) + 4 * (lane & 3)) * 2);
        const int psw = ((lane & 3) == 1) ? 2 : (((lane & 3) == 2) ? 1 : (lane & 3));
        const unsigned trk = (unsigned)((8 * hh + ((lane & 15) >> 2)) * PT + (16 * ((lane >> 4) & 1) + 4 * psw) * 2);
        MLane A;
        A.av = base + SC_V + trl + vs * 2; A.ak = base + SC_KST + trk; A.aq = base + SC_QS + l31 * PQ + 16 * hh; A.aaux = base + SC_AUX + 32 * hh; A.ap = base + SC_P + l31 * 80 + 16 * hh;
        A.aout = base + SC_OUT + l31 * PQ + (vs + 4 * hh) * 2; A.assq = base + SC_SSQ + (wave * 32 + l31) * 4;
        asm volatile("" : "+v"(A.av), "+v"(A.ak), "+v"(A.aq), "+v"(A.aaux), "+v"(A.ap), "+v"(A.aout), "+v"(A.assq));
        f32x16 S[4];
#pragma unroll
        for (int kt = 0; kt < 4; ++kt)
#pragma unroll
            for (int r = 0; r < 16; ++r) S[kt][r] = 0.f;
        __syncthreads();
        for (int n = 0; n < NCHUNK; n += 2) {
            if (MF_ON) mfma_step<IS_RET, 0>(S, A, lane, g32);
            __syncthreads();
            if (MF_ON) mfma_step<IS_RET, 1>(S, A, lane, g32);
            __syncthreads();
        }
        if (!MF_ON) asm volatile("" :: "v"(S[0][0]));
    } else if (wave < 4) {
        const int sw = wave - 2;
        if (!ST_ON) { __syncthreads(); for (int n = 0; n < NCHUNK; ++n) __syncthreads(); }
        else {
        asm volatile("" : "+v"(lane));
        const int l31 = lane & 31, hh = lane >> 5, r4 = lane >> 4, c16 = lane & 15, p0 = (sw == 0 || IS_RET) ? NIN : MIXW;
        StLane L;
        L.g0 = (unsigned)((r4 * p0 + 8 * c16) * 2); L.gg = 0; L.ga = (unsigned)(lane * 4);
        L.l0 = (unsigned)(r4 * (sw == 0 ? PQ : PT) + 16 * c16); L.lg = (unsigned)(lane * 16); L.la = (unsigned)(lane * 4); L.sk = (unsigned)(l31 * PQ + 16 * hh);
        if (sw == 0) { L.g1 = (unsigned)((l31 * NIN + 8 * hh) * 2); L.l1 = 0; }
        else { const int rv = lane / VPR, cv = VPR * vh + lane % VPR; L.g1 = (unsigned)((rv * NIN + 8 * cv) * 2); L.l1 = (unsigned)(rv * PT + 16 * cv); }
        asm volatile("" : "+v"(L.g0), "+v"(L.g1), "+v"(L.gg), "+v"(L.ga), "+v"(L.l0), "+v"(L.l1), "+v"(L.lg), "+v"(L.la), "+v"(L.sk));
        HRegs RA, RB;
        stager_load<IS_RET>(RA, Z, KST, AUXG, b, h, hu, sw, L, 0);
        stager_stage<IS_RET>(RA, lds, lds + SC_BUF, sw, L);
        if (sw == 0) scores_stage(RA, lds, L, l31, hh);
        stager_load<IS_RET>(RB, Z, KST, AUXG, b, h, hu, sw, L, 1);
        __syncthreads();
        for (int n = 0; n < NCHUNK; n += 2) {
            if (ST_LD) stager_load<IS_RET>(RA, Z, KST, AUXG, b, h, hu, sw, L, n + 2);
            if (ST_ST) { stager_stage<IS_RET>(RB, lds + SC_BUF, lds, sw, L);
                if (sw == 0) scores_stage(RB, lds + SC_BUF, L, l31, hh); }
            else asm volatile("" :: "v"(RB.x0[0]), "v"(RB.x0[7]), "v"(RB.x1[0]), "v"(RB.aux[1]));
            __syncthreads();
            if (ST_LD) stager_load<IS_RET>(RB, Z, KST, AUXG, b, h, hu, sw, L, n + 3);
            if (ST_ST) { stager_stage<IS_RET>(RA, lds, lds + SC_BUF, sw, L);
                if (sw == 0) scores_stage(RA, lds, L, l31, hh); }
            else asm volatile("" :: "v"(RA.x0[0]), "v"(RA.x0[7]), "v"(RA.x1[0]), "v"(RA.aux[1]));
            __syncthreads();
        }
        }
    } else {
        asm volatile("" : "+v"(lane));
        FinLane L;
        {   const int c0 = lane / VPR, v0 = 8 * (VPR * vh + lane % VPR);
            L.lo = (unsigned)(c0 * PQ + v0 * 2); L.ls = (unsigned)(c0 * 4); L.go = (unsigned)((c0 * D + v0) * 2); L.gs = (unsigned)(c0 * 64); L.gz = (unsigned)((c0 * NIN + v0) * 2); }
        asm volatile("" : "+v"(L.lo), "+v"(L.ls), "+v"(L.go), "+v"(L.gs), "+v"(L.gz));
        if (wave == 4) {
            u32x4 gA[FPT], gB[FPT];
            gate_load<IS_RET>(gA, Z, b, h, L, 0); gate_load<IS_RET>(gB, Z, b, h, L, 1);
            __syncthreads();
            for (int n = 0; n < NCHUNK; n += 2) {
                if (FI_ON) { gate_stage(gA, lds, lane); gate_load<IS_RET>(gA, Z, b, h, L, n + 2); }
                __syncthreads();
                if (FI_ON) { gate_stage(gB, lds + SC_BUF, lane); gate_load<IS_RET>(gB, Z, b, h, L, n + 3); }
                __syncthreads();
            }
        } else {
            const bool first = (lane % VPR) == 0;
            __syncthreads();
            __syncthreads();
            for (int n = 1; n < NCHUNK; ++n) { if (FI_ON) fin_store<IS_RET>(lds + ((n - 1) & 1) * SC_BUF, CAT, SSQO, b, h, vh, L, lane, first, n - 1); __syncthreads(); }
            if (FI_ON) fin_store<IS_RET>(lds + ((NCHUNK - 1) & 1) * SC_BUF, CAT, SSQO, b, h, vh, L, lane, first, NCHUNK - 1);
        }
    }
}

constexpr int XA_K = 0, XA_KP = 144, XA_V = 256 * XA_KP, XA_VP = 192;
#define XRD(dst, areg, off) "ds_read_b128 " dst ", " areg " offset:" #off "\n\t"
__device__ __forceinline__ void xattn2_unit(unsigned char* ws, LAS unsigned char* lds, int unit, int layer, int tid) {
    gbf Z = (gbf)(ws + WS_Z); gbf MKV = (gbf)(ws + WS_MKV); GAS bf16_t* CAT = (GAS bf16_t*)(ws + WS_CAT);
    const int b = unit >> 5, hx = (unit >> 3) & 3, qb = unit & 7;
    const int wave = tid >> 6, lane = tid & 63, l31 = lane & 31, hh = lane >> 5;
    const size_t tok = (size_t)b * SEQ + qb * 256 + wave * 32 + l31;
    bf16x8 qf[4];
#pragma unroll
    for (int ks = 0; ks < 4; ++ks) qf[ks] = *(const GAS bf16x8*)(Z + tok * NIN + 3072 + hx * 64 + 16 * ks + 8 * hh);
    __syncthreads();
    {   gbf src = MKV + (size_t)(b * NMEM) * 2048 + layer * 512 + hx * 64;
        u32x4 kr[4], vr[4];
#pragma unroll
        for (int i = 0; i < 4; ++i) { const int piece = tid + 512 * i, key = piece >> 3, j = piece & 7;
            kr[i] = *(const GAS u32x4*)(src + (size_t)key * 2048 + 8 * j); vr[i] = *(const GAS u32x4*)(src + (size_t)key * 2048 + 256 + 8 * j); }
#pragma unroll
        for (int i = 0; i < 4; ++i) { const int piece = tid + 512 * i, key = piece >> 3, j = piece & 7;
            *(LAS u32x4*)(lds + XA_K + key * XA_KP + 16 * j) = kr[i]; *(LAS u32x4*)(lds + XA_V + key * XA_VP + 16 * j) = vr[i]; }
    }
    __syncthreads();
    f32x16 st[8];
    const unsigned ak = (unsigned)(size_t)(lds + XA_K) + (unsigned)(l31 * XA_KP + 16 * hh);
#define XBLK(T0, o0, o1, o2, o3, o4, o5, o6, o7) { u32x4 f0, f1, f2, f3, f4, f5, f6, f7; \
        asm volatile(XRD("%0", "%8", o0) XRD("%1", "%8", o1) XRD("%2", "%8", o2) XRD("%3", "%8", o3) XRD("%4", "%8", o4) XRD("%5", "%8", o5) XRD("%6", "%8", o6) XRD("%7", "%8", o7) "s_waitcnt lgkmcnt(0)" \
            : "=&v"(f0), "=&v"(f1), "=&v"(f2), "=&v"(f3), "=&v"(f4), "=&v"(f5), "=&v"(f6), "=&v"(f7) : "v"(ak) : "memory"); \
        __builtin_amdgcn_sched_barrier(0); \
        f32x16 a0, a1; _Pragma("unroll") for (int r = 0; r < 16; ++r) { a0[r] = 0.f; a1[r] = 0.f; } \
        a0 = __builtin_amdgcn_mfma_f32_32x32x16_bf16(as_bf16x8(f0), qf[0], a0, 0, 0, 0); a1 = __builtin_amdgcn_mfma_f32_32x32x16_bf16(as_bf16x8(f4), qf[0], a1, 0, 0, 0); \
        a0 = __builtin_amdgcn_mfma_f32_32x32x16_bf16(as_bf16x8(f1), qf[1], a0, 0, 0, 0); a1 = __builtin_amdgcn_mfma_f32_32x32x16_bf16(as_bf16x8(f5), qf[1], a1, 0, 0, 0); \
        a0 = __builtin_amdgcn_mfma_f32_32x32x16_bf16(as_bf16x8(f2), qf[2], a0, 0, 0, 0); a1 = __builtin_amdgcn_mfma_f32_32x32x16_bf16(as_bf16x8(f6), qf[2], a1, 0, 0, 0); \
        a0 = __builtin_amdgcn_mfma_f32_32x32x16_bf16(as_bf16x8(f3), qf[3], a0, 0, 0, 0); a1 = __builtin_amdgcn_mfma_f32_32x32x16_bf16(as_bf16x8(f7), qf[3], a1, 0, 0, 0); \
        st[T0] = a0; st[T0 + 1] = a1; }
    XBLK(0, 0, 32, 64, 96, 4608, 4640, 4672, 4704)
    XBLK(2, 9216, 9248, 9280, 9312, 13824, 13856, 13888, 13920)
    XBLK(4, 18432, 18464, 18496, 18528, 23040, 23072, 23104, 23136)
    XBLK(6, 27648, 27680, 27712, 27744, 32256, 32288, 32320, 32352)
#undef XBLK
    float mx = -1e30f;
#pragma unroll
    for (int T = 0; T < 8; ++T)
#pragma unroll
        for (int r = 0; r < 16; ++r) mx = fmaxf(mx, st[T][r]);
    mx = fmaxf(mx, shfl_xor_l(mx, lane, 32));
    const float c2 = 0.125f * 1.4426950408889634f, mc = mx * c2;
    float sum = 0.f;
#pragma unroll
    for (int T = 0; T < 8; ++T)
#pragma unroll
        for (int r = 0; r < 16; ++r) { const float p = exp2f(st[T][r] * c2 - mc); st[T][r] = p; sum += p; }
    sum += shfl_xor_l(sum, lane, 32);
    f32x16 ot[2];
#pragma unroll
    for (int dt = 0; dt < 2; ++dt)
#pragma unroll
        for (int r = 0; r < 16; ++r) ot[dt][r] = 0.f;
    const unsigned av = (unsigned)(size_t)(lds + XA_V) + (unsigned)((4 * hh + ((lane & 15) >> 2)) * XA_VP + (16 * ((lane >> 4) & 1) + 4 * (lane & 3)) * 2);
#define XTR(dst, off) "ds_read_b64_tr_b16 " dst ", %8 offset:" #off "\n\t"
#define VBLK(T, o00, o01, o10, o11, o20, o21, o30, o31) { u32x2 g0, g1, g2, g3, g4, g5, g6, g7; \
        asm volatile(XTR("%0", o00) XTR("%1", o01) XTR("%2", o10) XTR("%3", o11) XTR("%4", o20) XTR("%5", o21) XTR("%6", o30) XTR("%7", o31) "s_waitcnt lgkmcnt(0)" \
            : "=&v"(g0), "=&v"(g1), "=&v"(g2), "=&v"(g3), "=&v"(g4), "=&v"(g5), "=&v"(g6), "=&v"(g7) : "v"(av) : "memory"); \
        __builtin_amdgcn_sched_barrier(0); \
        u32x4 p0, p1; _Pragma("unroll") for (int j = 0; j < 4; ++j) { p0[j] = pg8::cvt_pk_bf16(st[T][2 * j], st[T][2 * j + 1]); p1[j] = pg8::cvt_pk_bf16(st[T][8 + 2 * j], st[T][8 + 2 * j + 1]); } \
        ot[0] = __builtin_amdgcn_mfma_f32_32x32x16_bf16(as_bf16x8((u32x4){g0.x, g0.y, g1.x, g1.y}), as_bf16x8(p0), ot[0], 0, 0, 0); \
        ot[1] = __builtin_amdgcn_mfma_f32_32x32x16_bf16(as_bf16x8((u32x4){g2.x, g2.y, g3.x, g3.y}), as_bf16x8(p0), ot[1], 0, 0, 0); \
        ot[0] = __builtin_amdgcn_mfma_f32_32x32x16_bf16(as_bf16x8((u32x4){g4.x, g4.y, g5.x, g5.y}), as_bf16x8(p1), ot[0], 0, 0, 0); \
        ot[1] = __builtin_amdgcn_mfma_f32_32x32x16_bf16(as_bf16x8((u32x4){g6.x, g6.y, g7.x, g7.y}), as_bf16x8(p1), ot[1], 0, 0, 0); }
    VBLK(0, 0, 1536, 64, 1600, 3072, 4608, 3136, 4672)
    VBLK(1, 6144, 7680, 6208, 7744, 9216, 10752, 9280, 10816)
    VBLK(2, 12288, 13824, 12352, 13888, 15360, 16896, 15424, 16960)
    VBLK(3, 18432, 19968, 18496, 20032, 21504, 23040, 21568, 23104)
    VBLK(4, 24576, 26112, 24640, 26176, 27648, 29184, 27712, 29248)
    VBLK(5, 30720, 32256, 30784, 32320, 33792, 35328, 33856, 35392)
    VBLK(6, 36864, 38400, 36928, 38464, 39936, 41472, 40000, 41536)
    VBLK(7, 43008, 44544, 43072, 44608, 46080, 47616, 46144, 47680)
#undef VBLK
#undef XTR
    const float il = 1.0f / sum;
    GAS bf16_t* op = CAT + tok * D + MIXW + hx * 64 + 4 * hh;
#pragma unroll
    for (int dt = 0; dt < 2; ++dt)
#pragma unroll
        for (int q = 0; q < 4; ++q) { u32x2 w; w.x = pg8::cvt_pk_bf16(ot[dt][4 * q] * il, ot[dt][4 * q + 1] * il); w.y = pg8::cvt_pk_bf16(ot[dt][4 * q + 2] * il, ot[dt][4 * q + 3] * il);
            *(GAS u32x2*)(op + 32 * dt + 8 * q) = w; }
}

__device__ __forceinline__ void final_rows(const unsigned char* ws, float* out, const float* nf, int row0, int row1, int gw, int NGW, int lane) {
    const GAS f32x4* wv = (const GAS f32x4*)nf + lane;
    for (int row = row0 + gw; row < row1; row += NGW) {
        const GAS u32x2* xr = (const GAS u32x2*)((const GAS bf16_t*)(ws + WS_XB) + (size_t)row * D) + lane; f32x4 v[4]; float s = 0.f;
#pragma unroll
        for (int j = 0; j < 4; ++j) { const u32x2 w = xr[64 * j]; v[j][0] = bf2f(w.x & 0xffffu); v[j][1] = bf2f(w.x >> 16); v[j][2] = bf2f(w.y & 0xffffu); v[j][3] = bf2f(w.y >> 16);
            s += (v[j].x * v[j].x + v[j].y * v[j].y) + (v[j].z * v[j].z + v[j].w * v[j].w); }
        const float rs = rsqrtf(wave_sum(s, lane) * (1.0f / D) + EPS);
        GAS f32x4* orow = (GAS f32x4*)(out + (size_t)row * D) + lane;
#pragma unroll
        for (int j = 0; j < 4; ++j) orow[64 * j] = v[j] * rs * wv[64 * j];
    }
}

__global__ void __launch_bounds__(NWAVES * 64, 2) mega_fwd(Args args) {
    extern __shared__ __attribute__((aligned(16))) unsigned char lds_raw[];
    LAS unsigned char* lds = (LAS unsigned char*)lds_raw;
    volatile LAS unsigned* MISC = (volatile LAS unsigned*)(lds + MISC_OFF);
    const int G = gridDim.x, bx = blockIdx.x;
    const int wave_s = __builtin_amdgcn_readfirstlane(threadIdx.x >> 6);
    unsigned char* ws = args.ws;
    for (int u = threadIdx.x; u < (LDS_BYTES - LDSCTL_OFF) / 4; u += NWAVES * 64) ((LAS unsigned*)(lds + LDSCTL_OFF))[u] = 0u;
    __syncthreads();
    XcdBarrier bar = xcd_barrier_post((unsigned*)(ws + WS_CTL) + CW_BAR, MISC + 8);
#define GBAR() xcd_barrier(bar, wave_s == 0 && lane_id_volatile() == 0)
#define OPAQ() unsigned char* wsp = ws; int Gp = G, bxp = bx, tidp = wave_s * 64 + lane_id_volatile(); asm volatile("" : "+s"(wsp), "+s"(Gp), "+s"(bxp), "+v"(tidp)); \
    const int lanep = tidp & 63, wavep = __builtin_amdgcn_readfirstlane(tidp >> 6), vcup = (Gp % 8 == 0) ? (bxp % 8) * (Gp / 8) + bxp / 8 : bxp, gwp = vcup * NWAVES + wavep, NGWp = Gp * NWAVES; \
    (void)lanep; (void)gwp; (void)NGWp
#define XPART() const int xn = misc_rd(lds, 8), xnx = misc_rd(lds, 9), xrank = misc_rd(lds, 10), xslot = misc_rd(lds, 11); \
    (void)xn; (void)xnx; (void)xrank; (void)xslot
#define LBAR() xcc_barrier(bar, (unsigned)misc_rd(lds, 8), wave_s == 0 && lane_id_volatile() == 0)

    { OPAQ(); p0_prologue(args, wsp, lds, gwp, NGWp, wavep, lanep); }
    GBAR();
    if (threadIdx.x == 0) {
        unsigned slot = 0;
        for (unsigned j = 0; j < 16; ++j) { const unsigned c = xb_ld(&bar.bar[XB_XCNT(j)]); if (j < bar.x && c > 0u) ++slot; }
        MISC[11] = slot;
    }
    __syncthreads();
    for (int l = 0; l < DEPTH; ++l) {
        const int is_ret = l & 1;
        if (l >= 2) cv_wait(bar, l - 2, (unsigned)misc_rd(lds, 9), wave_s == 0 && lane_id_volatile() == 0);
        { OPAQ(); XPART();
            if (l == 0) {
                pg8::Gemm g{(const bf16_t*)(wsp + WS_MEMB), (const bf16_t*)(wsp + WS_WM), MROWS, 2048, D}; pg8::XccOrderMem S{xrank, xn, xslot, xnx};
                EpiPlain E{(bf16_t*)(wsp + WS_MKV), 2048};
                pg8::gemm_phase<EpiPlain, pg8::XccOrderMem, true, true>(lds, g, S, E, tidp);
            }
            pg8::Gemm g{(const bf16_t*)(wsp + WS_XB), (const bf16_t*)(wsp + WS_WIN) + (size_t)l * NIN * D, M, NIN, D}; pg8::XccOrder S{xrank, xn, xslot, xnx, (NIN - XW) / 256, RBG_A, 1 << 30};
            EpiIn E{(bf16_t*)(wsp + WS_Z), (bf16_t*)(wsp + WS_KST), (float*)(wsp + WS_AUX), (const float*)(wsp + WS_SSQA), (const float*)(wsp + WS_LB) + (l >> 1) * MIXW, (const float*)(wsp + WS_COS), (const float*)(wsp + WS_SIN), is_ret, (LAS float*)(lds + RSTD_TAB_OFF)};
            pg8::gemm_phase<EpiIn, pg8::XccOrder, true, true>(lds, g, S, E, tidp);
        }
        LBAR();
        { OPAQ(); XPART();
            constexpr int UB = NH * NVS + 8;
            const int nb = xslot < 8 ? (8 - xslot + xnx - 1) / xnx : 0;
            for (int u = xrank; u < UB * nb; u += xn) {
                const int b = xslot + (u / UB) * xnx, uu = u % UB;
                if (uu < NH * NVS) { if (is_ret) scan2_unit<1, 0>(wsp, lds, b * NH * NVS + uu, tidp); else scan2_unit<0, 0>(wsp, lds, b * NH * NVS + uu, tidp); }
                else { const int rb = 8 * b + (uu - NH * NVS);
                    {   pg8::Gemm g{(const bf16_t*)(wsp + WS_XB), (const bf16_t*)(wsp + WS_WIN) + (size_t)l * NIN * D, M, NIN, D}; pg8::OneUnit S{rb, 12};
                        EpiIn E{(bf16_t*)(wsp + WS_Z), (bf16_t*)(wsp + WS_KST), (float*)(wsp + WS_AUX), (const float*)(wsp + WS_SSQA), (const float*)(wsp + WS_LB) + (l >> 1) * MIXW, (const float*)(wsp + WS_COS), (const float*)(wsp + WS_SIN), is_ret, (LAS float*)(lds + RSTD_TAB_OFF)};
                        pg8::gemm_phase<EpiIn, pg8::OneUnit, true, true>(lds, g, S, E, tidp); }
                    asm volatile("s_waitcnt vmcnt(0)" ::: "memory"); __builtin_amdgcn_fence(__ATOMIC_RELEASE, "agent"); __syncthreads(); __builtin_amdgcn_fence(__ATOMIC_ACQUIRE, "agent");
                    for (int hx = 0; hx < NXH; ++hx) xattn2_unit(wsp, lds, (rb >> 3) * 32 + hx * 8 + (rb & 7), l, tidp);
                }
            }
            if (l < DEPTH - 1) {
                const int busy = UB * nb < xn ? UB * nb : 0, nidle = xn - busy;
                if (xrank >= busy) { const int wv = (xrank - busy) * NWAVES + wavep, nwv = nidle * NWAVES;
                    __syncthreads();
                    for (int l2 = (l == 0 ? 0 : l + 1); l2 < l + 2; ++l2) convert_weights(args, wsp, (LAS float*)(lds + wavep * 16384), l2 * TITEMS_PER_LAYER + (l2 == 0 ? 16 * (NIN / 32) : 0), (l2 + 1) * TITEMS_PER_LAYER - 256, wv, nwv, lanep, xslot < xnx ? xslot : 0, xnx);
                    if (l > 0) cv_signal(bar, l - 1, (unsigned)nidle, wave_s == 0 && lane_id_volatile() == 0);
                }
            }
            __syncthreads();
        }
        if (l == 0) GBAR(); else LBAR();
        if (NVS > 1 && is_ret) {
            { OPAQ(); XPART(); for (int b = xslot; b < BATCH; b += xnx) norm_rows(wsp, b * SEQ, (b + 1) * SEQ, xrank * NWAVES + wavep, xn * NWAVES, lanep); }
            LBAR();
        }
        { OPAQ(); XPART();
            pg8::Gemm g{(const bf16_t*)(wsp + WS_CAT), (const bf16_t*)(wsp + WS_WOUT) + (size_t)l * D * D, M, D, D}; pg8::XccOrder S{xrank, xn, xslot, xnx, D / 256, 4, 1 << 30};
            EpiResC E{EpiRes{(const bf16_t*)(wsp + WS_XB), (bf16_t*)(wsp + WS_XB), (float*)(wsp + WS_SSQD)}, is_ret ? nullptr : (const float*)(wsp + WS_SSQO)};
            pg8::gemm_phase<EpiResC, pg8::XccOrder, true, true>(lds, g, S, E, tidp);
        }
        LBAR();
        { OPAQ(); XPART();
            pg8::Gemm g{(const bf16_t*)(wsp + WS_XB), (const bf16_t*)(wsp + WS_WFI) + (size_t)l * NFI * D, M, NFI, D};
            const int totD = (xslot < 8 ? (8 - xslot + xnx - 1) / xnx : 0) * 8 * (NFI / 256), fullD = (totD / xn) * xn, leftD = totD - fullD; const bool halves = leftD > 0 && 2 * leftD <= xn;
            pg8::XccOrder S{xrank, xn, xslot, xnx, NFI / 256, RBG_D, halves ? fullD : (1 << 30)};
            EpiFfn E{(bf16_t*)(wsp + WS_ACT), (const float*)(wsp + WS_SSQD), (LAS float*)(lds + RSTD_TAB_OFF), -1};
            pg8::gemm_phase<EpiFfn, pg8::XccOrder, true, true>(lds, g, S, E, tidp);
            if (halves && xrank < 2 * leftD) { pg8::Unit hu; S.decode(fullD + xrank % leftD, hu);
                pg8::HalfUnit SH{hu.pm, hu.pn, xrank / leftD}; EpiFfn EH{(bf16_t*)(wsp + WS_ACT), (const float*)(wsp + WS_SSQD), (LAS float*)(lds + RSTD_TAB_OFF), xrank / leftD};
                pg8::gemm_phase<EpiFfn, pg8::HalfUnit, true, true, true>(lds, g, SH, EH, tidp); }
        }
        LBAR();
        { OPAQ(); XPART();
            pg8::Gemm g{(const bf16_t*)(wsp + WS_ACT), (const bf16_t*)(wsp + WS_WFO) + (size_t)l * D * DFF, M, D, DFF}; pg8::XccOrder S{xrank, xn, xslot, xnx, D / 256, 4, 1 << 30};
            EpiRes E{(const bf16_t*)(wsp + WS_XB), (bf16_t*)(wsp + WS_XB), (float*)(wsp + WS_SSQA)};
            pg8::gemm_phase<EpiRes, pg8::XccOrder, true, true>(lds, g, S, E, tidp);
        }
        LBAR();
    }
    { OPAQ(); XPART();
        for (int b = xslot; b < BATCH; b += xnx) final_rows(wsp, args.out, args.in[14], b * SEQ, (b + 1) * SEQ, xrank * NWAVES + wavep, xn * NWAVES, lanep);
    }
#undef OPAQ
#undef XPART
#undef GBAR
#undef LBAR
}

extern "C" void kernel_launch(void* const* d_in, const int* in_sizes, int n_in, void* d_out, int out_size, void* d_ws, size_t ws_size, hipStream_t stream) {
    static int grid = 0;
    if (grid == 0) {
        if (n_in != 15 || in_sizes[0] != M * D || out_size != M * D || ws_size < WS_END) {
            fprintf(stderr, "kernel_launch: unexpected shapes: n_in %d in0 %d out %d ws %zu (need %zu)\n", n_in, n_in > 0 ? in_sizes[0] : -1, out_size, ws_size, (size_t)WS_END); grid = -1; return; }
        int dev = 0, cus = 0, per_cu = 0;
        if (hipGetDevice(&dev) != hipSuccess || hipDeviceGetAttribute(&cus, hipDeviceAttributeMultiprocessorCount, dev) != hipSuccess) { grid = -1; return; }
        if (hipFuncSetAttribute((const void*)mega_fwd, hipFuncAttributeMaxDynamicSharedMemorySize, LDS_BYTES) != hipSuccess) { fprintf(stderr, "kernel_launch: hipFuncSetAttribute failed\n"); grid = -1; return; }
        if (hipOccupancyMaxActiveBlocksPerMultiprocessor(&per_cu, (const void*)mega_fwd, NWAVES * 64, LDS_BYTES) != hipSuccess || per_cu < 1)
            fprintf(stderr, "kernel_launch: occupancy query reports %d workgroups per CU\n", per_cu);
        (void)hipGetLastError();
        grid = cus;
        if (grid < 176) { fprintf(stderr, "kernel_launch: this kernel needs at least 176 CUs (found %d)\n", cus); grid = -1; return; }
    }
    if (grid < 0) return;
    if (hipMemsetAsync((char*)d_ws + WS_CTL, 0, CTL_ZERO_BYTES, stream) != hipSuccess) { fprintf(stderr, "kernel_launch: memset failed\n"); return; }
    Args a{};
    for (int i = 0; i < 15; ++i) a.in[i] = (const float*)d_in[i];
    a.out = (float*)d_out; a.ws = (unsigned char*)d_ws;
    a.ph_lo = 0; a.ph_hi = 0;
    hipLaunchKernelGGL(mega_fwd, dim3(grid), dim3(NWAVES * 64), LDS_BYTES, stream, a);
    const hipError_t le = hipPeekAtLastError();
    if (le != hipSuccess) fprintf(stderr, "kernel_launch: launch failed: %s\n", hipGetErrorName(le));
}
```

```cpp
#include <hip/hip_runtime.h>
#include <cstdio>
#include <cstdint>

#ifndef DBG_SKIP
#define DBG_SKIP 0
#endif
#ifndef PROBE_REP
#define PROBE_REP 0
#endif
#ifndef RBG_A
#define RBG_A 4
#endif
#ifndef RBG_D
#define RBG_D 4
#endif
#ifndef PROBE_VAR
#define PROBE_VAR 0
#endif
#ifndef MK_N_LAUNCHES
#define MK_N_LAUNCHES 1
#endif

#define GAS __attribute__((address_space(1)))
#define LAS __attribute__((address_space(3)))
typedef unsigned short bf16_t;
typedef short bf16x8 __attribute__((ext_vector_type(8)));
typedef float f32x4 __attribute__((ext_vector_type(4)));
typedef float f32x2 __attribute__((ext_vector_type(2)));
typedef unsigned u32x4 __attribute__((ext_vector_type(4)));
typedef unsigned u32x2 __attribute__((ext_vector_type(2)));

constexpr int BATCH = 8, SEQ = 2048, D = 1024, DEPTH = 4;
constexpr int M = BATCH * SEQ;
constexpr int NH = 6, HD = 128, MIXW = 768, XW = 256, NXH = 4, XHD = 64, NMEM = 256;
constexpr int NIN = 3328, DFF = 2816, NFI = 2 * DFF;
constexpr int MROWS = BATCH * NMEM;
constexpr float EPS = 1e-6f;
constexpr int NVS = 2;
constexpr int VPR = 16 / NVS;

constexpr size_t MiB = 1u << 20;
constexpr size_t WS_CTL = 0, CTL_ZERO_BYTES = 1 * MiB;
constexpr size_t WS_LB = 1 * MiB;
constexpr size_t WS_SSQA = 2 * MiB;
constexpr size_t WS_SSQD = 3 * MiB;
constexpr size_t WS_COS = 4 * MiB, WS_SIN = 8 * MiB;
constexpr size_t WS_MEMB = 12 * MiB;
constexpr size_t WS_MKV = 16 * MiB;
constexpr size_t WS_WIN = 24 * MiB;
constexpr size_t WS_WOUT = 50 * MiB;
constexpr size_t WS_WFI = 58 * MiB;
constexpr size_t WS_WFO = 102 * MiB;
constexpr size_t WS_WM = 124 * MiB;
constexpr size_t WS_XB = 128 * MiB;
constexpr size_t WS_CAT = 160 * MiB;
constexpr size_t WS_Z = 192 * MiB;
constexpr size_t WS_F = 296 * MiB;
constexpr size_t WS_KST = 296 * MiB;
constexpr size_t WS_AUX = 320 * MiB;
constexpr size_t WS_SSQO = 323 * MiB;
constexpr size_t WS_ACT = 192 * MiB;
constexpr size_t WS_END = 344 * MiB;
static_assert(WS_WIN + (size_t)DEPTH * NIN * D * 2 <= WS_WOUT && WS_WOUT + (size_t)DEPTH * D * D * 2 <= WS_WFI && WS_WFI + (size_t)DEPTH * NFI * D * 2 <= WS_WFO &&
              WS_WFO + (size_t)DEPTH * D * DFF * 2 <= WS_WM && WS_WM + (size_t)2048 * 1024 * 2 <= WS_XB && WS_Z + (size_t)M * NIN * 2 <= WS_F && WS_F + (size_t)M * MIXW * 4 <= WS_END &&
              WS_ACT + (size_t)M * DFF * 2 <= WS_F, "ws map");
constexpr int CW_BAR = 4096;

__device__ __forceinline__ int lane_id_volatile() { int l; asm volatile("v_mbcnt_lo_u32_b32 %0, -1, 0\n\tv_mbcnt_hi_u32_b32 %0, -1, %0" : "=v"(l)); return l; }
namespace pg8 {
constexpr int BM = 256, BK = 64, HALF = 128, HTB = HALF * BK * 2, STAGE_BYTES = 8 * HTB, NXCD = 8, WGM = 8;
__host__ __device__ __forceinline__ int lds_byte(int r, int c) { const int st = (r >> 4) * 2 + (c >> 5), rr = r & 15, cc = c & 31, ob = rr * 64 + cc * 2; return st * 1024 + (ob ^ (((ob >> 9) & 1) << 5)); }
__host__ __device__ __forceinline__ void stage_rc(int b, int& R, int& C) { const int st = b / 1024, sb = b % 1024, swz = sb ^ (((sb >> 9) & 1) << 5); R = (st >> 1) * 16 + swz / 64; C = (st & 1) * 32 + (swz % 64) / 2; }
__host__ __device__ __forceinline__ int perm32(int rho) { const int n = rho >> 4, i = rho & 15; return 8 * (i >> 2) + 4 * n + (i & 3); }
struct Unit { int pm, pn; };
struct Gemm { const bf16_t* A; const bf16_t* Bt; int M, N, K; };
struct StaticOrder {
    int nM, nN, nwg, G, c;
    __host__ __device__ void init(int M_, int N_, int G_, int c_) { nM = M_ / BM; nN = N_ / BM; nwg = nM * nN; G = G_; c = c_; }
    __host__ __device__ bool next(int i, Unit& u) const {
        const long L = (long)i * G + c; if (L >= nwg) return false;
        int wgid = (int)L; { const int q = nwg / NXCD, r = nwg % NXCD, xcd = wgid % NXCD, off = wgid / NXCD; wgid = (xcd < r ? xcd * (q + 1) : r * (q + 1) + (xcd - r) * q) + off; }
        const int nig = WGM * nN, gid = wgid / nig, fm = gid * WGM, gsz = (nM - fm) < WGM ? (nM - fm) : WGM;
        u.pm = fm + ((wgid % nig) % gsz); u.pn = (wgid % nig) / gsz; return true;
    }
    __device__ __forceinline__ void a_ready(const Unit&) const {}
    __device__ __forceinline__ void done(const Unit&) const {}
};
struct XccOrder {
    int rank, n, slot, nx, nN, rbg, tlim;
    __device__ __forceinline__ bool next(int i, Unit& u) const {
        const int t = i * n + rank, nb = (8 - slot + nx - 1) / nx;
        if (slot >= 8 || t >= nb * 8 * nN || t >= tlim) return false;
        decode(t, u); return true;
    }
    __device__ __forceinline__ void decode(int t, Unit& u) const {
        const int per = 8 * nN;
        const int bi = t / per, tt = t - bi * per, g = tt / (rbg * nN), r = tt - g * rbg * nN;
        u.pm = 8 * (slot + bi * nx) + rbg * g + (r % rbg); u.pn = r / rbg;
    }
    __device__ __forceinline__ void a_ready(const Unit&) const {}
};
struct XccOrderMem {
    int rank, n, slot, nx;
    __device__ __forceinline__ bool next(int i, Unit& u) const {
        const int t = i * n + rank, nb = (8 - slot + nx - 1) / nx;
        if (slot >= 8 || t >= nb * 8) return false;
        u.pm = slot + (t >> 3) * nx; u.pn = t & 7; return true;
    }
    __device__ __forceinline__ void a_ready(const Unit&) const {}
};
struct OneUnit {
    int pm, pn;
    __device__ __forceinline__ bool next(int i, Unit& u) const { if (i) return false; u.pm = pm; u.pn = pn; return true; }
    __device__ __forceinline__ void a_ready(const Unit&) const {}
};
struct HalfUnit {
    int pm, pn, half;
    __device__ __forceinline__ bool next(int i, Unit& u) const { if (i) return false; u.pm = pm; u.pn = pn; return true; }
    __device__ __forceinline__ void a_ready(const Unit&) const {}
};
__device__ __forceinline__ unsigned cvt_pk_bf16(float lo, float hi) { unsigned r; asm volatile("v_cvt_pk_bf16_f32 %0, %1, %2" : "=v"(r) : "v"(lo), "v"(hi)); return r; }

template <class Epi, class Sched, bool ALIGN_EPI = false, bool SP2 = false, bool HM = false>
__device__ __forceinline__ void gemm_phase(LAS unsigned char* lds, const Gemm g, const Sched& S, const Epi& E, int tid) {
    asm volatile("" : "+v"(tid));
    const int wid = __builtin_amdgcn_readfirstlane(tid >> 6), lane = tid & 63, wr = wid >> 2, wc = wid & 3, fr = lane & 15, fq = lane >> 4;
    const int K = g.K, nt = K / BK;
    unsigned voffA[2], voffB[2];
#pragma unroll
    for (int i = 0; i < 2; ++i) { int R, C; stage_rc(tid * 16 + i * 8192, R, C); const int Rb = Epi::PERM ? ((R & ~31) + perm32(R & 31)) : R;
        voffA[i] = (unsigned)(R * K + C) * 2u; voffB[i] = (unsigned)(Rb * K + C) * 2u; }
    asm volatile("" : "+v"(voffA[0]), "+v"(voffA[1]), "+v"(voffB[0]), "+v"(voffB[1]));
    const size_t kstep = (size_t)(BK * 2);
    const size_t hstep = (size_t)HALF * K * 2;
    const size_t tstep = 2 * hstep;
    static_assert(!HM || SP2, "half tiles use the SP2 body");
    const size_t ahs = HM ? (size_t)0 : hstep;
    const unsigned ldsw = (unsigned)wid * 1024u;
    const int aoff = lds_byte(wr * 64 + fr, fq * 8), boff = lds_byte(wc * 32 + fr, fq * 8);
#define PG8_SA(b, h) (((b) * 2 + (h)) * HTB)
#define PG8_SB(b, h) ((4 + (b) * 2 + (h)) * HTB)
#define PG8_STAGE(bufoff, gbase, voff) do { _Pragma("unroll") for (int _i = 0; _i < 2; ++_i) \
        __builtin_amdgcn_global_load_lds((const unsigned*)((const char*)(gbase) + (voff)[_i]), (LAS unsigned*)(lds + (bufoff) + ldsw + _i * 8192), 16, 0, 0); } while (0)
#define PG8_LDA(dst, b, h) do { _Pragma("unroll") for (int m = 0; m < 4; ++m) _Pragma("unroll") for (int k = 0; k < 2; ++k) dst[m][k] = *(const LAS bf16x8*)(lds + PG8_SA(b, h) + aoff + m * 2048 + k * 1024); } while (0)
#define PG8_LDB(dst, b, h) do { _Pragma("unroll") for (int n = 0; n < 2; ++n) _Pragma("unroll") for (int k = 0; k < 2; ++k) dst[n][k] = *(const LAS bf16x8*)(lds + PG8_SB(b, h) + boff + n * 2048 + k * 1024); } while (0)
#define PG8_MMA(ai, bj, At, Bt) do { __builtin_amdgcn_s_setprio(1); _Pragma("unroll") for (int m = 0; m < 4; ++m) _Pragma("unroll") for (int n = 0; n < 2; ++n) _Pragma("unroll") for (int k = 0; k < 2; ++k) \
        acc[ai][bj][m][n] = __builtin_amdgcn_mfma_f32_16x16x32_bf16(Bt[n][k], At[m][k], acc[ai][bj][m][n], 0, 0, 0); __builtin_amdgcn_s_setprio(0); } while (0)
#define PG8_WAIT_V(n) asm volatile("s_waitcnt vmcnt(" #n ")" ::: "memory")
#define PG8_WAIT_L(n) asm volatile("s_waitcnt lgkmcnt(" #n ")" ::: "memory")
#define PG8_BAR __builtin_amdgcn_s_barrier()
#define PG8_SCHED __builtin_amdgcn_sched_barrier(0)
    Unit cur, nxt; int ui = 0;
    if (!S.next(0, cur)) return;
    f32x4 acc[2][2][4][2];
#pragma unroll
    for (int a = 0; a < 2; ++a)
#pragma unroll
        for (int b = 0; b < 2; ++b)
#pragma unroll
            for (int m = 0; m < 4; ++m)
#pragma unroll
                for (int n = 0; n < 2; ++n) acc[a][b][m][n] = (f32x4){0.f, 0.f, 0.f, 0.f};
    bf16x8 At[4][2], B0[2][2], B1[2][2];
    const char* cA = (const char*)g.A + (size_t)cur.pm * tstep; if constexpr (HM) cA += (size_t)S.half * hstep;
    const char* cB = (const char*)g.Bt + (size_t)cur.pn * tstep;
    S.a_ready(cur);
    if constexpr (SP2) {
        PG8_STAGE(PG8_SB(0, 0), cB, voffB); PG8_STAGE(PG8_SB(0, 1), cB + hstep, voffB); PG8_STAGE(PG8_SA(0, 0), cA, voffA); PG8_STAGE(PG8_SA(0, 1), cA + ahs, voffA);
        if (wr == 1) PG8_BAR;
        PG8_WAIT_V(2); PG8_BAR;
        PG8_STAGE(PG8_SB(1, 0), cB + kstep, voffB); PG8_STAGE(PG8_SA(1, 0), cA + kstep, voffA); PG8_STAGE(PG8_SB(1, 1), cB + hstep + kstep, voffB);
        PG8_WAIT_V(6); PG8_BAR;
    } else {
        PG8_STAGE(PG8_SB(0, 0), cB, voffB); PG8_STAGE(PG8_SA(0, 0), cA, voffA); PG8_STAGE(PG8_SB(0, 1), cB + hstep, voffB); PG8_STAGE(PG8_SA(0, 1), cA + hstep, voffA);
        if (wr == 1) PG8_BAR;
        PG8_WAIT_V(4); PG8_BAR;
        PG8_STAGE(PG8_SB(1, 0), cB + kstep, voffB); PG8_STAGE(PG8_SA(1, 0), cA + kstep, voffA); PG8_STAGE(PG8_SB(1, 1), cB + hstep + kstep, voffB);
        PG8_WAIT_V(6); PG8_BAR;
    }
    for (;;) {
        const bool has_next = S.next(ui + 1, nxt);
        const char* nA = has_next ? (const char*)g.A + (size_t)nxt.pm * tstep : cA; const char* nB = has_next ? (const char*)g.Bt + (size_t)nxt.pn * tstep : cB;
        for (int t = 0; t < nt; t += 2) {
            const bool last = (t == nt - 2);
            const char* a1 = cA + (size_t)(t + 1) * kstep;
            const char* a2 = last ? nA : cA + (size_t)(t + 2) * kstep; const char* b2 = last ? nB : cB + (size_t)(t + 2) * kstep;
            const char* a3 = a2 + kstep; const char* b3 = b2 + kstep;
            if (last && has_next) S.a_ready(nxt);
            if constexpr (Epi::MID_T > 0) { if (t == Epi::MID_T) { const int l2 = lane_id_volatile(); E.mid(acc, cur, wr, wc, l2 & 15, l2 >> 4); } }
            if constexpr (SP2) {
            PG8_LDB(B0, 0, 0); PG8_LDB(B1, 0, 1); PG8_SCHED; PG8_LDA(At, 0, 0); PG8_STAGE(PG8_SA(1, 1), a1 + ahs, voffA);
            PG8_WAIT_V(8); PG8_WAIT_L(0); PG8_BAR; PG8_MMA(0, 0, At, B0); PG8_MMA(0, 1, At, B1); PG8_BAR; PG8_SCHED;
            if constexpr (!HM) PG8_LDA(At, 0, 1);
            PG8_STAGE(PG8_SB(0, 0), b2, voffB); PG8_STAGE(PG8_SB(0, 1), b2 + hstep, voffB); PG8_STAGE(PG8_SA(0, 0), a2, voffA);
            PG8_WAIT_V(8); PG8_WAIT_L(0); PG8_BAR; if constexpr (!HM) { PG8_MMA(1, 0, At, B0); PG8_MMA(1, 1, At, B1); } PG8_BAR; PG8_SCHED;
            PG8_LDB(B0, 1, 0); PG8_LDB(B1, 1, 1); PG8_SCHED; PG8_LDA(At, 1, 0); PG8_STAGE(PG8_SA(0, 1), a2 + ahs, voffA);
            PG8_WAIT_V(8); PG8_WAIT_L(0); PG8_BAR; PG8_MMA(0, 0, At, B0); PG8_MMA(0, 1, At, B1); PG8_BAR; PG8_SCHED;
            if constexpr (!HM) PG8_LDA(At, 1, 1);
            PG8_STAGE(PG8_SB(1, 0), b3, voffB); PG8_STAGE(PG8_SB(1, 1), b3 + hstep, voffB); PG8_STAGE(PG8_SA(1, 0), a3, voffA);
            PG8_WAIT_V(8); PG8_WAIT_L(0); PG8_BAR; if constexpr (!HM) { PG8_MMA(1, 0, At, B0); PG8_MMA(1, 1, At, B1); } PG8_BAR; PG8_SCHED;
            } else {
            PG8_LDB(B0, 0, 0); PG8_SCHED; PG8_LDA(At, 0, 0); PG8_STAGE(PG8_SA(1, 1), a1 + hstep, voffA);
            PG8_WAIT_L(8); PG8_BAR; PG8_WAIT_L(0); PG8_MMA(0, 0, At, B0); PG8_BAR; PG8_SCHED;
            PG8_LDB(B1, 0, 1); PG8_STAGE(PG8_SB(0, 0), b2, voffB);
            PG8_BAR; PG8_WAIT_L(0); PG8_MMA(0, 1, At, B1); PG8_BAR;
            PG8_LDA(At, 0, 1); PG8_STAGE(PG8_SA(0, 0), a2, voffA);
            PG8_BAR; PG8_WAIT_L(0); PG8_MMA(1, 0, At, B0); PG8_BAR; PG8_SCHED;
            PG8_STAGE(PG8_SB(0, 1), b2 + hstep, voffB);
            PG8_WAIT_V(6); PG8_BAR; PG8_MMA(1, 1, At, B1); PG8_BAR;
            PG8_LDB(B0, 1, 0); PG8_SCHED; PG8_LDA(At, 1, 0); PG8_STAGE(PG8_SA(0, 1), a2 + hstep, voffA);
            PG8_WAIT_L(8); PG8_BAR; PG8_WAIT_L(0); PG8_MMA(0, 0, At, B0); PG8_BAR; PG8_SCHED;
            PG8_LDB(B1, 1, 1); PG8_STAGE(PG8_SB(1, 0), b3, voffB);
            PG8_BAR; PG8_WAIT_L(0); PG8_MMA(0, 1, At, B1); PG8_BAR;
            PG8_LDA(At, 1, 1); PG8_STAGE(PG8_SA(1, 0), a3, voffA);
            PG8_BAR; PG8_WAIT_L(0); PG8_MMA(1, 0, At, B0); PG8_BAR; PG8_SCHED;
            PG8_STAGE(PG8_SB(1, 1), b3 + hstep, voffB);
            PG8_WAIT_V(6); PG8_BAR; PG8_MMA(1, 1, At, B1); PG8_BAR;
            }
        }
        if constexpr (ALIGN_EPI) { if (wr == 0) PG8_BAR; }
        { const int l2 = lane_id_volatile(); E(acc, cur, wr, wc, l2 & 15, l2 >> 4); }
        if (!has_next) break;
#pragma unroll
        for (int a = 0; a < 2; ++a)
#pragma unroll
            for (int b = 0; b < 2; ++b)
#pragma unroll
                for (int m = 0; m < 4; ++m)
#pragma unroll
                    for (int n = 0; n < 2; ++n) acc[a][b][m][n] = (f32x4){0.f, 0.f, 0.f, 0.f};
        cur = nxt; cA = nA; cB = nB; ++ui;
        if constexpr (ALIGN_EPI) { if (wr == 1) PG8_BAR; }
    }
    PG8_WAIT_V(0);
    if constexpr (!ALIGN_EPI) { if (wr == 0) PG8_BAR; }
    PG8_BAR;
#undef PG8_SA
#undef PG8_SB
#undef PG8_STAGE
#undef PG8_LDA
#undef PG8_LDB
#undef PG8_MMA
#undef PG8_WAIT_V
#undef PG8_WAIT_L
#undef PG8_BAR
#undef PG8_SCHED
}
}

__device__ __forceinline__ float bf2f(unsigned h) { return __uint_as_float(h << 16); }
__device__ __forceinline__ unsigned f2bf(float f) { unsigned u = __float_as_uint(f); return (u + 0x7fffu + ((u >> 16) & 1u)) >> 16; }
__device__ __forceinline__ unsigned pk2(float lo, float hi) { return f2bf(lo) | (f2bf(hi) << 16); }
__device__ __forceinline__ float fast_rcp(float x) { return __builtin_amdgcn_rcpf(x); }
__device__ __forceinline__ float sigmoidf_(float x) { return fast_rcp(1.0f + __expf(-x)); }
__device__ __forceinline__ float siluf_(float x) { return x * sigmoidf_(x); }
__device__ __forceinline__ float shfl_xor_l(float v, int lane, int mask) { return __int_as_float(__builtin_amdgcn_ds_bpermute((lane ^ mask) << 2, __float_as_int(v))); }
__device__ __forceinline__ float wave_sum(float v, int lane) {
#pragma unroll
    for (int o = 1; o < 64; o <<= 1) v += shfl_xor_l(v, lane, o);
    return v;
}
__device__ __forceinline__ float rstd_from_partials(const float* ssq, int row, float invn) {
    const f32x4* p = (const f32x4*)(ssq + (size_t)row * 16);
    const f32x4 a = p[0], b = p[1], c = p[2], d = p[3];
    const f32x4 s = (a + b) + (c + d);
    return rsqrtf(((s[0] + s[1]) + (s[2] + s[3])) * invn + EPS);
}
constexpr int RSTD_TAB_OFF = 132096;
__device__ __forceinline__ void rstd_table(const float* ssq, int pm, LAS float* tab, int wr, int wc, int fr, int fq) {
    const int t = (wr * 4 + wc) * 64 + fq * 16 + fr;
    if (t < 256) { const GAS f32x4* p = (const GAS f32x4*)((const GAS float*)ssq + (size_t)(pm * 256 + t) * 16);
        const f32x4 a = p[0], b = p[1], c = p[2], d = p[3]; const f32x4 sm = (a + b) + (c + d);
        tab[t] = rsqrtf(((sm[0] + sm[1]) + (sm[2] + sm[3])) * (1.0f / D) + EPS); }
    asm volatile("s_waitcnt lgkmcnt(0)" ::: "memory"); __builtin_amdgcn_s_barrier(); asm volatile("" ::: "memory");
}
__device__ __forceinline__ u32x4 pack8(const f32x4 v0, const f32x4 v1) {
    u32x4 w; w.x = pg8::cvt_pk_bf16(v0[0], v0[1]); w.y = pg8::cvt_pk_bf16(v0[2], v0[3]); w.z = pg8::cvt_pk_bf16(v1[0], v1[1]); w.w = pg8::cvt_pk_bf16(v1[2], v1[3]); return w;
}

#define DPP_SHR(x, n) __int_as_float(__builtin_amdgcn_update_dpp(0, __float_as_int(x), 0x110 + (n), 0xf, 0xf, false))
__device__ __forceinline__ float rowscan16(float x) {
    x += DPP_SHR(x, 1); x += DPP_SHR(x, 2); x += DPP_SHR(x, 4); x += DPP_SHR(x, 8); return x;
}
__device__ __forceinline__ float bcast15(float x, int lane) { return __int_as_float(__builtin_amdgcn_ds_bpermute((lane | 15) << 2, __float_as_int(x))); }
__device__ __forceinline__ float expc(float x) { return __expf(fminf(x, 80.0f)); }
using pg8::Unit;
struct EpiPlain {
    static constexpr bool PERM = true; static constexpr int MID_T = 0;
    bf16_t* O; int ldc;
    __device__ __forceinline__ void operator()(const f32x4 (&acc)[2][2][4][2], const Unit& u, int wr, int wc, int fr, int fq) const {
        const int row0 = u.pm * 256 + wr * 64 + fr, col0 = u.pn * 256 + wc * 32 + 8 * fq;
#pragma unroll
        for (int ai = 0; ai < 2; ++ai)
#pragma unroll
            for (int m = 0; m < 4; ++m) { bf16_t* rowp = O + (size_t)(row0 + ai * 128 + m * 16) * ldc + col0;
#pragma unroll
                for (int bj = 0; bj < 2; ++bj) *(GAS u32x4*)((GAS bf16_t*)rowp + bj * 128) = pack8(acc[ai][bj][m][0], acc[ai][bj][m][1]); }
    }
};
struct EpiIn {
    static constexpr bool PERM = true; static constexpr int MID_T = 0;
    bf16_t* Z; bf16_t* KST; float* AUX; const float* ssq; const float* lb; const float* cosT; const float* sinT; int is_ret; LAS float* tab;
    __device__ __forceinline__ void operator()(const f32x4 (&acc)[2][2][4][2], const Unit& u, int wr, int wc, int fr, int fq) const {
        const int row0 = u.pm * 256 + wr * 64 + fr, jl = wc * 32 + 8 * fq, t = u.pn;
        rstd_table(ssq, u.pm, tab, wr, wc, fr, fq);
        const LAS float* tl = tab + wr * 64 + fr;
        if (t < 6) {
            if (!is_ret) {
                const f32x4 lb0 = *(const GAS f32x4*)((const GAS float*)lb + t * 128 + (jl >> 1)), lb1 = *(const GAS f32x4*)((const GAS float*)lb + t * 128 + (jl >> 1) + 64);
#pragma unroll
                for (int ai = 0; ai < 2; ++ai)
#pragma unroll
                    for (int mp = 0; mp < 2; ++mp) {
                        const int tok0 = u.pm * 256 + ai * 128 + wr * 64 + mp * 32, rlo = tok0 + fr, rhi = rlo + 16;
                        const float rs0 = tl[ai * 128 + mp * 32], rs1 = tl[ai * 128 + mp * 32 + 16];
                        f32x4 qsv[2][2], ksv[2][2], ktv[2][2], erv[2], dcv[2];
#pragma unroll
                        for (int n = 0; n < 2; ++n)
#pragma unroll
                            for (int i = 0; i < 4; ++i) {
                                const float lbv = n ? lb1[i] : lb0[i];
                                float g[2], kk[2], qq[2];
#pragma unroll
                                for (int e = 0; e < 2; ++e) {
                                    const float x = acc[ai][1][2 * mp + e][n][i] * (e ? rs1 : rs0), za = acc[ai][0][2 * mp + e][n][i] * (e ? rs1 : rs0);
                                    const float a = __expf(-fabsf(x)), r = fast_rcp(1.0f + a);
                                    const float sneg = x >= 0.f ? a * r : r;
                                    const float em = x >= 0.f ? a : fminf(fast_rcp(a), 1.0686475e13f);
                                    g[e] = (fminf(x, 0.f) - __logf(1.0f + a)) + __logf(1.0f + lbv * em);
                                    kk[e] = (1.0f - lbv) * sneg;
                                    qq[e] = siluf_(za);
                                }
                                const float blo = rowscan16(g[0]), ref = bcast15(blo, fq * 16 + fr), bhi = ref + rowscan16(g[1]), blast = bcast15(bhi, fq * 16 + fr);
                                qsv[0][n][i] = qq[0] * expc(blo - ref); qsv[1][n][i] = qq[1] * expc(bhi - ref);
                                ksv[0][n][i] = kk[0] * expc(ref - blo); ksv[1][n][i] = kk[1] * expc(ref - bhi);
                                ktv[0][n][i] = kk[0] * __expf(blast - blo); ktv[1][n][i] = kk[1] * __expf(blast - bhi);
                                erv[n][i] = __expf(ref); dcv[n][i] = __expf(blast);
                            }
                        GAS bf16_t* zlo = (GAS bf16_t*)Z + (size_t)rlo * NIN + t * 256 + jl; GAS bf16_t* zhi = (GAS bf16_t*)Z + (size_t)rhi * NIN + t * 256 + jl;
                        *(GAS u32x4*)zlo = pack8(qsv[0][0], qsv[0][1]); *(GAS u32x4*)(zlo + 128) = pack8(ksv[0][0], ksv[0][1]);
                        *(GAS u32x4*)zhi = pack8(qsv[1][0], qsv[1][1]); *(GAS u32x4*)(zhi + 128) = pack8(ksv[1][0], ksv[1][1]);
                        *(GAS u32x4*)((GAS bf16_t*)KST + (size_t)rlo * MIXW + t * 128 + jl) = pack8(ktv[0][0], ktv[0][1]);
                        *(GAS u32x4*)((GAS bf16_t*)KST + (size_t)rhi * MIXW + t * 128 + jl) = pack8(ktv[1][0], ktv[1][1]);
                        if (fr == 15) { GAS float* ap = (GAS float*)AUX + ((size_t)((tok0 >> 11) * NH + t) * 64 + ((tok0 & 2047) >> 5)) * 256 + jl;
                            *(GAS f32x4*)ap = erv[0]; *(GAS f32x4*)(ap + 4) = erv[1]; *(GAS f32x4*)(ap + 128) = dcv[0]; *(GAS f32x4*)(ap + 132) = dcv[1]; }
                    }
            } else {
                const float lg = __log2f(1.0f - exp2f(-5.0f - (float)t));
#pragma unroll
                for (int ai = 0; ai < 2; ++ai)
#pragma unroll
                    for (int m = 0; m < 4; ++m) { const int row = row0 + ai * 128 + m * 16; const float rs = tl[ai * 128 + m * 16];
                        const f32x4 cs = *(const GAS f32x4*)((const GAS float*)cosT + (size_t)row * 64 + (jl >> 1)), sn = *(const GAS f32x4*)((const GAS float*)sinT + (size_t)row * 64 + (jl >> 1));
                        const float cp1 = (float)(16 * (m & 1) + fr + 1), pw = exp2f(cp1 * lg), ipw = exp2f(-cp1 * lg);
                        const float qsc = rs * pw, ksc = rs * 0.08838834764831845f * ipw;
                        f32x4 q0, q1, k0, k1;
#pragma unroll
                        for (int i = 0; i < 4; ++i) {
                            const float a1 = acc[ai][0][m][0][i] * qsc, a2 = acc[ai][0][m][1][i] * qsc; q0[i] = a1 * cs[i] - a2 * sn[i]; q1[i] = a1 * sn[i] + a2 * cs[i];
                            const float b1 = acc[ai][1][m][0][i] * ksc, b2 = acc[ai][1][m][1][i] * ksc; k0[i] = b1 * cs[i] - b2 * sn[i]; k1[i] = b1 * sn[i] + b2 * cs[i];
                        }
                        GAS bf16_t* zp = (GAS bf16_t*)Z + (size_t)row * NIN + t * 256 + jl; *(GAS u32x4*)zp = pack8(q0, q1); *(GAS u32x4*)(zp + 128) = pack8(k0, k1); }
            }
        } else {
            const int mode = (t >= 9 && t < 12) ? (is_ret ? 2 : 1) : 0;
#pragma unroll
            for (int ai = 0; ai < 2; ++ai)
#pragma unroll
                for (int m = 0; m < 4; ++m) { const int row = row0 + ai * 128 + m * 16; const float rs = tl[ai * 128 + m * 16];
                    GAS bf16_t* zp = (GAS bf16_t*)Z + (size_t)row * NIN + t * 256 + jl;
#pragma unroll
                    for (int bj = 0; bj < 2; ++bj) { f32x4 v0 = acc[ai][bj][m][0] * rs, v1 = acc[ai][bj][m][1] * rs;
                        if (mode == 1) {
#pragma unroll
                            for (int i = 0; i < 4; ++i) { v0[i] = sigmoidf_(v0[i]); v1[i] = sigmoidf_(v1[i]); } }
                        else if (mode == 2) {
#pragma unroll
                            for (int i = 0; i < 4; ++i) { v0[i] = siluf_(v0[i]); v1[i] = siluf_(v1[i]); } }
                        *(GAS u32x4*)(zp + bj * 128) = pack8(v0, v1); } }
        }
    }
};
struct EpiRes {
    static constexpr bool PERM = true; static constexpr int MID_T = 0;
    const bf16_t* xin; bf16_t* xb; float* ssq;
    __device__ __forceinline__ void operator()(const f32x4 (&acc)[2][2][4][2], const Unit& u, int wr, int wc, int fr, int fq) const {
        const int row0 = u.pm * 256 + wr * 64 + fr, col0 = u.pn * 256 + wc * 32 + 8 * fq;
#pragma unroll
        for (int ai = 0; ai < 2; ++ai)
#pragma unroll
            for (int m = 0; m < 4; ++m) { const int row = row0 + ai * 128 + m * 16; const size_t off = (size_t)row * D + col0; float s = 0.f;
#pragma unroll
                for (int bj = 0; bj < 2; ++bj) {
                    const u32x4 r = *(const GAS u32x4*)((const GAS bf16_t*)xin + off + bj * 128);
                    f32x4 v0, v1;
                    v0[0] = bf2f(r.x & 0xffffu); v0[1] = bf2f(r.x >> 16); v0[2] = bf2f(r.y & 0xffffu); v0[3] = bf2f(r.y >> 16);
                    v1[0] = bf2f(r.z & 0xffffu); v1[1] = bf2f(r.z >> 16); v1[2] = bf2f(r.w & 0xffffu); v1[3] = bf2f(r.w >> 16);
                    v0 = v0 + acc[ai][bj][m][0]; v1 = v1 + acc[ai][bj][m][1];
                    *(GAS u32x4*)((GAS bf16_t*)xb + off + bj * 128) = pack8(v0, v1);
                    s += (v0[0] * v0[0] + v0[1] * v0[1]) + (v0[2] * v0[2] + v0[3] * v0[3]) + (v1[0] * v1[0] + v1[1] * v1[1]) + (v1[2] * v1[2] + v1[3] * v1[3]);
                }
                s += shfl_xor_l(s, fq * 16 + fr, 16); s += shfl_xor_l(s, fq * 16 + fr, 32);
                if (fq == 0) ((GAS float*)ssq)[(size_t)row * 16 + u.pn * 4 + wc] = s; }
    }
};
struct EpiResC {
    static constexpr bool PERM = true; static constexpr int MID_T = 12;
    EpiRes base; const float* ssqo;
    __device__ __forceinline__ void mid(f32x4 (&acc)[2][2][4][2], const Unit& u, int wr, int wc, int fr, int fq) const {
        if (!ssqo) return;
        const int row0 = u.pm * 256 + wr * 64 + fr;
#pragma unroll
        for (int ai = 0; ai < 2; ++ai)
#pragma unroll
            for (int m = 0; m < 4; ++m) { const int row = row0 + ai * 128 + m * 16;
                const GAS f32x4* sp = (const GAS f32x4*)((const GAS float*)ssqo + (size_t)row * 16); float tot = 0.f;
#pragma unroll
                for (int q4 = 0; q4 < (NH * NVS + 3) / 4; ++q4) { const f32x4 a = sp[q4];
#pragma unroll
                    for (int e = 0; e < 4; ++e) if (4 * q4 + e < NH * NVS) tot += a[e]; }
                const float rs = rsqrtf(tot * (1.0f / MIXW) + EPS);
#pragma unroll
                for (int bj = 0; bj < 2; ++bj)
#pragma unroll
                    for (int n = 0; n < 2; ++n) acc[ai][bj][m][n] = acc[ai][bj][m][n] * rs;
                asm volatile("" ::: "memory"); }
    }
    __device__ __forceinline__ void operator()(const f32x4 (&acc)[2][2][4][2], const Unit& u, int wr, int wc, int fr, int fq) const { base(acc, u, wr, wc, fr, fq); }
};
struct EpiFfn {
    static constexpr bool PERM = true; static constexpr int MID_T = 0;
    bf16_t* act; const float* ssq; LAS float* tab; int half;
    __device__ __forceinline__ void operator()(const f32x4 (&acc)[2][2][4][2], const Unit& u, int wr, int wc, int fr, int fq) const {
        const int hb = half < 0 ? 0 : 128 * half;
        const int row0 = u.pm * 256 + hb + wr * 64 + fr, jl = wc * 32 + 8 * fq;
        rstd_table(ssq, u.pm, tab, wr, wc, fr, fq);
        const LAS float* tl = tab + hb + wr * 64 + fr;
#pragma unroll
        for (int ai = 0; ai < 2; ++ai)
#pragma unroll
            for (int m = 0; m < 4; ++m) { if (ai == 1 && half >= 0) break; const int row = row0 + ai * 128 + m * 16; const float rs = tl[ai * 128 + m * 16];
                f32x4 v0, v1;
#pragma unroll
                for (int i = 0; i < 4; ++i) { v0[i] = siluf_(acc[ai][0][m][0][i] * rs) * (acc[ai][1][m][0][i] * rs); v1[i] = siluf_(acc[ai][0][m][1][i] * rs) * (acc[ai][1][m][1][i] * rs); }
                *(GAS u32x4*)((GAS bf16_t*)act + (size_t)row * DFF + u.pn * 128 + jl) = pack8(v0, v1); }
    }
};

#define XB_TMO      128
#define XB_XCNT(j)  (256  + 64 * (j))
#define XB_XSUB(j)  (1280 + 64 * (j))
#define XB_XGEN(j)  (2304 + 64 * (j))
#define XB_TOP      3328
#define XB_TOPGEN   3392
#define XCD_BAR_WORDS 3456
#define XB_SPIN_CAP (1u << 18)
__device__ __forceinline__ unsigned xb_ld(unsigned* p)              { return __hip_atomic_load(p, __ATOMIC_RELAXED, __HIP_MEMORY_SCOPE_AGENT); }
__device__ __forceinline__ unsigned xb_add(unsigned* p, unsigned v) { return __hip_atomic_fetch_add(p, v, __ATOMIC_RELAXED, __HIP_MEMORY_SCOPE_AGENT); }
__device__ __forceinline__ unsigned xb_xcc_id() { return (unsigned)__builtin_amdgcn_s_getreg((3 << 11) | 20) & 0xFu; }
#define XB_SPIN(cond, bar) do { unsigned _sp = 0; while (cond) { __builtin_amdgcn_s_sleep(1); \
    if ((++_sp & 255u) == 0u) { if (xb_ld(&(bar)[XB_TMO])) break; if (_sp > XB_SPIN_CAP) { atomicAdd(&(bar)[XB_TMO], 1u); break; } } } } while (0)
struct XcdBarrier { unsigned* bar; unsigned x; volatile LAS unsigned* st; };
__device__ __forceinline__ XcdBarrier xcd_barrier_post(unsigned* bar, volatile LAS unsigned* st) {
    XcdBarrier b; b.bar = bar; b.x = xb_xcc_id(); b.st = st;
    if (threadIdx.x == 0) st[2] = xb_add(&bar[XB_XCNT(b.x)], 1u);
    return b;
}
#define XB_LOC(j) (3456 + 64 * (j))
__device__ __forceinline__ void xcc_barrier(const XcdBarrier& b, unsigned n, bool leader) {
    asm volatile("s_waitcnt vmcnt(0)" ::: "memory");
    __syncthreads();
    if (leader) {
        unsigned* bar = b.bar; unsigned* cnt = &bar[XB_LOC(b.x)];
        __builtin_amdgcn_s_waitcnt(0);
        const unsigned old = xb_add(cnt, 1u), target = (old / n + 1u) * n;
        XB_SPIN(xb_ld(cnt) < target, bar);
        __builtin_amdgcn_fence(__ATOMIC_ACQUIRE, "agent");
        asm volatile("s_waitcnt vmcnt(0)" ::: "memory");
    }
    __syncthreads();
}
#define XB_CVX(k, j) (4608 + 64 * (16 * (k) + (j)))
#define XB_CVG(k)    (6656 + 64 * (k))
#define XB_MKV(j)    (6912 + 64 * (j))
__device__ __forceinline__ void cv_signal(const XcdBarrier& b, int k, unsigned nconv, bool leader) {
    asm volatile("s_waitcnt vmcnt(0)" ::: "memory");
    __syncthreads();
    if (leader) {
        __builtin_amdgcn_s_waitcnt(0);
        if (xb_add(&b.bar[XB_CVX(k, b.x)], 1u) + 1u == nconv) {
            __builtin_amdgcn_fence(__ATOMIC_RELEASE, "agent");
            asm volatile("s_waitcnt vmcnt(0)" ::: "memory");
            xb_add(&b.bar[XB_CVG(k)], 1u);
        }
    }
}
__device__ __forceinline__ void cv_wait(const XcdBarrier& b, int k, unsigned nx, bool leader) {
    if (leader) {
        unsigned* bar = b.bar;
        XB_SPIN(xb_ld(&bar[XB_CVG(k)]) < nx, bar);
        __builtin_amdgcn_fence(__ATOMIC_ACQUIRE, "agent");
        asm volatile("s_waitcnt vmcnt(0)" ::: "memory");
    }
    __syncthreads();
}
__device__ __forceinline__ void xcd_barrier_complete(unsigned* bar, unsigned x, unsigned& nloc, unsigned& nx) {
    const unsigned G = gridDim.x * gridDim.y * gridDim.z;
    unsigned sum, cnt, mine, sp = 0u;
    for (;;) {
        sum = 0u; cnt = 0u; mine = 0u;
#pragma unroll
        for (unsigned j = 0; j < 16; ++j) { const unsigned c = xb_ld(&bar[XB_XCNT(j)]); sum += c; cnt += (c > 0u) ? 1u : 0u; mine = (j == x) ? c : mine; }
        if (sum == G) break;
        __builtin_amdgcn_s_sleep(1);
        if ((++sp & 255u) == 0u) { if (xb_ld(&bar[XB_TMO])) break; if (sp > XB_SPIN_CAP) { atomicAdd(&bar[XB_TMO], 1u); break; } }
    }
    nloc = mine > 0u ? mine : 1u; nx = cnt > 0u ? cnt : 1u;
}
__device__ __forceinline__ void xcd_barrier(const XcdBarrier& b, bool leader) {
    asm volatile("s_waitcnt vmcnt(0)" ::: "memory");
    __syncthreads();
    if (leader) {
        unsigned* bar = b.bar;
        __builtin_amdgcn_s_waitcnt(0);
        unsigned nloc = b.st[0], nx = b.st[1];
        if (nloc == 0u) { xcd_barrier_complete(bar, b.x, nloc, nx); b.st[0] = nloc; b.st[1] = nx; }
        const unsigned old = xb_add(&bar[XB_XSUB(b.x)], 1u);
        const unsigned gen = old / nloc;
        if (old + 1u == (gen + 1u) * nloc) {
            __builtin_amdgcn_fence(__ATOMIC_RELEASE, "agent");
            asm volatile("s_waitcnt vmcnt(0)" ::: "memory");
            const unsigned og = xb_add(&bar[XB_TOP], 1u);
            const unsigned tg = og / nx;
            if (og + 1u == (tg + 1u) * nx) xb_add(&bar[XB_TOPGEN], 1u);
            else XB_SPIN(xb_ld(&bar[XB_TOPGEN]) == tg, bar);
            __builtin_amdgcn_fence(__ATOMIC_ACQUIRE, "agent");
            xb_add(&bar[XB_XGEN(b.x)], 1u);
            asm volatile("s_waitcnt vmcnt(0)" ::: "memory");
        } else {
            XB_SPIN(xb_ld(&bar[XB_XGEN(b.x)]) == gen, bar);
            __builtin_amdgcn_fence(__ATOMIC_ACQUIRE, "agent");
            asm volatile("s_waitcnt vmcnt(0)" ::: "memory");
        }
    }
    __syncthreads();
}

constexpr int RING_BYTES = 131072, LDSCTL_OFF = RING_BYTES, MISC_OFF = LDSCTL_OFF + 320, LDS_BYTES = 147456;
constexpr int NWAVES = 8;

__device__ __forceinline__ int misc_rd(LAS unsigned char* lds, int idx) { unsigned off = (unsigned)(MISC_OFF + 4 * idx); asm volatile("" : "+v"(off)); return __builtin_amdgcn_readfirstlane((int)*(volatile LAS unsigned*)(lds + off)); }
struct Args { const float* in[15]; float* out; unsigned char* ws; int ph_lo, ph_hi; };

__device__ __forceinline__ int win_srccol(int j) {
    const int t = j >> 8;
    if (t >= 6) return j;
    const int jj = j & 255, half = jj >> 7, p = jj & 127, d = 4 * (p >> 3) + (p & 3) + 64 * ((p >> 2) & 1);
    return half * MIXW + t * 128 + d;
}
__device__ __forceinline__ int wfi_srccol(int j) { const int t = j >> 8, jj = j & 255; return (jj < 128 ? 0 : DFF) + t * 128 + (jj & 127); }
struct TItem { const GAS float* W; GAS bf16_t* WT; const GAS float* kscale; int K, N, ndst, kind, nscale, item; };
__device__ __forceinline__ TItem titem_decode(const Args& a, unsigned char* ws, int it) {
    constexpr int I0 = 16 * (NIN / 32), I1 = 16 * 32, I2 = 16 * (NFI / 32), I3 = (DFF / 64) * 32, I4 = 16 * 16, IL = I0 + I1 + I2 + I3 + I4;
    const int l = it / IL; int r = it % IL; TItem t;
    if (r < I0) { t.W = (const GAS float*)a.in[4] + (size_t)l * D * NIN; t.WT = (GAS bf16_t*)(ws + WS_WIN) + (size_t)l * NIN * D; t.kscale = (const GAS float*)a.in[3] + l * D; t.K = D; t.N = NIN; t.ndst = NIN; t.kind = 0; t.nscale = D; t.item = r; return t; } r -= I0;
    if (r < I1) { t.W = (const GAS float*)a.in[5] + (size_t)l * D * D; t.WT = (GAS bf16_t*)(ws + WS_WOUT) + (size_t)l * D * D; t.kscale = (const GAS float*)((l & 1) ? a.in[10] : a.in[9]) + (l >> 1) * MIXW; t.K = D; t.N = D; t.ndst = D; t.kind = 1; t.nscale = MIXW; t.item = r; return t; } r -= I1;
    if (r < I2) { t.W = (const GAS float*)a.in[12] + (size_t)l * D * NFI; t.WT = (GAS bf16_t*)(ws + WS_WFI) + (size_t)l * NFI * D; t.kscale = (const GAS float*)a.in[11] + l * D; t.K = D; t.N = NFI; t.ndst = NFI; t.kind = 2; t.nscale = D; t.item = r; return t; } r -= I2;
    if (r < I3) { t.W = (const GAS float*)a.in[13] + (size_t)l * DFF * D; t.WT = (GAS bf16_t*)(ws + WS_WFO) + (size_t)l * D * DFF; t.kscale = (const GAS float*)a.in[13]; t.K = DFF; t.N = D; t.ndst = D; t.kind = 3; t.nscale = 0; t.item = r; return t; } r -= I3;
    t.W = (const GAS float*)a.in[7] + (size_t)l * D * 512; t.WT = (GAS bf16_t*)(ws + WS_WM) + (size_t)l * 512 * D; t.kscale = (const GAS float*)a.in[6] + l * D; t.K = D; t.N = 512; t.ndst = 512; t.kind = 4; t.nscale = D; t.item = r; return t;
}
__device__ __forceinline__ void titem_load(const TItem& t, f32x4 (&v)[8], int lane) {
    const int nblk = t.ndst / 32, kb = t.item / nblk, nb = t.item % nblk, k0 = 64 * kb, n0 = 32 * nb, kq = lane >> 3, jd = n0 + 4 * (lane & 7);
    const int sc = t.kind == 0 ? win_srccol(jd) : (t.kind == 2 ? wfi_srccol(jd) : jd);
#pragma unroll
    for (int i = 0; i < 8; ++i) v[i] = *(const GAS f32x4*)(t.W + (size_t)(k0 + 8 * i + kq) * t.N + sc);
}
__device__ __forceinline__ void titem_store(const TItem& t, const f32x4 (&v)[8], LAS float* scr, int lane) {
    const int nblk = t.ndst / 32, kb = t.item / nblk, nb = t.item % nblk, k0 = 64 * kb, n0 = 32 * nb, kq = lane >> 3, nq = lane & 7;
#pragma unroll
    for (int i = 0; i < 8; ++i)
#pragma unroll
        for (int e = 0; e < 4; ++e) scr[(8 * i + kq) * 33 + 4 * nq + e] = v[i][e];
    const int c = lane & 7;
    f32x4 s0 = (f32x4){1.f, 1.f, 1.f, 1.f}, s1 = s0;
    if (k0 + 8 * c < t.nscale) { s0 = *(const GAS f32x4*)(t.kscale + k0 + 8 * c); s1 = *(const GAS f32x4*)(t.kscale + k0 + 8 * c + 4); }
    asm volatile("s_waitcnt lgkmcnt(0)" ::: "memory");
#pragma unroll
    for (int j = 0; j < 4; ++j) { const int n = (lane >> 3) + 8 * j; const LAS float* s = scr + (8 * c) * 33 + n;
        u32x4 o; o.x = pk2(s[0 * 33] * s0[0], s[1 * 33] * s0[1]); o.y = pk2(s[2 * 33] * s0[2], s[3 * 33] * s0[3]); o.z = pk2(s[4 * 33] * s1[0], s[5 * 33] * s1[1]); o.w = pk2(s[6 * 33] * s1[2], s[7 * 33] * s1[3]);
        *(GAS u32x4*)(t.WT + (size_t)(n0 + n) * t.K + k0 + 8 * c) = o; }
    asm volatile("s_waitcnt lgkmcnt(0)" ::: "memory");
}

constexpr int TITEMS_PER_LAYER = 16 * (NIN / 32) + 16 * 32 + 16 * (NFI / 32) + (DFF / 64) * 32 + 16 * 16;
__device__ __forceinline__ void convert_weights(const Args& a, unsigned char* ws, LAS float* scr, int it0, int it1, int w, int nw, int lane, int off = 0, int mul = 1) {
    f32x4 va[8], vb[8];
    nw *= mul;
    int it = it0 + off + mul * w;
    if (it < it1) { const TItem t = titem_decode(a, ws, it); titem_load(t, va, lane); }
    while (it < it1) {
        const int itn = it + nw;
        if (itn < it1) { const TItem t = titem_decode(a, ws, itn); titem_load(t, vb, lane); }
        { const TItem t = titem_decode(a, ws, it); titem_store(t, va, scr, lane); }
        it = itn;
        if (it >= it1) break;
        const int itn2 = it + nw;
        if (itn2 < it1) { const TItem t = titem_decode(a, ws, itn2); titem_load(t, va, lane); }
        { const TItem t = titem_decode(a, ws, it); titem_store(t, vb, scr, lane); }
        it = itn2;
    }
}

__device__ __forceinline__ void p0_prologue(const Args& a, unsigned char* ws, LAS unsigned char* lds, int gw, int NGW, int wave, int lane) {
    LAS float* scr = (LAS float*)(lds + wave * 16384);
    convert_weights(a, ws, scr, 0, 16 * (NIN / 32), gw, NGW, lane);
    for (int l = 0; l < DEPTH; ++l) convert_weights(a, ws, scr, l * TITEMS_PER_LAYER + TITEMS_PER_LAYER - 256, (l + 1) * TITEMS_PER_LAYER, gw, NGW, lane);
    for (int m = gw; m < M; m += NGW) {
        const f32x4* xr = (const f32x4*)(a.in[0] + (size_t)m * D) + lane; f32x4 v[4]; float s = 0.f;
#pragma unroll
        for (int j = 0; j < 4; ++j) { v[j] = xr[64 * j]; s += (v[j].x * v[j].x + v[j].y * v[j].y) + (v[j].z * v[j].z + v[j].w * v[j].w); }
        s = wave_sum(s, lane);
        u32x2* o8 = (u32x2*)((bf16_t*)(ws + WS_XB) + (size_t)m * D) + lane;
#pragma unroll
        for (int j = 0; j < 4; ++j) { u32x2 w; w.x = pk2(v[j].x, v[j].y); w.y = pk2(v[j].z, v[j].w); o8[64 * j] = w; }
        if (lane < 16) ((float*)(ws + WS_SSQA))[(size_t)m * 16 + lane] = lane == 0 ? s : 0.f;
    }
    for (int m = gw; m < MROWS; m += NGW) {
        const f32x4* xr = (const f32x4*)(a.in[1] + (size_t)m * D) + lane; f32x4 v[4]; float s = 0.f;
#pragma unroll
        for (int j = 0; j < 4; ++j) { v[j] = xr[64 * j]; s += (v[j].x * v[j].x + v[j].y * v[j].y) + (v[j].z * v[j].z + v[j].w * v[j].w); }
        const float rs = rsqrtf(wave_sum(s, lane) * (1.0f / D) + EPS);
        u32x2* o8 = (u32x2*)((bf16_t*)(ws + WS_MEMB) + (size_t)m * D) + lane;
#pragma unroll
        for (int j = 0; j < 4; ++j) { u32x2 w; w.x = pk2(v[j].x * rs, v[j].y * rs); w.y = pk2(v[j].z * rs, v[j].w * rs); o8[64 * j] = w; }
    }
    {   const double invf = exp(-9.210340371976184 * ((double)lane / 63.0));
        for (int m = gw; m < M; m += NGW) {
            const double ang = (double)((const GAS int*)a.in[2])[m] * invf;
            const double kr = rint(ang * 0.15915494309189535);
            const float r = (float)fma(-kr, 1.2246467991473532e-16 * 2.0, fma(-kr, 6.283185307179586, ang));
            float sn, cs; sincosf(r, &sn, &cs);
            ((GAS float*)(ws + WS_COS))[(size_t)m * 64 + lane] = cs;
            ((GAS float*)(ws + WS_SIN))[(size_t)m * 64 + lane] = sn;
        }
    }
    for (int c = gw * 64 + lane; c < MIXW; c += NGW * 64) {
        const float l0 = a.in[8][c], l1 = a.in[8][MIXW + c]; const float mx = fmaxf(l0, l1), e0 = expf(l0 - mx), e1 = expf(l1 - mx);
        ((float*)(ws + WS_LB))[c] = 0.f; ((float*)(ws + WS_LB))[MIXW + c] = e1 / (e0 + e1);
    }
}

typedef float f32x16 __attribute__((ext_vector_type(16)));
constexpr int SC_QS = 0, SC_KS = 8704, SC_KST = 17408, SC_V = 27648, SC_P = 37888, SC_AUX = 40448, SC_OUT = 41472, SC_SSQ = 50176, SC_GATE = 50688, SC_BUF = 50688 + 32 * VPR * 16;
constexpr int PQ = 272, PT = 320;
constexpr int NCHUNK = SEQ / 32;
typedef const GAS bf16_t* gbf;
struct HRegs { u32x4 x0[8], x1[8]; float aux[2]; };
__device__ __forceinline__ bf16x8 as_bf16x8(u32x4 v) { return __builtin_bit_cast(bf16x8, v); }

struct StLane { unsigned g0, g1, gg, ga, l0, l1, lg, la, sk; };
template <int IS_RET>
__device__ __forceinline__ void stager_load(HRegs& R, gbf Z, gbf KST, const GAS float* AUXG, int b, int h, int unit, int sw, const StLane& L, int chunk) {
    chunk = chunk < NCHUNK ? chunk : NCHUNK - 1;
    const size_t tok0 = (size_t)b * SEQ + chunk * 32;
    const int p0 = (sw == 0 || IS_RET) ? NIN : MIXW;
    const GAS char* s0 = (const GAS char*)(sw == 0 ? Z + h * 256 : (IS_RET ? Z + h * 256 + 128 : KST + h * 128)) + tok0 * p0 * 2;
    const GAS char* s1 = (const GAS char*)(sw == 0 ? Z + h * 256 + 128 : Z + 1536 + h * 128) + tok0 * NIN * 2;
#pragma unroll
    for (int i = 0; i < 8; ++i) R.x0[i] = *(const GAS u32x4*)(s0 + (size_t)(4 * i) * p0 * 2 + L.g0);
    if (sw == 0) {
#pragma unroll
        for (int i = 0; i < 8; ++i) R.x1[i] = *(const GAS u32x4*)(s1 + 32 * i + L.g1);
    } else {
#pragma unroll
        for (int i = 0; i < 8 / NVS; ++i) R.x1[i] = *(const GAS u32x4*)(s1 + (size_t)(4 * NVS * i) * NIN * 2 + L.g1);
    }
    if (!IS_RET) { const GAS char* ag = (const GAS char*)(AUXG + ((size_t)unit * 64 + chunk) * 256 + 128 * sw); R.aux[0] = *(const GAS float*)(ag + L.ga); R.aux[1] = *(const GAS float*)(ag + 256 + L.ga); }
}
template <int IS_RET>
__device__ __forceinline__ void stager_stage(const HRegs& R, LAS unsigned char* buf, LAS unsigned char* gbuf, int sw, const StLane& L) {
    const int o0 = sw == 0 ? SC_QS : SC_KST, o1 = sw == 0 ? SC_KS : SC_V, pit = sw == 0 ? PQ : PT;
    LAS unsigned char* d0 = buf + o0 + L.l0; LAS unsigned char* d1 = buf + o1 + L.l1;
#pragma unroll
    for (int i = 0; i < 8; ++i) *(LAS u32x4*)(d0 + 4 * i * pit) = R.x0[i];
    if (sw != 0) {
#pragma unroll
        for (int i = 0; i < 8 / NVS; ++i) *(LAS u32x4*)(d1 + 4 * NVS * i * PT) = R.x1[i];
    }
    if (!IS_RET) { LAS unsigned char* al = buf + SC_AUX + 512 * sw + L.la; *(LAS float*)al = R.aux[0]; *(LAS float*)(al + 256) = R.aux[1]; }
}
__device__ __forceinline__ void scores_stage(const HRegs& R, LAS unsigned char* buf, const StLane& L, int l31, int hh) {
    f32x16 d;
#pragma unroll
    for (int r = 0; r < 16; ++r) d[r] = 0.f;
    u32x4 qf[8];
    {   const unsigned aq = (unsigned)(size_t)(buf + SC_QS) + L.sk;
        asm volatile(
            "ds_read_b128 %0, %8 offset:0\n\tds_read_b128 %1, %8 offset:32\n\tds_read_b128 %2, %8 offset:64\n\tds_read_b128 %3, %8 offset:96\n\t"
            "ds_read_b128 %4, %8 offset:128\n\tds_read_b128 %5, %8 offset:160\n\tds_read_b128 %6, %8 offset:192\n\tds_read_b128 %7, %8 offset:224\n\t"
            "s_waitcnt lgkmcnt(0)"
            : "=&v"(qf[0]), "=&v"(qf[1]), "=&v"(qf[2]), "=&v"(qf[3]), "=&v"(qf[4]), "=&v"(qf[5]), "=&v"(qf[6]), "=&v"(qf[7])
            : "v"(aq) : "memory");
        __builtin_amdgcn_sched_barrier(0);
    }
#pragma unroll
    for (int kk = 0; kk < 8; ++kk) d = __builtin_amdgcn_mfma_f32_32x32x16_bf16(as_bf16x8(R.x1[kk]), as_bf16x8(qf[kk]), d, 0, 0, 0);
#pragma unroll
    for (int q = 0; q < 4; ++q) { float v4[4];
#pragma unroll
        for (int i = 0; i < 4; ++i) { const int srow = 8 * q + 4 * hh + i; v4[i] = (srow <= l31) ? d[4 * q + i] : 0.f; }
        u32x2 w; w.x = pg8::cvt_pk_bf16(v4[0], v4[1]); w.y = pg8::cvt_pk_bf16(v4[2], v4[3]);
        *(LAS u32x2*)(buf + SC_P + l31 * 80 + (8 * q + 4 * hh) * 2) = w; }
}
struct FinLane { unsigned lo, ls, go, gs, gz; };
constexpr int FPT = 32 * VPR / 64;
template <int IS_RET>
__device__ __forceinline__ void gate_load(u32x4 (&g)[FPT], gbf Z, int b, int h, const FinLane& L, int chunk) {
    chunk = chunk < NCHUNK ? chunk : NCHUNK - 1;
    const GAS char* sg = (const GAS char*)(Z + 2304 + h * 128) + ((size_t)b * SEQ + chunk * 32) * NIN * 2;
#pragma unroll
    for (int i = 0; i < FPT; ++i) g[i] = *(const GAS u32x4*)(sg + (size_t)(64 / VPR * i) * NIN * 2 + L.gz);
}
__device__ __forceinline__ void gate_stage(const u32x4 (&g)[FPT], LAS unsigned char* buf, int lane) {
#pragma unroll
    for (int i = 0; i < FPT; ++i) *(LAS u32x4*)(buf + SC_GATE + (lane + 64 * i) * 16) = g[i];
}
template <int IS_RET>
__device__ __forceinline__ void fin_store(LAS unsigned char* buf, GAS bf16_t* CAT, GAS float* SSQO, int b, int h, int vh, const FinLane& L, int lane, bool first, int chunk) {
    const size_t tok0 = (size_t)b * SEQ + chunk * 32;
    GAS char* cg = (GAS char*)(CAT + tok0 * D + h * 128); GAS char* sgp = (GAS char*)(SSQO + tok0 * 16 + h * NVS + vh);
#pragma unroll
    for (int i = 0; i < FPT; ++i) {
        const u32x2 lo = *(const LAS u32x2*)(buf + SC_OUT + (64 / VPR) * i * PQ + L.lo), hi = *(const LAS u32x2*)(buf + SC_OUT + (64 / VPR) * i * PQ + 8 + L.lo);
        const LAS unsigned char* sq = buf + SC_SSQ + (64 / VPR) * 4 * i + L.ls;
        float ssum = *(const LAS float*)sq;
#pragma unroll
        for (int w = 1; w < 4 / NVS; ++w) ssum += *(const LAS float*)(sq + 128 * w);
        const float sc = (IS_RET && NVS == 1) ? rsqrtf(ssum * (1.0f / HD) + EPS) : 1.0f;
        const u32x4 gt = *(const LAS u32x4*)(buf + SC_GATE + (lane + 64 * i) * 16);
        const unsigned ow[4] = {lo.x, lo.y, hi.x, hi.y}; u32x4 out;
#pragma unroll
        for (int j = 0; j < 4; ++j) out[j] = pg8::cvt_pk_bf16(__uint_as_float(ow[j] << 16) * sc * __uint_as_float(gt[j] << 16), __uint_as_float(ow[j] & 0xffff0000u) * sc * __uint_as_float(gt[j] & 0xffff0000u));
        *(GAS u32x4*)(cg + (size_t)(64 / VPR * i) * D * 2 + L.go) = out;
        if ((!IS_RET || NVS > 1) && first) *(GAS float*)(sgp + (size_t)(64 / VPR * i) * 64 + L.gs) = ssum; }
}
__device__ __forceinline__ void norm_rows(unsigned char* ws, int row0, int row1, int gw, int NGW, int lane) {
    GAS bf16_t* CAT = (GAS bf16_t*)(ws + WS_CAT); const GAS float* SSQO = (const GAS float*)(ws + WS_SSQO);
    for (int row = row0 + gw; row < row1; row += NGW) {
#pragma unroll
        for (int j = 0; j < 3; ++j) { const int e = lane * 4 + 256 * j, h = e >> 7;
            float ssum = 0.f;
#pragma unroll
            for (int q = 0; q < NVS; ++q) ssum += SSQO[(size_t)row * 16 + h * NVS + q];
            const float sc = rsqrtf(ssum * (1.0f / HD) + EPS);
            GAS u32x2* p = (GAS u32x2*)(CAT + (size_t)row * D + e); const u32x2 w = *p; u32x2 o;
            o.x = pg8::cvt_pk_bf16(__uint_as_float(w.x << 16) * sc, __uint_as_float(w.x & 0xffff0000u) * sc); o.y = pg8::cvt_pk_bf16(__uint_as_float(w.y << 16) * sc, __uint_as_float(w.y & 0xffff0000u) * sc);
            *p = o; }
    }
}
#define TRR(dst, areg, off) "ds_read_b64_tr_b16 " dst ", " areg " offset:" #off "\n\t"
struct MLane { unsigned av, ak, aq, aaux, ap, aout, assq; };
template <int IS_RET, int PAR>
__device__ __forceinline__ void mfma_step(f32x16 (&S)[4], const MLane& A, int lane, float g32) {
    constexpr unsigned PB = PAR * SC_BUF;
    u32x2 v00, v01, v10, v11, k[4][2][2]; u32x4 qf[4][2];
    const unsigned av = A.av + PB, ak = A.ak + PB, aq = A.aq + PB;
    asm volatile(
        "ds_read_b128 %0, %8 offset:0\n\tds_read_b128 %1, %8 offset:32\n\tds_read_b128 %2, %8 offset:64\n\tds_read_b128 %3, %8 offset:96\n\t"
        "ds_read_b128 %4, %8 offset:128\n\tds_read_b128 %5, %8 offset:160\n\tds_read_b128 %6, %8 offset:192\n\tds_read_b128 %7, %8 offset:224"
        : "=&v"(qf[0][0]), "=&v"(qf[0][1]), "=&v"(qf[1][0]), "=&v"(qf[1][1]), "=&v"(qf[2][0]), "=&v"(qf[2][1]), "=&v"(qf[3][0]), "=&v"(qf[3][1])
        : "v"(aq) : "memory");
    asm volatile(
        TRR("%0", "%12", 0) TRR("%1", "%12", 1280) TRR("%2", "%12", 5120) TRR("%3", "%12", 6400)
        TRR("%4", "%13", 0) TRR("%5", "%13", 1280) TRR("%6", "%13", 5120) TRR("%7", "%13", 6400)
        TRR("%8", "%13", 64) TRR("%9", "%13", 1344) TRR("%10", "%13", 5184) TRR("%11", "%13", 6464)
        : "=&v"(v00), "=&v"(v01), "=&v"(v10), "=&v"(v11),
          "=&v"(k[0][0][0]), "=&v"(k[0][0][1]), "=&v"(k[0][1][0]), "=&v"(k[0][1][1]), "=&v"(k[1][0][0]), "=&v"(k[1][0][1]), "=&v"(k[1][1][0]), "=&v"(k[1][1][1])
        : "v"(av), "v"(ak) : "memory");
    const LAS unsigned char* auxp = (const LAS unsigned char*)(size_t)(A.aaux + PB);
    bf16x8 sf[4][2];
#pragma unroll
    for (int kt = 0; kt < 4; ++kt) { f32x16 t = S[kt];
        if (!IS_RET) {
#pragma unroll
            for (int q = 0; q < 4; ++q) { const f32x4 e = *(const LAS f32x4*)(auxp + (32 * kt + 16 * (q >> 1) + 4 * (q & 1)) * 4);
#pragma unroll
                for (int i = 0; i < 4; ++i) t[4 * q + i] *= e[i]; } }
#pragma unroll
        for (int s2 = 0; s2 < 2; ++s2) { u32x4 pk;
#pragma unroll
            for (int j = 0; j < 4; ++j) pk[j] = pg8::cvt_pk_bf16(t[8 * s2 + 2 * j], t[8 * s2 + 2 * j + 1]);
            sf[kt][s2] = as_bf16x8(pk); } }
    asm volatile("s_waitcnt lgkmcnt(12)" : "+v"(qf[0][0]), "+v"(qf[0][1]), "+v"(qf[1][0]), "+v"(qf[1][1]), "+v"(qf[2][0]), "+v"(qf[2][1]), "+v"(qf[3][0]), "+v"(qf[3][1]) :: "memory");
    asm volatile(
        TRR("%0", "%8", 128) TRR("%1", "%8", 1408) TRR("%2", "%8", 5248) TRR("%3", "%8", 6528)
        TRR("%4", "%8", 192) TRR("%5", "%8", 1472) TRR("%6", "%8", 5312) TRR("%7", "%8", 6592)
        : "=&v"(k[2][0][0]), "=&v"(k[2][0][1]), "=&v"(k[2][1][0]), "=&v"(k[2][1][1]), "=&v"(k[3][0][0]), "=&v"(k[3][0][1]), "=&v"(k[3][1][0]), "=&v"(k[3][1][1])
        : "v"(ak) : "memory");
    __builtin_amdgcn_sched_barrier(0);
    f32x16 o;
#pragma unroll
    for (int r = 0; r < 16; ++r) o[r] = 0.f;
#pragma unroll
    for (int kt = 0; kt < 4; ++kt)
#pragma unroll
        for (int s2 = 0; s2 < 2; ++s2) o = __builtin_amdgcn_mfma_f32_32x32x16_bf16(sf[kt][s2], as_bf16x8(qf[kt][s2]), o, 0, 0, 0);
    __builtin_amdgcn_sched_barrier(0);
    asm volatile("s_waitcnt lgkmcnt(0)" : "+v"(v00), "+v"(v01), "+v"(v10), "+v"(v11),
          "+v"(k[0][0][0]), "+v"(k[0][0][1]), "+v"(k[0][1][0]), "+v"(k[0][1][1]), "+v"(k[1][0][0]), "+v"(k[1][0][1]), "+v"(k[1][1][0]), "+v"(k[1][1][1]),
          "+v"(k[2][0][0]), "+v"(k[2][0][1]), "+v"(k[2][1][0]), "+v"(k[2][1][1]), "+v"(k[3][0][0]), "+v"(k[3][0][1]), "+v"(k[3][1][0]), "+v"(k[3][1][1]) :: "memory");
    __builtin_amdgcn_sched_barrier(0);
    const bf16x8 vt[2] = {as_bf16x8((u32x4){v00.x, v00.y, v01.x, v01.y}), as_bf16x8((u32x4){v10.x, v10.y, v11.x, v11.y})};
    const LAS unsigned char* pp = (const LAS unsigned char*)(size_t)(A.ap + PB);
#pragma unroll
    for (int kk = 0; kk < 2; ++kk) { const bf16x8 pf = *(const LAS bf16x8*)(pp + 32 * kk);
        o = __builtin_amdgcn_mfma_f32_32x32x16_bf16(vt[kk], pf, o, 0, 0, 0); }
#pragma unroll
    for (int kt = 0; kt < 4; ++kt) {
        if (!IS_RET) {
#pragma unroll
            for (int q = 0; q < 4; ++q) { const f32x4 e = *(const LAS f32x4*)(auxp + 512 + (32 * kt + 16 * (q >> 1) + 4 * (q & 1)) * 4);
#pragma unroll
                for (int i = 0; i < 4; ++i) S[kt][4 * q + i] *= e[i]; } }
#pragma unroll
        for (int kk = 0; kk < 2; ++kk) S[kt] = __builtin_amdgcn_mfma_f32_32x32x16_bf16(as_bf16x8((u32x4){k[kt][kk][0].x, k[kt][kk][0].y, k[kt][kk][1].x, k[kt][kk][1].y}), vt[kk], S[kt], 0, 0, 0);
        if (IS_RET) S[kt] = S[kt] * g32;
    }
    float ss = 0.f;
#pragma unroll
    for (int r = 0; r < 16; ++r) ss += o[r] * o[r];
    ss += shfl_xor_l(ss, lane, 32);
    if (lane < 32) *(LAS float*)(size_t)(A.assq + PB) = ss;
    LAS unsigned char* op = (LAS unsigned char*)(size_t)(A.aout + PB);
#pragma unroll
    for (int q = 0; q < 4; ++q) { u32x2 wv; wv.x = pg8::cvt_pk_bf16(o[4 * q], o[4 * q + 1]); wv.y = pg8::cvt_pk_bf16(o[4 * q + 2], o[4 * q + 3]);
        *(LAS u32x2*)(op + 16 * q) = wv; }
}
template <int IS_RET, int VAR>
__device__ __forceinline__ void scan2_unit(unsigned char* ws, LAS unsigned char* lds, int unit, int tid) {
    constexpr bool MF_ON = VAR == 0 || ((VAR & 16) && (VAR & 1)), ST_ON = VAR == 0 || ((VAR & 16) && (VAR & 2)), FI_ON = VAR == 0 || ((VAR & 16) && (VAR & 4)), ST_LD = ST_ON && !(VAR & 64), ST_ST = ST_ON && !(VAR & 32);
    gbf Z = (gbf)(ws + WS_Z); gbf KST = (gbf)(ws + WS_KST); const GAS float* AUXG = (const GAS float*)(ws + WS_AUX);
    GAS bf16_t* CAT = (GAS bf16_t*)(ws + WS_CAT); GAS float* SSQO = (GAS float*)(ws + WS_SSQO);
    const int b = unit / (NH * NVS), h = (unit / NVS) % NH, vh = unit % NVS, hu = b * NH + h, wave = __builtin_amdgcn_readfirstlane(tid >> 6); int lane = tid & 63;
    const float g32 = exp2f(32.0f * __log2f(1.0f - exp2f(-5.0f - (float)h)));
    __syncthreads();
    static_assert(NVS == 2, "wave roles below are written for two value slices per head");
    if (wave >= 6) {
        __syncthreads();
        for (int n = 0; n < NCHUNK; ++n) __syncthreads();
    } else if (wave < 2) {
        asm volatile("" : "+v"(lane));
        const int l31 = lane & 31, hh = lane >> 5, vs = (128 / NVS) * vh + 32 * wave;
        const unsigned base = (unsigned)(size_t)lds, trl = (unsigned)((8 * hh + ((lane & 15) >> 2)) * PT + (16 * ((lane >> 4) & 1) + 4 * (lane & 3)) * 2);
        const int psw = ((lane & 3) == 1) ? 2 : (((lane & 3) == 2) ? 1 : (lane & 3));
        const unsigned trk = (unsigned)((8 * hh + ((lane & 15) >> 2)) * PT + (16 * ((lane >> 4) & 1) + 4 * psw) * 2);
        MLane A;
        A.av = base + SC_V + trl + vs * 2; A.ak = base + SC_KST + trk; A.aq = base + SC_QS + l31 * PQ + 16 * hh; A.aaux = base + SC_AUX + 32 * hh; A.ap = base + SC_P + l31 * 80 + 16 * hh;
        A.aout = base + SC_OUT + l31 * PQ + (vs + 4 * hh) * 2; A.assq = base + SC_SSQ + (wave * 32 + l31) * 4;
        asm volatile("" : "+v"(A.av), "+v"(A.ak), "+v"(A.aq), "+v"(A.aaux), "+v"(A.ap), "+v"(A.aout), "+v"(A.assq));
        f32x16 S[4];
#pragma unroll
        for (int kt = 0; kt < 4; ++kt)
#pragma unroll
            for (int r = 0; r < 16; ++r) S[kt][r] = 0.f;
        __syncthreads();
        for (int n = 0; n < NCHUNK; n += 2) {
            if (MF_ON) mfma_step<IS_RET, 0>(S, A, lane, g32);
            __syncthreads();
            if (MF_ON) mfma_step<IS_RET, 1>(S, A, lane, g32);
            __syncthreads();
        }
        if (!MF_ON) asm volatile("" :: "v"(S[0][0]));
    } else if (wave < 4) {
        const int sw = wave - 2;
        if (!ST_ON) { __syncthreads(); for (int n = 0; n < NCHUNK; ++n) __syncthreads(); }
        else {
        asm volatile("" : "+v"(lane));
        const int l31 = lane & 31, hh = lane >> 5, r4 = lane >> 4, c16 = lane & 15, p0 = (sw == 0 || IS_RET) ? NIN : MIXW;
        StLane L;
        L.g0 = (unsigned)((r4 * p0 + 8 * c16) * 2); L.gg = 0; L.ga = (unsigned)(lane * 4);
        L.l0 = (unsigned)(r4 * (sw == 0 ? PQ : PT) + 16 * c16); L.lg = (unsigned)(lane * 16); L.la = (unsigned)(lane * 4); L.sk = (unsigned)(l31 * PQ + 16 * hh);
        if (sw == 0) { L.g1 = (unsigned)((l31 * NIN + 8 * hh) * 2); L.l1 = 0; }
        else { const int rv = lane / VPR, cv = VPR * vh + lane % VPR; L.g1 = (unsigned)((rv * NIN + 8 * cv) * 2); L.l1 = (unsigned)(rv * PT + 16 * cv); }
        asm volatile("" : "+v"(L.g0), "+v"(L.g1), "+v"(L.gg), "+v"(L.ga), "+v"(L.l0), "+v"(L.l1), "+v"(L.lg), "+v"(L.la), "+v"(L.sk));
        HRegs RA, RB;
        stager_load<IS_RET>(RA, Z, KST, AUXG, b, h, hu, sw, L, 0);
        stager_stage<IS_RET>(RA, lds, lds + SC_BUF, sw, L);
        if (sw == 0) scores_stage(RA, lds, L, l31, hh);
        stager_load<IS_RET>(RB, Z, KST, AUXG, b, h, hu, sw, L, 1);
        __syncthreads();
        for (int n = 0; n < NCHUNK; n += 2) {
            if (ST_LD) stager_load<IS_RET>(RA, Z, KST, AUXG, b, h, hu, sw, L, n + 2);
            if (ST_ST) { stager_stage<IS_RET>(RB, lds + SC_BUF, lds, sw, L);
                if (sw == 0) scores_stage(RB, lds + SC_BUF, L, l31, hh); }
            else asm volatile("" :: "v"(RB.x0[0]), "v"(RB.x0[7]), "v"(RB.x1[0]), "v"(RB.aux[1]));
            __syncthreads();
            if (ST_LD) stager_load<IS_RET>(RB, Z, KST, AUXG, b, h, hu, sw, L, n + 3);
            if (ST_ST) { stager_stage<IS_RET>(RA, lds, lds + SC_BUF, sw, L);
                if (sw == 0) scores_stage(RA, lds, L, l31, hh); }
            else asm volatile("" :: "v"(RA.x0[0]), "v"(RA.x0[7]), "v"(RA.x1[0]), "v"(RA.aux[1]));
            __syncthreads();
        }
        }
    } else {
        asm volatile("" : "+v"(lane));
        FinLane L;
        {   const int c0 = lane / VPR, v0 = 8 * (VPR * vh + lane % VPR);
            L.lo = (unsigned)(c0 * PQ + v0 * 2); L.ls = (unsigned)(c0 * 4); L.go = (unsigned)((c0 * D + v0) * 2); L.gs = (unsigned)(c0 * 64); L.gz = (unsigned)((c0 * NIN + v0) * 2); }
        asm volatile("" : "+v"(L.lo), "+v"(L.ls), "+v"(L.go), "+v"(L.gs), "+v"(L.gz));
        if (wave == 4) {
            u32x4 gA[FPT], gB[FPT];
            gate_load<IS_RET>(gA, Z, b, h, L, 0); gate_load<IS_RET>(gB, Z, b, h, L, 1);
            __syncthreads();
            for (int n = 0; n < NCHUNK; n += 2) {
                if (FI_ON) { gate_stage(gA, lds, lane); gate_load<IS_RET>(gA, Z, b, h, L, n + 2); }
                __syncthreads();
                if (FI_ON) { gate_stage(gB, lds + SC_BUF, lane); gate_load<IS_RET>(gB, Z, b, h, L, n + 3); }
                __syncthreads();
            }
        } else {
            const bool first = (lane % VPR) == 0;
            __syncthreads();
            __syncthreads();
            for (int n = 1; n < NCHUNK; ++n) { if (FI_ON) fin_store<IS_RET>(lds + ((n - 1) & 1) * SC_BUF, CAT, SSQO, b, h, vh, L, lane, first, n - 1); __syncthreads(); }
            if (FI_ON) fin_store<IS_RET>(lds + ((NCHUNK - 1) & 1) * SC_BUF, CAT, SSQO, b, h, vh, L, lane, first, NCHUNK - 1);
        }
    }
}

constexpr int XA_K = 0, XA_KP = 144, XA_V = 256 * XA_KP, XA_VP = 192;
#define XRD(dst, areg, off) "ds_read_b128 " dst ", " areg " offset:" #off "\n\t"
__device__ __forceinline__ void xattn2_unit(unsigned char* ws, LAS unsigned char* lds, int unit, int layer, int tid) {
    gbf Z = (gbf)(ws + WS_Z); gbf MKV = (gbf)(ws + WS_MKV); GAS bf16_t* CAT = (GAS bf16_t*)(ws + WS_CAT);
    const int b = unit >> 5, hx = (unit >> 3) & 3, qb = unit & 7;
    const int wave = tid >> 6, lane = tid & 63, l31 = lane & 31, hh = lane >> 5;
    const size_t tok = (size_t)b * SEQ + qb * 256 + wave * 32 + l31;
    bf16x8 qf[4];
#pragma unroll
    for (int ks = 0; ks < 4; ++ks) qf[ks] = *(const GAS bf16x8*)(Z + tok * NIN + 3072 + hx * 64 + 16 * ks + 8 * hh);
    __syncthreads();
    {   gbf src = MKV + (size_t)(b * NMEM) * 2048 + layer * 512 + hx * 64;
        u32x4 kr[4], vr[4];
#pragma unroll
        for (int i = 0; i < 4; ++i) { const int piece = tid + 512 * i, key = piece >> 3, j = piece & 7;
            kr[i] = *(const GAS u32x4*)(src + (size_t)key * 2048 + 8 * j); vr[i] = *(const GAS u32x4*)(src + (size_t)key * 2048 + 256 + 8 * j); }
#pragma unroll
        for (int i = 0; i < 4; ++i) { const int piece = tid + 512 * i, key = piece >> 3, j = piece & 7;
            *(LAS u32x4*)(lds + XA_K + key * XA_KP + 16 * j) = kr[i]; *(LAS u32x4*)(lds + XA_V + key * XA_VP + 16 * j) = vr[i]; }
    }
    __syncthreads();
    f32x16 st[8];
    const unsigned ak = (unsigned)(size_t)(lds + XA_K) + (unsigned)(l31 * XA_KP + 16 * hh);
#define XBLK(T0, o0, o1, o2, o3, o4, o5, o6, o7) { u32x4 f0, f1, f2, f3, f4, f5, f6, f7; \
        asm volatile(XRD("%0", "%8", o0) XRD("%1", "%8", o1) XRD("%2", "%8", o2) XRD("%3", "%8", o3) XRD("%4", "%8", o4) XRD("%5", "%8", o5) XRD("%6", "%8", o6) XRD("%7", "%8", o7) "s_waitcnt lgkmcnt(0)" \
            : "=&v"(f0), "=&v"(f1), "=&v"(f2), "=&v"(f3), "=&v"(f4), "=&v"(f5), "=&v"(f6), "=&v"(f7) : "v"(ak) : "memory"); \
        __builtin_amdgcn_sched_barrier(0); \
        f32x16 a0, a1; _Pragma("unroll") for (int r = 0; r < 16; ++r) { a0[r] = 0.f; a1[r] = 0.f; } \
        a0 = __builtin_amdgcn_mfma_f32_32x32x16_bf16(as_bf16x8(f0), qf[0], a0, 0, 0, 0); a1 = __builtin_amdgcn_mfma_f32_32x32x16_bf16(as_bf16x8(f4), qf[0], a1, 0, 0, 0); \
        a0 = __builtin_amdgcn_mfma_f32_32x32x16_bf16(as_bf16x8(f1), qf[1], a0, 0, 0, 0); a1 = __builtin_amdgcn_mfma_f32_32x32x16_bf16(as_bf16x8(f5), qf[1], a1, 0, 0, 0); \
        a0 = __builtin_amdgcn_mfma_f32_32x32x16_bf16(as_bf16x8(f2), qf[2], a0, 0, 0, 0); a1 = __builtin_amdgcn_mfma_f32_32x32x16_bf16(as_bf16x8(f6), qf[2], a1, 0, 0, 0); \
        a0 = __builtin_amdgcn_mfma_f32_32x32x16_bf16(as_bf16x8(f3), qf[3], a0, 0, 0, 0); a1 = __builtin_amdgcn_mfma_f32_32x32x16_bf16(as_bf16x8(f7), qf[3], a1, 0, 0, 0); \
        st[T0] = a0; st[T0 + 1] = a1; }
    XBLK(0, 0, 32, 64, 96, 4608, 4640, 4672, 4704)
    XBLK(2, 9216, 9248, 9280, 9312, 13824, 13856, 13888, 13920)
    XBLK(4, 18432, 18464, 18496, 18528, 23040, 23072, 23104, 23136)
    XBLK(6, 27648, 27680, 27712, 27744, 32256, 32288, 32320, 32352)
#undef XBLK
    float mx = -1e30f;
#pragma unroll
    for (int T = 0; T < 8; ++T)
#pragma unroll
        for (int r = 0; r < 16; ++r) mx = fmaxf(mx, st[T][r]);
    mx = fmaxf(mx, shfl_xor_l(mx, lane, 32));
    const float c2 = 0.125f * 1.4426950408889634f, mc = mx * c2;
    float sum = 0.f;
#pragma unroll
    for (int T = 0; T < 8; ++T)
#pragma unroll
        for (int r = 0; r < 16; ++r) { const float p = exp2f(st[T][r] * c2 - mc); st[T][r] = p; sum += p; }
    sum += shfl_xor_l(sum, lane, 32);
    f32x16 ot[2];
#pragma unroll
    for (int dt = 0; dt < 2; ++dt)
#pragma unroll
        for (int r = 0; r < 16; ++r) ot[dt][r] = 0.f;
    const unsigned av = (unsigned)(size_t)(lds + XA_V) + (unsigned)((4 * hh + ((lane & 15) >> 2)) * XA_VP + (16 * ((lane >> 4) & 1) + 4 * (lane & 3)) * 2);
#define XTR(dst, off) "ds_read_b64_tr_b16 " dst ", %8 offset:" #off "\n\t"
#define VBLK(T, o00, o01, o10, o11, o20, o21, o30, o31) { u32x2 g0, g1, g2, g3, g4, g5, g6, g7; \
        asm volatile(XTR("%0", o00) XTR("%1", o01) XTR("%2", o10) XTR("%3", o11) XTR("%4", o20) XTR("%5", o21) XTR("%6", o30) XTR("%7", o31) "s_waitcnt lgkmcnt(0)" \
            : "=&v"(g0), "=&v"(g1), "=&v"(g2), "=&v"(g3), "=&v"(g4), "=&v"(g5), "=&v"(g6), "=&v"(g7) : "v"(av) : "memory"); \
        __builtin_amdgcn_sched_barrier(0); \
        u32x4 p0, p1; _Pragma("unroll") for (int j = 0; j < 4; ++j) { p0[j] = pg8::cvt_pk_bf16(st[T][2 * j], st[T][2 * j + 1]); p1[j] = pg8::cvt_pk_bf16(st[T][8 + 2 * j], st[T][8 + 2 * j + 1]); } \
        ot[0] = __builtin_amdgcn_mfma_f32_32x32x16_bf16(as_bf16x8((u32x4){g0.x, g0.y, g1.x, g1.y}), as_bf16x8(p0), ot[0], 0, 0, 0); \
        ot[1] = __builtin_amdgcn_mfma_f32_32x32x16_bf16(as_bf16x8((u32x4){g2.x, g2.y, g3.x, g3.y}), as_bf16x8(p0), ot[1], 0, 0, 0); \
        ot[0] = __builtin_amdgcn_mfma_f32_32x32x16_bf16(as_bf16x8((u32x4){g4.x, g4.y, g5.x, g5.y}), as_bf16x8(p1), ot[0], 0, 0, 0); \
        ot[1] = __builtin_amdgcn_mfma_f32_32x32x16_bf16(as_bf16x8((u32x4){g6.x, g6.y, g7.x, g7.y}), as_bf16x8(p1), ot[1], 0, 0, 0); }
    VBLK(0, 0, 1536, 64, 1600, 3072, 4608, 3136, 4672)
    VBLK(1, 6144, 7680, 6208, 7744, 9216, 10752, 9280, 10816)
    VBLK(2, 12288, 13824, 12352, 13888, 15360, 16896, 15424, 16960)
    VBLK(3, 18432, 19968, 18496, 20032, 21504, 23040, 21568, 23104)
    VBLK(4, 24576, 26112, 24640, 26176, 27648, 29184, 27712, 29248)
    VBLK(5, 30720, 32256, 30784, 32320, 33792, 35328, 33856, 35392)
    VBLK(6, 36864, 38400, 36928, 38464, 39936, 41472, 40000, 41536)
    VBLK(7, 43008, 44544, 43072, 44608, 46080, 47616, 46144, 47680)
#undef VBLK
#undef XTR
    const float il = 1.0f / sum;
    GAS bf16_t* op = CAT + tok * D + MIXW + hx * 64 + 4 * hh;
#pragma unroll
    for (int dt = 0; dt < 2; ++dt)
#pragma unroll
        for (int q = 0; q < 4; ++q) { u32x2 w; w.x = pg8::cvt_pk_bf16(ot[dt][4 * q] * il, ot[dt][4 * q + 1] * il); w.y = pg8::cvt_pk_bf16(ot[dt][4 * q + 2] * il, ot[dt][4 * q + 3] * il);
            *(GAS u32x2*)(op + 32 * dt + 8 * q) = w; }
}

__device__ __forceinline__ void final_rows(const unsigned char* ws, float* out, const float* nf, int row0, int row1, int gw, int NGW, int lane) {
    const GAS f32x4* wv = (const GAS f32x4*)nf + lane;
    for (int row = row0 + gw; row < row1; row += NGW) {
        const GAS u32x2* xr = (const GAS u32x2*)((const GAS bf16_t*)(ws + WS_XB) + (size_t)row * D) + lane; f32x4 v[4]; float s = 0.f;
#pragma unroll
        for (int j = 0; j < 4; ++j) { const u32x2 w = xr[64 * j]; v[j][0] = bf2f(w.x & 0xffffu); v[j][1] = bf2f(w.x >> 16); v[j][2] = bf2f(w.y & 0xffffu); v[j][3] = bf2f(w.y >> 16);
            s += (v[j].x * v[j].x + v[j].y * v[j].y) + (v[j].z * v[j].z + v[j].w * v[j].w); }
        const float rs = rsqrtf(wave_sum(s, lane) * (1.0f / D) + EPS);
        GAS f32x4* orow = (GAS f32x4*)(out + (size_t)row * D) + lane;
#pragma unroll
        for (int j = 0; j < 4; ++j) orow[64 * j] = v[j] * rs * wv[64 * j];
    }
}

__global__ void __launch_bounds__(NWAVES * 64, 2) mega_fwd(Args args) {
    extern __shared__ __attribute__((aligned(16))) unsigned char lds_raw[];
    LAS unsigned char* lds = (LAS unsigned char*)lds_raw;
    volatile LAS unsigned* MISC = (volatile LAS unsigned*)(lds + MISC_OFF);
    const int G = gridDim.x, bx = blockIdx.x;
    const int wave_s = __builtin_amdgcn_readfirstlane(threadIdx.x >> 6);
    unsigned char* ws = args.ws;
    for (int u = threadIdx.x; u < (LDS_BYTES - LDSCTL_OFF) / 4; u += NWAVES * 64) ((LAS unsigned*)(lds + LDSCTL_OFF))[u] = 0u;
    __syncthreads();
    XcdBarrier bar = xcd_barrier_post((unsigned*)(ws + WS_CTL) + CW_BAR, MISC + 8);
#define GBAR() xcd_barrier(bar, wave_s == 0 && lane_id_volatile() == 0)
#define OPAQ() unsigned char* wsp = ws; int Gp = G, bxp = bx, tidp = wave_s * 64 + lane_id_volatile(); asm volatile("" : "+s"(wsp), "+s"(Gp), "+s"(bxp), "+v"(tidp)); \
    const int lanep = tidp & 63, wavep = __builtin_amdgcn_readfirstlane(tidp >> 6), vcup = (Gp % 8 == 0) ? (bxp % 8) * (Gp / 8) + bxp / 8 : bxp, gwp = vcup * NWAVES + wavep, NGWp = Gp * NWAVES; \
    (void)lanep; (void)gwp; (void)NGWp
#define XPART() const int xn = misc_rd(lds, 8), xnx = misc_rd(lds, 9), xrank = misc_rd(lds, 10), xslot = misc_rd(lds, 11); \
    (void)xn; (void)xnx; (void)xrank; (void)xslot
#define LBAR() xcc_barrier(bar, (unsigned)misc_rd(lds, 8), wave_s == 0 && lane_id_volatile() == 0)

    { OPAQ(); p0_prologue(args, wsp, lds, gwp, NGWp, wavep, lanep); }
    GBAR();
    if (threadIdx.x == 0) {
        unsigned slot = 0;
        for (unsigned j = 0; j < 16; ++j) { const unsigned c = xb_ld(&bar.bar[XB_XCNT(j)]); if (j < bar.x && c > 0u) ++slot; }
        MISC[11] = slot;
    }
    __syncthreads();
    for (int l = 0; l < DEPTH; ++l) {
        const int is_ret = l & 1;
        if (l >= 2) cv_wait(bar, l - 2, (unsigned)misc_rd(lds, 9), wave_s == 0 && lane_id_volatile() == 0);
        { OPAQ(); XPART();
            pg8::Gemm g{(const bf16_t*)(wsp + WS_XB), (const bf16_t*)(wsp + WS_WIN) + (size_t)l * NIN * D, M, NIN, D}; pg8::XccOrder S{xrank, xn, xslot, xnx, (NIN - XW) / 256, RBG_A, 1 << 30};
            EpiIn E{(bf16_t*)(wsp + WS_Z), (bf16_t*)(wsp + WS_KST), (float*)(wsp + WS_AUX), (const float*)(wsp + WS_SSQA), (const float*)(wsp + WS_LB) + (l >> 1) * MIXW, (const float*)(wsp + WS_COS), (const float*)(wsp + WS_SIN), is_ret, (LAS float*)(lds + RSTD_TAB_OFF)};
            pg8::gemm_phase<EpiIn, pg8::XccOrder, true, true>(lds, g, S, E, tidp);
        }
        LBAR();
        if (l == 0) { OPAQ(); XPART();
            constexpr int UB = NH * NVS + 8; const int nb = xslot < 8 ? (8 - xslot + xnx - 1) / xnx : 0, busy = UB * nb < xn ? UB * nb : 0, nidle = xn - busy;
            {
                if (xrank >= busy) {
                    pg8::Gemm g{(const bf16_t*)(wsp + WS_MEMB), (const bf16_t*)(wsp + WS_WM), MROWS, 2048, D}; pg8::XccOrderMem S{xrank - busy, nidle, xslot, xnx};
                    EpiPlain E{(bf16_t*)(wsp + WS_MKV), 2048};
                    pg8::gemm_phase<EpiPlain, pg8::XccOrderMem, true, true>(lds, g, S, E, tidp);
                }
                if (busy == 0) { xcc_barrier(bar, (unsigned)xn, wave_s == 0 && lane_id_volatile() == 0); }
                else if (xrank >= busy) {
                    asm volatile("s_waitcnt vmcnt(0)" ::: "memory"); __syncthreads();
                    if (wave_s == 0 && lane_id_volatile() == 0) { __builtin_amdgcn_s_waitcnt(0); xb_add(&bar.bar[XB_MKV(bar.x)], 1u); }
                }
            }
        }
        { OPAQ(); XPART();
            constexpr int UB = NH * NVS + 8;
            const int nb = xslot < 8 ? (8 - xslot + xnx - 1) / xnx : 0;
            const int busy = UB * nb < xn ? UB * nb : 0, nidle = xn - busy;
            for (int u = xrank; u < UB * nb; u += xn) {
                const int b = xslot + (u / UB) * xnx, uu = u % UB;
                if (uu < NH * NVS) { if (is_ret) scan2_unit<1, 0>(wsp, lds, b * NH * NVS + uu, tidp); else scan2_unit<0, 0>(wsp, lds, b * NH * NVS + uu, tidp); }
                else { const int rb = 8 * b + (uu - NH * NVS);
                    {   pg8::Gemm g{(const bf16_t*)(wsp + WS_XB), (const bf16_t*)(wsp + WS_WIN) + (size_t)l * NIN * D, M, NIN, D}; pg8::OneUnit S{rb, 12};
                        EpiIn E{(bf16_t*)(wsp + WS_Z), (bf16_t*)(wsp + WS_KST), (float*)(wsp + WS_AUX), (const float*)(wsp + WS_SSQA), (const float*)(wsp + WS_LB) + (l >> 1) * MIXW, (const float*)(wsp + WS_COS), (const float*)(wsp + WS_SIN), is_ret, (LAS float*)(lds + RSTD_TAB_OFF)};
                        pg8::gemm_phase<EpiIn, pg8::OneUnit, true, true>(lds, g, S, E, tidp); }
                    if (l == 0 && busy > 0) {
                        if (wave_s == 0 && lane_id_volatile() == 0) { unsigned* bb = bar.bar; XB_SPIN(xb_ld(&bb[XB_MKV(bar.x)]) < (unsigned)nidle, bb); }
                    }
                    asm volatile("s_waitcnt vmcnt(0)" ::: "memory"); __builtin_amdgcn_fence(__ATOMIC_RELEASE, "agent"); __syncthreads(); __builtin_amdgcn_fence(__ATOMIC_ACQUIRE, "agent");
                    int tidq = wave_s * 64 + lane_id_volatile(); asm volatile("" : "+v"(tidq));
                    for (int hx = 0; hx < NXH; ++hx) xattn2_unit(wsp, lds, (rb >> 3) * 32 + hx * 8 + (rb & 7), l, tidq);
                }
            }
            if (l < DEPTH - 1) {
                if (xrank >= busy) { const int wv = (xrank - busy) * NWAVES + wavep, nwv = nidle * NWAVES;
                    __syncthreads();
                    for (int l2 = (l == 0 ? 0 : l + 1); l2 < l + 2; ++l2) convert_weights(args, wsp, (LAS float*)(lds + wavep * 16384), l2 * TITEMS_PER_LAYER + (l2 == 0 ? 16 * (NIN / 32) : 0), (l2 + 1) * TITEMS_PER_LAYER - 256, wv, nwv, lanep, xslot < xnx ? xslot : 0, xnx);
                    if (l > 0) cv_signal(bar, l - 1, (unsigned)nidle, wave_s == 0 && lane_id_volatile() == 0);
                }
            }
            __syncthreads();
        }
        if (l == 0) GBAR(); else LBAR();
        if (NVS > 1 && is_ret) {
            { OPAQ(); XPART(); for (int b = xslot; b < BATCH; b += xnx) norm_rows(wsp, b * SEQ, (b + 1) * SEQ, xrank * NWAVES + wavep, xn * NWAVES, lanep); }
            LBAR();
        }
        { OPAQ(); XPART();
            pg8::Gemm g{(const bf16_t*)(wsp + WS_CAT), (const bf16_t*)(wsp + WS_WOUT) + (size_t)l * D * D, M, D, D}; pg8::XccOrder S{xrank, xn, xslot, xnx, D / 256, 4, 1 << 30};
            EpiResC E{EpiRes{(const bf16_t*)(wsp + WS_XB), (bf16_t*)(wsp + WS_XB), (float*)(wsp + WS_SSQD)}, is_ret ? nullptr : (const float*)(wsp + WS_SSQO)};
            pg8::gemm_phase<EpiResC, pg8::XccOrder, true, true>(lds, g, S, E, tidp);
        }
        LBAR();
        { OPAQ(); XPART();
            pg8::Gemm g{(const bf16_t*)(wsp + WS_XB), (const bf16_t*)(wsp + WS_WFI) + (size_t)l * NFI * D, M, NFI, D};
            const int totD = (xslot < 8 ? (8 - xslot + xnx - 1) / xnx : 0) * 8 * (NFI / 256), fullD = (totD / xn) * xn, leftD = totD - fullD; const bool halves = leftD > 0 && 2 * leftD <= xn;
            pg8::XccOrder S{xrank, xn, xslot, xnx, NFI / 256, RBG_D, halves ? fullD : (1 << 30)};
            EpiFfn E{(bf16_t*)(wsp + WS_ACT), (const float*)(wsp + WS_SSQD), (LAS float*)(lds + RSTD_TAB_OFF), -1};
            pg8::gemm_phase<EpiFfn, pg8::XccOrder, true, true>(lds, g, S, E, tidp);
            if (halves && xrank < 2 * leftD) { pg8::Unit hu; S.decode(fullD + xrank % leftD, hu);
                pg8::HalfUnit SH{hu.pm, hu.pn, xrank / leftD}; EpiFfn EH{(bf16_t*)(wsp + WS_ACT), (const float*)(wsp + WS_SSQD), (LAS float*)(lds + RSTD_TAB_OFF), xrank / leftD};
                pg8::gemm_phase<EpiFfn, pg8::HalfUnit, true, true, true>(lds, g, SH, EH, tidp); }
        }
        LBAR();
        { OPAQ(); XPART();
            pg8::Gemm g{(const bf16_t*)(wsp + WS_ACT), (const bf16_t*)(wsp + WS_WFO) + (size_t)l * D * DFF, M, D, DFF}; pg8::XccOrder S{xrank, xn, xslot, xnx, D / 256, 4, 1 << 30};
            EpiRes E{(const bf16_t*)(wsp + WS_XB), (bf16_t*)(wsp + WS_XB), (float*)(wsp + WS_SSQA)};
            pg8::gemm_phase<EpiRes, pg8::XccOrder, true, true>(lds, g, S, E, tidp);
        }
        LBAR();
    }
    { OPAQ(); XPART();
        for (int b = xslot; b < BATCH; b += xnx) final_rows(wsp, args.out, args.in[14], b * SEQ, (b + 1) * SEQ, xrank * NWAVES + wavep, xn * NWAVES, lanep);
    }
#undef OPAQ
#undef XPART
#undef GBAR
#undef LBAR
}

extern "C" void kernel_launch(void* const* d_in, const int* in_sizes, int n_in, void* d_out, int out_size, void* d_ws, size_t ws_size, hipStream_t stream) {
    static int grid = 0;
    if (grid == 0) {
        if (n_in != 15 || in_sizes[0] != M * D || out_size != M * D || ws_size < WS_END) {
            fprintf(stderr, "kernel_launch: unexpected shapes: n_in %d in0 %d out %d ws %zu (need %zu)\n", n_in, n_in > 0 ? in_sizes[0] : -1, out_size, ws_size, (size_t)WS_END); grid = -1; return; }
        int dev = 0, cus = 0, per_cu = 0;
        if (hipGetDevice(&dev) != hipSuccess || hipDeviceGetAttribute(&cus, hipDeviceAttributeMultiprocessorCount, dev) != hipSuccess) { grid = -1; return; }
        if (hipFuncSetAttribute((const void*)mega_fwd, hipFuncAttributeMaxDynamicSharedMemorySize, LDS_BYTES) != hipSuccess) { fprintf(stderr, "kernel_launch: hipFuncSetAttribute failed\n"); grid = -1; return; }
        if (hipOccupancyMaxActiveBlocksPerMultiprocessor(&per_cu, (const void*)mega_fwd, NWAVES * 64, LDS_BYTES) != hipSuccess || per_cu < 1)
            fprintf(stderr, "kernel_launch: occupancy query reports %d workgroups per CU\n", per_cu);
        (void)hipGetLastError();
        grid = cus;
        if (grid < 176) { fprintf(stderr, "kernel_launch: this kernel needs at least 176 CUs (found %d)\n", cus); grid = -1; return; }
    }
    if (grid < 0) return;
    if (hipMemsetAsync((char*)d_ws + WS_CTL, 0, CTL_ZERO_BYTES, stream) != hipSuccess) { fprintf(stderr, "kernel_launch: memset failed\n"); return; }
    Args a{};
    for (int i = 0; i < 15; ++i) a.in[i] = (const float*)d_in[i];
    a.out = (float*)d_out; a.ws = (unsigned char*)d_ws;
    a.ph_lo = 0; a.ph_hi = 0;
    hipLaunchKernelGGL(mega_fwd, dim3(grid), dim3(NWAVES * 64), LDS_BYTES, stream, a);
    const hipError_t le = hipPeekAtLastError();
    if (le != hipSuccess) fprintf(stderr, "kernel_launch: launch failed: %s\n", hipGetErrorName(le));
}
```

```cpp
#include <hip/hip_runtime.h>
#include <cstdio>
#include <cstdint>

#ifndef DBG_SKIP
#define DBG_SKIP 0
#endif
#ifndef PROBE_REP
#define PROBE_REP 0
#endif
#ifndef RBG_A
#define RBG_A 4
#endif
#ifndef RBG_D
#define RBG_D 4
#endif
#ifndef PROBE_VAR
#define PROBE_VAR 0
#endif
#ifndef MK_N_LAUNCHES
#define MK_N_LAUNCHES 1
#endif

#define GAS __attribute__((address_space(1)))
#define LAS __attribute__((address_space(3)))
typedef unsigned short bf16_t;
typedef short bf16x8 __attribute__((ext_vector_type(8)));
typedef float f32x4 __attribute__((ext_vector_type(4)));
typedef float f32x2 __attribute__((ext_vector_type(2)));
typedef unsigned u32x4 __attribute__((ext_vector_type(4)));
typedef unsigned u32x2 __attribute__((ext_vector_type(2)));

constexpr int BATCH = 8, SEQ = 2048, D = 1024, DEPTH = 4;
constexpr int M = BATCH * SEQ;
constexpr int NH = 6, HD = 128, MIXW = 768, XW = 256, NXH = 4, XHD = 64, NMEM = 256;
constexpr int NIN = 3328, DFF = 2816, NFI = 2 * DFF;
constexpr int MROWS = BATCH * NMEM;
constexpr float EPS = 1e-6f;
constexpr int NVS = 2;
constexpr int VPR = 16 / NVS;

constexpr size_t MiB = 1u << 20;
constexpr size_t WS_CTL = 0, CTL_ZERO_BYTES = 1 * MiB;
constexpr size_t WS_LB = 1 * MiB;
constexpr size_t WS_SSQA = 2 * MiB;
constexpr size_t WS_SSQD = 3 * MiB;
constexpr size_t WS_COS = 4 * MiB, WS_SIN = 8 * MiB;
constexpr size_t WS_MEMB = 12 * MiB;
constexpr size_t WS_MKV = 16 * MiB;
constexpr size_t WS_WIN = 24 * MiB;
constexpr size_t WS_WOUT = 50 * MiB;
constexpr size_t WS_WFI = 58 * MiB;
constexpr size_t WS_WFO = 102 * MiB;
constexpr size_t WS_WM = 124 * MiB;
constexpr size_t WS_XB = 128 * MiB;
constexpr size_t WS_CAT = 160 * MiB;
constexpr size_t WS_Z = 192 * MiB;
constexpr size_t WS_F = 296 * MiB;
constexpr size_t WS_KST = 296 * MiB;
constexpr size_t WS_AUX = 320 * MiB;
constexpr size_t WS_SSQO = 323 * MiB;
constexpr size_t WS_ACT = 192 * MiB;
constexpr size_t WS_END = 344 * MiB;
static_assert(WS_WIN + (size_t)DEPTH * NIN * D * 2 <= WS_WOUT && WS_WOUT + (size_t)DEPTH * D * D * 2 <= WS_WFI && WS_WFI + (size_t)DEPTH * NFI * D * 2 <= WS_WFO &&
              WS_WFO + (size_t)DEPTH * D * DFF * 2 <= WS_WM && WS_WM + (size_t)2048 * 1024 * 2 <= WS_XB && WS_Z + (size_t)M * NIN * 2 <= WS_F && WS_F + (size_t)M * MIXW * 4 <= WS_END &&
              WS_ACT + (size_t)M * DFF * 2 <= WS_F, "ws map");
constexpr int CW_BAR = 4096;

__device__ __forceinline__ int lane_id_volatile() { int l; asm volatile("v_mbcnt_lo_u32_b32 %0, -1, 0\n\tv_mbcnt_hi_u32_b32 %0, -1, %0" : "=v"(l)); return l; }
namespace pg8 {
constexpr int BM = 256, BK = 64, HALF = 128, HTB = HALF * BK * 2, STAGE_BYTES = 8 * HTB, NXCD = 8, WGM = 8;
__host__ __device__ __forceinline__ int lds_byte(int r, int c) { const int st = (r >> 4) * 2 + (c >> 5), rr = r & 15, cc = c & 31, ob = rr * 64 + cc * 2; return st * 1024 + (ob ^ (((ob >> 9) & 1) << 5)); }
__host__ __device__ __forceinline__ void stage_rc(int b, int& R, int& C) { const int st = b / 1024, sb = b % 1024, swz = sb ^ (((sb >> 9) & 1) << 5); R = (st >> 1) * 16 + swz / 64; C = (st & 1) * 32 + (swz % 64) / 2; }
__host__ __device__ __forceinline__ int perm32(int rho) { const int n = rho >> 4, i = rho & 15; return 8 * (i >> 2) + 4 * n + (i & 3); }
struct Unit { int pm, pn; };
struct Gemm { const bf16_t* A; const bf16_t* Bt; int M, N, K; };
struct StaticOrder {
    int nM, nN, nwg, G, c;
    __host__ __device__ void init(int M_, int N_, int G_, int c_) { nM = M_ / BM; nN = N_ / BM; nwg = nM * nN; G = G_; c = c_; }
    __host__ __device__ bool next(int i, Unit& u) const {
        const long L = (long)i * G + c; if (L >= nwg) return false;
        int wgid = (int)L; { const int q = nwg / NXCD, r = nwg % NXCD, xcd = wgid % NXCD, off = wgid / NXCD; wgid = (xcd < r ? xcd * (q + 1) : r * (q + 1) + (xcd - r) * q) + off; }
        const int nig = WGM * nN, gid = wgid / nig, fm = gid * WGM, gsz = (nM - fm) < WGM ? (nM - fm) : WGM;
        u.pm = fm + ((wgid % nig) % gsz); u.pn = (wgid % nig) / gsz; return true;
    }
    __device__ __forceinline__ void a_ready(const Unit&) const {}
    __device__ __forceinline__ void done(const Unit&) const {}
};
struct XccOrder {
    int rank, n, slot, nx, nN, rbg, tlim;
    __device__ __forceinline__ bool next(int i, Unit& u) const {
        const int t = i * n + rank, nb = (8 - slot + nx - 1) / nx;
        if (slot >= 8 || t >= nb * 8 * nN || t >= tlim) return false;
        decode(t, u); return true;
    }
    __device__ __forceinline__ void decode(int t, Unit& u) const {
        const int per = 8 * nN;
        const int bi = t / per, tt = t - bi * per, g = tt / (rbg * nN), r = tt - g * rbg * nN;
        u.pm = 8 * (slot + bi * nx) + rbg * g + (r % rbg); u.pn = r / rbg;
    }
    __device__ __forceinline__ void a_ready(const Unit&) const {}
};
struct XccOrderMem {
    int rank, n, slot, nx;
    __device__ __forceinline__ bool next(int i, Unit& u) const {
        const int t = i * n + rank, nb = (8 - slot + nx - 1) / nx;
        if (slot >= 8 || t >= nb * 8) return false;
        u.pm = slot + (t >> 3) * nx; u.pn = t & 7; return true;
    }
    __device__ __forceinline__ void a_ready(const Unit&) const {}
};
struct OneUnit {
    int pm, pn;
    __device__ __forceinline__ bool next(int i, Unit& u) const { if (i) return false; u.pm = pm; u.pn = pn; return true; }
    __device__ __forceinline__ void a_ready(const Unit&) const {}
};
struct HalfUnit {
    int pm, pn, half;
    __device__ __forceinline__ bool next(int i, Unit& u) const { if (i) return false; u.pm = pm; u.pn = pn; return true; }
    __device__ __forceinline__ void a_ready(const Unit&) const {}
};
__device__ __forceinline__ unsigned cvt_pk_bf16(float lo, float hi) { unsigned r; asm volatile("v_cvt_pk_bf16_f32 %0, %1, %2" : "=v"(r) : "v"(lo), "v"(hi)); return r; }

template <class Epi, class Sched, bool ALIGN_EPI = false, bool SP2 = false, bool HM = false>
__device__ __forceinline__ void gemm_phase(LAS unsigned char* lds, const Gemm g, const Sched& S, const Epi& E, int tid) {
    asm volatile("" : "+v"(tid));
    const int wid = __builtin_amdgcn_readfirstlane(tid >> 6), lane = tid & 63, wr = wid >> 2, wc = wid & 3, fr = lane & 15, fq = lane >> 4;
    const int K = g.K, nt = K / BK;
    unsigned voffA[2], voffB[2];
#pragma unroll
    for (int i = 0; i < 2; ++i) { int R, C; stage_rc(tid * 16 + i * 8192, R, C); const int Rb = Epi::PERM ? ((R & ~31) + perm32(R & 31)) : R;
        voffA[i] = (unsigned)(R * K + C) * 2u; voffB[i] = (unsigned)(Rb * K + C) * 2u; }
    asm volatile("" : "+v"(voffA[0]), "+v"(voffA[1]), "+v"(voffB[0]), "+v"(voffB[1]));
    const size_t kstep = (size_t)(BK * 2);
    const size_t hstep = (size_t)HALF * K * 2;
    const size_t tstep = 2 * hstep;
    static_assert(!HM || SP2, "half tiles use the SP2 body");
    const size_t ahs = HM ? (size_t)0 : hstep;
    const unsigned ldsw = (unsigned)wid * 1024u;
    const int aoff = lds_byte(wr * 64 + fr, fq * 8), boff = lds_byte(wc * 32 + fr, fq * 8);
#define PG8_SA(b, h) (((b) * 2 + (h)) * HTB)
#define PG8_SB(b, h) ((4 + (b) * 2 + (h)) * HTB)
#define PG8_STAGE(bufoff, gbase, voff) do { _Pragma("unroll") for (int _i = 0; _i < 2; ++_i) \
        __builtin_amdgcn_global_load_lds((const unsigned*)((const char*)(gbase) + (voff)[_i]), (LAS unsigned*)(lds + (bufoff) + ldsw + _i * 8192), 16, 0, 0); } while (0)
#define PG8_LDA(dst, b, h) do { _Pragma("unroll") for (int m = 0; m < 4; ++m) _Pragma("unroll") for (int k = 0; k < 2; ++k) dst[m][k] = *(const LAS bf16x8*)(lds + PG8_SA(b, h) + aoff + m * 2048 + k * 1024); } while (0)
#define PG8_LDB(dst, b, h) do { _Pragma("unroll") for (int n = 0; n < 2; ++n) _Pragma("unroll") for (int k = 0; k < 2; ++k) dst[n][k] = *(const LAS bf16x8*)(lds + PG8_SB(b, h) + boff + n * 2048 + k * 1024); } while (0)
#define PG8_MMA(ai, bj, At, Bt) do { __builtin_amdgcn_s_setprio(1); _Pragma("unroll") for (int m = 0; m < 4; ++m) _Pragma("unroll") for (int n = 0; n < 2; ++n) _Pragma("unroll") for (int k = 0; k < 2; ++k) \
        acc[ai][bj][m][n] = __builtin_amdgcn_mfma_f32_16x16x32_bf16(Bt[n][k], At[m][k], acc[ai][bj][m][n], 0, 0, 0); __builtin_amdgcn_s_setprio(0); } while (0)
#define PG8_WAIT_V(n) asm volatile("s_waitcnt vmcnt(" #n ")" ::: "memory")
#define PG8_WAIT_L(n) asm volatile("s_waitcnt lgkmcnt(" #n ")" ::: "memory")
#define PG8_BAR __builtin_amdgcn_s_barrier()
#define PG8_SCHED __builtin_amdgcn_sched_barrier(0)
    Unit cur, nxt; int ui = 0;
    if (!S.next(0, cur)) return;
    f32x4 acc[2][2][4][2];
#pragma unroll
    for (int a = 0; a < 2; ++a)
#pragma unroll
        for (int b = 0; b < 2; ++b)
#pragma unroll
            for (int m = 0; m < 4; ++m)
#pragma unroll
                for (int n = 0; n < 2; ++n) acc[a][b][m][n] = (f32x4){0.f, 0.f, 0.f, 0.f};
    bf16x8 At[4][2], B0[2][2], B1[2][2];
    const char* cA = (const char*)g.A + (size_t)cur.pm * tstep; if constexpr (HM) cA += (size_t)S.half * hstep;
    const char* cB = (const char*)g.Bt + (size_t)cur.pn * tstep;
    S.a_ready(cur);
    if constexpr (SP2) {
        PG8_STAGE(PG8_SB(0, 0), cB, voffB); PG8_STAGE(PG8_SB(0, 1), cB + hstep, voffB); PG8_STAGE(PG8_SA(0, 0), cA, voffA); PG8_STAGE(PG8_SA(0, 1), cA + ahs, voffA);
        if (wr == 1) PG8_BAR;
        PG8_WAIT_V(2); PG8_BAR;
        PG8_STAGE(PG8_SB(1, 0), cB + kstep, voffB); PG8_STAGE(PG8_SA(1, 0), cA + kstep, voffA); PG8_STAGE(PG8_SB(1, 1), cB + hstep + kstep, voffB);
        PG8_WAIT_V(6); PG8_BAR;
    } else {
        PG8_STAGE(PG8_SB(0, 0), cB, voffB); PG8_STAGE(PG8_SA(0, 0), cA, voffA); PG8_STAGE(PG8_SB(0, 1), cB + hstep, voffB); PG8_STAGE(PG8_SA(0, 1), cA + hstep, voffA);
        if (wr == 1) PG8_BAR;
        PG8_WAIT_V(4); PG8_BAR;
        PG8_STAGE(PG8_SB(1, 0), cB + kstep, voffB); PG8_STAGE(PG8_SA(1, 0), cA + kstep, voffA); PG8_STAGE(PG8_SB(1, 1), cB + hstep + kstep, voffB);
        PG8_WAIT_V(6); PG8_BAR;
    }
    for (;;) {
        const bool has_next = S.next(ui + 1, nxt);
        const char* nA = has_next ? (const char*)g.A + (size_t)nxt.pm * tstep : cA; const char* nB = has_next ? (const char*)g.Bt + (size_t)nxt.pn * tstep : cB;
        for (int t = 0; t < nt; t += 2) {
            const bool last = (t == nt - 2);
            const char* a1 = cA + (size_t)(t + 1) * kstep;
            const char* a2 = last ? nA : cA + (size_t)(t + 2) * kstep; const char* b2 = last ? nB : cB + (size_t)(t + 2) * kstep;
            const char* a3 = a2 + kstep; const char* b3 = b2 + kstep;
            if (last && has_next) S.a_ready(nxt);
            if constexpr (Epi::MID_T > 0) { if (t == Epi::MID_T) { const int l2 = lane_id_volatile(); E.mid(acc, cur, wr, wc, l2 & 15, l2 >> 4); } }
            if constexpr (SP2) {
            PG8_LDB(B0, 0, 0); PG8_LDB(B1, 0, 1); PG8_SCHED; PG8_LDA(At, 0, 0); PG8_STAGE(PG8_SA(1, 1), a1 + ahs, voffA);
            PG8_WAIT_V(8); PG8_WAIT_L(0); PG8_BAR; PG8_MMA(0, 0, At, B0); PG8_MMA(0, 1, At, B1); PG8_BAR; PG8_SCHED;
            if constexpr (!HM) PG8_LDA(At, 0, 1);
            PG8_STAGE(PG8_SB(0, 0), b2, voffB); PG8_STAGE(PG8_SB(0, 1), b2 + hstep, voffB); PG8_STAGE(PG8_SA(0, 0), a2, voffA);
            PG8_WAIT_V(8); PG8_WAIT_L(0); PG8_BAR; if constexpr (!HM) { PG8_MMA(1, 0, At, B0); PG8_MMA(1, 1, At, B1); } PG8_BAR; PG8_SCHED;
            PG8_LDB(B0, 1, 0); PG8_LDB(B1, 1, 1); PG8_SCHED; PG8_LDA(At, 1, 0); PG8_STAGE(PG8_SA(0, 1), a2 + ahs, voffA);
            PG8_WAIT_V(8); PG8_WAIT_L(0); PG8_BAR; PG8_MMA(0, 0, At, B0); PG8_MMA(0, 1, At, B1); PG8_BAR; PG8_SCHED;
            if constexpr (!HM) PG8_LDA(At, 1, 1);
            PG8_STAGE(PG8_SB(1, 0), b3, voffB); PG8_STAGE(PG8_SB(1, 1), b3 + hstep, voffB); PG8_STAGE(PG8_SA(1, 0), a3, voffA);
            PG8_WAIT_V(8); PG8_WAIT_L(0); PG8_BAR; if constexpr (!HM) { PG8_MMA(1, 0, At, B0); PG8_MMA(1, 1, At, B1); } PG8_BAR; PG8_SCHED;
            } else {
            PG8_LDB(B0, 0, 0); PG8_SCHED; PG8_LDA(At, 0, 0); PG8_STAGE(PG8_SA(1, 1), a1 + hstep, voffA);
            PG8_WAIT_L(8); PG8_BAR; PG8_WAIT_L(0); PG8_MMA(0, 0, At, B0); PG8_BAR; PG8_SCHED;
            PG8_LDB(B1, 0, 1); PG8_STAGE(PG8_SB(0, 0), b2, voffB);
            PG8_BAR; PG8_WAIT_L(0); PG8_MMA(0, 1, At, B1); PG8_BAR;
            PG8_LDA(At, 0, 1); PG8_STAGE(PG8_SA(0, 0), a2, voffA);
            PG8_BAR; PG8_WAIT_L(0); PG8_MMA(1, 0, At, B0); PG8_BAR; PG8_SCHED;
            PG8_STAGE(PG8_SB(0, 1), b2 + hstep, voffB);
            PG8_WAIT_V(6); PG8_BAR; PG8_MMA(1, 1, At, B1); PG8_BAR;
            PG8_LDB(B0, 1, 0); PG8_SCHED; PG8_LDA(At, 1, 0); PG8_STAGE(PG8_SA(0, 1), a2 + hstep, voffA);
            PG8_WAIT_L(8); PG8_BAR; PG8_WAIT_L(0); PG8_MMA(0, 0, At, B0); PG8_BAR; PG8_SCHED;
            PG8_LDB(B1, 1, 1); PG8_STAGE(PG8_SB(1, 0), b3, voffB);
            PG8_BAR; PG8_WAIT_L(0); PG8_MMA(0, 1, At, B1); PG8_BAR;
            PG8_LDA(At, 1, 1); PG8_STAGE(PG8_SA(1, 0), a3, voffA);
            PG8_BAR; PG8_WAIT_L(0); PG8_MMA(1, 0, At, B0); PG8_BAR; PG8_SCHED;
            PG8_STAGE(PG8_SB(1, 1), b3 + hstep, voffB);
            PG8_WAIT_V(6); PG8_BAR; PG8_MMA(1, 1, At, B1); PG8_BAR;
            }
        }
        if constexpr (ALIGN_EPI) { if (wr == 0) PG8_BAR; }
        { const int l2 = lane_id_volatile(); E(acc, cur, wr, wc, l2 & 15, l2 >> 4); }
        if (!has_next) break;
#pragma unroll
        for (int a = 0; a < 2; ++a)
#pragma unroll
            for (int b = 0; b < 2; ++b)
#pragma unroll
                for (int m = 0; m < 4; ++m)
#pragma unroll
                    for (int n = 0; n < 2; ++n) acc[a][b][m][n] = (f32x4){0.f, 0.f, 0.f, 0.f};
        cur = nxt; cA = nA; cB = nB; ++ui;
        if constexpr (ALIGN_EPI) { if (wr == 1) PG8_BAR; }
    }
    PG8_WAIT_V(0);
    if constexpr (!ALIGN_EPI) { if (wr == 0) PG8_BAR; }
    PG8_BAR;
#undef PG8_SA
#undef PG8_SB
#undef PG8_STAGE
#undef PG8_LDA
#undef PG8_LDB
#undef PG8_MMA
#undef PG8_WAIT_V
#undef PG8_WAIT_L
#undef PG8_BAR
#undef PG8_SCHED
}
}

__device__ __forceinline__ float bf2f(unsigned h) { return __uint_as_float(h << 16); }
__device__ __forceinline__ unsigned f2bf(float f) { unsigned u = __float_as_uint(f); return (u + 0x7fffu + ((u >> 16) & 1u)) >> 16; }
__device__ __forceinline__ unsigned pk2(float lo, float hi) { return f2bf(lo) | (f2bf(hi) << 16); }
__device__ __forceinline__ float fast_rcp(float x) { return __builtin_amdgcn_rcpf(x); }
__device__ __forceinline__ float sigmoidf_(float x) { return fast_rcp(1.0f + __expf(-x)); }
__device__ __forceinline__ float siluf_(float x) { return x * sigmoidf_(x); }
__device__ __forceinline__ float shfl_xor_l(float v, int lane, int mask) { return __int_as_float(__builtin_amdgcn_ds_bpermute((lane ^ mask) << 2, __float_as_int(v))); }
__device__ __forceinline__ float wave_sum(float v, int lane) {
#pragma unroll
    for (int o = 1; o < 64; o <<= 1) v += shfl_xor_l(v, lane, o);
    return v;
}
__device__ __forceinline__ float rstd_from_partials(const float* ssq, int row, float invn) {
    const f32x4* p = (const f32x4*)(ssq + (size_t)row * 16);
    const f32x4 a = p[0], b = p[1], c = p[2], d = p[3];
    const f32x4 s = (a + b) + (c + d);
    return rsqrtf(((s[0] + s[1]) + (s[2] + s[3])) * invn + EPS);
}
constexpr int RSTD_TAB_OFF = 132096;
__device__ __forceinline__ void rstd_table(const float* ssq, int pm, LAS float* tab, int wr, int wc, int fr, int fq) {
    const int t = (wr * 4 + wc) * 64 + fq * 16 + fr;
    if (t < 256) { const GAS f32x4* p = (const GAS f32x4*)((const GAS float*)ssq + (size_t)(pm * 256 + t) * 16);
        const f32x4 a = p[0], b = p[1], c = p[2], d = p[3]; const f32x4 sm = (a + b) + (c + d);
        tab[t] = rsqrtf(((sm[0] + sm[1]) + (sm[2] + sm[3])) * (1.0f / D) + EPS); }
    asm volatile("s_waitcnt lgkmcnt(0)" ::: "memory"); __builtin_amdgcn_s_barrier(); asm volatile("" ::: "memory");
}
__device__ __forceinline__ u32x4 pack8(const f32x4 v0, const f32x4 v1) {
    u32x4 w; w.x = pg8::cvt_pk_bf16(v0[0], v0[1]); w.y = pg8::cvt_pk_bf16(v0[2], v0[3]); w.z = pg8::cvt_pk_bf16(v1[0], v1[1]); w.w = pg8::cvt_pk_bf16(v1[2], v1[3]); return w;
}

#define DPP_SHR(x, n) __int_as_float(__builtin_amdgcn_update_dpp(0, __float_as_int(x), 0x110 + (n), 0xf, 0xf, false))
__device__ __forceinline__ float rowscan16(float x) {
    x += DPP_SHR(x, 1); x += DPP_SHR(x, 2); x += DPP_SHR(x, 4); x += DPP_SHR(x, 8); return x;
}
__device__ __forceinline__ float bcast15(float x, int lane) { return __int_as_float(__builtin_amdgcn_ds_bpermute((lane | 15) << 2, __float_as_int(x))); }
__device__ __forceinline__ float expc(float x) { return __expf(fminf(x, 80.0f)); }
using pg8::Unit;
struct EpiPlain {
    static constexpr bool PERM = true; static constexpr int MID_T = 0;
    bf16_t* O; int ldc;
    __device__ __forceinline__ void operator()(const f32x4 (&acc)[2][2][4][2], const Unit& u, int wr, int wc, int fr, int fq) const {
        const int row0 = u.pm * 256 + wr * 64 + fr, col0 = u.pn * 256 + wc * 32 + 8 * fq;
#pragma unroll
        for (int ai = 0; ai < 2; ++ai)
#pragma unroll
            for (int m = 0; m < 4; ++m) { bf16_t* rowp = O + (size_t)(row0 + ai * 128 + m * 16) * ldc + col0;
#pragma unroll
                for (int bj = 0; bj < 2; ++bj) *(GAS u32x4*)((GAS bf16_t*)rowp + bj * 128) = pack8(acc[ai][bj][m][0], acc[ai][bj][m][1]); }
    }
};
struct EpiIn {
    static constexpr bool PERM = true; static constexpr int MID_T = 0;
    bf16_t* Z; bf16_t* KST; float* AUX; const float* ssq; const float* lb; const float* cosT; const float* sinT; int is_ret; LAS float* tab;
    __device__ __forceinline__ void operator()(const f32x4 (&acc)[2][2][4][2], const Unit& u, int wr, int wc, int fr, int fq) const {
        const int row0 = u.pm * 256 + wr * 64 + fr, jl = wc * 32 + 8 * fq, t = u.pn;
        rstd_table(ssq, u.pm, tab, wr, wc, fr, fq);
        const LAS float* tl = tab + wr * 64 + fr;
        if (t < 6) {
            if (!is_ret) {
                const f32x4 lb0 = *(const GAS f32x4*)((const GAS float*)lb + t * 128 + (jl >> 1)), lb1 = *(const GAS f32x4*)((const GAS float*)lb + t * 128 + (jl >> 1) + 64);
#pragma unroll
                for (int ai = 0; ai < 2; ++ai)
#pragma unroll
                    for (int mp = 0; mp < 2; ++mp) {
                        const int tok0 = u.pm * 256 + ai * 128 + wr * 64 + mp * 32, rlo = tok0 + fr, rhi = rlo + 16;
                        const float rs0 = tl[ai * 128 + mp * 32], rs1 = tl[ai * 128 + mp * 32 + 16];
                        f32x4 qsv[2][2], ksv[2][2], ktv[2][2], erv[2], dcv[2];
#pragma unroll
                        for (int n = 0; n < 2; ++n)
#pragma unroll
                            for (int i = 0; i < 4; ++i) {
                                const float lbv = n ? lb1[i] : lb0[i];
                                float g[2], kk[2], qq[2];
#pragma unroll
                                for (int e = 0; e < 2; ++e) {
                                    const float x = acc[ai][1][2 * mp + e][n][i] * (e ? rs1 : rs0), za = acc[ai][0][2 * mp + e][n][i] * (e ? rs1 : rs0);
                                    const float a = __expf(-fabsf(x)), r = fast_rcp(1.0f + a);
                                    const float sneg = x >= 0.f ? a * r : r;
                                    const float em = x >= 0.f ? a : fminf(fast_rcp(a), 1.0686475e13f);
                                    g[e] = (fminf(x, 0.f) - __logf(1.0f + a)) + __logf(1.0f + lbv * em);
                                    kk[e] = (1.0f - lbv) * sneg;
                                    qq[e] = siluf_(za);
                                }
                                const float blo = rowscan16(g[0]), ref = bcast15(blo, fq * 16 + fr), bhi = ref + rowscan16(g[1]), blast = bcast15(bhi, fq * 16 + fr);
                                qsv[0][n][i] = qq[0] * expc(blo - ref); qsv[1][n][i] = qq[1] * expc(bhi - ref);
                                ksv[0][n][i] = kk[0] * expc(ref - blo); ksv[1][n][i] = kk[1] * expc(ref - bhi);
                                ktv[0][n][i] = kk[0] * __expf(blast - blo); ktv[1][n][i] = kk[1] * __expf(blast - bhi);
                                erv[n][i] = __expf(ref); dcv[n][i] = __expf(blast);
                            }
                        GAS bf16_t* zlo = (GAS bf16_t*)Z + (size_t)rlo * NIN + t * 256 + jl; GAS bf16_t* zhi = (GAS bf16_t*)Z + (size_t)rhi * NIN + t * 256 + jl;
                        *(GAS u32x4*)zlo = pack8(qsv[0][0], qsv[0][1]); *(GAS u32x4*)(zlo + 128) = pack8(ksv[0][0], ksv[0][1]);
                        *(GAS u32x4*)zhi = pack8(qsv[1][0], qsv[1][1]); *(GAS u32x4*)(zhi + 128) = pack8(ksv[1][0], ksv[1][1]);
                        *(GAS u32x4*)((GAS bf16_t*)KST + (size_t)rlo * MIXW + t * 128 + jl) = pack8(ktv[0][0], ktv[0][1]);
                        *(GAS u32x4*)((GAS bf16_t*)KST + (size_t)rhi * MIXW + t * 128 + jl) = pack8(ktv[1][0], ktv[1][1]);
                        if (fr == 15) { GAS float* ap = (GAS float*)AUX + ((size_t)((tok0 >> 11) * NH + t) * 64 + ((tok0 & 2047) >> 5)) * 256 + jl;
                            *(GAS f32x4*)ap = erv[0]; *(GAS f32x4*)(ap + 4) = erv[1]; *(GAS f32x4*)(ap + 128) = dcv[0]; *(GAS f32x4*)(ap + 132) = dcv[1]; }
                    }
            } else {
                const float lg = __log2f(1.0f - exp2f(-5.0f - (float)t));
                f32x4 csv[2][4], snv[2][4];
#pragma unroll
                for (int ai = 0; ai < 2; ++ai)
#pragma unroll
                    for (int m = 0; m < 4; ++m) { const int row = row0 + ai * 128 + m * 16;
                        csv[ai][m] = *(const GAS f32x4*)((const GAS float*)cosT + (size_t)row * 64 + (jl >> 1)); snv[ai][m] = *(const GAS f32x4*)((const GAS float*)sinT + (size_t)row * 64 + (jl >> 1)); }
#pragma unroll
                for (int ai = 0; ai < 2; ++ai)
#pragma unroll
                    for (int m = 0; m < 4; ++m) { const int row = row0 + ai * 128 + m * 16; const float rs = tl[ai * 128 + m * 16];
                        const f32x4 cs = csv[ai][m], sn = snv[ai][m];
                        const float cp1 = (float)(16 * (m & 1) + fr + 1), pw = exp2f(cp1 * lg), ipw = exp2f(-cp1 * lg);
                        const float qsc = rs * pw, ksc = rs * 0.08838834764831845f * ipw;
                        f32x4 q0, q1, k0, k1;
#pragma unroll
                        for (int i = 0; i < 4; ++i) {
                            const float a1 = acc[ai][0][m][0][i] * qsc, a2 = acc[ai][0][m][1][i] * qsc; q0[i] = a1 * cs[i] - a2 * sn[i]; q1[i] = a1 * sn[i] + a2 * cs[i];
                            const float b1 = acc[ai][1][m][0][i] * ksc, b2 = acc[ai][1][m][1][i] * ksc; k0[i] = b1 * cs[i] - b2 * sn[i]; k1[i] = b1 * sn[i] + b2 * cs[i];
                        }
                        GAS bf16_t* zp = (GAS bf16_t*)Z + (size_t)row * NIN + t * 256 + jl; *(GAS u32x4*)zp = pack8(q0, q1); *(GAS u32x4*)(zp + 128) = pack8(k0, k1); }
            }
        } else {
            const int mode = (t >= 9 && t < 12) ? (is_ret ? 2 : 1) : 0;
#pragma unroll
            for (int ai = 0; ai < 2; ++ai)
#pragma unroll
                for (int m = 0; m < 4; ++m) { const int row = row0 + ai * 128 + m * 16; const float rs = tl[ai * 128 + m * 16];
                    GAS bf16_t* zp = (GAS bf16_t*)Z + (size_t)row * NIN + t * 256 + jl;
#pragma unroll
                    for (int bj = 0; bj < 2; ++bj) { f32x4 v0 = acc[ai][bj][m][0] * rs, v1 = acc[ai][bj][m][1] * rs;
                        if (mode == 1) {
#pragma unroll
                            for (int i = 0; i < 4; ++i) { v0[i] = sigmoidf_(v0[i]); v1[i] = sigmoidf_(v1[i]); } }
                        else if (mode == 2) {
#pragma unroll
                            for (int i = 0; i < 4; ++i) { v0[i] = siluf_(v0[i]); v1[i] = siluf_(v1[i]); } }
                        *(GAS u32x4*)(zp + bj * 128) = pack8(v0, v1); } }
        }
    }
};
struct EpiRes {
    static constexpr bool PERM = true; static constexpr int MID_T = 0;
    const bf16_t* xin; bf16_t* xb; float* ssq;
    __device__ __forceinline__ void operator()(const f32x4 (&acc)[2][2][4][2], const Unit& u, int wr, int wc, int fr, int fq) const {
        const int row0 = u.pm * 256 + wr * 64 + fr, col0 = u.pn * 256 + wc * 32 + 8 * fq;
        u32x4 rr[2][4][2];
#pragma unroll
        for (int ai = 0; ai < 2; ++ai)
#pragma unroll
            for (int m = 0; m < 4; ++m)
#pragma unroll
                for (int bj = 0; bj < 2; ++bj) rr[ai][m][bj] = *(const GAS u32x4*)((const GAS bf16_t*)xin + (size_t)(row0 + ai * 128 + m * 16) * D + col0 + bj * 128);
#pragma unroll
        for (int ai = 0; ai < 2; ++ai)
#pragma unroll
            for (int m = 0; m < 4; ++m) { const int row = row0 + ai * 128 + m * 16; const size_t off = (size_t)row * D + col0; float s = 0.f;
#pragma unroll
                for (int bj = 0; bj < 2; ++bj) {
                    const u32x4 r = rr[ai][m][bj];
                    f32x4 v0, v1;
                    v0[0] = bf2f(r.x & 0xffffu); v0[1] = bf2f(r.x >> 16); v0[2] = bf2f(r.y & 0xffffu); v0[3] = bf2f(r.y >> 16);
                    v1[0] = bf2f(r.z & 0xffffu); v1[1] = bf2f(r.z >> 16); v1[2] = bf2f(r.w & 0xffffu); v1[3] = bf2f(r.w >> 16);
                    v0 = v0 + acc[ai][bj][m][0]; v1 = v1 + acc[ai][bj][m][1];
                    *(GAS u32x4*)((GAS bf16_t*)xb + off + bj * 128) = pack8(v0, v1);
                    s += (v0[0] * v0[0] + v0[1] * v0[1]) + (v0[2] * v0[2] + v0[3] * v0[3]) + (v1[0] * v1[0] + v1[1] * v1[1]) + (v1[2] * v1[2] + v1[3] * v1[3]);
                }
                s += shfl_xor_l(s, fq * 16 + fr, 16); s += shfl_xor_l(s, fq * 16 + fr, 32);
                if (fq == 0) ((GAS float*)ssq)[(size_t)row * 16 + u.pn * 4 + wc] = s; }
    }
};
struct EpiResC {
    static constexpr bool PERM = true; static constexpr int MID_T = 12;
    EpiRes base; const float* ssqo;
    __device__ __forceinline__ void mid(f32x4 (&acc)[2][2][4][2], const Unit& u, int wr, int wc, int fr, int fq) const {
        if (!ssqo) return;
        const int row0 = u.pm * 256 + wr * 64 + fr;
#pragma unroll
        for (int ai = 0; ai < 2; ++ai)
#pragma unroll
            for (int m = 0; m < 4; ++m) { const int row = row0 + ai * 128 + m * 16;
                const GAS f32x4* sp = (const GAS f32x4*)((const GAS float*)ssqo + (size_t)row * 16); float tot = 0.f;
#pragma unroll
                for (int q4 = 0; q4 < (NH * NVS + 3) / 4; ++q4) { const f32x4 a = sp[q4];
#pragma unroll
                    for (int e = 0; e < 4; ++e) if (4 * q4 + e < NH * NVS) tot += a[e]; }
                const float rs = rsqrtf(tot * (1.0f / MIXW) + EPS);
#pragma unroll
                for (int bj = 0; bj < 2; ++bj)
#pragma unroll
                    for (int n = 0; n < 2; ++n) acc[ai][bj][m][n] = acc[ai][bj][m][n] * rs;
                asm volatile("" ::: "memory"); }
    }
    __device__ __forceinline__ void operator()(const f32x4 (&acc)[2][2][4][2], const Unit& u, int wr, int wc, int fr, int fq) const { base(acc, u, wr, wc, fr, fq); }
};
struct EpiFfn {
    static constexpr bool PERM = true; static constexpr int MID_T = 0;
    bf16_t* act; const float* ssq; LAS float* tab; int half;
    __device__ __forceinline__ void operator()(const f32x4 (&acc)[2][2][4][2], const Unit& u, int wr, int wc, int fr, int fq) const {
        const int hb = half < 0 ? 0 : 128 * half;
        const int row0 = u.pm * 256 + hb + wr * 64 + fr, jl = wc * 32 + 8 * fq;
        rstd_table(ssq, u.pm, tab, wr, wc, fr, fq);
        const LAS float* tl = tab + hb + wr * 64 + fr;
#pragma unroll
        for (int ai = 0; ai < 2; ++ai)
#pragma unroll
            for (int m = 0; m < 4; ++m) { if (ai == 1 && half >= 0) break; const int row = row0 + ai * 128 + m * 16; const float rs = tl[ai * 128 + m * 16];
                f32x4 v0, v1;
#pragma unroll
                for (int i = 0; i < 4; ++i) { v0[i] = siluf_(acc[ai][0][m][0][i] * rs) * (acc[ai][1][m][0][i] * rs); v1[i] = siluf_(acc[ai][0][m][1][i] * rs) * (acc[ai][1][m][1][i] * rs); }
                *(GAS u32x4*)((GAS bf16_t*)act + (size_t)row * DFF + u.pn * 128 + jl) = pack8(v0, v1); }
    }
};

#define XB_TMO      128
#define XB_XCNT(j)  (256  + 64 * (j))
#define XB_XSUB(j)  (1280 + 64 * (j))
#define XB_XGEN(j)  (2304 + 64 * (j))
#define XB_TOP      3328
#define XB_TOPGEN   3392
#define XCD_BAR_WORDS 3456
#define XB_SPIN_CAP (1u << 18)
__device__ __forceinline__ unsigned xb_ld(unsigned* p)              { return __hip_atomic_load(p, __ATOMIC_RELAXED, __HIP_MEMORY_SCOPE_AGENT); }
__device__ __forceinline__ unsigned xb_add(unsigned* p, unsigned v) { return __hip_atomic_fetch_add(p, v, __ATOMIC_RELAXED, __HIP_MEMORY_SCOPE_AGENT); }
__device__ __forceinline__ unsigned xb_xcc_id() { return (unsigned)__builtin_amdgcn_s_getreg((3 << 11) | 20) & 0xFu; }
#define XB_SPIN(cond, bar) do { unsigned _sp = 0; while (cond) { __builtin_amdgcn_s_sleep(1); \
    if ((++_sp & 255u) == 0u) { if (xb_ld(&(bar)[XB_TMO])) break; if (_sp > XB_SPIN_CAP) { atomicAdd(&(bar)[XB_TMO], 1u); break; } } } } while (0)
struct XcdBarrier { unsigned* bar; unsigned x; volatile LAS unsigned* st; };
__device__ __forceinline__ XcdBarrier xcd_barrier_post(unsigned* bar, volatile LAS unsigned* st) {
    XcdBarrier b; b.bar = bar; b.x = xb_xcc_id(); b.st = st;
    if (threadIdx.x == 0) st[2] = xb_add(&bar[XB_XCNT(b.x)], 1u);
    return b;
}
#define XB_LOC(j) (3456 + 64 * (j))
__device__ __forceinline__ void xcc_barrier(const XcdBarrier& b, unsigned n, bool leader, unsigned k) {
    asm volatile("s_waitcnt vmcnt(0)" ::: "memory");
    __syncthreads();
    if (leader) {
        unsigned* bar = b.bar; unsigned* cnt = &bar[XB_LOC(b.x)];
        __builtin_amdgcn_s_waitcnt(0);
        (void)xb_add(cnt, 1u);
        const unsigned target = k * n;
        XB_SPIN(xb_ld(cnt) < target, bar);
        __builtin_amdgcn_fence(__ATOMIC_ACQUIRE, "agent");
        asm volatile("s_waitcnt vmcnt(0)" ::: "memory");
    }
    __syncthreads();
}
#define XB_CVX(k, j) (4608 + 64 * (16 * (k) + (j)))
#define XB_CVG(k)    (6656 + 64 * (k))
#define XB_MKV(j)    (6912 + 64 * (j))
__device__ __forceinline__ void cv_signal(const XcdBarrier& b, int k, unsigned nconv, bool leader) {
    asm volatile("s_waitcnt vmcnt(0)" ::: "memory");
    __syncthreads();
    if (leader) {
        __builtin_amdgcn_s_waitcnt(0);
        if (xb_add(&b.bar[XB_CVX(k, b.x)], 1u) + 1u == nconv) {
            __builtin_amdgcn_fence(__ATOMIC_RELEASE, "agent");
            asm volatile("s_waitcnt vmcnt(0)" ::: "memory");
            xb_add(&b.bar[XB_CVG(k)], 1u);
        }
    }
}
__device__ __forceinline__ void cv_wait(const XcdBarrier& b, int k, unsigned nx, bool leader) {
    if (leader) {
        unsigned* bar = b.bar;
        XB_SPIN(xb_ld(&bar[XB_CVG(k)]) < nx, bar);
        __builtin_amdgcn_fence(__ATOMIC_ACQUIRE, "agent");
        asm volatile("s_waitcnt vmcnt(0)" ::: "memory");
    }
    __syncthreads();
}
__device__ __forceinline__ void xcd_barrier_complete(unsigned* bar, unsigned x, unsigned& nloc, unsigned& nx) {
    const unsigned G = gridDim.x * gridDim.y * gridDim.z;
    unsigned sum, cnt, mine, sp = 0u;
    for (;;) {
        sum = 0u; cnt = 0u; mine = 0u;
#pragma unroll
        for (unsigned j = 0; j < 16; ++j) { const unsigned c = xb_ld(&bar[XB_XCNT(j)]); sum += c; cnt += (c > 0u) ? 1u : 0u; mine = (j == x) ? c : mine; }
        if (sum == G) break;
        __builtin_amdgcn_s_sleep(1);
        if ((++sp & 255u) == 0u) { if (xb_ld(&bar[XB_TMO])) break; if (sp > XB_SPIN_CAP) { atomicAdd(&bar[XB_TMO], 1u); break; } }
    }
    nloc = mine > 0u ? mine : 1u; nx = cnt > 0u ? cnt : 1u;
}
__device__ __forceinline__ void xcd_barrier(const XcdBarrier& b, bool leader) {
    asm volatile("s_waitcnt vmcnt(0)" ::: "memory");
    __syncthreads();
    if (leader) {
        unsigned* bar = b.bar;
        __builtin_amdgcn_s_waitcnt(0);
        unsigned nloc = b.st[0], nx = b.st[1];
        if (nloc == 0u) { xcd_barrier_complete(bar, b.x, nloc, nx); b.st[0] = nloc; b.st[1] = nx; }
        const unsigned old = xb_add(&bar[XB_XSUB(b.x)], 1u);
        const unsigned gen = old / nloc;
        if (old + 1u == (gen + 1u) * nloc) {
            __builtin_amdgcn_fence(__ATOMIC_RELEASE, "agent");
            asm volatile("s_waitcnt vmcnt(0)" ::: "memory");
            const unsigned og = xb_add(&bar[XB_TOP], 1u);
            const unsigned tg = og / nx;
            if (og + 1u == (tg + 1u) * nx) xb_add(&bar[XB_TOPGEN], 1u);
            else XB_SPIN(xb_ld(&bar[XB_TOPGEN]) == tg, bar);
            __builtin_amdgcn_fence(__ATOMIC_ACQUIRE, "agent");
            xb_add(&bar[XB_XGEN(b.x)], 1u);
            asm volatile("s_waitcnt vmcnt(0)" ::: "memory");
        } else {
            XB_SPIN(xb_ld(&bar[XB_XGEN(b.x)]) == gen, bar);
            __builtin_amdgcn_fence(__ATOMIC_ACQUIRE, "agent");
            asm volatile("s_waitcnt vmcnt(0)" ::: "memory");
        }
    }
    __syncthreads();
}

constexpr int RING_BYTES = 131072, LDSCTL_OFF = RING_BYTES, MISC_OFF = LDSCTL_OFF + 320, LDS_BYTES = 147456;
constexpr int NWAVES = 8;

__device__ __forceinline__ int misc_rd(LAS unsigned char* lds, int idx) { unsigned off = (unsigned)(MISC_OFF + 4 * idx); asm volatile("" : "+v"(off)); return __builtin_amdgcn_readfirstlane((int)*(volatile LAS unsigned*)(lds + off)); }
struct Args { const float* in[15]; float* out; unsigned char* ws; int ph_lo, ph_hi; };

__device__ __forceinline__ int win_srccol(int j) {
    const int t = j >> 8;
    if (t >= 6) return j;
    const int jj = j & 255, half = jj >> 7, p = jj & 127, d = 4 * (p >> 3) + (p & 3) + 64 * ((p >> 2) & 1);
    return half * MIXW + t * 128 + d;
}
__device__ __forceinline__ int wfi_srccol(int j) { const int t = j >> 8, jj = j & 255; return (jj < 128 ? 0 : DFF) + t * 128 + (jj & 127); }
struct TItem { const GAS float* W; GAS bf16_t* WT; const GAS float* kscale; int K, N, ndst, kind, nscale, item; };
__device__ __forceinline__ TItem titem_decode(const Args& a, unsigned char* ws, int it) {
    constexpr int I0 = 16 * (NIN / 32), I1 = 16 * 32, I2 = 16 * (NFI / 32), I3 = (DFF / 64) * 32, I4 = 16 * 16, IL = I0 + I1 + I2 + I3 + I4;
    const int l = it / IL; int r = it % IL; TItem t;
    if (r < I0) { t.W = (const GAS float*)a.in[4] + (size_t)l * D * NIN; t.WT = (GAS bf16_t*)(ws + WS_WIN) + (size_t)l * NIN * D; t.kscale = (const GAS float*)a.in[3] + l * D; t.K = D; t.N = NIN; t.ndst = NIN; t.kind = 0; t.nscale = D; t.item = r; return t; } r -= I0;
    if (r < I1) { t.W = (const GAS float*)a.in[5] + (size_t)l * D * D; t.WT = (GAS bf16_t*)(ws + WS_WOUT) + (size_t)l * D * D; t.kscale = (const GAS float*)((l & 1) ? a.in[10] : a.in[9]) + (l >> 1) * MIXW; t.K = D; t.N = D; t.ndst = D; t.kind = 1; t.nscale = MIXW; t.item = r; return t; } r -= I1;
    if (r < I2) { t.W = (const GAS float*)a.in[12] + (size_t)l * D * NFI; t.WT = (GAS bf16_t*)(ws + WS_WFI) + (size_t)l * NFI * D; t.kscale = (const GAS float*)a.in[11] + l * D; t.K = D; t.N = NFI; t.ndst = NFI; t.kind = 2; t.nscale = D; t.item = r; return t; } r -= I2;
    if (r < I3) { t.W = (const GAS float*)a.in[13] + (size_t)l * DFF * D; t.WT = (GAS bf16_t*)(ws + WS_WFO) + (size_t)l * D * DFF; t.kscale = (const GAS float*)a.in[13]; t.K = DFF; t.N = D; t.ndst = D; t.kind = 3; t.nscale = 0; t.item = r; return t; } r -= I3;
    t.W = (const GAS float*)a.in[7] + (size_t)l * D * 512; t.WT = (GAS bf16_t*)(ws + WS_WM) + (size_t)l * 512 * D; t.kscale = (const GAS float*)a.in[6] + l * D; t.K = D; t.N = 512; t.ndst = 512; t.kind = 4; t.nscale = D; t.item = r; return t;
}
__device__ __forceinline__ void titem_load(const TItem& t, f32x4 (&v)[8], int lane) {
    const int nblk = t.ndst / 32, kb = t.item / nblk, nb = t.item % nblk, k0 = 64 * kb, n0 = 32 * nb, kq = lane >> 3, jd = n0 + 4 * (lane & 7);
    const int sc = t.kind == 0 ? win_srccol(jd) : (t.kind == 2 ? wfi_srccol(jd) : jd);
#pragma unroll
    for (int i = 0; i < 8; ++i) v[i] = *(const GAS f32x4*)(t.W + (size_t)(k0 + 8 * i + kq) * t.N + sc);
}
__device__ __forceinline__ void titem_store(const TItem& t, const f32x4 (&v)[8], LAS float* scr, int lane) {
    const int nblk = t.ndst / 32, kb = t.item / nblk, nb = t.item % nblk, k0 = 64 * kb, n0 = 32 * nb, kq = lane >> 3, nq = lane & 7;
#pragma unroll
    for (int i = 0; i < 8; ++i)
#pragma unroll
        for (int e = 0; e < 4; ++e) scr[(8 * i + kq) * 33 + 4 * nq + e] = v[i][e];
    const int c = lane & 7;
    f32x4 s0 = (f32x4){1.f, 1.f, 1.f, 1.f}, s1 = s0;
    if (k0 + 8 * c < t.nscale) { s0 = *(const GAS f32x4*)(t.kscale + k0 + 8 * c); s1 = *(const GAS f32x4*)(t.kscale + k0 + 8 * c + 4); }
    asm volatile("s_waitcnt lgkmcnt(0)" ::: "memory");
#pragma unroll
    for (int j = 0; j < 4; ++j) { const int n = (lane >> 3) + 8 * j; const LAS float* s = scr + (8 * c) * 33 + n;
        u32x4 o; o.x = pk2(s[0 * 33] * s0[0], s[1 * 33] * s0[1]); o.y = pk2(s[2 * 33] * s0[2], s[3 * 33] * s0[3]); o.z = pk2(s[4 * 33] * s1[0], s[5 * 33] * s1[1]); o.w = pk2(s[6 * 33] * s1[2], s[7 * 33] * s1[3]);
        *(GAS u32x4*)(t.WT + (size_t)(n0 + n) * t.K + k0 + 8 * c) = o; }
    asm volatile("s_waitcnt lgkmcnt(0)" ::: "memory");
}

constexpr int TITEMS_PER_LAYER = 16 * (NIN / 32) + 16 * 32 + 16 * (NFI / 32) + (DFF / 64) * 32 + 16 * 16;
__device__ __forceinline__ void convert_weights(const Args& a, unsigned char* ws, LAS float* scr, int it0, int it1, int w, int nw, int lane, int off = 0, int mul = 1) {
    f32x4 va[8], vb[8];
    nw *= mul;
    int it = it0 + off + mul * w;
    if (it < it1) { const TItem t = titem_decode(a, ws, it); titem_load(t, va, lane); }
    while (it < it1) {
        const int itn = it + nw;
        if (itn < it1) { const TItem t = titem_decode(a, ws, itn); titem_load(t, vb, lane); }
        { const TItem t = titem_decode(a, ws, it); titem_store(t, va, scr, lane); }
        it = itn;
        if (it >= it1) break;
        const int itn2 = it + nw;
        if (itn2 < it1) { const TItem t = titem_decode(a, ws, itn2); titem_load(t, va, lane); }
        { const TItem t = titem_decode(a, ws, it); titem_store(t, vb, scr, lane); }
        it = itn2;
    }
}

__device__ __forceinline__ void p0_prologue(const Args& a, unsigned char* ws, LAS unsigned char* lds, int gw, int NGW, int wave, int lane) {
    LAS float* scr = (LAS float*)(lds + wave * 16384);
    convert_weights(a, ws, scr, 0, 16 * (NIN / 32), gw, NGW, lane);
    for (int l = 0; l < DEPTH; ++l) convert_weights(a, ws, scr, l * TITEMS_PER_LAYER + TITEMS_PER_LAYER - 256, (l + 1) * TITEMS_PER_LAYER, gw, NGW, lane);
    for (int m = gw; m < M; m += NGW) {
        const f32x4* xr = (const f32x4*)(a.in[0] + (size_t)m * D) + lane; f32x4 v[4]; float s = 0.f;
#pragma unroll
        for (int j = 0; j < 4; ++j) { v[j] = xr[64 * j]; s += (v[j].x * v[j].x + v[j].y * v[j].y) + (v[j].z * v[j].z + v[j].w * v[j].w); }
        s = wave_sum(s, lane);
        u32x2* o8 = (u32x2*)((bf16_t*)(ws + WS_XB) + (size_t)m * D) + lane;
#pragma unroll
        for (int j = 0; j < 4; ++j) { u32x2 w; w.x = pk2(v[j].x, v[j].y); w.y = pk2(v[j].z, v[j].w); o8[64 * j] = w; }
        if (lane < 16) ((float*)(ws + WS_SSQA))[(size_t)m * 16 + lane] = lane == 0 ? s : 0.f;
    }
    for (int m = gw; m < MROWS; m += NGW) {
        const f32x4* xr = (const f32x4*)(a.in[1] + (size_t)m * D) + lane; f32x4 v[4]; float s = 0.f;
#pragma unroll
        for (int j = 0; j < 4; ++j) { v[j] = xr[64 * j]; s += (v[j].x * v[j].x + v[j].y * v[j].y) + (v[j].z * v[j].z + v[j].w * v[j].w); }
        const float rs = rsqrtf(wave_sum(s, lane) * (1.0f / D) + EPS);
        u32x2* o8 = (u32x2*)((bf16_t*)(ws + WS_MEMB) + (size_t)m * D) + lane;
#pragma unroll
        for (int j = 0; j < 4; ++j) { u32x2 w; w.x = pk2(v[j].x * rs, v[j].y * rs); w.y = pk2(v[j].z * rs, v[j].w * rs); o8[64 * j] = w; }
    }
    {   const double invf = exp(-9.210340371976184 * ((double)lane / 63.0));
        for (int m = gw; m < M; m += NGW) {
            const double ang = (double)((const GAS int*)a.in[2])[m] * invf;
            const double kr = rint(ang * 0.15915494309189535);
            const float r = (float)fma(-kr, 1.2246467991473532e-16 * 2.0, fma(-kr, 6.283185307179586, ang));
            float sn, cs; sincosf(r, &sn, &cs);
            ((GAS float*)(ws + WS_COS))[(size_t)m * 64 + lane] = cs;
            ((GAS float*)(ws + WS_SIN))[(size_t)m * 64 + lane] = sn;
        }
    }
    for (int c = gw * 64 + lane; c < MIXW; c += NGW * 64) {
        const float l0 = a.in[8][c], l1 = a.in[8][MIXW + c]; const float mx = fmaxf(l0, l1), e0 = expf(l0 - mx), e1 = expf(l1 - mx);
        ((float*)(ws + WS_LB))[c] = 0.f; ((float*)(ws + WS_LB))[MIXW + c] = e1 / (e0 + e1);
    }
}

typedef float f32x16 __attribute__((ext_vector_type(16)));
constexpr int SC_QS = 0, SC_KS = 8704, SC_KST = 17408, SC_V = 27648, SC_P = 37888, SC_AUX = 40448, SC_OUT = 41472, SC_SSQ = 50176, SC_GATE = 50688, SC_BUF = 50688 + 32 * VPR * 16;
constexpr int PQ = 272, PT = 320;
constexpr int NCHUNK = SEQ / 32;
typedef const GAS bf16_t* gbf;
struct HRegs { u32x4 x0[8], x1[8]; float aux[2]; };
__device__ __forceinline__ bf16x8 as_bf16x8(u32x4 v) { return __builtin_bit_cast(bf16x8, v); }

struct StLane { unsigned g0, g1, gg, ga, l0, l1, lg, la, sk; };
template <int IS_RET>
__device__ __forceinline__ void stager_load(HRegs& R, gbf Z, gbf KST, const GAS float* AUXG, int b, int h, int unit, int sw, const StLane& L, int chunk) {
    chunk = chunk < NCHUNK ? chunk : NCHUNK - 1;
    const size_t tok0 = (size_t)b * SEQ + chunk * 32;
    const int p0 = (sw == 0 || IS_RET) ? NIN : MIXW;
    const GAS char* s0 = (const GAS char*)(sw == 0 ? Z + h * 256 : (IS_RET ? Z + h * 256 + 128 : KST + h * 128)) + tok0 * p0 * 2;
    const GAS char* s1 = (const GAS char*)(sw == 0 ? Z + h * 256 + 128 : Z + 1536 + h * 128) + tok0 * NIN * 2;
#pragma unroll
    for (int i = 0; i < 8; ++i) R.x0[i] = *(const GAS u32x4*)(s0 + (size_t)(4 * i) * p0 * 2 + L.g0);
    if (sw == 0) {
#pragma unroll
        for (int i = 0; i < 8; ++i) R.x1[i] = *(const GAS u32x4*)(s1 + 32 * i + L.g1);
    } else {
#pragma unroll
        for (int i = 0; i < 8 / NVS; ++i) R.x1[i] = *(const GAS u32x4*)(s1 + (size_t)(4 * NVS * i) * NIN * 2 + L.g1);
    }
    if (!IS_RET) { const GAS char* ag = (const GAS char*)(AUXG + ((size_t)unit * 64 + chunk) * 256 + 128 * sw); R.aux[0] = *(const GAS float*)(ag + L.ga); R.aux[1] = *(const GAS float*)(ag + 256 + L.ga); }
}
template <int IS_RET>
__device__ __forceinline__ void stager_stage(const HRegs& R, LAS unsigned char* buf, LAS unsigned char* gbuf, int sw, const StLane& L) {
    const int o0 = sw == 0 ? SC_QS : SC_KST, o1 = sw == 0 ? SC_KS : SC_V, pit = sw == 0 ? PQ : PT;
    LAS unsigned char* d0 = buf + o0 + L.l0; LAS unsigned char* d1 = buf + o1 + L.l1;
#pragma unroll
    for (int i = 0; i < 8; ++i) *(LAS u32x4*)(d0 + 4 * i * pit) = R.x0[i];
    if (sw != 0) {
#pragma unroll
        for (int i = 0; i < 8 / NVS; ++i) *(LAS u32x4*)(d1 + 4 * NVS * i * PT) = R.x1[i];
    }
    if (!IS_RET) { LAS unsigned char* al = buf + SC_AUX + 512 * sw + L.la; *(LAS float*)al = R.aux[0]; *(LAS float*)(al + 256) = R.aux[1]; }
}
__device__ __forceinline__ void scores_stage(const HRegs& R, LAS unsigned char* buf, const StLane& L, int l31, int hh) {
    f32x16 d;
#pragma unroll
    for (int r = 0; r < 16; ++r) d[r] = 0.f;
    u32x4 qf[8];
    {   const unsigned aq = (unsigned)(size_t)(buf + SC_QS) + L.sk;
        asm volatile(
            "ds_read_b128 %0, %8 offset:0\n\tds_read_b128 %1, %8 offset:32\n\tds_read_b128 %2, %8 offset:64\n\tds_read_b128 %3, %8 offset:96\n\t"
            "ds_read_b128 %4, %8 offset:128\n\tds_read_b128 %5, %8 offset:160\n\tds_read_b128 %6, %8 offset:192\n\tds_read_b128 %7, %8 offset:224\n\t"
            "s_waitcnt lgkmcnt(0)"
            : "=&v"(qf[0]), "=&v"(qf[1]), "=&v"(qf[2]), "=&v"(qf[3]), "=&v"(qf[4]), "=&v"(qf[5]), "=&v"(qf[6]), "=&v"(qf[7])
            : "v"(aq) : "memory");
        __builtin_amdgcn_sched_barrier(0);
    }
#pragma unroll
    for (int kk = 0; kk < 8; ++kk) d = __builtin_amdgcn_mfma_f32_32x32x16_bf16(as_bf16x8(R.x1[kk]), as_bf16x8(qf[kk]), d, 0, 0, 0);
#pragma unroll
    for (int q = 0; q < 4; ++q) { float v4[4];
#pragma unroll
        for (int i = 0; i < 4; ++i) { const int srow = 8 * q + 4 * hh + i; v4[i] = (srow <= l31) ? d[4 * q + i] : 0.f; }
        u32x2 w; w.x = pg8::cvt_pk_bf16(v4[0], v4[1]); w.y = pg8::cvt_pk_bf16(v4[2], v4[3]);
        *(LAS u32x2*)(buf + SC_P + l31 * 80 + (8 * q + 4 * hh) * 2) = w; }
}
struct FinLane { unsigned lo, ls, go, gs, gz; };
constexpr int FPT = 32 * VPR / 64;
template <int IS_RET>
__device__ __forceinline__ void gate_load(u32x4 (&g)[FPT], gbf Z, int b, int h, const FinLane& L, int chunk) {
    chunk = chunk < NCHUNK ? chunk : NCHUNK - 1;
    const GAS char* sg = (const GAS char*)(Z + 2304 + h * 128) + ((size_t)b * SEQ + chunk * 32) * NIN * 2;
#pragma unroll
    for (int i = 0; i < FPT; ++i) g[i] = *(const GAS u32x4*)(sg + (size_t)(64 / VPR * i) * NIN * 2 + L.gz);
}
__device__ __forceinline__ void gate_stage(const u32x4 (&g)[FPT], LAS unsigned char* buf, int lane) {
#pragma unroll
    for (int i = 0; i < FPT; ++i) *(LAS u32x4*)(buf + SC_GATE + (lane + 64 * i) * 16) = g[i];
}
template <int IS_RET>
__device__ __forceinline__ void fin_store(LAS unsigned char* buf, GAS bf16_t* CAT, GAS float* SSQO, int b, int h, int vh, const FinLane& L, int lane, bool first, int chunk) {
    const size_t tok0 = (size_t)b * SEQ + chunk * 32;
    GAS char* cg = (GAS char*)(CAT + tok0 * D + h * 128); GAS char* sgp = (GAS char*)(SSQO + tok0 * 16 + h * NVS + vh);
#pragma unroll
    for (int i = 0; i < FPT; ++i) {
        const u32x2 lo = *(const LAS u32x2*)(buf + SC_OUT + (64 / VPR) * i * PQ + L.lo), hi = *(const LAS u32x2*)(buf + SC_OUT + (64 / VPR) * i * PQ + 8 + L.lo);
        const LAS unsigned char* sq = buf + SC_SSQ + (64 / VPR) * 4 * i + L.ls;
        float ssum = *(const LAS float*)sq;
#pragma unroll
        for (int w = 1; w < 4 / NVS; ++w) ssum += *(const LAS float*)(sq + 128 * w);
        const float sc = (IS_RET && NVS == 1) ? rsqrtf(ssum * (1.0f / HD) + EPS) : 1.0f;
        const u32x4 gt = *(const LAS u32x4*)(buf + SC_GATE + (lane + 64 * i) * 16);
        const unsigned ow[4] = {lo.x, lo.y, hi.x, hi.y}; u32x4 out;
#pragma unroll
        for (int j = 0; j < 4; ++j) out[j] = pg8::cvt_pk_bf16(__uint_as_float(ow[j] << 16) * sc * __uint_as_float(gt[j] << 16), __uint_as_float(ow[j] & 0xffff0000u) * sc * __uint_as_float(gt[j] & 0xffff0000u));
        *(GAS u32x4*)(cg + (size_t)(64 / VPR * i) * D * 2 + L.go) = out;
        if ((!IS_RET || NVS > 1) && first) *(GAS float*)(sgp + (size_t)(64 / VPR * i) * 64 + L.gs) = ssum; }
}
__device__ __forceinline__ void norm_rows(unsigned char* ws, int row0, int row1, int gw, int NGW, int lane) {
    GAS bf16_t* CAT = (GAS bf16_t*)(ws + WS_CAT); const GAS float* SSQO = (const GAS float*)(ws + WS_SSQO);
    static_assert(NVS == 2, "the two partial sums of a head are read as one 8-byte pair");
    for (int rowb = row0 + gw; rowb < row1; rowb += 4 * NGW) {
        u32x2 w[4][3]; f32x2 sq[4][3];
#pragma unroll
        for (int k = 0; k < 4; ++k) { const int row = rowb + k * NGW < row1 ? rowb + k * NGW : rowb;
#pragma unroll
            for (int j = 0; j < 3; ++j) { const int e = lane * 4 + 256 * j, h = e >> 7;
                sq[k][j] = *(const GAS f32x2*)(SSQO + (size_t)row * 16 + h * NVS); w[k][j] = *(const GAS u32x2*)(CAT + (size_t)row * D + e); } }
#pragma unroll
        for (int k = 0; k < 4; ++k) { const int row = rowb + k * NGW;
            if (row < row1) {
#pragma unroll
                for (int j = 0; j < 3; ++j) { const int e = lane * 4 + 256 * j;
                    const float sc = rsqrtf((sq[k][j][0] + sq[k][j][1]) * (1.0f / HD) + EPS); u32x2 o;
                    o.x = pg8::cvt_pk_bf16(__uint_as_float(w[k][j].x << 16) * sc, __uint_as_float(w[k][j].x & 0xffff0000u) * sc); o.y = pg8::cvt_pk_bf16(__uint_as_float(w[k][j].y << 16) * sc, __uint_as_float(w[k][j].y & 0xffff0000u) * sc);
                    *(GAS u32x2*)(CAT + (size_t)row * D + e) = o; } } }
    }
}
#define TRR(dst, areg, off) "ds_read_b64_tr_b16 " dst ", " areg " offset:" #off "\n\t"
struct MLane { unsigned av, ak, aq, aaux, ap, aout, assq; };
template <int IS_RET, int PAR>
__device__ __forceinline__ void mfma_step(f32x16 (&S)[4], const MLane& A, int lane, float g32) {
    constexpr unsigned PB = PAR * SC_BUF;
    u32x2 v00, v01, v10, v11, k[4][2][2]; u32x4 qf[4][2];
    const unsigned av = A.av + PB, ak = A.ak + PB, aq = A.aq + PB;
    asm volatile(
        "ds_read_b128 %0, %8 offset:0\n\tds_read_b128 %1, %8 offset:32\n\tds_read_b128 %2, %8 offset:64\n\tds_read_b128 %3, %8 offset:96\n\t"
        "ds_read_b128 %4, %8 offset:128\n\tds_read_b128 %5, %8 offset:160\n\tds_read_b128 %6, %8 offset:192\n\tds_read_b128 %7, %8 offset:224"
        : "=&v"(qf[0][0]), "=&v"(qf[0][1]), "=&v"(qf[1][0]), "=&v"(qf[1][1]), "=&v"(qf[2][0]), "=&v"(qf[2][1]), "=&v"(qf[3][0]), "=&v"(qf[3][1])
        : "v"(aq) : "memory");
    asm volatile(
        TRR("%0", "%12", 0) TRR("%1", "%12", 1280) TRR("%2", "%12", 5120) TRR("%3", "%12", 6400)
        TRR("%4", "%13", 0) TRR("%5", "%13", 1280) TRR("%6", "%13", 5120) TRR("%7", "%13", 6400)
        TRR("%8", "%13", 64) TRR("%9", "%13", 1344) TRR("%10", "%13", 5184) TRR("%11", "%13", 6464)
        : "=&v"(v00), "=&v"(v01), "=&v"(v10), "=&v"(v11),
          "=&v"(k[0][0][0]), "=&v"(k[0][0][1]), "=&v"(k[0][1][0]), "=&v"(k[0][1][1]), "=&v"(k[1][0][0]), "=&v"(k[1][0][1]), "=&v"(k[1][1][0]), "=&v"(k[1][1][1])
        : "v"(av), "v"(ak) : "memory");
    const LAS unsigned char* auxp = (const LAS unsigned char*)(size_t)(A.aaux + PB);
    bf16x8 sf[4][2];
#pragma unroll
    for (int kt = 0; kt < 4; ++kt) { f32x16 t = S[kt];
        if (!IS_RET) {
#pragma unroll
            for (int q = 0; q < 4; ++q) { const f32x4 e = *(const LAS f32x4*)(auxp + (32 * kt + 16 * (q >> 1) + 4 * (q & 1)) * 4);
#pragma unroll
                for (int i = 0; i < 4; ++i) t[4 * q + i] *= e[i]; } }
#pragma unroll
        for (int s2 = 0; s2 < 2; ++s2) { u32x4 pk;
#pragma unroll
            for (int j = 0; j < 4; ++j) pk[j] = pg8::cvt_pk_bf16(t[8 * s2 + 2 * j], t[8 * s2 + 2 * j + 1]);
            sf[kt][s2] = as_bf16x8(pk); } }
    asm volatile("s_waitcnt lgkmcnt(12)" : "+v"(qf[0][0]), "+v"(qf[0][1]), "+v"(qf[1][0]), "+v"(qf[1][1]), "+v"(qf[2][0]), "+v"(qf[2][1]), "+v"(qf[3][0]), "+v"(qf[3][1]) :: "memory");
    asm volatile(
        TRR("%0", "%8", 128) TRR("%1", "%8", 1408) TRR("%2", "%8", 5248) TRR("%3", "%8", 6528)
        TRR("%4", "%8", 192) TRR("%5", "%8", 1472) TRR("%6", "%8", 5312) TRR("%7", "%8", 6592)
        : "=&v"(k[2][0][0]), "=&v"(k[2][0][1]), "=&v"(k[2][1][0]), "=&v"(k[2][1][1]), "=&v"(k[3][0][0]), "=&v"(k[3][0][1]), "=&v"(k[3][1][0]), "=&v"(k[3][1][1])
        : "v"(ak) : "memory");
    __builtin_amdgcn_sched_barrier(0);
    f32x16 o;
#pragma unroll
    for (int r = 0; r < 16; ++r) o[r] = 0.f;
#pragma unroll
    for (int kt = 0; kt < 4; ++kt)
#pragma unroll
        for (int s2 = 0; s2 < 2; ++s2) o = __builtin_amdgcn_mfma_f32_32x32x16_bf16(sf[kt][s2], as_bf16x8(qf[kt][s2]), o, 0, 0, 0);
    __builtin_amdgcn_sched_barrier(0);
    asm volatile("s_waitcnt lgkmcnt(0)" : "+v"(v00), "+v"(v01), "+v"(v10), "+v"(v11),
          "+v"(k[0][0][0]), "+v"(k[0][0][1]), "+v"(k[0][1][0]), "+v"(k[0][1][1]), "+v"(k[1][0][0]), "+v"(k[1][0][1]), "+v"(k[1][1][0]), "+v"(k[1][1][1]),
          "+v"(k[2][0][0]), "+v"(k[2][0][1]), "+v"(k[2][1][0]), "+v"(k[2][1][1]), "+v"(k[3][0][0]), "+v"(k[3][0][1]), "+v"(k[3][1][0]), "+v"(k[3][1][1]) :: "memory");
    __builtin_amdgcn_sched_barrier(0);
    const bf16x8 vt[2] = {as_bf16x8((u32x4){v00.x, v00.y, v01.x, v01.y}), as_bf16x8((u32x4){v10.x, v10.y, v11.x, v11.y})};
    const LAS unsigned char* pp = (const LAS unsigned char*)(size_t)(A.ap + PB);
#pragma unroll
    for (int kk = 0; kk < 2; ++kk) { const bf16x8 pf = *(const LAS bf16x8*)(pp + 32 * kk);
        o = __builtin_amdgcn_mfma_f32_32x32x16_bf16(vt[kk], pf, o, 0, 0, 0); }
#pragma unroll
    for (int kt = 0; kt < 4; ++kt) {
        if (!IS_RET) {
#pragma unroll
            for (int q = 0; q < 4; ++q) { const f32x4 e = *(const LAS f32x4*)(auxp + 512 + (32 * kt + 16 * (q >> 1) + 4 * (q & 1)) * 4);
#pragma unroll
                for (int i = 0; i < 4; ++i) S[kt][4 * q + i] *= e[i]; } }
#pragma unroll
        for (int kk = 0; kk < 2; ++kk) S[kt] = __builtin_amdgcn_mfma_f32_32x32x16_bf16(as_bf16x8((u32x4){k[kt][kk][0].x, k[kt][kk][0].y, k[kt][kk][1].x, k[kt][kk][1].y}), vt[kk], S[kt], 0, 0, 0);
        if (IS_RET) S[kt] = S[kt] * g32;
    }
    float ss = 0.f;
#pragma unroll
    for (int r = 0; r < 16; ++r) ss += o[r] * o[r];
    ss += shfl_xor_l(ss, lane, 32);
    if (lane < 32) *(LAS float*)(size_t)(A.assq + PB) = ss;
    LAS unsigned char* op = (LAS unsigned char*)(size_t)(A.aout + PB);
#pragma unroll
    for (int q = 0; q < 4; ++q) { u32x2 wv; wv.x = pg8::cvt_pk_bf16(o[4 * q], o[4 * q + 1]); wv.y = pg8::cvt_pk_bf16(o[4 * q + 2], o[4 * q + 3]);
        *(LAS u32x2*)(op + 16 * q) = wv; }
}
template <int IS_RET, int VAR>
__device__ __forceinline__ void scan2_unit(unsigned char* ws, LAS unsigned char* lds, int unit, int tid) {
    constexpr bool MF_ON = VAR == 0 || ((VAR & 16) && (VAR & 1)), ST_ON = VAR == 0 || ((VAR & 16) && (VAR & 2)), FI_ON = VAR == 0 || ((VAR & 16) && (VAR & 4)), ST_LD = ST_ON && !(VAR & 64), ST_ST = ST_ON && !(VAR & 32);
    gbf Z = (gbf)(ws + WS_Z); gbf KST = (gbf)(ws + WS_KST); const GAS float* AUXG = (const GAS float*)(ws + WS_AUX);
    GAS bf16_t* CAT = (GAS bf16_t*)(ws + WS_CAT); GAS float* SSQO = (GAS float*)(ws + WS_SSQO);
    const int b = unit / (NH * NVS), h = (unit / NVS) % NH, vh = unit % NVS, hu = b * NH + h, wave = __builtin_amdgcn_readfirstlane(tid >> 6); int lane = tid & 63;
    const float g32 = exp2f(32.0f * __log2f(1.0f - exp2f(-5.0f - (float)h)));
    __syncthreads();
    static_assert(NVS == 2, "wave roles below are written for two value slices per head");
    if (wave >= 6) {
        __syncthreads();
        for (int n = 0; n < NCHUNK; ++n) __syncthreads();
    } else if (wave < 2) {
        asm volatile("" : "+v"(lane));
        const int l31 = lane & 31, hh = lane >> 5, vs = (128 / NVS) * vh + 32 * wave;
        const unsigned base = (unsigned)(size_t)lds, trl = (unsigned)((8 * hh + ((lane & 15) >> 2)) * PT + (16 * ((lane >> 4) & 1) + 4 * (lane & 3)) * 2);
        const int psw = ((lane & 3) == 1) ? 2 : (((lane & 3) == 2) ? 1 : (lane & 3));
        const unsigned trk = (unsigned)((8 * hh + ((lane & 15) >> 2)) * PT + (16 * ((lane >> 4) & 1) + 4 * psw) * 2);
        MLane A;
        A.av = base + SC_V + trl + vs * 2; A.ak = base + SC_KST + trk; A.aq = base + SC_QS + l31 * PQ + 16 * hh; A.aaux = base + SC_AUX + 32 * hh; A.ap = base + SC_P + l31 * 80 + 16 * hh;
        A.aout = base + SC_OUT + l31 * PQ + (vs + 4 * hh) * 2; A.assq = base + SC_SSQ + (wave * 32 + l31) * 4;
        asm volatile("" : "+v"(A.av), "+v"(A.ak), "+v"(A.aq), "+v"(A.aaux), "+v"(A.ap), "+v"(A.aout), "+v"(A.assq));
        f32x16 S[4];
#pragma unroll
        for (int kt = 0; kt < 4; ++kt)
#pragma unroll
            for (int r = 0; r < 16; ++r) S[kt][r] = 0.f;
        __syncthreads();
        for (int n = 0; n < NCHUNK; n += 2) {
            if (MF_ON) mfma_step<IS_RET, 0>(S, A, lane, g32);
            __syncthreads();
            if (MF_ON) mfma_step<IS_RET, 1>(S, A, lane, g32);
            __syncthreads();
        }
        if (!MF_ON) asm volatile("" :: "v"(S[0][0]));
    } else if (wave < 4) {
        const int sw = wave - 2;
        if (!ST_ON) { __syncthreads(); for (int n = 0; n < NCHUNK; ++n) __syncthreads(); }
        else {
        asm volatile("" : "+v"(lane));
        const int l31 = lane & 31, hh = lane >> 5, r4 = lane >> 4, c16 = lane & 15, p0 = (sw == 0 || IS_RET) ? NIN : MIXW;
        StLane L;
        L.g0 = (unsigned)((r4 * p0 + 8 * c16) * 2); L.gg = 0; L.ga = (unsigned)(lane * 4);
        L.l0 = (unsigned)(r4 * (sw == 0 ? PQ : PT) + 16 * c16); L.lg = (unsigned)(lane * 16); L.la = (unsigned)(lane * 4); L.sk = (unsigned)(l31 * PQ + 16 * hh);
        if (sw == 0) { L.g1 = (unsigned)((l31 * NIN + 8 * hh) * 2); L.l1 = 0; }
        else { const int rv = lane / VPR, cv = VPR * vh + lane % VPR; L.g1 = (unsigned)((rv * NIN + 8 * cv) * 2); L.l1 = (unsigned)(rv * PT + 16 * cv); }
        asm volatile("" : "+v"(L.g0), "+v"(L.g1), "+v"(L.gg), "+v"(L.ga), "+v"(L.l0), "+v"(L.l1), "+v"(L.lg), "+v"(L.la), "+v"(L.sk));
        HRegs RA, RB;
        stager_load<IS_RET>(RA, Z, KST, AUXG, b, h, hu, sw, L, 0);
        stager_stage<IS_RET>(RA, lds, lds + SC_BUF, sw, L);
        if (sw == 0) scores_stage(RA, lds, L, l31, hh);
        stager_load<IS_RET>(RB, Z, KST, AUXG, b, h, hu, sw, L, 1);
        __syncthreads();
        for (int n = 0; n < NCHUNK; n += 2) {
            if (ST_LD) stager_load<IS_RET>(RA, Z, KST, AUXG, b, h, hu, sw, L, n + 2);
            if (ST_ST) { stager_stage<IS_RET>(RB, lds + SC_BUF, lds, sw, L);
                if (sw == 0) scores_stage(RB, lds + SC_BUF, L, l31, hh); }
            else asm volatile("" :: "v"(RB.x0[0]), "v"(RB.x0[7]), "v"(RB.x1[0]), "v"(RB.aux[1]));
            __syncthreads();
            if (ST_LD) stager_load<IS_RET>(RB, Z, KST, AUXG, b, h, hu, sw, L, n + 3);
            if (ST_ST) { stager_stage<IS_RET>(RA, lds, lds + SC_BUF, sw, L);
                if (sw == 0) scores_stage(RA, lds, L, l31, hh); }
            else asm volatile("" :: "v"(RA.x0[0]), "v"(RA.x0[7]), "v"(RA.x1[0]), "v"(RA.aux[1]));
            __syncthreads();
        }
        }
    } else {
        asm volatile("" : "+v"(lane));
        FinLane L;
        {   const int c0 = lane / VPR, v0 = 8 * (VPR * vh + lane % VPR);
            L.lo = (unsigned)(c0 * PQ + v0 * 2); L.ls = (unsigned)(c0 * 4); L.go = (unsigned)((c0 * D + v0) * 2); L.gs = (unsigned)(c0 * 64); L.gz = (unsigned)((c0 * NIN + v0) * 2); }
        asm volatile("" : "+v"(L.lo), "+v"(L.ls), "+v"(L.go), "+v"(L.gs), "+v"(L.gz));
        if (wave == 4) {
            u32x4 gA[FPT], gB[FPT];
            gate_load<IS_RET>(gA, Z, b, h, L, 0); gate_load<IS_RET>(gB, Z, b, h, L, 1);
            __syncthreads();
            for (int n = 0; n < NCHUNK; n += 2) {
                if (FI_ON) { gate_stage(gA, lds, lane); gate_load<IS_RET>(gA, Z, b, h, L, n + 2); }
                __syncthreads();
                if (FI_ON) { gate_stage(gB, lds + SC_BUF, lane); gate_load<IS_RET>(gB, Z, b, h, L, n + 3); }
                __syncthreads();
            }
        } else {
            const bool first = (lane % VPR) == 0;
            __syncthreads();
            __syncthreads();
            for (int n = 1; n < NCHUNK; ++n) { if (FI_ON) fin_store<IS_RET>(lds + ((n - 1) & 1) * SC_BUF, CAT, SSQO, b, h, vh, L, lane, first, n - 1); __syncthreads(); }
            if (FI_ON) fin_store<IS_RET>(lds + ((NCHUNK - 1) & 1) * SC_BUF, CAT, SSQO, b, h, vh, L, lane, first, NCHUNK - 1);
        }
    }
}

constexpr int XA_K = 0, XA_KP = 144, XA_V = 256 * XA_KP, XA_VP = 192;
#define XRD(dst, areg, off) "ds_read_b128 " dst ", " areg " offset:" #off "\n\t"
__device__ __forceinline__ void xattn2_unit(unsigned char* ws, LAS unsigned char* lds, int unit, int layer, int tid) {
    gbf Z = (gbf)(ws + WS_Z); gbf MKV = (gbf)(ws + WS_MKV); GAS bf16_t* CAT = (GAS bf16_t*)(ws + WS_CAT);
    const int b = unit >> 5, hx = (unit >> 3) & 3, qb = unit & 7;
    const int wave = tid >> 6, lane = tid & 63, l31 = lane & 31, hh = lane >> 5;
    const size_t tok = (size_t)b * SEQ + qb * 256 + wave * 32 + l31;
    bf16x8 qf[4];
#pragma unroll
    for (int ks = 0; ks < 4; ++ks) qf[ks] = *(const GAS bf16x8*)(Z + tok * NIN + 3072 + hx * 64 + 16 * ks + 8 * hh);
    __syncthreads();
    {   gbf src = MKV + (size_t)(b * NMEM) * 2048 + layer * 512 + hx * 64;
        u32x4 kr[4], vr[4];
#pragma unroll
        for (int i = 0; i < 4; ++i) { const int piece = tid + 512 * i, key = piece >> 3, j = piece & 7;
            kr[i] = *(const GAS u32x4*)(src + (size_t)key * 2048 + 8 * j); vr[i] = *(const GAS u32x4*)(src + (size_t)key * 2048 + 256 + 8 * j); }
#pragma unroll
        for (int i = 0; i < 4; ++i) { const int piece = tid + 512 * i, key = piece >> 3, j = piece & 7;
            *(LAS u32x4*)(lds + XA_K + key * XA_KP + 16 * j) = kr[i]; *(LAS u32x4*)(lds + XA_V + key * XA_VP + 16 * j) = vr[i]; }
    }
    __syncthreads();
    f32x16 st[8];
    const unsigned ak = (unsigned)(size_t)(lds + XA_K) + (unsigned)(l31 * XA_KP + 16 * hh);
#define XBLK(T0, o0, o1, o2, o3, o4, o5, o6, o7) { u32x4 f0, f1, f2, f3, f4, f5, f6, f7; \
        asm volatile(XRD("%0", "%8", o0) XRD("%1", "%8", o1) XRD("%2", "%8", o2) XRD("%3", "%8", o3) XRD("%4", "%8", o4) XRD("%5", "%8", o5) XRD("%6", "%8", o6) XRD("%7", "%8", o7) "s_waitcnt lgkmcnt(0)" \
            : "=&v"(f0), "=&v"(f1), "=&v"(f2), "=&v"(f3), "=&v"(f4), "=&v"(f5), "=&v"(f6), "=&v"(f7) : "v"(ak) : "memory"); \
        __builtin_amdgcn_sched_barrier(0); \
        f32x16 a0, a1; _Pragma("unroll") for (int r = 0; r < 16; ++r) { a0[r] = 0.f; a1[r] = 0.f; } \
        a0 = __builtin_amdgcn_mfma_f32_32x32x16_bf16(as_bf16x8(f0), qf[0], a0, 0, 0, 0); a1 = __builtin_amdgcn_mfma_f32_32x32x16_bf16(as_bf16x8(f4), qf[0], a1, 0, 0, 0); \
        a0 = __builtin_amdgcn_mfma_f32_32x32x16_bf16(as_bf16x8(f1), qf[1], a0, 0, 0, 0); a1 = __builtin_amdgcn_mfma_f32_32x32x16_bf16(as_bf16x8(f5), qf[1], a1, 0, 0, 0); \
        a0 = __builtin_amdgcn_mfma_f32_32x32x16_bf16(as_bf16x8(f2), qf[2], a0, 0, 0, 0); a1 = __builtin_amdgcn_mfma_f32_32x32x16_bf16(as_bf16x8(f6), qf[2], a1, 0, 0, 0); \
        a0 = __builtin_amdgcn_mfma_f32_32x32x16_bf16(as_bf16x8(f3), qf[3], a0, 0, 0, 0); a1 = __builtin_amdgcn_mfma_f32_32x32x16_bf16(as_bf16x8(f7), qf[3], a1, 0, 0, 0); \
        st[T0] = a0; st[T0 + 1] = a1; }
    XBLK(0, 0, 32, 64, 96, 4608, 4640, 4672, 4704)
    XBLK(2, 9216, 9248, 9280, 9312, 13824, 13856, 13888, 13920)
    XBLK(4, 18432, 18464, 18496, 18528, 23040, 23072, 23104, 23136)
    XBLK(6, 27648, 27680, 27712, 27744, 32256, 32288, 32320, 32352)
#undef XBLK
    float mx = -1e30f;
#pragma unroll
    for (int T = 0; T < 8; ++T)
#pragma unroll
        for (int r = 0; r < 16; ++r) mx = fmaxf(mx, st[T][r]);
    mx = fmaxf(mx, shfl_xor_l(mx, lane, 32));
    const float c2 = 0.125f * 1.4426950408889634f, mc = mx * c2;
    float sum = 0.f;
#pragma unroll
    for (int T = 0; T < 8; ++T)
#pragma unroll
        for (int r = 0; r < 16; ++r) { const float p = exp2f(st[T][r] * c2 - mc); st[T][r] = p; sum += p; }
    sum += shfl_xor_l(sum, lane, 32);
    f32x16 ot[2];
#pragma unroll
    for (int dt = 0; dt < 2; ++dt)
#pragma unroll
        for (int r = 0; r < 16; ++r) ot[dt][r] = 0.f;
    const unsigned av = (unsigned)(size_t)(lds + XA_V) + (unsigned)((4 * hh + ((lane & 15) >> 2)) * XA_VP + (16 * ((lane >> 4) & 1) + 4 * (lane & 3)) * 2);
#define XTR(dst, off) "ds_read_b64_tr_b16 " dst ", %8 offset:" #off "\n\t"
#define VBLK(T, o00, o01, o10, o11, o20, o21, o30, o31) { u32x2 g0, g1, g2, g3, g4, g5, g6, g7; \
        asm volatile(XTR("%0", o00) XTR("%1", o01) XTR("%2", o10) XTR("%3", o11) XTR("%4", o20) XTR("%5", o21) XTR("%6", o30) XTR("%7", o31) "s_waitcnt lgkmcnt(0)" \
            : "=&v"(g0), "=&v"(g1), "=&v"(g2), "=&v"(g3), "=&v"(g4), "=&v"(g5), "=&v"(g6), "=&v"(g7) : "v"(av) : "memory"); \
        __builtin_amdgcn_sched_barrier(0); \
        u32x4 p0, p1; _Pragma("unroll") for (int j = 0; j < 4; ++j) { p0[j] = pg8::cvt_pk_bf16(st[T][2 * j], st[T][2 * j + 1]); p1[j] = pg8::cvt_pk_bf16(st[T][8 + 2 * j], st[T][8 + 2 * j + 1]); } \
        ot[0] = __builtin_amdgcn_mfma_f32_32x32x16_bf16(as_bf16x8((u32x4){g0.x, g0.y, g1.x, g1.y}), as_bf16x8(p0), ot[0], 0, 0, 0); \
        ot[1] = __builtin_amdgcn_mfma_f32_32x32x16_bf16(as_bf16x8((u32x4){g2.x, g2.y, g3.x, g3.y}), as_bf16x8(p0), ot[1], 0, 0, 0); \
        ot[0] = __builtin_amdgcn_mfma_f32_32x32x16_bf16(as_bf16x8((u32x4){g4.x, g4.y, g5.x, g5.y}), as_bf16x8(p1), ot[0], 0, 0, 0); \
        ot[1] = __builtin_amdgcn_mfma_f32_32x32x16_bf16(as_bf16x8((u32x4){g6.x, g6.y, g7.x, g7.y}), as_bf16x8(p1), ot[1], 0, 0, 0); }
    VBLK(0, 0, 1536, 64, 1600, 3072, 4608, 3136, 4672)
    VBLK(1, 6144, 7680, 6208, 7744, 9216, 10752, 9280, 10816)
    VBLK(2, 12288, 13824, 12352, 13888, 15360, 16896, 15424, 16960)
    VBLK(3, 18432, 19968, 18496, 20032, 21504, 23040, 21568, 23104)
    VBLK(4, 24576, 26112, 24640, 26176, 27648, 29184, 27712, 29248)
    VBLK(5, 30720, 32256, 30784, 32320, 33792, 35328, 33856, 35392)
    VBLK(6, 36864, 38400, 36928, 38464, 39936, 41472, 40000, 41536)
    VBLK(7, 43008, 44544, 43072, 44608, 46080, 47616, 46144, 47680)
#undef VBLK
#undef XTR
    const float il = 1.0f / sum;
    GAS bf16_t* op = CAT + tok * D + MIXW + hx * 64 + 4 * hh;
#pragma unroll
    for (int dt = 0; dt < 2; ++dt)
#pragma unroll
        for (int q = 0; q < 4; ++q) { u32x2 w; w.x = pg8::cvt_pk_bf16(ot[dt][4 * q] * il, ot[dt][4 * q + 1] * il); w.y = pg8::cvt_pk_bf16(ot[dt][4 * q + 2] * il, ot[dt][4 * q + 3] * il);
            *(GAS u32x2*)(op + 32 * dt + 8 * q) = w; }
}

__device__ __forceinline__ void final_rows(const unsigned char* ws, float* out, const float* nf, int row0, int row1, int gw, int NGW, int lane) {
    const GAS f32x4* wv = (const GAS f32x4*)nf + lane;
    for (int row = row0 + gw; row < row1; row += NGW) {
        const GAS u32x2* xr = (const GAS u32x2*)((const GAS bf16_t*)(ws + WS_XB) + (size_t)row * D) + lane; f32x4 v[4]; float s = 0.f;
#pragma unroll
        for (int j = 0; j < 4; ++j) { const u32x2 w = xr[64 * j]; v[j][0] = bf2f(w.x & 0xffffu); v[j][1] = bf2f(w.x >> 16); v[j][2] = bf2f(w.y & 0xffffu); v[j][3] = bf2f(w.y >> 16);
            s += (v[j].x * v[j].x + v[j].y * v[j].y) + (v[j].z * v[j].z + v[j].w * v[j].w); }
        const float rs = rsqrtf(wave_sum(s, lane) * (1.0f / D) + EPS);
        GAS f32x4* orow = (GAS f32x4*)(out + (size_t)row * D) + lane;
#pragma unroll
        for (int j = 0; j < 4; ++j) orow[64 * j] = v[j] * rs * wv[64 * j];
    }
}

__global__ void __launch_bounds__(NWAVES * 64, 2) mega_fwd(Args args) {
    extern __shared__ __attribute__((aligned(16))) unsigned char lds_raw[];
    LAS unsigned char* lds = (LAS unsigned char*)lds_raw;
    volatile LAS unsigned* MISC = (volatile LAS unsigned*)(lds + MISC_OFF);
    const int G = gridDim.x, bx = blockIdx.x;
    const int wave_s = __builtin_amdgcn_readfirstlane(threadIdx.x >> 6);
    unsigned char* ws = args.ws;
    for (int u = threadIdx.x; u < (LDS_BYTES - LDSCTL_OFF) / 4; u += NWAVES * 64) ((LAS unsigned*)(lds + LDSCTL_OFF))[u] = 0u;
    __syncthreads();
    XcdBarrier bar = xcd_barrier_post((unsigned*)(ws + WS_CTL) + CW_BAR, MISC + 8);
#define GBAR() xcd_barrier(bar, wave_s == 0 && lane_id_volatile() == 0)
#define OPAQ() unsigned char* wsp = ws; int Gp = G, bxp = bx, tidp = wave_s * 64 + lane_id_volatile(); asm volatile("" : "+s"(wsp), "+s"(Gp), "+s"(bxp), "+v"(tidp)); \
    const int lanep = tidp & 63, wavep = __builtin_amdgcn_readfirstlane(tidp >> 6), vcup = (Gp % 8 == 0) ? (bxp % 8) * (Gp / 8) + bxp / 8 : bxp, gwp = vcup * NWAVES + wavep, NGWp = Gp * NWAVES; \
    (void)lanep; (void)gwp; (void)NGWp
#define XPART() const int xn = misc_rd(lds, 8), xnx = misc_rd(lds, 9), xrank = misc_rd(lds, 10), xslot = misc_rd(lds, 11); \
    (void)xn; (void)xnx; (void)xrank; (void)xslot
    unsigned lbar_k = 0;
#define LBAR() xcc_barrier(bar, (unsigned)misc_rd(lds, 8), wave_s == 0 && lane_id_volatile() == 0, ++lbar_k)

    { OPAQ(); p0_prologue(args, wsp, lds, gwp, NGWp, wavep, lanep); }
    GBAR();
    if (threadIdx.x == 0) {
        unsigned slot = 0;
        for (unsigned j = 0; j < 16; ++j) { const unsigned c = xb_ld(&bar.bar[XB_XCNT(j)]); if (j < bar.x && c > 0u) ++slot; }
        MISC[11] = slot;
    }
    __syncthreads();
    for (int l = 0; l < DEPTH; ++l) {
        const int is_ret = l & 1;
        if (l >= 2) cv_wait(bar, l - 2, (unsigned)misc_rd(lds, 9), wave_s == 0 && lane_id_volatile() == 0);
        { OPAQ(); XPART();
            pg8::Gemm g{(const bf16_t*)(wsp + WS_XB), (const bf16_t*)(wsp + WS_WIN) + (size_t)l * NIN * D, M, NIN, D}; pg8::XccOrder S{xrank, xn, xslot, xnx, (NIN - XW) / 256, RBG_A, 1 << 30};
            EpiIn E{(bf16_t*)(wsp + WS_Z), (bf16_t*)(wsp + WS_KST), (float*)(wsp + WS_AUX), (const float*)(wsp + WS_SSQA), (const float*)(wsp + WS_LB) + (l >> 1) * MIXW, (const float*)(wsp + WS_COS), (const float*)(wsp + WS_SIN), is_ret, (LAS float*)(lds + RSTD_TAB_OFF)};
            pg8::gemm_phase<EpiIn, pg8::XccOrder, true, true>(lds, g, S, E, tidp);
        }
        LBAR();
        if (l == 0) { OPAQ(); XPART();
            constexpr int UB = NH * NVS + 8; const int nb = xslot < 8 ? (8 - xslot + xnx - 1) / xnx : 0, busy = UB * nb < xn ? UB * nb : 0, nidle = xn - busy;
            {
                if (xrank >= busy) {
                    pg8::Gemm g{(const bf16_t*)(wsp + WS_MEMB), (const bf16_t*)(wsp + WS_WM), MROWS, 2048, D}; pg8::XccOrderMem S{xrank - busy, nidle, xslot, xnx};
                    EpiPlain E{(bf16_t*)(wsp + WS_MKV), 2048};
                    pg8::gemm_phase<EpiPlain, pg8::XccOrderMem, true, true>(lds, g, S, E, tidp);
                }
                if (busy == 0) { xcc_barrier(bar, (unsigned)xn, wave_s == 0 && lane_id_volatile() == 0, ++lbar_k); }
                else if (xrank >= busy) {
                    asm volatile("s_waitcnt vmcnt(0)" ::: "memory"); __syncthreads();
                    if (wave_s == 0 && lane_id_volatile() == 0) { __builtin_amdgcn_s_waitcnt(0); xb_add(&bar.bar[XB_MKV(bar.x)], 1u); }
                }
            }
        }
        { OPAQ(); XPART();
            constexpr int UB = NH * NVS + 8;
            const int nb = xslot < 8 ? (8 - xslot + xnx - 1) / xnx : 0;
            const int busy = UB * nb < xn ? UB * nb : 0, nidle = xn - busy;
            for (int u = xrank; u < UB * nb; u += xn) {
                const int b = xslot + (u / UB) * xnx, uu = u % UB;
                if (uu < NH * NVS) { if (is_ret) scan2_unit<1, 0>(wsp, lds, b * NH * NVS + uu, tidp); else scan2_unit<0, 0>(wsp, lds, b * NH * NVS + uu, tidp); }
                else { const int rb = 8 * b + (uu - NH * NVS);
                    {   pg8::Gemm g{(const bf16_t*)(wsp + WS_XB), (const bf16_t*)(wsp + WS_WIN) + (size_t)l * NIN * D, M, NIN, D}; pg8::OneUnit S{rb, 12};
                        EpiIn E{(bf16_t*)(wsp + WS_Z), (bf16_t*)(wsp + WS_KST), (float*)(wsp + WS_AUX), (const float*)(wsp + WS_SSQA), (const float*)(wsp + WS_LB) + (l >> 1) * MIXW, (const float*)(wsp + WS_COS), (const float*)(wsp + WS_SIN), is_ret, (LAS float*)(lds + RSTD_TAB_OFF)};
                        pg8::gemm_phase<EpiIn, pg8::OneUnit, true, true>(lds, g, S, E, tidp); }
                    if (l == 0 && busy > 0) {
                        if (wave_s == 0 && lane_id_volatile() == 0) { unsigned* bb = bar.bar; XB_SPIN(xb_ld(&bb[XB_MKV(bar.x)]) < (unsigned)nidle, bb); }
                    }
                    asm volatile("s_waitcnt vmcnt(0)" ::: "memory"); __builtin_amdgcn_fence(__ATOMIC_RELEASE, "agent"); __syncthreads(); __builtin_amdgcn_fence(__ATOMIC_ACQUIRE, "agent");
                    int tidq = wave_s * 64 + lane_id_volatile(); asm volatile("" : "+v"(tidq));
                    for (int hx = 0; hx < NXH; ++hx) xattn2_unit(wsp, lds, (rb >> 3) * 32 + hx * 8 + (rb & 7), l, tidq);
                }
            }
            if (l < DEPTH - 1) {
                if (xrank >= busy) { const int wv = (xrank - busy) * NWAVES + wavep, nwv = nidle * NWAVES;
                    __syncthreads();
                    for (int l2 = (l == 0 ? 0 : l + 1); l2 < l + 2; ++l2) convert_weights(args, wsp, (LAS float*)(lds + wavep * 16384), l2 * TITEMS_PER_LAYER + (l2 == 0 ? 16 * (NIN / 32) : 0), (l2 + 1) * TITEMS_PER_LAYER - 256, wv, nwv, lanep, xslot < xnx ? xslot : 0, xnx);
                    if (l > 0) cv_signal(bar, l - 1, (unsigned)nidle, wave_s == 0 && lane_id_volatile() == 0);
                }
            }
            __syncthreads();
        }
        if (l == 0) GBAR(); else LBAR();
        if (NVS > 1 && is_ret) {
            { OPAQ(); XPART(); for (int b = xslot; b < BATCH; b += xnx) norm_rows(wsp, b * SEQ, (b + 1) * SEQ, xrank * NWAVES + wavep, xn * NWAVES, lanep); }
            LBAR();
        }
        { OPAQ(); XPART();
            pg8::Gemm g{(const bf16_t*)(wsp + WS_CAT), (const bf16_t*)(wsp + WS_WOUT) + (size_t)l * D * D, M, D, D}; pg8::XccOrder S{xrank, xn, xslot, xnx, D / 256, 4, 1 << 30};
            EpiResC E{EpiRes{(const bf16_t*)(wsp + WS_XB), (bf16_t*)(wsp + WS_XB), (float*)(wsp + WS_SSQD)}, is_ret ? nullptr : (const float*)(wsp + WS_SSQO)};
            pg8::gemm_phase<EpiResC, pg8::XccOrder, true, true>(lds, g, S, E, tidp);
        }
        LBAR();
        { OPAQ(); XPART();
            pg8::Gemm g{(const bf16_t*)(wsp + WS_XB), (const bf16_t*)(wsp + WS_WFI) + (size_t)l * NFI * D, M, NFI, D};
            const int totD = (xslot < 8 ? (8 - xslot + xnx - 1) / xnx : 0) * 8 * (NFI / 256), fullD = (totD / xn) * xn, leftD = totD - fullD; const bool halves = leftD > 0 && 2 * leftD <= xn;
            pg8::XccOrder S{xrank, xn, xslot, xnx, NFI / 256, RBG_D, halves ? fullD : (1 << 30)};
            EpiFfn E{(bf16_t*)(wsp + WS_ACT), (const float*)(wsp + WS_SSQD), (LAS float*)(lds + RSTD_TAB_OFF), -1};
            pg8::gemm_phase<EpiFfn, pg8::XccOrder, true, true>(lds, g, S, E, tidp);
            if (halves && xrank < 2 * leftD) { pg8::Unit hu; S.decode(fullD + xrank % leftD, hu);
                pg8::HalfUnit SH{hu.pm, hu.pn, xrank / leftD}; EpiFfn EH{(bf16_t*)(wsp + WS_ACT), (const float*)(wsp + WS_SSQD), (LAS float*)(lds + RSTD_TAB_OFF), xrank / leftD};
                pg8::gemm_phase<EpiFfn, pg8::HalfUnit, true, true, true>(lds, g, SH, EH, tidp); }
        }
        LBAR();
        { OPAQ(); XPART();
            pg8::Gemm g{(const bf16_t*)(wsp + WS_ACT), (const bf16_t*)(wsp + WS_WFO) + (size_t)l * D * DFF, M, D, DFF}; pg8::XccOrder S{xrank, xn, xslot, xnx, D / 256, 4, 1 << 30};
            EpiRes E{(const bf16_t*)(wsp + WS_XB), (bf16_t*)(wsp + WS_XB), (float*)(wsp + WS_SSQA)};
            pg8::gemm_phase<EpiRes, pg8::XccOrder, true, true>(lds, g, S, E, tidp);
        }
        LBAR();
    }
    { OPAQ(); XPART();
        for (int b = xslot; b < BATCH; b += xnx) final_rows(wsp, args.out, args.in[14], b * SEQ, (b + 1) * SEQ, xrank * NWAVES + wavep, xn * NWAVES, lanep);
    }
#undef OPAQ
#undef XPART
#undef GBAR
#undef LBAR
}

extern "C" void kernel_launch(void* const* d_in, const int* in_sizes, int n_in, void* d_out, int out_size, void* d_ws, size_t ws_size, hipStream_t stream) {
    static int grid = 0;
    if (grid == 0) {
        if (n_in != 15 || in_sizes[0] != M * D || out_size != M * D || ws_size < WS_END) {
            fprintf(stderr, "kernel_launch: unexpected shapes: n_in %d in0 %d out %d ws %zu (need %zu)\n", n_in, n_in > 0 ? in_sizes[0] : -1, out_size, ws_size, (size_t)WS_END); grid = -1; return; }
        int dev = 0, cus = 0, per_cu = 0;
        if (hipGetDevice(&dev) != hipSuccess || hipDeviceGetAttribute(&cus, hipDeviceAttributeMultiprocessorCount, dev) != hipSuccess) { grid = -1; return; }
        if (hipFuncSetAttribute((const void*)mega_fwd, hipFuncAttributeMaxDynamicSharedMemorySize, LDS_BYTES) != hipSuccess) { fprintf(stderr, "kernel_launch: hipFuncSetAttribute failed\n"); grid = -1; return; }
        if (hipOccupancyMaxActiveBlocksPerMultiprocessor(&per_cu, (const void*)mega_fwd, NWAVES * 64, LDS_BYTES) != hipSuccess || per_cu < 1)
            fprintf(stderr, "kernel_launch: occupancy query reports %d workgroups per CU\n", per_cu);
        (void)hipGetLastError();
        grid = cus;
        if (grid < 176) { fprintf(stderr, "kernel_launch: this kernel needs at least 176 CUs (found %d)\n", cus); grid = -1; return; }
    }
    if (grid < 0) return;
    if (hipMemsetAsync((char*)d_ws + WS_CTL, 0, CTL_ZERO_BYTES, stream) != hipSuccess) { fprintf(stderr, "kernel_launch: memset failed\n"); return; }
    Args a{};
    for (int i = 0; i < 15; ++i) a.in[i] = (const float*)d_in[i];
    a.out = (float*)d_out; a.ws = (unsigned char*)d_ws;
    a.ph_lo = 0; a.ph_hi = 0;
    hipLaunchKernelGGL(mega_fwd, dim3(grid), dim3(NWAVES * 64), LDS_BYTES, stream, a);
    const hipError_t le = hipPeekAtLastError();
    if (le != hipSuccess) fprintf(stderr, "kernel_launch: launch failed: %s\n", hipGetErrorName(le));
}
```

```cpp
#include <hip/hip_runtime.h>
#include <cstdio>
#include <cstdint>

#ifndef DBG_SKIP
#define DBG_SKIP 0
#endif
#ifndef PROBE_REP
#define PROBE_REP 0
#endif
#ifndef RBG_A
#define RBG_A 4
#endif
#ifndef RBG_D
#define RBG_D 4
#endif
#ifndef PROBE_VAR
#define PROBE_VAR 0
#endif
#ifndef MK_N_LAUNCHES
#define MK_N_LAUNCHES 1
#endif

#define GAS __attribute__((address_space(1)))
#define LAS __attribute__((address_space(3)))
typedef unsigned short bf16_t;
typedef short bf16x8 __attribute__((ext_vector_type(8)));
typedef float f32x4 __attribute__((ext_vector_type(4)));
typedef float f32x2 __attribute__((ext_vector_type(2)));
typedef unsigned u32x4 __attribute__((ext_vector_type(4)));
typedef unsigned u32x2 __attribute__((ext_vector_type(2)));

constexpr int BATCH = 8, SEQ = 2048, D = 1024, DEPTH = 4;
constexpr int M = BATCH * SEQ;
constexpr int NH = 6, HD = 128, MIXW = 768, XW = 256, NXH = 4, XHD = 64, NMEM = 256;
constexpr int NIN = 3328, DFF = 2816, NFI = 2 * DFF;
constexpr int MROWS = BATCH * NMEM;
constexpr float EPS = 1e-6f;
constexpr int NVS = 2;
constexpr int VPR = 16 / NVS;

constexpr size_t MiB = 1u << 20;
constexpr size_t WS_CTL = 0, CTL_ZERO_BYTES = 1 * MiB;
constexpr size_t WS_LB = 1 * MiB;
constexpr size_t WS_SSQA = 2 * MiB;
constexpr size_t WS_SSQD = 3 * MiB;
constexpr size_t WS_COS = 4 * MiB, WS_SIN = 8 * MiB;
constexpr size_t WS_MEMB = 12 * MiB;
constexpr size_t WS_MKV = 16 * MiB;
constexpr size_t WS_WIN = 24 * MiB;
constexpr size_t WS_WOUT = 50 * MiB;
constexpr size_t WS_WFI = 58 * MiB;
constexpr size_t WS_WFO = 102 * MiB;
constexpr size_t WS_WM = 124 * MiB;
constexpr size_t WS_XB = 128 * MiB;
constexpr size_t WS_CAT = 160 * MiB;
constexpr size_t WS_Z = 192 * MiB;
constexpr size_t WS_F = 296 * MiB;
constexpr size_t WS_KST = 296 * MiB;
constexpr size_t WS_AUX = 320 * MiB;
constexpr size_t WS_SSQO = 323 * MiB;
constexpr size_t WS_ACT = 192 * MiB;
constexpr size_t WS_END = 344 * MiB;
static_assert(WS_WIN + (size_t)DEPTH * NIN * D * 2 <= WS_WOUT && WS_WOUT + (size_t)DEPTH * D * D * 2 <= WS_WFI && WS_WFI + (size_t)DEPTH * NFI * D * 2 <= WS_WFO &&
              WS_WFO + (size_t)DEPTH * D * DFF * 2 <= WS_WM && WS_WM + (size_t)2048 * 1024 * 2 <= WS_XB && WS_Z + (size_t)M * NIN * 2 <= WS_F && WS_F + (size_t)M * MIXW * 4 <= WS_END &&
              WS_ACT + (size_t)M * DFF * 2 <= WS_F, "ws map");
constexpr int CW_BAR = 4096;

__device__ __forceinline__ int lane_id_volatile() { int l; asm volatile("v_mbcnt_lo_u32_b32 %0, -1, 0\n\tv_mbcnt_hi_u32_b32 %0, -1, %0" : "=v"(l)); return l; }
namespace pg8 {
constexpr int BM = 256, BK = 64, HALF = 128, HTB = HALF * BK * 2, STAGE_BYTES = 8 * HTB, NXCD = 8, WGM = 8;
__host__ __device__ __forceinline__ int lds_byte(int r, int c) { const int st = (r >> 4) * 2 + (c >> 5), rr = r & 15, cc = c & 31, ob = rr * 64 + cc * 2; return st * 1024 + (ob ^ (((ob >> 9) & 1) << 5)); }
__host__ __device__ __forceinline__ void stage_rc(int b, int& R, int& C) { const int st = b / 1024, sb = b % 1024, swz = sb ^ (((sb >> 9) & 1) << 5); R = (st >> 1) * 16 + swz / 64; C = (st & 1) * 32 + (swz % 64) / 2; }
__host__ __device__ __forceinline__ int perm32(int rho) { const int n = rho >> 4, i = rho & 15; return 8 * (i >> 2) + 4 * n + (i & 3); }
struct Unit { int pm, pn; };
struct Gemm { const bf16_t* A; const bf16_t* Bt; int M, N, K; };
struct StaticOrder {
    int nM, nN, nwg, G, c;
    __host__ __device__ void init(int M_, int N_, int G_, int c_) { nM = M_ / BM; nN = N_ / BM; nwg = nM * nN; G = G_; c = c_; }
    __host__ __device__ bool next(int i, Unit& u) const {
        const long L = (long)i * G + c; if (L >= nwg) return false;
        int wgid = (int)L; { const int q = nwg / NXCD, r = nwg % NXCD, xcd = wgid % NXCD, off = wgid / NXCD; wgid = (xcd < r ? xcd * (q + 1) : r * (q + 1) + (xcd - r) * q) + off; }
        const int nig = WGM * nN, gid = wgid / nig, fm = gid * WGM, gsz = (nM - fm) < WGM ? (nM - fm) : WGM;
        u.pm = fm + ((wgid % nig) % gsz); u.pn = (wgid % nig) / gsz; return true;
    }
    __device__ __forceinline__ void a_ready(const Unit&) const {}
    __device__ __forceinline__ void done(const Unit&) const {}
};
struct XccOrder {
    int rank, n, slot, nx, nN, rbg, tlim;
    __device__ __forceinline__ bool next(int i, Unit& u) const {
        const int t = i * n + rank, nb = (8 - slot + nx - 1) / nx;
        if (slot >= 8 || t >= nb * 8 * nN || t >= tlim) return false;
        decode(t, u); return true;
    }
    __device__ __forceinline__ void decode(int t, Unit& u) const {
        const int per = 8 * nN;
        const int bi = t / per, tt = t - bi * per, g = tt / (rbg * nN), r = tt - g * rbg * nN;
        u.pm = 8 * (slot + bi * nx) + rbg * g + (r % rbg); u.pn = r / rbg;
    }
    __device__ __forceinline__ void a_ready(const Unit&) const {}
};
struct XccOrderMem {
    int rank, n, slot, nx;
    __device__ __forceinline__ bool next(int i, Unit& u) const {
        const int t = i * n + rank, nb = (8 - slot + nx - 1) / nx;
        if (slot >= 8 || t >= nb * 8) return false;
        u.pm = slot + (t >> 3) * nx; u.pn = t & 7; return true;
    }
    __device__ __forceinline__ void a_ready(const Unit&) const {}
};
struct OneUnit {
    int pm, pn;
    __device__ __forceinline__ bool next(int i, Unit& u) const { if (i) return false; u.pm = pm; u.pn = pn; return true; }
    __device__ __forceinline__ void a_ready(const Unit&) const {}
};
struct HalfUnit {
    int pm, pn, half;
    __device__ __forceinline__ bool next(int i, Unit& u) const { if (i) return false; u.pm = pm; u.pn = pn; return true; }
    __device__ __forceinline__ void a_ready(const Unit&) const {}
};
__device__ __forceinline__ unsigned cvt_pk_bf16(float lo, float hi) { unsigned r; asm volatile("v_cvt_pk_bf16_f32 %0, %1, %2" : "=v"(r) : "v"(lo), "v"(hi)); return r; }

template <class Epi, class Sched, bool ALIGN_EPI = false, bool SP2 = false, bool HM = false>
__device__ __forceinline__ void gemm_phase(LAS unsigned char* lds, const Gemm g, const Sched& S, const Epi& E, int tid) {
    asm volatile("" : "+v"(tid));
    const int wid = __builtin_amdgcn_readfirstlane(tid >> 6), lane = tid & 63, wr = wid >> 2, wc = wid & 3, fr = lane & 15, fq = lane >> 4;
    const int K = g.K, nt = K / BK;
    unsigned voffA[2], voffB[2];
#pragma unroll
    for (int i = 0; i < 2; ++i) { int R, C; stage_rc(tid * 16 + i * 8192, R, C); const int Rb = Epi::PERM ? ((R & ~31) + perm32(R & 31)) : R;
        voffA[i] = (unsigned)(R * K + C) * 2u; voffB[i] = (unsigned)(Rb * K + C) * 2u; }
    asm volatile("" : "+v"(voffA[0]), "+v"(voffA[1]), "+v"(voffB[0]), "+v"(voffB[1]));
    const size_t kstep = (size_t)(BK * 2);
    const size_t hstep = (size_t)HALF * K * 2;
    const size_t tstep = 2 * hstep;
    static_assert(!HM || SP2, "half tiles use the SP2 body");
    const size_t ahs = HM ? (size_t)0 : hstep;
    const unsigned ldsw = (unsigned)wid * 1024u;
    const int aoff = lds_byte(wr * 64 + fr, fq * 8), boff = lds_byte(wc * 32 + fr, fq * 8);
#define PG8_SA(b, h) (((b) * 2 + (h)) * HTB)
#define PG8_SB(b, h) ((4 + (b) * 2 + (h)) * HTB)
#define PG8_STAGE(bufoff, gbase, voff) do { _Pragma("unroll") for (int _i = 0; _i < 2; ++_i) \
        __builtin_amdgcn_global_load_lds((const unsigned*)((const char*)(gbase) + (voff)[_i]), (LAS unsigned*)(lds + (bufoff) + ldsw + _i * 8192), 16, 0, 0); } while (0)
#define PG8_LDA(dst, b, h) do { _Pragma("unroll") for (int m = 0; m < 4; ++m) _Pragma("unroll") for (int k = 0; k < 2; ++k) dst[m][k] = *(const LAS bf16x8*)(lds + PG8_SA(b, h) + aoff + m * 2048 + k * 1024); } while (0)
#define PG8_LDB(dst, b, h) do { _Pragma("unroll") for (int n = 0; n < 2; ++n) _Pragma("unroll") for (int k = 0; k < 2; ++k) dst[n][k] = *(const LAS bf16x8*)(lds + PG8_SB(b, h) + boff + n * 2048 + k * 1024); } while (0)
#define PG8_MMA(ai, bj, At, Bt) do { __builtin_amdgcn_s_setprio(1); _Pragma("unroll") for (int m = 0; m < 4; ++m) _Pragma("unroll") for (int n = 0; n < 2; ++n) _Pragma("unroll") for (int k = 0; k < 2; ++k) \
        acc[ai][bj][m][n] = __builtin_amdgcn_mfma_f32_16x16x32_bf16(Bt[n][k], At[m][k], acc[ai][bj][m][n], 0, 0, 0); __builtin_amdgcn_s_setprio(0); } while (0)
#define PG8_WAIT_V(n) asm volatile("s_waitcnt vmcnt(" #n ")" ::: "memory")
#define PG8_WAIT_L(n) asm volatile("s_waitcnt lgkmcnt(" #n ")" ::: "memory")
#define PG8_BAR __builtin_amdgcn_s_barrier()
#define PG8_SCHED __builtin_amdgcn_sched_barrier(0)
    Unit cur, nxt; int ui = 0;
    if (!S.next(0, cur)) return;
    f32x4 acc[2][2][4][2];
#pragma unroll
    for (int a = 0; a < 2; ++a)
#pragma unroll
        for (int b = 0; b < 2; ++b)
#pragma unroll
            for (int m = 0; m < 4; ++m)
#pragma unroll
                for (int n = 0; n < 2; ++n) acc[a][b][m][n] = (f32x4){0.f, 0.f, 0.f, 0.f};
    bf16x8 At[4][2], B0[2][2], B1[2][2];
    const char* cA = (const char*)g.A + (size_t)cur.pm * tstep; if constexpr (HM) cA += (size_t)S.half * hstep;
    const char* cB = (const char*)g.Bt + (size_t)cur.pn * tstep;
    S.a_ready(cur);
    if constexpr (SP2) {
        PG8_STAGE(PG8_SB(0, 0), cB, voffB); PG8_STAGE(PG8_SB(0, 1), cB + hstep, voffB); PG8_STAGE(PG8_SA(0, 0), cA, voffA); PG8_STAGE(PG8_SA(0, 1), cA + ahs, voffA);
        if (wr == 1) PG8_BAR;
        PG8_WAIT_V(2); PG8_BAR;
        PG8_STAGE(PG8_SB(1, 0), cB + kstep, voffB); PG8_STAGE(PG8_SA(1, 0), cA + kstep, voffA); PG8_STAGE(PG8_SB(1, 1), cB + hstep + kstep, voffB);
        PG8_WAIT_V(6); PG8_BAR;
    } else {
        PG8_STAGE(PG8_SB(0, 0), cB, voffB); PG8_STAGE(PG8_SA(0, 0), cA, voffA); PG8_STAGE(PG8_SB(0, 1), cB + hstep, voffB); PG8_STAGE(PG8_SA(0, 1), cA + hstep, voffA);
        if (wr == 1) PG8_BAR;
        PG8_WAIT_V(4); PG8_BAR;
        PG8_STAGE(PG8_SB(1, 0), cB + kstep, voffB); PG8_STAGE(PG8_SA(1, 0), cA + kstep, voffA); PG8_STAGE(PG8_SB(1, 1), cB + hstep + kstep, voffB);
        PG8_WAIT_V(6); PG8_BAR;
    }
    for (;;) {
        const bool has_next = S.next(ui + 1, nxt);
        const char* nA = has_next ? (const char*)g.A + (size_t)nxt.pm * tstep : cA; const char* nB = has_next ? (const char*)g.Bt + (size_t)nxt.pn * tstep : cB;
        for (int t = 0; t < nt; t += 2) {
            const bool last = (t == nt - 2);
            const char* a1 = cA + (size_t)(t + 1) * kstep;
            const char* a2 = last ? nA : cA + (size_t)(t + 2) * kstep; const char* b2 = last ? nB : cB + (size_t)(t + 2) * kstep;
            const char* a3 = a2 + kstep; const char* b3 = b2 + kstep;
            if (last && has_next) S.a_ready(nxt);
            if constexpr (Epi::MID_T > 0) { if (t == Epi::MID_T) { const int l2 = lane_id_volatile(); E.mid(acc, cur, wr, wc, l2 & 15, l2 >> 4); } }
            if constexpr (SP2) {
            PG8_LDB(B0, 0, 0); PG8_LDB(B1, 0, 1); PG8_SCHED; PG8_LDA(At, 0, 0); PG8_STAGE(PG8_SA(1, 1), a1 + ahs, voffA);
            PG8_WAIT_V(8); PG8_WAIT_L(0); PG8_BAR; PG8_MMA(0, 0, At, B0); PG8_MMA(0, 1, At, B1); PG8_BAR; PG8_SCHED;
            if constexpr (!HM) PG8_LDA(At, 0, 1);
            PG8_STAGE(PG8_SB(0, 0), b2, voffB); PG8_STAGE(PG8_SB(0, 1), b2 + hstep, voffB); PG8_STAGE(PG8_SA(0, 0), a2, voffA);
            PG8_WAIT_V(8); PG8_WAIT_L(0); PG8_BAR; if constexpr (!HM) { PG8_MMA(1, 0, At, B0); PG8_MMA(1, 1, At, B1); } PG8_BAR; PG8_SCHED;
            PG8_LDB(B0, 1, 0); PG8_LDB(B1, 1, 1); PG8_SCHED; PG8_LDA(At, 1, 0); PG8_STAGE(PG8_SA(0, 1), a2 + ahs, voffA);
            PG8_WAIT_V(8); PG8_WAIT_L(0); PG8_BAR; PG8_MMA(0, 0, At, B0); PG8_MMA(0, 1, At, B1); PG8_BAR; PG8_SCHED;
            if constexpr (!HM) PG8_LDA(At, 1, 1);
            PG8_STAGE(PG8_SB(1, 0), b3, voffB); PG8_STAGE(PG8_SB(1, 1), b3 + hstep, voffB); PG8_STAGE(PG8_SA(1, 0), a3, voffA);
            PG8_WAIT_V(8); PG8_WAIT_L(0); PG8_BAR; if constexpr (!HM) { PG8_MMA(1, 0, At, B0); PG8_MMA(1, 1, At, B1); } PG8_BAR; PG8_SCHED;
            } else {
            PG8_LDB(B0, 0, 0); PG8_SCHED; PG8_LDA(At, 0, 0); PG8_STAGE(PG8_SA(1, 1), a1 + hstep, voffA);
            PG8_WAIT_L(8); PG8_BAR; PG8_WAIT_L(0); PG8_MMA(0, 0, At, B0); PG8_BAR; PG8_SCHED;
            PG8_LDB(B1, 0, 1); PG8_STAGE(PG8_SB(0, 0), b2, voffB);
            PG8_BAR; PG8_WAIT_L(0); PG8_MMA(0, 1, At, B1); PG8_BAR;
            PG8_LDA(At, 0, 1); PG8_STAGE(PG8_SA(0, 0), a2, voffA);
            PG8_BAR; PG8_WAIT_L(0); PG8_MMA(1, 0, At, B0); PG8_BAR; PG8_SCHED;
            PG8_STAGE(PG8_SB(0, 1), b2 + hstep, voffB);
            PG8_WAIT_V(6); PG8_BAR; PG8_MMA(1, 1, At, B1); PG8_BAR;
            PG8_LDB(B0, 1, 0); PG8_SCHED; PG8_LDA(At, 1, 0); PG8_STAGE(PG8_SA(0, 1), a2 + hstep, voffA);
            PG8_WAIT_L(8); PG8_BAR; PG8_WAIT_L(0); PG8_MMA(0, 0, At, B0); PG8_BAR; PG8_SCHED;
            PG8_LDB(B1, 1, 1); PG8_STAGE(PG8_SB(1, 0), b3, voffB);
            PG8_BAR; PG8_WAIT_L(0); PG8_MMA(0, 1, At, B1); PG8_BAR;
            PG8_LDA(At, 1, 1); PG8_STAGE(PG8_SA(1, 0), a3, voffA);
            PG8_BAR; PG8_WAIT_L(0); PG8_MMA(1, 0, At, B0); PG8_BAR; PG8_SCHED;
            PG8_STAGE(PG8_SB(1, 1), b3 + hstep, voffB);
            PG8_WAIT_V(6); PG8_BAR; PG8_MMA(1, 1, At, B1); PG8_BAR;
            }
        }
        if constexpr (ALIGN_EPI) { if (wr == 0) PG8_BAR; }
        { const int l2 = lane_id_volatile(); E(acc, cur, wr, wc, l2 & 15, l2 >> 4); }
        if (!has_next) break;
#pragma unroll
        for (int a = 0; a < 2; ++a)
#pragma unroll
            for (int b = 0; b < 2; ++b)
#pragma unroll
                for (int m = 0; m < 4; ++m)
#pragma unroll
                    for (int n = 0; n < 2; ++n) acc[a][b][m][n] = (f32x4){0.f, 0.f, 0.f, 0.f};
        cur = nxt; cA = nA; cB = nB; ++ui;
        if constexpr (ALIGN_EPI) { if (wr == 1) PG8_BAR; }
    }
    PG8_WAIT_V(0);
    if constexpr (!ALIGN_EPI) { if (wr == 0) PG8_BAR; }
    PG8_BAR;
#undef PG8_SA
#undef PG8_SB
#undef PG8_STAGE
#undef PG8_LDA
#undef PG8_LDB
#undef PG8_MMA
#undef PG8_WAIT_V
#undef PG8_WAIT_L
#undef PG8_BAR
#undef PG8_SCHED
}
}

__device__ __forceinline__ float bf2f(unsigned h) { return __uint_as_float(h << 16); }
__device__ __forceinline__ unsigned f2bf(float f) { unsigned u = __float_as_uint(f); return (u + 0x7fffu + ((u >> 16) & 1u)) >> 16; }
__device__ __forceinline__ unsigned pk2(float lo, float hi) { return f2bf(lo) | (f2bf(hi) << 16); }
__device__ __forceinline__ float fast_rcp(float x) { return __builtin_amdgcn_rcpf(x); }
__device__ __forceinline__ float sigmoidf_(float x) { return fast_rcp(1.0f + __expf(-x)); }
__device__ __forceinline__ float siluf_(float x) { return x * sigmoidf_(x); }
__device__ __forceinline__ float shfl_xor_l(float v, int lane, int mask) { return __int_as_float(__builtin_amdgcn_ds_bpermute((lane ^ mask) << 2, __float_as_int(v))); }
__device__ __forceinline__ float wave_sum(float v, int lane) {
#pragma unroll
    for (int o = 1; o < 64; o <<= 1) v += shfl_xor_l(v, lane, o);
    return v;
}
__device__ __forceinline__ float rstd_from_partials(const float* ssq, int row, float invn) {
    const f32x4* p = (const f32x4*)(ssq + (size_t)row * 16);
    const f32x4 a = p[0], b = p[1], c = p[2], d = p[3];
    const f32x4 s = (a + b) + (c + d);
    return rsqrtf(((s[0] + s[1]) + (s[2] + s[3])) * invn + EPS);
}
constexpr int RSTD_TAB_OFF = 132096;
__device__ __forceinline__ void rstd_table(const float* ssq, int pm, LAS float* tab, int wr, int wc, int fr, int fq) {
    const int t = (wr * 4 + wc) * 64 + fq * 16 + fr;
    if (t < 256) { const GAS f32x4* p = (const GAS f32x4*)((const GAS float*)ssq + (size_t)(pm * 256 + t) * 16);
        const f32x4 a = p[0], b = p[1], c = p[2], d = p[3]; const f32x4 sm = (a + b) + (c + d);
        tab[t] = rsqrtf(((sm[0] + sm[1]) + (sm[2] + sm[3])) * (1.0f / D) + EPS); }
    asm volatile("s_waitcnt lgkmcnt(0)" ::: "memory"); __builtin_amdgcn_s_barrier(); asm volatile("" ::: "memory");
}
__device__ __forceinline__ u32x4 pack8(const f32x4 v0, const f32x4 v1) {
    u32x4 w; w.x = pg8::cvt_pk_bf16(v0[0], v0[1]); w.y = pg8::cvt_pk_bf16(v0[2], v0[3]); w.z = pg8::cvt_pk_bf16(v1[0], v1[1]); w.w = pg8::cvt_pk_bf16(v1[2], v1[3]); return w;
}

#define DPP_SHR(x, n) __int_as_float(__builtin_amdgcn_update_dpp(0, __float_as_int(x), 0x110 + (n), 0xf, 0xf, false))
__device__ __forceinline__ float rowscan16(float x) {
    x += DPP_SHR(x, 1); x += DPP_SHR(x, 2); x += DPP_SHR(x, 4); x += DPP_SHR(x, 8); return x;
}
__device__ __forceinline__ float bcast15(float x, int lane) { return __int_as_float(__builtin_amdgcn_ds_bpermute((lane | 15) << 2, __float_as_int(x))); }
__device__ __forceinline__ float expc(float x) { return __expf(fminf(x, 80.0f)); }
using pg8::Unit;
struct EpiPlain {
    static constexpr bool PERM = true; static constexpr int MID_T = 0;
    bf16_t* O; int ldc;
    __device__ __forceinline__ void operator()(const f32x4 (&acc)[2][2][4][2], const Unit& u, int wr, int wc, int fr, int fq) const {
        const int row0 = u.pm * 256 + wr * 64 + fr, col0 = u.pn * 256 + wc * 32 + 8 * fq;
#pragma unroll
        for (int ai = 0; ai < 2; ++ai)
#pragma unroll
            for (int m = 0; m < 4; ++m) { bf16_t* rowp = O + (size_t)(row0 + ai * 128 + m * 16) * ldc + col0;
#pragma unroll
                for (int bj = 0; bj < 2; ++bj) *(GAS u32x4*)((GAS bf16_t*)rowp + bj * 128) = pack8(acc[ai][bj][m][0], acc[ai][bj][m][1]); }
    }
};
struct EpiIn {
    static constexpr bool PERM = true; static constexpr int MID_T = 0;
    bf16_t* Z; bf16_t* KST; float* AUX; const float* ssq; const float* lb; const float* cosT; const float* sinT; int is_ret; LAS float* tab;
    __device__ __forceinline__ void operator()(const f32x4 (&acc)[2][2][4][2], const Unit& u, int wr, int wc, int fr, int fq) const {
        const int row0 = u.pm * 256 + wr * 64 + fr, jl = wc * 32 + 8 * fq, t = u.pn;
        rstd_table(ssq, u.pm, tab, wr, wc, fr, fq);
        const LAS float* tl = tab + wr * 64 + fr;
        if (t < 6) {
            if (!is_ret) {
                const f32x4 lb0 = *(const GAS f32x4*)((const GAS float*)lb + t * 128 + (jl >> 1)), lb1 = *(const GAS f32x4*)((const GAS float*)lb + t * 128 + (jl >> 1) + 64);
#pragma unroll
                for (int ai = 0; ai < 2; ++ai)
#pragma unroll
                    for (int mp = 0; mp < 2; ++mp) {
                        const int tok0 = u.pm * 256 + ai * 128 + wr * 64 + mp * 32, rlo = tok0 + fr, rhi = rlo + 16;
                        const float rs0 = tl[ai * 128 + mp * 32], rs1 = tl[ai * 128 + mp * 32 + 16];
                        f32x4 qsv[2][2], ksv[2][2], ktv[2][2], erv[2], dcv[2];
#pragma unroll
                        for (int n = 0; n < 2; ++n)
#pragma unroll
                            for (int i = 0; i < 4; ++i) {
                                const float lbv = n ? lb1[i] : lb0[i];
                                float g[2], kk[2], qq[2];
#pragma unroll
                                for (int e = 0; e < 2; ++e) {
                                    const float x = acc[ai][1][2 * mp + e][n][i] * (e ? rs1 : rs0), za = acc[ai][0][2 * mp + e][n][i] * (e ? rs1 : rs0);
                                    const float a = __expf(-fabsf(x)), r = fast_rcp(1.0f + a);
                                    const float sneg = x >= 0.f ? a * r : r;
                                    const float em = x >= 0.f ? a : fminf(fast_rcp(a), 1.0686475e13f);
                                    g[e] = (fminf(x, 0.f) - __logf(1.0f + a)) + __logf(1.0f + lbv * em);
                                    kk[e] = (1.0f - lbv) * sneg;
                                    qq[e] = siluf_(za);
                                }
                                const float blo = rowscan16(g[0]), ref = bcast15(blo, fq * 16 + fr), bhi = ref + rowscan16(g[1]), blast = bcast15(bhi, fq * 16 + fr);
                                qsv[0][n][i] = qq[0] * expc(blo - ref); qsv[1][n][i] = qq[1] * expc(bhi - ref);
                                ksv[0][n][i] = kk[0] * expc(ref - blo); ksv[1][n][i] = kk[1] * expc(ref - bhi);
                                ktv[0][n][i] = kk[0] * __expf(blast - blo); ktv[1][n][i] = kk[1] * __expf(blast - bhi);
                                erv[n][i] = __expf(ref); dcv[n][i] = __expf(blast);
                            }
                        GAS bf16_t* zlo = (GAS bf16_t*)Z + (size_t)rlo * NIN + t * 256 + jl; GAS bf16_t* zhi = (GAS bf16_t*)Z + (size_t)rhi * NIN + t * 256 + jl;
                        *(GAS u32x4*)zlo = pack8(qsv[0][0], qsv[0][1]); *(GAS u32x4*)(zlo + 128) = pack8(ksv[0][0], ksv[0][1]);
                        *(GAS u32x4*)zhi = pack8(qsv[1][0], qsv[1][1]); *(GAS u32x4*)(zhi + 128) = pack8(ksv[1][0], ksv[1][1]);
                        *(GAS u32x4*)((GAS bf16_t*)KST + (size_t)rlo * MIXW + t * 128 + jl) = pack8(ktv[0][0], ktv[0][1]);
                        *(GAS u32x4*)((GAS bf16_t*)KST + (size_t)rhi * MIXW + t * 128 + jl) = pack8(ktv[1][0], ktv[1][1]);
                        if (fr == 15) { GAS float* ap = (GAS float*)AUX + ((size_t)((tok0 >> 11) * NH + t) * 64 + ((tok0 & 2047) >> 5)) * 256 + jl;
                            *(GAS f32x4*)ap = erv[0]; *(GAS f32x4*)(ap + 4) = erv[1]; *(GAS f32x4*)(ap + 128) = dcv[0]; *(GAS f32x4*)(ap + 132) = dcv[1]; }
                    }
            } else {
                const float lg = __log2f(1.0f - exp2f(-5.0f - (float)t));
                f32x4 csv[2][4], snv[2][4];
#pragma unroll
                for (int ai = 0; ai < 2; ++ai)
#pragma unroll
                    for (int m = 0; m < 4; ++m) { const int row = row0 + ai * 128 + m * 16;
                        csv[ai][m] = *(const GAS f32x4*)((const GAS float*)cosT + (size_t)row * 64 + (jl >> 1)); snv[ai][m] = *(const GAS f32x4*)((const GAS float*)sinT + (size_t)row * 64 + (jl >> 1)); }
#pragma unroll
                for (int ai = 0; ai < 2; ++ai)
#pragma unroll
                    for (int m = 0; m < 4; ++m) { const int row = row0 + ai * 128 + m * 16; const float rs = tl[ai * 128 + m * 16];
                        const f32x4 cs = csv[ai][m], sn = snv[ai][m];
                        const float cp1 = (float)(16 * (m & 1) + fr + 1), pw = exp2f(cp1 * lg), ipw = exp2f(-cp1 * lg);
                        const float qsc = rs * pw, ksc = rs * 0.08838834764831845f * ipw;
                        f32x4 q0, q1, k0, k1;
#pragma unroll
                        for (int i = 0; i < 4; ++i) {
                            const float a1 = acc[ai][0][m][0][i] * qsc, a2 = acc[ai][0][m][1][i] * qsc; q0[i] = a1 * cs[i] - a2 * sn[i]; q1[i] = a1 * sn[i] + a2 * cs[i];
                            const float b1 = acc[ai][1][m][0][i] * ksc, b2 = acc[ai][1][m][1][i] * ksc; k0[i] = b1 * cs[i] - b2 * sn[i]; k1[i] = b1 * sn[i] + b2 * cs[i];
                        }
                        GAS bf16_t* zp = (GAS bf16_t*)Z + (size_t)row * NIN + t * 256 + jl; *(GAS u32x4*)zp = pack8(q0, q1); *(GAS u32x4*)(zp + 128) = pack8(k0, k1); }
            }
        } else {
            const int mode = (t >= 9 && t < 12) ? (is_ret ? 2 : 1) : 0;
#pragma unroll
            for (int ai = 0; ai < 2; ++ai)
#pragma unroll
                for (int m = 0; m < 4; ++m) { const int row = row0 + ai * 128 + m * 16; const float rs = tl[ai * 128 + m * 16];
                    GAS bf16_t* zp = (GAS bf16_t*)Z + (size_t)row * NIN + t * 256 + jl;
#pragma unroll
                    for (int bj = 0; bj < 2; ++bj) { f32x4 v0 = acc[ai][bj][m][0] * rs, v1 = acc[ai][bj][m][1] * rs;
                        if (mode == 1) {
#pragma unroll
                            for (int i = 0; i < 4; ++i) { v0[i] = sigmoidf_(v0[i]); v1[i] = sigmoidf_(v1[i]); } }
                        else if (mode == 2) {
#pragma unroll
                            for (int i = 0; i < 4; ++i) { v0[i] = siluf_(v0[i]); v1[i] = siluf_(v1[i]); } }
                        *(GAS u32x4*)(zp + bj * 128) = pack8(v0, v1); } }
        }
    }
};
struct EpiRes {
    static constexpr bool PERM = true; static constexpr int MID_T = 0;
    const bf16_t* xin; bf16_t* xb; float* ssq;
    __device__ __forceinline__ void operator()(const f32x4 (&acc)[2][2][4][2], const Unit& u, int wr, int wc, int fr, int fq) const {
        const int row0 = u.pm * 256 + wr * 64 + fr, col0 = u.pn * 256 + wc * 32 + 8 * fq;
        u32x4 rr[2][4][2];
#pragma unroll
        for (int ai = 0; ai < 2; ++ai)
#pragma unroll
            for (int m = 0; m < 4; ++m)
#pragma unroll
                for (int bj = 0; bj < 2; ++bj) rr[ai][m][bj] = *(const GAS u32x4*)((const GAS bf16_t*)xin + (size_t)(row0 + ai * 128 + m * 16) * D + col0 + bj * 128);
#pragma unroll
        for (int ai = 0; ai < 2; ++ai)
#pragma unroll
            for (int m = 0; m < 4; ++m) { const int row = row0 + ai * 128 + m * 16; const size_t off = (size_t)row * D + col0; float s = 0.f;
#pragma unroll
                for (int bj = 0; bj < 2; ++bj) {
                    const u32x4 r = rr[ai][m][bj];
                    f32x4 v0, v1;
                    v0[0] = bf2f(r.x & 0xffffu); v0[1] = bf2f(r.x >> 16); v0[2] = bf2f(r.y & 0xffffu); v0[3] = bf2f(r.y >> 16);
                    v1[0] = bf2f(r.z & 0xffffu); v1[1] = bf2f(r.z >> 16); v1[2] = bf2f(r.w & 0xffffu); v1[3] = bf2f(r.w >> 16);
                    v0 = v0 + acc[ai][bj][m][0]; v1 = v1 + acc[ai][bj][m][1];
                    *(GAS u32x4*)((GAS bf16_t*)xb + off + bj * 128) = pack8(v0, v1);
                    s += (v0[0] * v0[0] + v0[1] * v0[1]) + (v0[2] * v0[2] + v0[3] * v0[3]) + (v1[0] * v1[0] + v1[1] * v1[1]) + (v1[2] * v1[2] + v1[3] * v1[3]);
                }
                s += shfl_xor_l(s, fq * 16 + fr, 16); s += shfl_xor_l(s, fq * 16 + fr, 32);
                if (fq == 0) ((GAS float*)ssq)[(size_t)row * 16 + u.pn * 4 + wc] = s; }
    }
};
struct EpiResC {
    static constexpr bool PERM = true; static constexpr int MID_T = 12;
    EpiRes base; const float* ssqo;
    __device__ __forceinline__ void mid(f32x4 (&acc)[2][2][4][2], const Unit& u, int wr, int wc, int fr, int fq) const {
        if (!ssqo) return;
        const int row0 = u.pm * 256 + wr * 64 + fr;
#pragma unroll
        for (int ai = 0; ai < 2; ++ai)
#pragma unroll
            for (int m = 0; m < 4; ++m) { const int row = row0 + ai * 128 + m * 16;
                const GAS f32x4* sp = (const GAS f32x4*)((const GAS float*)ssqo + (size_t)row * 16); float tot = 0.f;
#pragma unroll
                for (int q4 = 0; q4 < (NH * NVS + 3) / 4; ++q4) { const f32x4 a = sp[q4];
#pragma unroll
                    for (int e = 0; e < 4; ++e) if (4 * q4 + e < NH * NVS) tot += a[e]; }
                const float rs = rsqrtf(tot * (1.0f / MIXW) + EPS);
#pragma unroll
                for (int bj = 0; bj < 2; ++bj)
#pragma unroll
                    for (int n = 0; n < 2; ++n) acc[ai][bj][m][n] = acc[ai][bj][m][n] * rs;
                asm volatile("" ::: "memory"); }
    }
    __device__ __forceinline__ void operator()(const f32x4 (&acc)[2][2][4][2], const Unit& u, int wr, int wc, int fr, int fq) const { base(acc, u, wr, wc, fr, fq); }
};
struct EpiFfn {
    static constexpr bool PERM = true; static constexpr int MID_T = 0;
    bf16_t* act; const float* ssq; LAS float* tab; int half;
    __device__ __forceinline__ void operator()(const f32x4 (&acc)[2][2][4][2], const Unit& u, int wr, int wc, int fr, int fq) const {
        const int hb = half < 0 ? 0 : 128 * half;
        const int row0 = u.pm * 256 + hb + wr * 64 + fr, jl = wc * 32 + 8 * fq;
        rstd_table(ssq, u.pm, tab, wr, wc, fr, fq);
        const LAS float* tl = tab + hb + wr * 64 + fr;
#pragma unroll
        for (int ai = 0; ai < 2; ++ai)
#pragma unroll
            for (int m = 0; m < 4; ++m) { if (ai == 1 && half >= 0) break; const int row = row0 + ai * 128 + m * 16; const float rs = tl[ai * 128 + m * 16];
                f32x4 v0, v1;
#pragma unroll
                for (int i = 0; i < 4; ++i) { v0[i] = siluf_(acc[ai][0][m][0][i] * rs) * (acc[ai][1][m][0][i] * rs); v1[i] = siluf_(acc[ai][0][m][1][i] * rs) * (acc[ai][1][m][1][i] * rs); }
                *(GAS u32x4*)((GAS bf16_t*)act + (size_t)row * DFF + u.pn * 128 + jl) = pack8(v0, v1); }
    }
};

#define XB_TMO      128
#define XB_XCNT(j)  (256  + 64 * (j))
#define XB_XSUB(j)  (1280 + 64 * (j))
#define XB_XGEN(j)  (2304 + 64 * (j))
#define XB_TOP      3328
#define XB_TOPGEN   3392
#define XCD_BAR_WORDS 3456
#define XB_SPIN_CAP (1u << 18)
__device__ __forceinline__ unsigned xb_ld(unsigned* p)              { return __hip_atomic_load(p, __ATOMIC_RELAXED, __HIP_MEMORY_SCOPE_AGENT); }
__device__ __forceinline__ unsigned xb_add(unsigned* p, unsigned v) { return __hip_atomic_fetch_add(p, v, __ATOMIC_RELAXED, __HIP_MEMORY_SCOPE_AGENT); }
__device__ __forceinline__ unsigned xb_xcc_id() { return (unsigned)__builtin_amdgcn_s_getreg((3 << 11) | 20) & 0xFu; }
#define XB_SPIN(cond, bar) do { unsigned _sp = 0; while (cond) { __builtin_amdgcn_s_sleep(1); \
    if ((++_sp & 255u) == 0u) { if (xb_ld(&(bar)[XB_TMO])) break; if (_sp > XB_SPIN_CAP) { atomicAdd(&(bar)[XB_TMO], 1u); break; } } } } while (0)
struct XcdBarrier { unsigned* bar; unsigned x; volatile LAS unsigned* st; };
__device__ __forceinline__ XcdBarrier xcd_barrier_post(unsigned* bar, volatile LAS unsigned* st) {
    XcdBarrier b; b.bar = bar; b.x = xb_xcc_id(); b.st = st;
    if (threadIdx.x == 0) st[2] = xb_add(&bar[XB_XCNT(b.x)], 1u);
    return b;
}
#define XB_LOC(j) (3456 + 64 * (j))
__device__ __forceinline__ void xcc_barrier(const XcdBarrier& b, unsigned n, bool leader, unsigned k) {
    asm volatile("s_waitcnt vmcnt(0)" ::: "memory");
    __syncthreads();
    if (leader) {
        unsigned* bar = b.bar; unsigned* cnt = &bar[XB_LOC(b.x)];
        __builtin_amdgcn_s_waitcnt(0);
        (void)xb_add(cnt, 1u);
        const unsigned target = k * n;
        XB_SPIN(xb_ld(cnt) < target, bar);
        __builtin_amdgcn_fence(__ATOMIC_ACQUIRE, "agent");
        asm volatile("s_waitcnt vmcnt(0)" ::: "memory");
    }
    __syncthreads();
}
#define XB_CVX(k, j) (4608 + 64 * (16 * (k) + (j)))
#define XB_CVG(k)    (6656 + 64 * (k))
#define XB_MKV(j)    (6912 + 64 * (j))
__device__ __forceinline__ void cv_signal(const XcdBarrier& b, int k, unsigned nconv, bool leader) {
    asm volatile("s_waitcnt vmcnt(0)" ::: "memory");
    __syncthreads();
    if (leader) {
        __builtin_amdgcn_s_waitcnt(0);
        if (xb_add(&b.bar[XB_CVX(k, b.x)], 1u) + 1u == nconv) {
            __builtin_amdgcn_fence(__ATOMIC_RELEASE, "agent");
            asm volatile("s_waitcnt vmcnt(0)" ::: "memory");
            xb_add(&b.bar[XB_CVG(k)], 1u);
        }
    }
}
__device__ __forceinline__ void cv_wait(const XcdBarrier& b, int k, unsigned nx, bool leader) {
    if (leader) {
        unsigned* bar = b.bar;
        XB_SPIN(xb_ld(&bar[XB_CVG(k)]) < nx, bar);
        __builtin_amdgcn_fence(__ATOMIC_ACQUIRE, "agent");
        asm volatile("s_waitcnt vmcnt(0)" ::: "memory");
    }
    __syncthreads();
}
__device__ __forceinline__ void xcd_barrier_complete(unsigned* bar, unsigned x, unsigned& nloc, unsigned& nx) {
    const unsigned G = gridDim.x * gridDim.y * gridDim.z;
    unsigned sum, cnt, mine, sp = 0u;
    for (;;) {
        sum = 0u; cnt = 0u; mine = 0u;
#pragma unroll
        for (unsigned j = 0; j < 16; ++j) { const unsigned c = xb_ld(&bar[XB_XCNT(j)]); sum += c; cnt += (c > 0u) ? 1u : 0u; mine = (j == x) ? c : mine; }
        if (sum == G) break;
        __builtin_amdgcn_s_sleep(1);
        if ((++sp & 255u) == 0u) { if (xb_ld(&bar[XB_TMO])) break; if (sp > XB_SPIN_CAP) { atomicAdd(&bar[XB_TMO], 1u); break; } }
    }
    nloc = mine > 0u ? mine : 1u; nx = cnt > 0u ? cnt : 1u;
}
__device__ __forceinline__ void xcd_barrier(const XcdBarrier& b, bool leader) {
    asm volatile("s_waitcnt vmcnt(0)" ::: "memory");
    __syncthreads();
    if (leader) {
        unsigned* bar = b.bar;
        __builtin_amdgcn_s_waitcnt(0);
        unsigned nloc = b.st[0], nx = b.st[1];
        if (nloc == 0u) { xcd_barrier_complete(bar, b.x, nloc, nx); b.st[0] = nloc; b.st[1] = nx; }
        const unsigned old = xb_add(&bar[XB_XSUB(b.x)], 1u);
        const unsigned gen = old / nloc;
        if (old + 1u == (gen + 1u) * nloc) {
            __builtin_amdgcn_fence(__ATOMIC_RELEASE, "agent");
            asm volatile("s_waitcnt vmcnt(0)" ::: "memory");
            const unsigned og = xb_add(&bar[XB_TOP], 1u);
            const unsigned tg = og / nx;
            if (og + 1u == (tg + 1u) * nx) xb_add(&bar[XB_TOPGEN], 1u);
            else XB_SPIN(xb_ld(&bar[XB_TOPGEN]) == tg, bar);
            __builtin_amdgcn_fence(__ATOMIC_ACQUIRE, "agent");
            xb_add(&bar[XB_XGEN(b.x)], 1u);
            asm volatile("s_waitcnt vmcnt(0)" ::: "memory");
        } else {
            XB_SPIN(xb_ld(&bar[XB_XGEN(b.x)]) == gen, bar);
            __builtin_amdgcn_fence(__ATOMIC_ACQUIRE, "agent");
            asm volatile("s_waitcnt vmcnt(0)" ::: "memory");
        }
    }
    __syncthreads();
}

constexpr int RING_BYTES = 131072, LDSCTL_OFF = RING_BYTES, MISC_OFF = LDSCTL_OFF + 320, LDS_BYTES = 147456;
constexpr int NWAVES = 8;

__device__ __forceinline__ int misc_rd(LAS unsigned char* lds, int idx) { unsigned off = (unsigned)(MISC_OFF + 4 * idx); asm volatile("" : "+v"(off)); return __builtin_amdgcn_readfirstlane((int)*(volatile LAS unsigned*)(lds + off)); }
struct Args { const float* in[15]; float* out; unsigned char* ws; int ph_lo, ph_hi; };

__device__ __forceinline__ int win_srccol(int j) {
    const int t = j >> 8;
    if (t >= 6) return j;
    const int jj = j & 255, half = jj >> 7, p = jj & 127, d = 4 * (p >> 3) + (p & 3) + 64 * ((p >> 2) & 1);
    return half * MIXW + t * 128 + d;
}
__device__ __forceinline__ int wfi_srccol(int j) { const int t = j >> 8, jj = j & 255; return (jj < 128 ? 0 : DFF) + t * 128 + (jj & 127); }
struct TItem { const GAS float* W; GAS bf16_t* WT; const GAS float* kscale; int K, N, ndst, kind, nscale, item; };
__device__ __forceinline__ TItem titem_decode(const Args& a, unsigned char* ws, int it) {
    constexpr int I0 = 16 * (NIN / 32), I1 = 16 * 32, I2 = 16 * (NFI / 32), I3 = (DFF / 64) * 32, I4 = 16 * 16, IL = I0 + I1 + I2 + I3 + I4;
    const int l = it / IL; int r = it % IL; TItem t;
    if (r < I0) { t.W = (const GAS float*)a.in[4] + (size_t)l * D * NIN; t.WT = (GAS bf16_t*)(ws + WS_WIN) + (size_t)l * NIN * D; t.kscale = (const GAS float*)a.in[3] + l * D; t.K = D; t.N = NIN; t.ndst = NIN; t.kind = 0; t.nscale = D; t.item = r; return t; } r -= I0;
    if (r < I1) { t.W = (const GAS float*)a.in[5] + (size_t)l * D * D; t.WT = (GAS bf16_t*)(ws + WS_WOUT) + (size_t)l * D * D; t.kscale = (const GAS float*)((l & 1) ? a.in[10] : a.in[9]) + (l >> 1) * MIXW; t.K = D; t.N = D; t.ndst = D; t.kind = 1; t.nscale = MIXW; t.item = r; return t; } r -= I1;
    if (r < I2) { t.W = (const GAS float*)a.in[12] + (size_t)l * D * NFI; t.WT = (GAS bf16_t*)(ws + WS_WFI) + (size_t)l * NFI * D; t.kscale = (const GAS float*)a.in[11] + l * D; t.K = D; t.N = NFI; t.ndst = NFI; t.kind = 2; t.nscale = D; t.item = r; return t; } r -= I2;
    if (r < I3) { t.W = (const GAS float*)a.in[13] + (size_t)l * DFF * D; t.WT = (GAS bf16_t*)(ws + WS_WFO) + (size_t)l * D * DFF; t.kscale = (const GAS float*)a.in[13]; t.K = DFF; t.N = D; t.ndst = D; t.kind = 3; t.nscale = 0; t.item = r; return t; } r -= I3;
    t.W = (const GAS float*)a.in[7] + (size_t)l * D * 512; t.WT = (GAS bf16_t*)(ws + WS_WM) + (size_t)l * 512 * D; t.kscale = (const GAS float*)a.in[6] + l * D; t.K = D; t.N = 512; t.ndst = 512; t.kind = 4; t.nscale = D; t.item = r; return t;
}
__device__ __forceinline__ void titem_load(const TItem& t, f32x4 (&v)[8], int lane) {
    const int nblk = t.ndst / 32, kb = t.item / nblk, nb = t.item % nblk, k0 = 64 * kb, n0 = 32 * nb, kq = lane >> 3, jd = n0 + 4 * (lane & 7);
    const int sc = t.kind == 0 ? win_srccol(jd) : (t.kind == 2 ? wfi_srccol(jd) : jd);
#pragma unroll
    for (int i = 0; i < 8; ++i) v[i] = *(const GAS f32x4*)(t.W + (size_t)(k0 + 8 * i + kq) * t.N + sc);
}
__device__ __forceinline__ void titem_store(const TItem& t, const f32x4 (&v)[8], LAS float* scr, int lane) {
    const int nblk = t.ndst / 32, kb = t.item / nblk, nb = t.item % nblk, k0 = 64 * kb, n0 = 32 * nb, kq = lane >> 3, nq = lane & 7;
#pragma unroll
    for (int i = 0; i < 8; ++i)
#pragma unroll
        for (int e = 0; e < 4; ++e) scr[(8 * i + kq) * 33 + 4 * nq + e] = v[i][e];
    const int c = lane & 7;
    f32x4 s0 = (f32x4){1.f, 1.f, 1.f, 1.f}, s1 = s0;
    if (k0 + 8 * c < t.nscale) { s0 = *(const GAS f32x4*)(t.kscale + k0 + 8 * c); s1 = *(const GAS f32x4*)(t.kscale + k0 + 8 * c + 4); }
    asm volatile("s_waitcnt lgkmcnt(0)" ::: "memory");
#pragma unroll
    for (int j = 0; j < 4; ++j) { const int n = (lane >> 3) + 8 * j; const LAS float* s = scr + (8 * c) * 33 + n;
        u32x4 o; o.x = pk2(s[0 * 33] * s0[0], s[1 * 33] * s0[1]); o.y = pk2(s[2 * 33] * s0[2], s[3 * 33] * s0[3]); o.z = pk2(s[4 * 33] * s1[0], s[5 * 33] * s1[1]); o.w = pk2(s[6 * 33] * s1[2], s[7 * 33] * s1[3]);
        *(GAS u32x4*)(t.WT + (size_t)(n0 + n) * t.K + k0 + 8 * c) = o; }
    asm volatile("s_waitcnt lgkmcnt(0)" ::: "memory");
}

constexpr int TITEMS_PER_LAYER = 16 * (NIN / 32) + 16 * 32 + 16 * (NFI / 32) + (DFF / 64) * 32 + 16 * 16;
__device__ __forceinline__ void convert_weights(const Args& a, unsigned char* ws, LAS float* scr, int it0, int it1, int w, int nw, int lane, int off = 0, int mul = 1) {
    f32x4 va[8], vb[8];
    nw *= mul;
    int it = it0 + off + mul * w;
    if (it < it1) { const TItem t = titem_decode(a, ws, it); titem_load(t, va, lane); }
    while (it < it1) {
        const int itn = it + nw;
        if (itn < it1) { const TItem t = titem_decode(a, ws, itn); titem_load(t, vb, lane); }
        { const TItem t = titem_decode(a, ws, it); titem_store(t, va, scr, lane); }
        it = itn;
        if (it >= it1) break;
        const int itn2 = it + nw;
        if (itn2 < it1) { const TItem t = titem_decode(a, ws, itn2); titem_load(t, va, lane); }
        { const TItem t = titem_decode(a, ws, it); titem_store(t, vb, scr, lane); }
        it = itn2;
    }
}

__device__ __forceinline__ void p0_prologue(const Args& a, unsigned char* ws, LAS unsigned char* lds, int gw, int NGW, int wave, int lane) {
    LAS float* scr = (LAS float*)(lds + wave * 16384);
    convert_weights(a, ws, scr, 0, 16 * (NIN / 32), gw, NGW, lane);
    for (int l = 0; l < DEPTH; ++l) convert_weights(a, ws, scr, l * TITEMS_PER_LAYER + TITEMS_PER_LAYER - 256, (l + 1) * TITEMS_PER_LAYER, gw, NGW, lane);
    for (int m = gw; m < M; m += NGW) {
        const f32x4* xr = (const f32x4*)(a.in[0] + (size_t)m * D) + lane; f32x4 v[4]; float s = 0.f;
#pragma unroll
        for (int j = 0; j < 4; ++j) { v[j] = xr[64 * j]; s += (v[j].x * v[j].x + v[j].y * v[j].y) + (v[j].z * v[j].z + v[j].w * v[j].w); }
        s = wave_sum(s, lane);
        u32x2* o8 = (u32x2*)((bf16_t*)(ws + WS_XB) + (size_t)m * D) + lane;
#pragma unroll
        for (int j = 0; j < 4; ++j) { u32x2 w; w.x = pk2(v[j].x, v[j].y); w.y = pk2(v[j].z, v[j].w); o8[64 * j] = w; }
        if (lane < 16) ((float*)(ws + WS_SSQA))[(size_t)m * 16 + lane] = lane == 0 ? s : 0.f;
    }
    for (int m = gw; m < MROWS; m += NGW) {
        const f32x4* xr = (const f32x4*)(a.in[1] + (size_t)m * D) + lane; f32x4 v[4]; float s = 0.f;
#pragma unroll
        for (int j = 0; j < 4; ++j) { v[j] = xr[64 * j]; s += (v[j].x * v[j].x + v[j].y * v[j].y) + (v[j].z * v[j].z + v[j].w * v[j].w); }
        const float rs = rsqrtf(wave_sum(s, lane) * (1.0f / D) + EPS);
        u32x2* o8 = (u32x2*)((bf16_t*)(ws + WS_MEMB) + (size_t)m * D) + lane;
#pragma unroll
        for (int j = 0; j < 4; ++j) { u32x2 w; w.x = pk2(v[j].x * rs, v[j].y * rs); w.y = pk2(v[j].z * rs, v[j].w * rs); o8[64 * j] = w; }
    }
    {   const double invf = exp(-9.210340371976184 * ((double)lane / 63.0));
        for (int m = gw; m < M; m += NGW) {
            const double ang = (double)((const GAS int*)a.in[2])[m] * invf;
            const double kr = rint(ang * 0.15915494309189535);
            const float r = (float)fma(-kr, 1.2246467991473532e-16 * 2.0, fma(-kr, 6.283185307179586, ang));
            float sn, cs; sincosf(r, &sn, &cs);
            ((GAS float*)(ws + WS_COS))[(size_t)m * 64 + lane] = cs;
            ((GAS float*)(ws + WS_SIN))[(size_t)m * 64 + lane] = sn;
        }
    }
    for (int c = gw * 64 + lane; c < MIXW; c += NGW * 64) {
        const float l0 = a.in[8][c], l1 = a.in[8][MIXW + c]; const float mx = fmaxf(l0, l1), e0 = expf(l0 - mx), e1 = expf(l1 - mx);
        ((float*)(ws + WS_LB))[c] = 0.f; ((float*)(ws + WS_LB))[MIXW + c] = e1 / (e0 + e1);
    }
}

typedef float f32x16 __attribute__((ext_vector_type(16)));
constexpr int SC_QS = 0, SC_KS = 8704, SC_KST = 17408, SC_V = 27648, SC_P = 37888, SC_AUX = 40448, SC_OUT = 41472, SC_SSQ = 50176, SC_GATE = 50688, SC_BUF = 50688 + 32 * VPR * 16;
constexpr int PQ = 272, PT = 320;
constexpr int NCHUNK = SEQ / 32;
typedef const GAS bf16_t* gbf;
struct HRegs { u32x4 x0[8], x1[8]; float aux[2]; };
__device__ __forceinline__ bf16x8 as_bf16x8(u32x4 v) { return __builtin_bit_cast(bf16x8, v); }

struct StLane { unsigned g0, g1, gg, ga, l0, l1, lg, la, sk; };
template <int IS_RET>
__device__ __forceinline__ void stager_load(HRegs& R, gbf Z, gbf KST, const GAS float* AUXG, int b, int h, int unit, int sw, const StLane& L, int chunk) {
    chunk = chunk < NCHUNK ? chunk : NCHUNK - 1;
    const size_t tok0 = (size_t)b * SEQ + chunk * 32;
    const int p0 = (sw == 0 || IS_RET) ? NIN : MIXW;
    const GAS char* s0 = (const GAS char*)(sw == 0 ? Z + h * 256 : (IS_RET ? Z + h * 256 + 128 : KST + h * 128)) + tok0 * p0 * 2;
    const GAS char* s1 = (const GAS char*)(sw == 0 ? Z + h * 256 + 128 : Z + 1536 + h * 128) + tok0 * NIN * 2;
#pragma unroll
    for (int i = 0; i < 8; ++i) R.x0[i] = *(const GAS u32x4*)(s0 + (size_t)(4 * i) * p0 * 2 + L.g0);
    if (sw == 0) {
#pragma unroll
        for (int i = 0; i < 8; ++i) R.x1[i] = *(const GAS u32x4*)(s1 + 32 * i + L.g1);
    } else {
#pragma unroll
        for (int i = 0; i < 8 / NVS; ++i) R.x1[i] = *(const GAS u32x4*)(s1 + (size_t)(4 * NVS * i) * NIN * 2 + L.g1);
    }
    if (!IS_RET) { const GAS char* ag = (const GAS char*)(AUXG + ((size_t)unit * 64 + chunk) * 256 + 128 * sw); R.aux[0] = *(const GAS float*)(ag + L.ga); R.aux[1] = *(const GAS float*)(ag + 256 + L.ga); }
}
template <int IS_RET>
__device__ __forceinline__ void stager_stage(const HRegs& R, LAS unsigned char* buf, LAS unsigned char* gbuf, int sw, const StLane& L) {
    const int o0 = sw == 0 ? SC_QS : SC_KST, o1 = sw == 0 ? SC_KS : SC_V, pit = sw == 0 ? PQ : PT;
    LAS unsigned char* d0 = buf + o0 + L.l0; LAS unsigned char* d1 = buf + o1 + L.l1;
#pragma unroll
    for (int i = 0; i < 8; ++i) *(LAS u32x4*)(d0 + 4 * i * pit) = R.x0[i];
    if (sw != 0) {
#pragma unroll
        for (int i = 0; i < 8 / NVS; ++i) *(LAS u32x4*)(d1 + 4 * NVS * i * PT) = R.x1[i];
    }
    if (!IS_RET) { LAS unsigned char* al = buf + SC_AUX + 512 * sw + L.la; *(LAS float*)al = R.aux[0]; *(LAS float*)(al + 256) = R.aux[1]; }
}
__device__ __forceinline__ void scores_stage(const HRegs& R, LAS unsigned char* buf, const StLane& L, int l31, int hh) {
    f32x16 d;
#pragma unroll
    for (int r = 0; r < 16; ++r) d[r] = 0.f;
    u32x4 qf[8];
    {   const unsigned aq = (unsigned)(size_t)(buf + SC_QS) + L.sk;
        asm volatile(
            "ds_read_b128 %0, %8 offset:0\n\tds_read_b128 %1, %8 offset:32\n\tds_read_b128 %2, %8 offset:64\n\tds_read_b128 %3, %8 offset:96\n\t"
            "ds_read_b128 %4, %8 offset:128\n\tds_read_b128 %5, %8 offset:160\n\tds_read_b128 %6, %8 offset:192\n\tds_read_b128 %7, %8 offset:224\n\t"
            "s_waitcnt lgkmcnt(0)"
            : "=&v"(qf[0]), "=&v"(qf[1]), "=&v"(qf[2]), "=&v"(qf[3]), "=&v"(qf[4]), "=&v"(qf[5]), "=&v"(qf[6]), "=&v"(qf[7])
            : "v"(aq) : "memory");
        __builtin_amdgcn_sched_barrier(0);
    }
#pragma unroll
    for (int kk = 0; kk < 8; ++kk) d = __builtin_amdgcn_mfma_f32_32x32x16_bf16(as_bf16x8(R.x1[kk]), as_bf16x8(qf[kk]), d, 0, 0, 0);
#pragma unroll
    for (int q = 0; q < 4; ++q) { float v4[4];
#pragma unroll
        for (int i = 0; i < 4; ++i) { const int srow = 8 * q + 4 * hh + i; v4[i] = (srow <= l31) ? d[4 * q + i] : 0.f; }
        u32x2 w; w.x = pg8::cvt_pk_bf16(v4[0], v4[1]); w.y = pg8::cvt_pk_bf16(v4[2], v4[3]);
        *(LAS u32x2*)(buf + SC_P + l31 * 80 + (8 * q + 4 * hh) * 2) = w; }
}
struct FinLane { unsigned lo, ls, go, gs, gz; };
constexpr int FPT = 32 * VPR / 64;
template <int IS_RET>
__device__ __forceinline__ void gate_load(u32x4 (&g)[FPT], gbf Z, int b, int h, const FinLane& L, int chunk) {
    chunk = chunk < NCHUNK ? chunk : NCHUNK - 1;
    const GAS char* sg = (const GAS char*)(Z + 2304 + h * 128) + ((size_t)b * SEQ + chunk * 32) * NIN * 2;
#pragma unroll
    for (int i = 0; i < FPT; ++i) g[i] = *(const GAS u32x4*)(sg + (size_t)(64 / VPR * i) * NIN * 2 + L.gz);
}
__device__ __forceinline__ void gate_stage(const u32x4 (&g)[FPT], LAS unsigned char* buf, int lane) {
#pragma unroll
    for (int i = 0; i < FPT; ++i) *(LAS u32x4*)(buf + SC_GATE + (lane + 64 * i) * 16) = g[i];
}
template <int IS_RET>
__device__ __forceinline__ void fin_store(LAS unsigned char* buf, GAS bf16_t* CAT, GAS float* SSQO, int b, int h, int vh, const FinLane& L, int lane, bool first, int chunk) {
    const size_t tok0 = (size_t)b * SEQ + chunk * 32;
    GAS char* cg = (GAS char*)(CAT + tok0 * D + h * 128); GAS char* sgp = (GAS char*)(SSQO + tok0 * 16 + h * NVS + vh);
#pragma unroll
    for (int i = 0; i < FPT; ++i) {
        const u32x2 lo = *(const LAS u32x2*)(buf + SC_OUT + (64 / VPR) * i * PQ + L.lo), hi = *(const LAS u32x2*)(buf + SC_OUT + (64 / VPR) * i * PQ + 8 + L.lo);
        const LAS unsigned char* sq = buf + SC_SSQ + (64 / VPR) * 4 * i + L.ls;
        float ssum = *(const LAS float*)sq;
#pragma unroll
        for (int w = 1; w < 4 / NVS; ++w) ssum += *(const LAS float*)(sq + 128 * w);
        const float sc = (IS_RET && NVS == 1) ? rsqrtf(ssum * (1.0f / HD) + EPS) : 1.0f;
        const u32x4 gt = *(const LAS u32x4*)(buf + SC_GATE + (lane + 64 * i) * 16);
        const unsigned ow[4] = {lo.x, lo.y, hi.x, hi.y}; u32x4 out;
#pragma unroll
        for (int j = 0; j < 4; ++j) out[j] = pg8::cvt_pk_bf16(__uint_as_float(ow[j] << 16) * sc * __uint_as_float(gt[j] << 16), __uint_as_float(ow[j] & 0xffff0000u) * sc * __uint_as_float(gt[j] & 0xffff0000u));
        *(GAS u32x4*)(cg + (size_t)(64 / VPR * i) * D * 2 + L.go) = out;
        if ((!IS_RET || NVS > 1) && first) *(GAS float*)(sgp + (size_t)(64 / VPR * i) * 64 + L.gs) = ssum; }
}
__device__ __forceinline__ void norm_rows(unsigned char* ws, int row0, int row1, int gw, int NGW, int lane) {
    GAS bf16_t* CAT = (GAS bf16_t*)(ws + WS_CAT); const GAS float* SSQO = (const GAS float*)(ws + WS_SSQO);
    static_assert(NVS == 2, "the two partial sums of a head are read as one 8-byte pair");
    for (int rowb = row0 + gw; rowb < row1; rowb += 4 * NGW) {
        u32x2 w[4][3]; f32x2 sq[4][3];
#pragma unroll
        for (int k = 0; k < 4; ++k) { const int row = rowb + k * NGW < row1 ? rowb + k * NGW : rowb;
#pragma unroll
            for (int j = 0; j < 3; ++j) { const int e = lane * 4 + 256 * j, h = e >> 7;
                sq[k][j] = *(const GAS f32x2*)(SSQO + (size_t)row * 16 + h * NVS); w[k][j] = *(const GAS u32x2*)(CAT + (size_t)row * D + e); } }
#pragma unroll
        for (int k = 0; k < 4; ++k) { const int row = rowb + k * NGW;
            if (row < row1) {
#pragma unroll
                for (int j = 0; j < 3; ++j) { const int e = lane * 4 + 256 * j;
                    const float sc = rsqrtf((sq[k][j][0] + sq[k][j][1]) * (1.0f / HD) + EPS); u32x2 o;
                    o.x = pg8::cvt_pk_bf16(__uint_as_float(w[k][j].x << 16) * sc, __uint_as_float(w[k][j].x & 0xffff0000u) * sc); o.y = pg8::cvt_pk_bf16(__uint_as_float(w[k][j].y << 16) * sc, __uint_as_float(w[k][j].y & 0xffff0000u) * sc);
                    *(GAS u32x2*)(CAT + (size_t)row * D + e) = o; } } }
    }
}
#define TRR(dst, areg, off) "ds_read_b64_tr_b16 " dst ", " areg " offset:" #off "\n\t"
struct MLane { unsigned av, ak, aq, aaux, ap, aout, assq; };
template <int IS_RET, int PAR>
__device__ __forceinline__ void mfma_step(f32x16 (&S)[4], const MLane& A, int lane, float g32) {
    constexpr unsigned PB = PAR * SC_BUF;
    u32x2 v00, v01, v10, v11, k[4][2][2]; u32x4 qf[4][2];
    const unsigned av = A.av + PB, ak = A.ak + PB, aq = A.aq + PB;
    asm volatile(
        "ds_read_b128 %0, %8 offset:0\n\tds_read_b128 %1, %8 offset:32\n\tds_read_b128 %2, %8 offset:64\n\tds_read_b128 %3, %8 offset:96\n\t"
        "ds_read_b128 %4, %8 offset:128\n\tds_read_b128 %5, %8 offset:160\n\tds_read_b128 %6, %8 offset:192\n\tds_read_b128 %7, %8 offset:224"
        : "=&v"(qf[0][0]), "=&v"(qf[0][1]), "=&v"(qf[1][0]), "=&v"(qf[1][1]), "=&v"(qf[2][0]), "=&v"(qf[2][1]), "=&v"(qf[3][0]), "=&v"(qf[3][1])
        : "v"(aq) : "memory");
    asm volatile(
        TRR("%0", "%12", 0) TRR("%1", "%12", 1280) TRR("%2", "%12", 5120) TRR("%3", "%12", 6400)
        TRR("%4", "%13", 0) TRR("%5", "%13", 1280) TRR("%6", "%13", 5120) TRR("%7", "%13", 6400)
        TRR("%8", "%13", 64) TRR("%9", "%13", 1344) TRR("%10", "%13", 5184) TRR("%11", "%13", 6464)
        : "=&v"(v00), "=&v"(v01), "=&v"(v10), "=&v"(v11),
          "=&v"(k[0][0][0]), "=&v"(k[0][0][1]), "=&v"(k[0][1][0]), "=&v"(k[0][1][1]), "=&v"(k[1][0][0]), "=&v"(k[1][0][1]), "=&v"(k[1][1][0]), "=&v"(k[1][1][1])
        : "v"(av), "v"(ak) : "memory");
    const LAS unsigned char* auxp = (const LAS unsigned char*)(size_t)(A.aaux + PB);
    bf16x8 sf[4][2];
#pragma unroll
    for (int kt = 0; kt < 4; ++kt) { f32x16 t = S[kt];
        if (!IS_RET) {
#pragma unroll
            for (int q = 0; q < 4; ++q) { const f32x4 e = *(const LAS f32x4*)(auxp + (32 * kt + 16 * (q >> 1) + 4 * (q & 1)) * 4);
#pragma unroll
                for (int i = 0; i < 4; ++i) t[4 * q + i] *= e[i]; } }
#pragma unroll
        for (int s2 = 0; s2 < 2; ++s2) { u32x4 pk;
#pragma unroll
            for (int j = 0; j < 4; ++j) pk[j] = pg8::cvt_pk_bf16(t[8 * s2 + 2 * j], t[8 * s2 + 2 * j + 1]);
            sf[kt][s2] = as_bf16x8(pk); } }
    asm volatile("s_waitcnt lgkmcnt(12)" : "+v"(qf[0][0]), "+v"(qf[0][1]), "+v"(qf[1][0]), "+v"(qf[1][1]), "+v"(qf[2][0]), "+v"(qf[2][1]), "+v"(qf[3][0]), "+v"(qf[3][1]) :: "memory");
    asm volatile(
        TRR("%0", "%8", 128) TRR("%1", "%8", 1408) TRR("%2", "%8", 5248) TRR("%3", "%8", 6528)
        TRR("%4", "%8", 192) TRR("%5", "%8", 1472) TRR("%6", "%8", 5312) TRR("%7", "%8", 6592)
        : "=&v"(k[2][0][0]), "=&v"(k[2][0][1]), "=&v"(k[2][1][0]), "=&v"(k[2][1][1]), "=&v"(k[3][0][0]), "=&v"(k[3][0][1]), "=&v"(k[3][1][0]), "=&v"(k[3][1][1])
        : "v"(ak) : "memory");
    __builtin_amdgcn_sched_barrier(0);
    f32x16 o;
#pragma unroll
    for (int r = 0; r < 16; ++r) o[r] = 0.f;
#pragma unroll
    for (int kt = 0; kt < 4; ++kt)
#pragma unroll
        for (int s2 = 0; s2 < 2; ++s2) o = __builtin_amdgcn_mfma_f32_32x32x16_bf16(sf[kt][s2], as_bf16x8(qf[kt][s2]), o, 0, 0, 0);
    __builtin_amdgcn_sched_barrier(0);
    asm volatile("s_waitcnt lgkmcnt(0)" : "+v"(v00), "+v"(v01), "+v"(v10), "+v"(v11),
          "+v"(k[0][0][0]), "+v"(k[0][0][1]), "+v"(k[0][1][0]), "+v"(k[0][1][1]), "+v"(k[1][0][0]), "+v"(k[1][0][1]), "+v"(k[1][1][0]), "+v"(k[1][1][1]),
          "+v"(k[2][0][0]), "+v"(k[2][0][1]), "+v"(k[2][1][0]), "+v"(k[2][1][1]), "+v"(k[3][0][0]), "+v"(k[3][0][1]), "+v"(k[3][1][0]), "+v"(k[3][1][1]) :: "memory");
    __builtin_amdgcn_sched_barrier(0);
    const bf16x8 vt[2] = {as_bf16x8((u32x4){v00.x, v00.y, v01.x, v01.y}), as_bf16x8((u32x4){v10.x, v10.y, v11.x, v11.y})};
    const LAS unsigned char* pp = (const LAS unsigned char*)(size_t)(A.ap + PB);
#pragma unroll
    for (int kk = 0; kk < 2; ++kk) { const bf16x8 pf = *(const LAS bf16x8*)(pp + 32 * kk);
        o = __builtin_amdgcn_mfma_f32_32x32x16_bf16(vt[kk], pf, o, 0, 0, 0); }
#pragma unroll
    for (int kt = 0; kt < 4; ++kt) {
        if (!IS_RET) {
#pragma unroll
            for (int q = 0; q < 4; ++q) { const f32x4 e = *(const LAS f32x4*)(auxp + 512 + (32 * kt + 16 * (q >> 1) + 4 * (q & 1)) * 4);
#pragma unroll
                for (int i = 0; i < 4; ++i) S[kt][4 * q + i] *= e[i]; } }
#pragma unroll
        for (int kk = 0; kk < 2; ++kk) S[kt] = __builtin_amdgcn_mfma_f32_32x32x16_bf16(as_bf16x8((u32x4){k[kt][kk][0].x, k[kt][kk][0].y, k[kt][kk][1].x, k[kt][kk][1].y}), vt[kk], S[kt], 0, 0, 0);
        if (IS_RET) S[kt] = S[kt] * g32;
    }
    float ss = 0.f;
#pragma unroll
    for (int r = 0; r < 16; ++r) ss += o[r] * o[r];
    ss += shfl_xor_l(ss, lane, 32);
    if (lane < 32) *(LAS float*)(size_t)(A.assq + PB) = ss;
    LAS unsigned char* op = (LAS unsigned char*)(size_t)(A.aout + PB);
#pragma unroll
    for (int q = 0; q < 4; ++q) { u32x2 wv; wv.x = pg8::cvt_pk_bf16(o[4 * q], o[4 * q + 1]); wv.y = pg8::cvt_pk_bf16(o[4 * q + 2], o[4 * q + 3]);
        *(LAS u32x2*)(op + 16 * q) = wv; }
}
template <int IS_RET, int VAR>
__device__ __forceinline__ void scan2_unit(unsigned char* ws, LAS unsigned char* lds, int unit, int tid) {
    constexpr bool MF_ON = VAR == 0 || ((VAR & 16) && (VAR & 1)), ST_ON = VAR == 0 || ((VAR & 16) && (VAR & 2)), FI_ON = VAR == 0 || ((VAR & 16) && (VAR & 4)), ST_LD = ST_ON && !(VAR & 64), ST_ST = ST_ON && !(VAR & 32);
    gbf Z = (gbf)(ws + WS_Z); gbf KST = (gbf)(ws + WS_KST); const GAS float* AUXG = (const GAS float*)(ws + WS_AUX);
    GAS bf16_t* CAT = (GAS bf16_t*)(ws + WS_CAT); GAS float* SSQO = (GAS float*)(ws + WS_SSQO);
    const int b = unit / (NH * NVS), h = (unit / NVS) % NH, vh = unit % NVS, hu = b * NH + h, wave = __builtin_amdgcn_readfirstlane(tid >> 6); int lane = tid & 63;
    const float g32 = exp2f(32.0f * __log2f(1.0f - exp2f(-5.0f - (float)h)));
    __syncthreads();
    static_assert(NVS == 2, "wave roles below are written for two value slices per head");
    if (wave >= 6) {
        __syncthreads();
        for (int n = 0; n < NCHUNK; ++n) __syncthreads();
    } else if (wave < 2) {
        asm volatile("" : "+v"(lane));
        const int l31 = lane & 31, hh = lane >> 5, vs = (128 / NVS) * vh + 32 * wave;
        const unsigned base = (unsigned)(size_t)lds, trl = (unsigned)((8 * hh + ((lane & 15) >> 2)) * PT + (16 * ((lane >> 4) & 1) + 4 * (lane & 3)) * 2);
        const int psw = ((lane & 3) == 1) ? 2 : (((lane & 3) == 2) ? 1 : (lane & 3));
        const unsigned trk = (unsigned)((8 * hh + ((lane & 15) >> 2)) * PT + (16 * ((lane >> 4) & 1) + 4 * psw) * 2);
        MLane A;
        A.av = base + SC_V + trl + vs * 2; A.ak = base + SC_KST + trk; A.aq = base + SC_QS + l31 * PQ + 16 * hh; A.aaux = base + SC_AUX + 32 * hh; A.ap = base + SC_P + l31 * 80 + 16 * hh;
        A.aout = base + SC_OUT + l31 * PQ + (vs + 4 * hh) * 2; A.assq = base + SC_SSQ + (wave * 32 + l31) * 4;
        asm volatile("" : "+v"(A.av), "+v"(A.ak), "+v"(A.aq), "+v"(A.aaux), "+v"(A.ap), "+v"(A.aout), "+v"(A.assq));
        f32x16 S[4];
#pragma unroll
        for (int kt = 0; kt < 4; ++kt)
#pragma unroll
            for (int r = 0; r < 16; ++r) S[kt][r] = 0.f;
        __syncthreads();
        for (int n = 0; n < NCHUNK; n += 2) {
            if (MF_ON) mfma_step<IS_RET, 0>(S, A, lane, g32);
            __syncthreads();
            if (MF_ON) mfma_step<IS_RET, 1>(S, A, lane, g32);
            __syncthreads();
        }
        if (!MF_ON) asm volatile("" :: "v"(S[0][0]));
    } else if (wave < 4) {
        const int sw = wave - 2;
        if (!ST_ON) { __syncthreads(); for (int n = 0; n < NCHUNK; ++n) __syncthreads(); }
        else {
        asm volatile("" : "+v"(lane));
        const int l31 = lane & 31, hh = lane >> 5, r4 = lane >> 4, c16 = lane & 15, p0 = (sw == 0 || IS_RET) ? NIN : MIXW;
        StLane L;
        L.g0 = (unsigned)((r4 * p0 + 8 * c16) * 2); L.gg = 0; L.ga = (unsigned)(lane * 4);
        L.l0 = (unsigned)(r4 * (sw == 0 ? PQ : PT) + 16 * c16); L.lg = (unsigned)(lane * 16); L.la = (unsigned)(lane * 4); L.sk = (unsigned)(l31 * PQ + 16 * hh);
        if (sw == 0) { L.g1 = (unsigned)((l31 * NIN + 8 * hh) * 2); L.l1 = 0; }
        else { const int rv = lane / VPR, cv = VPR * vh + lane % VPR; L.g1 = (unsigned)((rv * NIN + 8 * cv) * 2); L.l1 = (unsigned)(rv * PT + 16 * cv); }
        asm volatile("" : "+v"(L.g0), "+v"(L.g1), "+v"(L.gg), "+v"(L.ga), "+v"(L.l0), "+v"(L.l1), "+v"(L.lg), "+v"(L.la), "+v"(L.sk));
        HRegs RA, RB;
        stager_load<IS_RET>(RA, Z, KST, AUXG, b, h, hu, sw, L, 0);
        stager_stage<IS_RET>(RA, lds, lds + SC_BUF, sw, L);
        if (sw == 0) scores_stage(RA, lds, L, l31, hh);
        stager_load<IS_RET>(RB, Z, KST, AUXG, b, h, hu, sw, L, 1);
        __syncthreads();
        for (int n = 0; n < NCHUNK; n += 2) {
            if (ST_LD) stager_load<IS_RET>(RA, Z, KST, AUXG, b, h, hu, sw, L, n + 2);
            if (ST_ST) { stager_stage<IS_RET>(RB, lds + SC_BUF, lds, sw, L);
                if (sw == 0) scores_stage(RB, lds + SC_BUF, L, l31, hh); }
            else asm volatile("" :: "v"(RB.x0[0]), "v"(RB.x0[7]), "v"(RB.x1[0]), "v"(RB.aux[1]));
            __syncthreads();
            if (ST_LD) stager_load<IS_RET>(RB, Z, KST, AUXG, b, h, hu, sw, L, n + 3);
            if (ST_ST) { stager_stage<IS_RET>(RA, lds, lds + SC_BUF, sw, L);
                if (sw == 0) scores_stage(RA, lds, L, l31, hh); }
            else asm volatile("" :: "v"(RA.x0[0]), "v"(RA.x0[7]), "v"(RA.x1[0]), "v"(RA.aux[1]));
            __syncthreads();
        }
        }
    } else {
        asm volatile("" : "+v"(lane));
        FinLane L;
        {   const int c0 = lane / VPR, v0 = 8 * (VPR * vh + lane % VPR);
            L.lo = (unsigned)(c0 * PQ + v0 * 2); L.ls = (unsigned)(c0 * 4); L.go = (unsigned)((c0 * D + v0) * 2); L.gs = (unsigned)(c0 * 64); L.gz = (unsigned)((c0 * NIN + v0) * 2); }
        asm volatile("" : "+v"(L.lo), "+v"(L.ls), "+v"(L.go), "+v"(L.gs), "+v"(L.gz));
        if (wave == 4) {
            u32x4 gA[FPT], gB[FPT];
            gate_load<IS_RET>(gA, Z, b, h, L, 0); gate_load<IS_RET>(gB, Z, b, h, L, 1);
            __syncthreads();
            for (int n = 0; n < NCHUNK; n += 2) {
                if (FI_ON) { gate_stage(gA, lds, lane); gate_load<IS_RET>(gA, Z, b, h, L, n + 2); }
                __syncthreads();
                if (FI_ON) { gate_stage(gB, lds + SC_BUF, lane); gate_load<IS_RET>(gB, Z, b, h, L, n + 3); }
                __syncthreads();
            }
        } else {
            const bool first = (lane % VPR) == 0;
            __syncthreads();
            __syncthreads();
            for (int n = 1; n < NCHUNK; ++n) { if (FI_ON) fin_store<IS_RET>(lds + ((n - 1) & 1) * SC_BUF, CAT, SSQO, b, h, vh, L, lane, first, n - 1); __syncthreads(); }
            if (FI_ON) fin_store<IS_RET>(lds + ((NCHUNK - 1) & 1) * SC_BUF, CAT, SSQO, b, h, vh, L, lane, first, NCHUNK - 1);
        }
    }
}

constexpr int XA_K = 0, XA_KP = 144, XA_V = 256 * XA_KP, XA_VP = 192;
#define XRD(dst, areg, off) "ds_read_b128 " dst ", " areg " offset:" #off "\n\t"
__device__ __forceinline__ void xattn2_unit(unsigned char* ws, LAS unsigned char* lds, int unit, int layer, int tid) {
    gbf Z = (gbf)(ws + WS_Z); gbf MKV = (gbf)(ws + WS_MKV); GAS bf16_t* CAT = (GAS bf16_t*)(ws + WS_CAT);
    const int b = unit >> 5, hx = (unit >> 3) & 3, qb = unit & 7;
    const int wave = tid >> 6, lane = tid & 63, l31 = lane & 31, hh = lane >> 5;
    const size_t tok = (size_t)b * SEQ + qb * 256 + wave * 32 + l31;
    bf16x8 qf[4];
#pragma unroll
    for (int ks = 0; ks < 4; ++ks) qf[ks] = *(const GAS bf16x8*)(Z + tok * NIN + 3072 + hx * 64 + 16 * ks + 8 * hh);
    __syncthreads();
    {   gbf src = MKV + (size_t)(b * NMEM) * 2048 + layer * 512 + hx * 64;
        u32x4 kr[4], vr[4];
#pragma unroll
        for (int i = 0; i < 4; ++i) { const int piece = tid + 512 * i, key = piece >> 3, j = piece & 7;
            kr[i] = *(const GAS u32x4*)(src + (size_t)key * 2048 + 8 * j); vr[i] = *(const GAS u32x4*)(src + (size_t)key * 2048 + 256 + 8 * j); }
#pragma unroll
        for (int i = 0; i < 4; ++i) { const int piece = tid + 512 * i, key = piece >> 3, j = piece & 7;
            *(LAS u32x4*)(lds + XA_K + key * XA_KP + 16 * j) = kr[i]; *(LAS u32x4*)(lds + XA_V + key * XA_VP + 16 * j) = vr[i]; }
    }
    __syncthreads();
    f32x16 st[8];
    const unsigned ak = (unsigned)(size_t)(lds + XA_K) + (unsigned)(l31 * XA_KP + 16 * hh);
#define XBLK(T0, o0, o1, o2, o3, o4, o5, o6, o7) { u32x4 f0, f1, f2, f3, f4, f5, f6, f7; \
        asm volatile(XRD("%0", "%8", o0) XRD("%1", "%8", o1) XRD("%2", "%8", o2) XRD("%3", "%8", o3) XRD("%4", "%8", o4) XRD("%5", "%8", o5) XRD("%6", "%8", o6) XRD("%7", "%8", o7) "s_waitcnt lgkmcnt(0)" \
            : "=&v"(f0), "=&v"(f1), "=&v"(f2), "=&v"(f3), "=&v"(f4), "=&v"(f5), "=&v"(f6), "=&v"(f7) : "v"(ak) : "memory"); \
        __builtin_amdgcn_sched_barrier(0); \
        f32x16 a0, a1; _Pragma("unroll") for (int r = 0; r < 16; ++r) { a0[r] = 0.f; a1[r] = 0.f; } \
        a0 = __builtin_amdgcn_mfma_f32_32x32x16_bf16(as_bf16x8(f0), qf[0], a0, 0, 0, 0); a1 = __builtin_amdgcn_mfma_f32_32x32x16_bf16(as_bf16x8(f4), qf[0], a1, 0, 0, 0); \
        a0 = __builtin_amdgcn_mfma_f32_32x32x16_bf16(as_bf16x8(f1), qf[1], a0, 0, 0, 0); a1 = __builtin_amdgcn_mfma_f32_32x32x16_bf16(as_bf16x8(f5), qf[1], a1, 0, 0, 0); \
        a0 = __builtin_amdgcn_mfma_f32_32x32x16_bf16(as_bf16x8(f2), qf[2], a0, 0, 0, 0); a1 = __builtin_amdgcn_mfma_f32_32x32x16_bf16(as_bf16x8(f6), qf[2], a1, 0, 0, 0); \
        a0 = __builtin_amdgcn_mfma_f32_32x32x16_bf16(as_bf16x8(f3), qf[3], a0, 0, 0, 0); a1 = __builtin_amdgcn_mfma_f32_32x32x16_bf16(as_bf16x8(f7), qf[3], a1, 0, 0, 0); \
        st[T0] = a0; st[T0 + 1] = a1; }
    XBLK(0, 0, 32, 64, 96, 4608, 4640, 4672, 4704)
    XBLK(2, 9216, 9248, 9280, 9312, 13824, 13856, 13888, 13920)
    XBLK(4, 18432, 18464, 18496, 18528, 23040, 23072, 23104, 23136)
    XBLK(6, 27648, 27680, 27712, 27744, 32256, 32288, 32320, 32352)
#undef XBLK
    float mx = -1e30f;
#pragma unroll
    for (int T = 0; T < 8; ++T)
#pragma unroll
        for (int r = 0; r < 16; ++r) mx = fmaxf(mx, st[T][r]);
    mx = fmaxf(mx, shfl_xor_l(mx, lane, 32));
    const float c2 = 0.125f * 1.4426950408889634f, mc = mx * c2;
    float sum = 0.f;
#pragma unroll
    for (int T = 0; T < 8; ++T)
#pragma unroll
        for (int r = 0; r < 16; ++r) { const float p = exp2f(st[T][r] * c2 - mc); st[T][r] = p; sum += p; }
    sum += shfl_xor_l(sum, lane, 32);
    f32x16 ot[2];
#pragma unroll
    for (int dt = 0; dt < 2; ++dt)
#pragma unroll
        for (int r = 0; r < 16; ++r) ot[dt][r] = 0.f;
    const unsigned av = (unsigned)(size_t)(lds + XA_V) + (unsigned)((4 * hh + ((lane & 15) >> 2)) * XA_VP + (16 * ((lane >> 4) & 1) + 4 * (lane & 3)) * 2);
#define XTR(dst, off) "ds_read_b64_tr_b16 " dst ", %8 offset:" #off "\n\t"
#define VBLK(T, o00, o01, o10, o11, o20, o21, o30, o31) { u32x2 g0, g1, g2, g3, g4, g5, g6, g7; \
        asm volatile(XTR("%0", o00) XTR("%1", o01) XTR("%2", o10) XTR("%3", o11) XTR("%4", o20) XTR("%5", o21) XTR("%6", o30) XTR("%7", o31) "s_waitcnt lgkmcnt(0)" \
            : "=&v"(g0), "=&v"(g1), "=&v"(g2), "=&v"(g3), "=&v"(g4), "=&v"(g5), "=&v"(g6), "=&v"(g7) : "v"(av) : "memory"); \
        __builtin_amdgcn_sched_barrier(0); \
        u32x4 p0, p1; _Pragma("unroll") for (int j = 0; j < 4; ++j) { p0[j] = pg8::cvt_pk_bf16(st[T][2 * j], st[T][2 * j + 1]); p1[j] = pg8::cvt_pk_bf16(st[T][8 + 2 * j], st[T][8 + 2 * j + 1]); } \
        ot[0] = __builtin_amdgcn_mfma_f32_32x32x16_bf16(as_bf16x8((u32x4){g0.x, g0.y, g1.x, g1.y}), as_bf16x8(p0), ot[0], 0, 0, 0); \
        ot[1] = __builtin_amdgcn_mfma_f32_32x32x16_bf16(as_bf16x8((u32x4){g2.x, g2.y, g3.x, g3.y}), as_bf16x8(p0), ot[1], 0, 0, 0); \
        ot[0] = __builtin_amdgcn_mfma_f32_32x32x16_bf16(as_bf16x8((u32x4){g4.x, g4.y, g5.x, g5.y}), as_bf16x8(p1), ot[0], 0, 0, 0); \
        ot[1] = __builtin_amdgcn_mfma_f32_32x32x16_bf16(as_bf16x8((u32x4){g6.x, g6.y, g7.x, g7.y}), as_bf16x8(p1), ot[1], 0, 0, 0); }
    VBLK(0, 0, 1536, 64, 1600, 3072, 4608, 3136, 4672)
    VBLK(1, 6144, 7680, 6208, 7744, 9216, 10752, 9280, 10816)
    VBLK(2, 12288, 13824, 12352, 13888, 15360, 16896, 15424, 16960)
    VBLK(3, 18432, 19968, 18496, 20032, 21504, 23040, 21568, 23104)
    VBLK(4, 24576, 26112, 24640, 26176, 27648, 29184, 27712, 29248)
    VBLK(5, 30720, 32256, 30784, 32320, 33792, 35328, 33856, 35392)
    VBLK(6, 36864, 38400, 36928, 38464, 39936, 41472, 40000, 41536)
    VBLK(7, 43008, 44544, 43072, 44608, 46080, 47616, 46144, 47680)
#undef VBLK
#undef XTR
    const float il = 1.0f / sum;
    GAS bf16_t* op = CAT + tok * D + MIXW + hx * 64 + 4 * hh;
#pragma unroll
    for (int dt = 0; dt < 2; ++dt)
#pragma unroll
        for (int q = 0; q < 4; ++q) { u32x2 w; w.x = pg8::cvt_pk_bf16(ot[dt][4 * q] * il, ot[dt][4 * q + 1] * il); w.y = pg8::cvt_pk_bf16(ot[dt][4 * q + 2] * il, ot[dt][4 * q + 3] * il);
            *(GAS u32x2*)(op + 32 * dt + 8 * q) = w; }
}

__device__ __forceinline__ void final_rows(const unsigned char* ws, float* out, const float* nf, int row0, int row1, int gw, int NGW, int lane) {
    const GAS f32x4* wv = (const GAS f32x4*)nf + lane;
    for (int row = row0 + gw; row < row1; row += NGW) {
        const GAS u32x2* xr = (const GAS u32x2*)((const GAS bf16_t*)(ws + WS_XB) + (size_t)row * D) + lane; f32x4 v[4]; float s = 0.f;
#pragma unroll
        for (int j = 0; j < 4; ++j) { const u32x2 w = xr[64 * j]; v[j][0] = bf2f(w.x & 0xffffu); v[j][1] = bf2f(w.x >> 16); v[j][2] = bf2f(w.y & 0xffffu); v[j][3] = bf2f(w.y >> 16);
            s += (v[j].x * v[j].x + v[j].y * v[j].y) + (v[j].z * v[j].z + v[j].w * v[j].w); }
        const float rs = rsqrtf(wave_sum(s, lane) * (1.0f / D) + EPS);
        GAS f32x4* orow = (GAS f32x4*)(out + (size_t)row * D) + lane;
#pragma unroll
        for (int j = 0; j < 4; ++j) orow[64 * j] = v[j] * rs * wv[64 * j];
    }
}

__global__ void __launch_bounds__(NWAVES * 64, 2) mega_fwd(Args args) {
    extern __shared__ __attribute__((aligned(16))) unsigned char lds_raw[];
    LAS unsigned char* lds = (LAS unsigned char*)lds_raw;
    volatile LAS unsigned* MISC = (volatile LAS unsigned*)(lds + MISC_OFF);
    const int G = gridDim.x, bx = blockIdx.x;
    const int wave_s = __builtin_amdgcn_readfirstlane(threadIdx.x >> 6);
    unsigned char* ws = args.ws;
    for (int u = threadIdx.x; u < (LDS_BYTES - LDSCTL_OFF) / 4; u += NWAVES * 64) ((LAS unsigned*)(lds + LDSCTL_OFF))[u] = 0u;
    __syncthreads();
    XcdBarrier bar = xcd_barrier_post((unsigned*)(ws + WS_CTL) + CW_BAR, MISC + 8);
#define GBAR() xcd_barrier(bar, wave_s == 0 && lane_id_volatile() == 0)
#define OPAQ() unsigned char* wsp = ws; int Gp = G, bxp = bx, tidp = wave_s * 64 + lane_id_volatile(); asm volatile("" : "+s"(wsp), "+s"(Gp), "+s"(bxp), "+v"(tidp)); \
    const int lanep = tidp & 63, wavep = __builtin_amdgcn_readfirstlane(tidp >> 6), vcup = (Gp % 8 == 0) ? (bxp % 8) * (Gp / 8) + bxp / 8 : bxp, gwp = vcup * NWAVES + wavep, NGWp = Gp * NWAVES; \
    (void)lanep; (void)gwp; (void)NGWp
#define XPART() const int xn = misc_rd(lds, 8), xnx = misc_rd(lds, 9), xrank = misc_rd(lds, 10), xslot = misc_rd(lds, 11); \
    (void)xn; (void)xnx; (void)xrank; (void)xslot
    unsigned lbar_k = 0;
#define LBAR() xcc_barrier(bar, (unsigned)misc_rd(lds, 8), wave_s == 0 && lane_id_volatile() == 0, ++lbar_k)

    { OPAQ(); p0_prologue(args, wsp, lds, gwp, NGWp, wavep, lanep); }
    GBAR();
    if (threadIdx.x == 0) {
        unsigned slot = 0;
        for (unsigned j = 0; j < 16; ++j) { const unsigned c = xb_ld(&bar.bar[XB_XCNT(j)]); if (j < bar.x && c > 0u) ++slot; }
        MISC[11] = slot;
    }
    __syncthreads();
    for (int l = 0; l < DEPTH; ++l) {
        const int is_ret = l & 1;
        if (l >= 2) cv_wait(bar, l - 2, (unsigned)misc_rd(lds, 9), wave_s == 0 && lane_id_volatile() == 0);
        { OPAQ(); XPART();
            pg8::Gemm g{(const bf16_t*)(wsp + WS_XB), (const bf16_t*)(wsp + WS_WIN) + (size_t)l * NIN * D, M, NIN, D}; pg8::XccOrder S{xrank, xn, xslot, xnx, (NIN - XW) / 256, RBG_A, 1 << 30};
            EpiIn E{(bf16_t*)(wsp + WS_Z), (bf16_t*)(wsp + WS_KST), (float*)(wsp + WS_AUX), (const float*)(wsp + WS_SSQA), (const float*)(wsp + WS_LB) + (l >> 1) * MIXW, (const float*)(wsp + WS_COS), (const float*)(wsp + WS_SIN), is_ret, (LAS float*)(lds + RSTD_TAB_OFF)};
            pg8::gemm_phase<EpiIn, pg8::XccOrder, true, true>(lds, g, S, E, tidp);
        }
        LBAR();
        if (l == 0) { OPAQ(); XPART();
            constexpr int UB = NH * NVS + 8; const int nb = xslot < 8 ? (8 - xslot + xnx - 1) / xnx : 0, busy = UB * nb < xn ? UB * nb : 0, nidle = xn - busy;
            {
                if (xrank >= busy) {
                    pg8::Gemm g{(const bf16_t*)(wsp + WS_MEMB), (const bf16_t*)(wsp + WS_WM), MROWS, 2048, D}; pg8::XccOrderMem S{xrank - busy, nidle, xslot, xnx};
                    EpiPlain E{(bf16_t*)(wsp + WS_MKV), 2048};
                    pg8::gemm_phase<EpiPlain, pg8::XccOrderMem, true, true>(lds, g, S, E, tidp);
                }
                if (busy == 0) { xcc_barrier(bar, (unsigned)xn, wave_s == 0 && lane_id_volatile() == 0, ++lbar_k); }
                else if (xrank >= busy) {
                    asm volatile("s_waitcnt vmcnt(0)" ::: "memory"); __syncthreads();
                    if (wave_s == 0 && lane_id_volatile() == 0) { __builtin_amdgcn_s_waitcnt(0); xb_add(&bar.bar[XB_MKV(bar.x)], 1u); }
                }
            }
        }
        { OPAQ(); XPART();
            constexpr int UB = NH * NVS + 8;
            const int nb = xslot < 8 ? (8 - xslot + xnx - 1) / xnx : 0;
            const int busy = UB * nb < xn ? UB * nb : 0, nidle = xn - busy;
            for (int u = xrank; u < UB * nb; u += xn) {
                const int b = xslot + (u / UB) * xnx, uu = u % UB;
                if (uu < NH * NVS) { if (is_ret) scan2_unit<1, 0>(wsp, lds, b * NH * NVS + uu, tidp); else scan2_unit<0, 0>(wsp, lds, b * NH * NVS + uu, tidp); }
                else { const int rb = 8 * b + (uu - NH * NVS);
                    {   pg8::Gemm g{(const bf16_t*)(wsp + WS_XB), (const bf16_t*)(wsp + WS_WIN) + (size_t)l * NIN * D, M, NIN, D}; pg8::OneUnit S{rb, 12};
                        EpiIn E{(bf16_t*)(wsp + WS_Z), (bf16_t*)(wsp + WS_KST), (float*)(wsp + WS_AUX), (const float*)(wsp + WS_SSQA), (const float*)(wsp + WS_LB) + (l >> 1) * MIXW, (const float*)(wsp + WS_COS), (const float*)(wsp + WS_SIN), is_ret, (LAS float*)(lds + RSTD_TAB_OFF)};
                        pg8::gemm_phase<EpiIn, pg8::OneUnit, true, true>(lds, g, S, E, tidp); }
                    if (l == 0 && busy > 0) {
                        if (wave_s == 0 && lane_id_volatile() == 0) { unsigned* bb = bar.bar; XB_SPIN(xb_ld(&bb[XB_MKV(bar.x)]) < (unsigned)nidle, bb); }
                    }
                    asm volatile("s_waitcnt vmcnt(0)" ::: "memory"); __builtin_amdgcn_fence(__ATOMIC_RELEASE, "agent"); __syncthreads(); __builtin_amdgcn_fence(__ATOMIC_ACQUIRE, "agent");
                    int tidq = wave_s * 64 + lane_id_volatile(); asm volatile("" : "+v"(tidq));
                    for (int hx = 0; hx < NXH; ++hx) xattn2_unit(wsp, lds, (rb >> 3) * 32 + hx * 8 + (rb & 7), l, tidq);
                }
            }
            if (l < DEPTH - 1) {
                if (xrank >= busy) {
                    const int j = xrank - busy, n3 = (l == 0 && nidle > 8 * nb) ? 8 * nb : 0, m5 = l == 0 ? 5 : 1, sh = j < n3 ? 3 : m5;
                    const int wv0 = j < n3 ? (j * NWAVES + wavep) * 3 : n3 * NWAVES * 3 + ((j - n3) * NWAVES + wavep) * m5, nwv = n3 * NWAVES * 3 + (nidle - n3) * NWAVES * m5;
                    __syncthreads();
                    for (int l2 = (l == 0 ? 0 : l + 1); l2 < l + 2; ++l2)
                        for (int v = 0; v < sh; ++v) convert_weights(args, wsp, (LAS float*)(lds + wavep * 16384), l2 * TITEMS_PER_LAYER + (l2 == 0 ? 16 * (NIN / 32) : 0), (l2 + 1) * TITEMS_PER_LAYER - 256, wv0 + v, nwv, lanep, xslot < xnx ? xslot : 0, xnx);
                    if (l > 0) cv_signal(bar, l - 1, (unsigned)nidle, wave_s == 0 && lane_id_volatile() == 0);
                }
            }
            __syncthreads();
        }
        if (l == 0) GBAR(); else LBAR();
        if (NVS > 1 && is_ret) {
            { OPAQ(); XPART(); for (int b = xslot; b < BATCH; b += xnx) norm_rows(wsp, b * SEQ, (b + 1) * SEQ, xrank * NWAVES + wavep, xn * NWAVES, lanep); }
            LBAR();
        }
        { OPAQ(); XPART();
            pg8::Gemm g{(const bf16_t*)(wsp + WS_CAT), (const bf16_t*)(wsp + WS_WOUT) + (size_t)l * D * D, M, D, D}; pg8::XccOrder S{xrank, xn, xslot, xnx, D / 256, 4, 1 << 30};
            EpiResC E{EpiRes{(const bf16_t*)(wsp + WS_XB), (bf16_t*)(wsp + WS_XB), (float*)(wsp + WS_SSQD)}, is_ret ? nullptr : (const float*)(wsp + WS_SSQO)};
            pg8::gemm_phase<EpiResC, pg8::XccOrder, true, true>(lds, g, S, E, tidp);
        }
        LBAR();
        { OPAQ(); XPART();
            pg8::Gemm g{(const bf16_t*)(wsp + WS_XB), (const bf16_t*)(wsp + WS_WFI) + (size_t)l * NFI * D, M, NFI, D};
            const int totD = (xslot < 8 ? (8 - xslot + xnx - 1) / xnx : 0) * 8 * (NFI / 256), fullD = (totD / xn) * xn, leftD = totD - fullD; const bool halves = leftD > 0 && 2 * leftD <= xn;
            pg8::XccOrder S{xrank, xn, xslot, xnx, NFI / 256, RBG_D, halves ? fullD : (1 << 30)};
            EpiFfn E{(bf16_t*)(wsp + WS_ACT), (const float*)(wsp + WS_SSQD), (LAS float*)(lds + RSTD_TAB_OFF), -1};
            pg8::gemm_phase<EpiFfn, pg8::XccOrder, true, true>(lds, g, S, E, tidp);
            if (halves && xrank < 2 * leftD) { pg8::Unit hu; S.decode(fullD + xrank % leftD, hu);
                pg8::HalfUnit SH{hu.pm, hu.pn, xrank / leftD}; EpiFfn EH{(bf16_t*)(wsp + WS_ACT), (const float*)(wsp + WS_SSQD), (LAS float*)(lds + RSTD_TAB_OFF), xrank / leftD};
                pg8::gemm_phase<EpiFfn, pg8::HalfUnit, true, true, true>(lds, g, SH, EH, tidp); }
        }
        LBAR();
        { OPAQ(); XPART();
            pg8::Gemm g{(const bf16_t*)(wsp + WS_ACT), (const bf16_t*)(wsp + WS_WFO) + (size_t)l * D * DFF, M, D, DFF}; pg8::XccOrder S{xrank, xn, xslot, xnx, D / 256, 4, 1 << 30};
            EpiRes E{(const bf16_t*)(wsp + WS_XB), (bf16_t*)(wsp + WS_XB), (float*)(wsp + WS_SSQA)};
            pg8::gemm_phase<EpiRes, pg8::XccOrder, true, true>(lds, g, S, E, tidp);
        }
        LBAR();
    }
    { OPAQ(); XPART();
        for (int b = xslot; b < BATCH; b += xnx) final_rows(wsp, args.out, args.in[14], b * SEQ, (b + 1) * SEQ, xrank * NWAVES + wavep, xn * NWAVES, lanep);
    }
#undef OPAQ
#undef XPART
#undef GBAR
#undef LBAR
}

extern "C" void kernel_launch(void* const* d_in, const int* in_sizes, int n_in, void* d_out, int out_size, void* d_ws, size_t ws_size, hipStream_t stream) {
    static int grid = 0;
    if (grid == 0) {
        if (n_in != 15 || in_sizes[0] != M * D || out_size != M * D || ws_size < WS_END) {
            fprintf(stderr, "kernel_launch: unexpected shapes: n_in %d in0 %d out %d ws %zu (need %zu)\n", n_in, n_in > 0 ? in_sizes[0] : -1, out_size, ws_size, (size_t)WS_END); grid = -1; return; }
        int dev = 0, cus = 0, per_cu = 0;
        if (hipGetDevice(&dev) != hipSuccess || hipDeviceGetAttribute(&cus, hipDeviceAttributeMultiprocessorCount, dev) != hipSuccess) { grid = -1; return; }
        if (hipFuncSetAttribute((const void*)mega_fwd, hipFuncAttributeMaxDynamicSharedMemorySize, LDS_BYTES) != hipSuccess) { fprintf(stderr, "kernel_launch: hipFuncSetAttribute failed\n"); grid = -1; return; }
        if (hipOccupancyMaxActiveBlocksPerMultiprocessor(&per_cu, (const void*)mega_fwd, NWAVES * 64, LDS_BYTES) != hipSuccess || per_cu < 1)
            fprintf(stderr, "kernel_launch: occupancy query reports %d workgroups per CU\n", per_cu);
        (void)hipGetLastError();
        grid = cus;
        if (grid < 176) { fprintf(stderr, "kernel_launch: this kernel needs at least 176 CUs (found %d)\n", cus); grid = -1; return; }
    }
    if (grid < 0) return;
    if (hipMemsetAsync((char*)d_ws + WS_CTL, 0, CTL_ZERO_BYTES, stream) != hipSuccess) { fprintf(stderr, "kernel_launch: memset failed\n"); return; }
    Args a{};
    for (int i = 0; i < 15; ++i) a.in[i] = (const float*)d_in[i];
    a.out = (float*)d_out; a.ws = (unsigned char*)d_ws;
    a.ph_lo = 0; a.ph_hi = 0;
    hipLaunchKernelGGL(mega_fwd, dim3(grid), dim3(NWAVES * 64), LDS_BYTES, stream, a);
    const hipError_t le = hipPeekAtLastError();
    if (le != hipSuccess) fprintf(stderr, "kernel_launch: launch failed: %s\n", hipGetErrorName(le));
}
```

```cpp
#include <hip/hip_runtime.h>
#include <cstdio>
#include <cstdint>

#ifndef DBG_SKIP
#define DBG_SKIP 0
#endif
#ifndef PROBE_REP
#define PROBE_REP 0
#endif
#ifndef RBG_A
#define RBG_A 4
#endif
#ifndef RBG_D
#define RBG_D 4
#endif
#ifndef PROBE_VAR
#define PROBE_VAR 0
#endif
#ifndef MK_N_LAUNCHES
#define MK_N_LAUNCHES 1
#endif

#define GAS __attribute__((address_space(1)))
#define LAS __attribute__((address_space(3)))
typedef unsigned short bf16_t;
typedef short bf16x8 __attribute__((ext_vector_type(8)));
typedef float f32x4 __attribute__((ext_vector_type(4)));
typedef float f32x2 __attribute__((ext_vector_type(2)));
typedef unsigned u32x4 __attribute__((ext_vector_type(4)));
typedef unsigned u32x2 __attribute__((ext_vector_type(2)));

constexpr int BATCH = 8, SEQ = 2048, D = 1024, DEPTH = 4;
constexpr int M = BATCH * SEQ;
constexpr int NH = 6, HD = 128, MIXW = 768, XW = 256, NXH = 4, XHD = 64, NMEM = 256;
constexpr int NIN = 3328, DFF = 2816, NFI = 2 * DFF;
constexpr int MROWS = BATCH * NMEM;
constexpr float EPS = 1e-6f;
constexpr int NVS = 2;
constexpr int VPR = 16 / NVS;

constexpr size_t MiB = 1u << 20;
constexpr size_t WS_CTL = 0, CTL_ZERO_BYTES = 64 * 1024;
constexpr size_t WS_LB = 1 * MiB;
constexpr size_t WS_SSQA = 2 * MiB;
constexpr size_t WS_SSQD = 3 * MiB;
constexpr size_t WS_COS = 4 * MiB, WS_SIN = 8 * MiB;
constexpr size_t WS_MEMB = 12 * MiB;
constexpr size_t WS_MKV = 16 * MiB;
constexpr size_t WS_WIN = 24 * MiB;
constexpr size_t WS_WOUT = 50 * MiB;
constexpr size_t WS_WFI = 58 * MiB;
constexpr size_t WS_WFO = 102 * MiB;
constexpr size_t WS_WM = 124 * MiB;
constexpr size_t WS_XB = 128 * MiB;
constexpr size_t WS_CAT = 160 * MiB;
constexpr size_t WS_Z = 192 * MiB;
constexpr size_t WS_F = 296 * MiB;
constexpr size_t WS_KST = 296 * MiB;
constexpr size_t WS_AUX = 320 * MiB;
constexpr size_t WS_SSQO = 323 * MiB;
constexpr size_t WS_ACT = 192 * MiB;
constexpr size_t WS_END = 344 * MiB;
static_assert(WS_WIN + (size_t)DEPTH * NIN * D * 2 <= WS_WOUT && WS_WOUT + (size_t)DEPTH * D * D * 2 <= WS_WFI && WS_WFI + (size_t)DEPTH * NFI * D * 2 <= WS_WFO &&
              WS_WFO + (size_t)DEPTH * D * DFF * 2 <= WS_WM && WS_WM + (size_t)2048 * 1024 * 2 <= WS_XB && WS_Z + (size_t)M * NIN * 2 <= WS_F && WS_F + (size_t)M * MIXW * 4 <= WS_END &&
              WS_ACT + (size_t)M * DFF * 2 <= WS_F, "ws map");
constexpr int CW_BAR = 4096;

__device__ __forceinline__ int lane_id_volatile() { int l; asm volatile("v_mbcnt_lo_u32_b32 %0, -1, 0\n\tv_mbcnt_hi_u32_b32 %0, -1, %0" : "=v"(l)); return l; }
namespace pg8 {
constexpr int BM = 256, BK = 64, HALF = 128, HTB = HALF * BK * 2, STAGE_BYTES = 8 * HTB, NXCD = 8, WGM = 8;
__host__ __device__ __forceinline__ int lds_byte(int r, int c) { const int st = (r >> 4) * 2 + (c >> 5), rr = r & 15, cc = c & 31, ob = rr * 64 + cc * 2; return st * 1024 + (ob ^ (((ob >> 9) & 1) << 5)); }
__host__ __device__ __forceinline__ void stage_rc(int b, int& R, int& C) { const int st = b / 1024, sb = b % 1024, swz = sb ^ (((sb >> 9) & 1) << 5); R = (st >> 1) * 16 + swz / 64; C = (st & 1) * 32 + (swz % 64) / 2; }
__host__ __device__ __forceinline__ int perm32(int rho) { const int n = rho >> 4, i = rho & 15; return 8 * (i >> 2) + 4 * n + (i & 3); }
struct Unit { int pm, pn; };
struct Gemm { const bf16_t* A; const bf16_t* Bt; int M, N, K; };
struct StaticOrder {
    int nM, nN, nwg, G, c;
    __host__ __device__ void init(int M_, int N_, int G_, int c_) { nM = M_ / BM; nN = N_ / BM; nwg = nM * nN; G = G_; c = c_; }
    __host__ __device__ bool next(int i, Unit& u) const {
        const long L = (long)i * G + c; if (L >= nwg) return false;
        int wgid = (int)L; { const int q = nwg / NXCD, r = nwg % NXCD, xcd = wgid % NXCD, off = wgid / NXCD; wgid = (xcd < r ? xcd * (q + 1) : r * (q + 1) + (xcd - r) * q) + off; }
        const int nig = WGM * nN, gid = wgid / nig, fm = gid * WGM, gsz = (nM - fm) < WGM ? (nM - fm) : WGM;
        u.pm = fm + ((wgid % nig) % gsz); u.pn = (wgid % nig) / gsz; return true;
    }
    __device__ __forceinline__ void a_ready(const Unit&) const {}
    __device__ __forceinline__ void done(const Unit&) const {}
};
struct XccOrder {
    int rank, n, slot, nx, nN, rbg, tlim;
    __device__ __forceinline__ bool next(int i, Unit& u) const {
        const int t = i * n + rank, nb = (8 - slot + nx - 1) / nx;
        if (slot >= 8 || t >= nb * 8 * nN || t >= tlim) return false;
        decode(t, u); return true;
    }
    __device__ __forceinline__ void decode(int t, Unit& u) const {
        const int per = 8 * nN;
        const int bi = t / per, tt = t - bi * per, g = tt / (rbg * nN), r = tt - g * rbg * nN;
        u.pm = 8 * (slot + bi * nx) + rbg * g + (r % rbg); u.pn = r / rbg;
    }
    __device__ __forceinline__ void a_ready(const Unit&) const {}
};
struct XccOrderMem {
    int rank, n, slot, nx;
    __device__ __forceinline__ bool next(int i, Unit& u) const {
        const int t = i * n + rank, nb = (8 - slot + nx - 1) / nx;
        if (slot >= 8 || t >= nb * 8) return false;
        u.pm = slot + (t >> 3) * nx; u.pn = t & 7; return true;
    }
    __device__ __forceinline__ void a_ready(const Unit&) const {}
};
struct OneUnit {
    int pm, pn;
    __device__ __forceinline__ bool next(int i, Unit& u) const { if (i) return false; u.pm = pm; u.pn = pn; return true; }
    __device__ __forceinline__ void a_ready(const Unit&) const {}
};
struct HalfUnit {
    int pm, pn, half;
    __device__ __forceinline__ bool next(int i, Unit& u) const { if (i) return false; u.pm = pm; u.pn = pn; return true; }
    __device__ __forceinline__ void a_ready(const Unit&) const {}
};
__device__ __forceinline__ unsigned cvt_pk_bf16(float lo, float hi) { unsigned r; asm volatile("v_cvt_pk_bf16_f32 %0, %1, %2" : "=v"(r) : "v"(lo), "v"(hi)); return r; }

template <class Epi, class Sched, bool ALIGN_EPI = false, bool SP2 = false, bool HM = false>
__device__ __forceinline__ void gemm_phase(LAS unsigned char* lds, const Gemm g, const Sched& S, const Epi& E, int tid) {
    asm volatile("" : "+v"(tid));
    const int wid = __builtin_amdgcn_readfirstlane(tid >> 6), lane = tid & 63, wr = wid >> 2, wc = wid & 3, fr = lane & 15, fq = lane >> 4;
    const int K = g.K, nt = K / BK;
    unsigned voffA[2], voffB[2];
#pragma unroll
    for (int i = 0; i < 2; ++i) { int R, C; stage_rc(tid * 16 + i * 8192, R, C); const int Rb = Epi::PERM ? ((R & ~31) + perm32(R & 31)) : R;
        voffA[i] = (unsigned)(R * K + C) * 2u; voffB[i] = (unsigned)(Rb * K + C) * 2u; }
    asm volatile("" : "+v"(voffA[0]), "+v"(voffA[1]), "+v"(voffB[0]), "+v"(voffB[1]));
    const size_t kstep = (size_t)(BK * 2);
    const size_t hstep = (size_t)HALF * K * 2;
    const size_t tstep = 2 * hstep;
    static_assert(!HM || SP2, "half tiles use the SP2 body");
    const size_t ahs = HM ? (size_t)0 : hstep;
    const unsigned ldsw = (unsigned)wid * 1024u;
    const int aoff = lds_byte(wr * 64 + fr, fq * 8), boff = lds_byte(wc * 32 + fr, fq * 8);
#define PG8_SA(b, h) (((b) * 2 + (h)) * HTB)
#define PG8_SB(b, h) ((4 + (b) * 2 + (h)) * HTB)
#define PG8_STAGE(bufoff, gbase, voff) do { _Pragma("unroll") for (int _i = 0; _i < 2; ++_i) \
        __builtin_amdgcn_global_load_lds((const unsigned*)((const char*)(gbase) + (voff)[_i]), (LAS unsigned*)(lds + (bufoff) + ldsw + _i * 8192), 16, 0, 0); } while (0)
#define PG8_LDA(dst, b, h) do { _Pragma("unroll") for (int m = 0; m < 4; ++m) _Pragma("unroll") for (int k = 0; k < 2; ++k) dst[m][k] = *(const LAS bf16x8*)(lds + PG8_SA(b, h) + aoff + m * 2048 + k * 1024); } while (0)
#define PG8_LDB(dst, b, h) do { _Pragma("unroll") for (int n = 0; n < 2; ++n) _Pragma("unroll") for (int k = 0; k < 2; ++k) dst[n][k] = *(const LAS bf16x8*)(lds + PG8_SB(b, h) + boff + n * 2048 + k * 1024); } while (0)
#define PG8_MMA(ai, bj, At, Bt) do { __builtin_amdgcn_s_setprio(1); _Pragma("unroll") for (int m = 0; m < 4; ++m) _Pragma("unroll") for (int n = 0; n < 2; ++n) _Pragma("unroll") for (int k = 0; k < 2; ++k) \
        acc[ai][bj][m][n] = __builtin_amdgcn_mfma_f32_16x16x32_bf16(Bt[n][k], At[m][k], acc[ai][bj][m][n], 0, 0, 0); __builtin_amdgcn_s_setprio(0); } while (0)
#define PG8_WAIT_V(n) asm volatile("s_waitcnt vmcnt(" #n ")" ::: "memory")
#define PG8_WAIT_L(n) asm volatile("s_waitcnt lgkmcnt(" #n ")" ::: "memory")
#define PG8_BAR __builtin_amdgcn_s_barrier()
#define PG8_SCHED __builtin_amdgcn_sched_barrier(0)
    Unit cur, nxt; int ui = 0;
    if (!S.next(0, cur)) return;
    f32x4 acc[2][2][4][2];
#pragma unroll
    for (int a = 0; a < 2; ++a)
#pragma unroll
        for (int b = 0; b < 2; ++b)
#pragma unroll
            for (int m = 0; m < 4; ++m)
#pragma unroll
                for (int n = 0; n < 2; ++n) acc[a][b][m][n] = (f32x4){0.f, 0.f, 0.f, 0.f};
    bf16x8 At[4][2], B0[2][2], B1[2][2];
    const char* cA = (const char*)g.A + (size_t)cur.pm * tstep; if constexpr (HM) cA += (size_t)S.half * hstep;
    const char* cB = (const char*)g.Bt + (size_t)cur.pn * tstep;
    S.a_ready(cur);
    if constexpr (SP2) {
        PG8_STAGE(PG8_SB(0, 0), cB, voffB); PG8_STAGE(PG8_SB(0, 1), cB + hstep, voffB); PG8_STAGE(PG8_SA(0, 0), cA, voffA); PG8_STAGE(PG8_SA(0, 1), cA + ahs, voffA);
        if (wr == 1) PG8_BAR;
        PG8_WAIT_V(2); PG8_BAR;
        PG8_STAGE(PG8_SB(1, 0), cB + kstep, voffB); PG8_STAGE(PG8_SA(1, 0), cA + kstep, voffA); PG8_STAGE(PG8_SB(1, 1), cB + hstep + kstep, voffB);
        PG8_WAIT_V(6); PG8_BAR;
    } else {
        PG8_STAGE(PG8_SB(0, 0), cB, voffB); PG8_STAGE(PG8_SA(0, 0), cA, voffA); PG8_STAGE(PG8_SB(0, 1), cB + hstep, voffB); PG8_STAGE(PG8_SA(0, 1), cA + hstep, voffA);
        if (wr == 1) PG8_BAR;
        PG8_WAIT_V(4); PG8_BAR;
        PG8_STAGE(PG8_SB(1, 0), cB + kstep, voffB); PG8_STAGE(PG8_SA(1, 0), cA + kstep, voffA); PG8_STAGE(PG8_SB(1, 1), cB + hstep + kstep, voffB);
        PG8_WAIT_V(6); PG8_BAR;
    }
    for (;;) {
        const bool has_next = S.next(ui + 1, nxt);
        const char* nA = has_next ? (const char*)g.A + (size_t)nxt.pm * tstep : cA; const char* nB = has_next ? (const char*)g.Bt + (size_t)nxt.pn * tstep : cB;
        for (int t = 0; t < nt; t += 2) {
            const bool last = (t == nt - 2);
            const char* a1 = cA + (size_t)(t + 1) * kstep;
            const char* a2 = last ? nA : cA + (size_t)(t + 2) * kstep; const char* b2 = last ? nB : cB + (size_t)(t + 2) * kstep;
            const char* a3 = a2 + kstep; const char* b3 = b2 + kstep;
            if (last && has_next) S.a_ready(nxt);
            if constexpr (Epi::MID_T > 0) { if (E.mid_at(t)) { const int l2 = lane_id_volatile(); E.mid(acc, cur, wr, wc, l2 & 15, l2 >> 4, t); } }
            if constexpr (SP2) {
            PG8_LDB(B0, 0, 0); PG8_LDB(B1, 0, 1); PG8_SCHED; PG8_LDA(At, 0, 0); PG8_STAGE(PG8_SA(1, 1), a1 + ahs, voffA);
            PG8_WAIT_V(8); PG8_WAIT_L(0); PG8_BAR; PG8_MMA(0, 0, At, B0); PG8_MMA(0, 1, At, B1); PG8_BAR; PG8_SCHED;
            if constexpr (!HM) PG8_LDA(At, 0, 1);
            PG8_STAGE(PG8_SB(0, 0), b2, voffB); PG8_STAGE(PG8_SB(0, 1), b2 + hstep, voffB); PG8_STAGE(PG8_SA(0, 0), a2, voffA);
            PG8_WAIT_V(8); PG8_WAIT_L(0); PG8_BAR; if constexpr (!HM) { PG8_MMA(1, 0, At, B0); PG8_MMA(1, 1, At, B1); } PG8_BAR; PG8_SCHED;
            PG8_LDB(B0, 1, 0); PG8_LDB(B1, 1, 1); PG8_SCHED; PG8_LDA(At, 1, 0); PG8_STAGE(PG8_SA(0, 1), a2 + ahs, voffA);
            PG8_WAIT_V(8); PG8_WAIT_L(0); PG8_BAR; PG8_MMA(0, 0, At, B0); PG8_MMA(0, 1, At, B1); PG8_BAR; PG8_SCHED;
            if constexpr (!HM) PG8_LDA(At, 1, 1);
            PG8_STAGE(PG8_SB(1, 0), b3, voffB); PG8_STAGE(PG8_SB(1, 1), b3 + hstep, voffB); PG8_STAGE(PG8_SA(1, 0), a3, voffA);
            PG8_WAIT_V(8); PG8_WAIT_L(0); PG8_BAR; if constexpr (!HM) { PG8_MMA(1, 0, At, B0); PG8_MMA(1, 1, At, B1); } PG8_BAR; PG8_SCHED;
            } else {
            PG8_LDB(B0, 0, 0); PG8_SCHED; PG8_LDA(At, 0, 0); PG8_STAGE(PG8_SA(1, 1), a1 + hstep, voffA);
            PG8_WAIT_L(8); PG8_BAR; PG8_WAIT_L(0); PG8_MMA(0, 0, At, B0); PG8_BAR; PG8_SCHED;
            PG8_LDB(B1, 0, 1); PG8_STAGE(PG8_SB(0, 0), b2, voffB);
            PG8_BAR; PG8_WAIT_L(0); PG8_MMA(0, 1, At, B1); PG8_BAR;
            PG8_LDA(At, 0, 1); PG8_STAGE(PG8_SA(0, 0), a2, voffA);
            PG8_BAR; PG8_WAIT_L(0); PG8_MMA(1, 0, At, B0); PG8_BAR; PG8_SCHED;
            PG8_STAGE(PG8_SB(0, 1), b2 + hstep, voffB);
            PG8_WAIT_V(6); PG8_BAR; PG8_MMA(1, 1, At, B1); PG8_BAR;
            PG8_LDB(B0, 1, 0); PG8_SCHED; PG8_LDA(At, 1, 0); PG8_STAGE(PG8_SA(0, 1), a2 + hstep, voffA);
            PG8_WAIT_L(8); PG8_BAR; PG8_WAIT_L(0); PG8_MMA(0, 0, At, B0); PG8_BAR; PG8_SCHED;
            PG8_LDB(B1, 1, 1); PG8_STAGE(PG8_SB(1, 0), b3, voffB);
            PG8_BAR; PG8_WAIT_L(0); PG8_MMA(0, 1, At, B1); PG8_BAR;
            PG8_LDA(At, 1, 1); PG8_STAGE(PG8_SA(1, 0), a3, voffA);
            PG8_BAR; PG8_WAIT_L(0); PG8_MMA(1, 0, At, B0); PG8_BAR; PG8_SCHED;
            PG8_STAGE(PG8_SB(1, 1), b3 + hstep, voffB);
            PG8_WAIT_V(6); PG8_BAR; PG8_MMA(1, 1, At, B1); PG8_BAR;
            }
        }
        if constexpr (ALIGN_EPI) { if (wr == 0) PG8_BAR; }
        { const int l2 = lane_id_volatile(); E(acc, cur, wr, wc, l2 & 15, l2 >> 4); }
        if (!has_next) break;
#pragma unroll
        for (int a = 0; a < 2; ++a)
#pragma unroll
            for (int b = 0; b < 2; ++b)
#pragma unroll
                for (int m = 0; m < 4; ++m)
#pragma unroll
                    for (int n = 0; n < 2; ++n) acc[a][b][m][n] = (f32x4){0.f, 0.f, 0.f, 0.f};
        cur = nxt; cA = nA; cB = nB; ++ui;
        if constexpr (ALIGN_EPI) { if (wr == 1) PG8_BAR; }
    }
    PG8_WAIT_V(0);
    if constexpr (!ALIGN_EPI) { if (wr == 0) PG8_BAR; }
    PG8_BAR;
#undef PG8_SA
#undef PG8_SB
#undef PG8_STAGE
#undef PG8_LDA
#undef PG8_LDB
#undef PG8_MMA
#undef PG8_WAIT_V
#undef PG8_WAIT_L
#undef PG8_BAR
#undef PG8_SCHED
}
}

__device__ __forceinline__ float bf2f(unsigned h) { return __uint_as_float(h << 16); }
__device__ __forceinline__ unsigned f2bf(float f) { unsigned u = __float_as_uint(f); return (u + 0x7fffu + ((u >> 16) & 1u)) >> 16; }
__device__ __forceinline__ unsigned pk2(float lo, float hi) { return f2bf(lo) | (f2bf(hi) << 16); }
__device__ __forceinline__ float fast_rcp(float x) { return __builtin_amdgcn_rcpf(x); }
__device__ __forceinline__ float sigmoidf_(float x) { return fast_rcp(1.0f + __expf(-x)); }
__device__ __forceinline__ float siluf_(float x) { return x * sigmoidf_(x); }
__device__ __forceinline__ float shfl_xor_l(float v, int lane, int mask) { return __int_as_float(__builtin_amdgcn_ds_bpermute((lane ^ mask) << 2, __float_as_int(v))); }
__device__ __forceinline__ float wave_sum(float v, int lane) {
#pragma unroll
    for (int o = 1; o < 64; o <<= 1) v += shfl_xor_l(v, lane, o);
    return v;
}
__device__ __forceinline__ float rstd_from_partials(const float* ssq, int row, float invn) {
    const f32x4* p = (const f32x4*)(ssq + (size_t)row * 16);
    const f32x4 a = p[0], b = p[1], c = p[2], d = p[3];
    const f32x4 s = (a + b) + (c + d);
    return rsqrtf(((s[0] + s[1]) + (s[2] + s[3])) * invn + EPS);
}
constexpr int RSTD_TAB_OFF = 132096;
__device__ __forceinline__ void rstd_table(const float* ssq, int pm, LAS float* tab, int wr, int wc, int fr, int fq) {
    const int t = (wr * 4 + wc) * 64 + fq * 16 + fr;
    if (t < 256) { const GAS f32x4* p = (const GAS f32x4*)((const GAS float*)ssq + (size_t)(pm * 256 + t) * 16);
        const f32x4 a = p[0], b = p[1], c = p[2], d = p[3]; const f32x4 sm = (a + b) + (c + d);
        tab[t] = rsqrtf(((sm[0] + sm[1]) + (sm[2] + sm[3])) * (1.0f / D) + EPS); }
    asm volatile("s_waitcnt lgkmcnt(0)" ::: "memory"); __builtin_amdgcn_s_barrier(); asm volatile("" ::: "memory");
}
__device__ __forceinline__ u32x4 pack8(const f32x4 v0, const f32x4 v1) {
    u32x4 w; w.x = pg8::cvt_pk_bf16(v0[0], v0[1]); w.y = pg8::cvt_pk_bf16(v0[2], v0[3]); w.z = pg8::cvt_pk_bf16(v1[0], v1[1]); w.w = pg8::cvt_pk_bf16(v1[2], v1[3]); return w;
}

#define DPP_SHR(x, n) __int_as_float(__builtin_amdgcn_update_dpp(0, __float_as_int(x), 0x110 + (n), 0xf, 0xf, false))
__device__ __forceinline__ float rowscan16(float x) {
    x += DPP_SHR(x, 1); x += DPP_SHR(x, 2); x += DPP_SHR(x, 4); x += DPP_SHR(x, 8); return x;
}
__device__ __forceinline__ float bcast15(float x, int lane) { (void)lane; return __int_as_float(__builtin_amdgcn_update_dpp(0, __float_as_int(x), 0x15F, 0xF, 0xF, true)); }
__device__ __forceinline__ float expc(float x) { return __expf(fminf(x, 80.0f)); }
__device__ __forceinline__ float exp2c(float x2) { return __builtin_amdgcn_exp2f(fminf(x2, 115.41560327111707f)); }
using pg8::Unit;
struct EpiPlain {
    static constexpr bool PERM = true; static constexpr int MID_T = 0;
    bf16_t* O; int ldc;
    __device__ __forceinline__ void operator()(const f32x4 (&acc)[2][2][4][2], const Unit& u, int wr, int wc, int fr, int fq) const {
        const int row0 = u.pm * 256 + wr * 64 + fr, col0 = u.pn * 256 + wc * 32 + 8 * fq;
#pragma unroll
        for (int ai = 0; ai < 2; ++ai)
#pragma unroll
            for (int m = 0; m < 4; ++m) { bf16_t* rowp = O + (size_t)(row0 + ai * 128 + m * 16) * ldc + col0;
#pragma unroll
                for (int bj = 0; bj < 2; ++bj) *(GAS u32x4*)((GAS bf16_t*)rowp + bj * 128) = pack8(acc[ai][bj][m][0], acc[ai][bj][m][1]); }
    }
};
struct EpiIn {
    static constexpr bool PERM = true; static constexpr int MID_T = 0;
    bf16_t* Z; bf16_t* KST; float* AUX; const float* ssq; const float* lb; const float* cosT; const float* sinT; int is_ret; LAS float* tab;
    __device__ __forceinline__ void operator()(const f32x4 (&acc)[2][2][4][2], const Unit& u, int wr, int wc, int fr, int fq) const {
        const int row0 = u.pm * 256 + wr * 64 + fr, jl = wc * 32 + 8 * fq, t = u.pn;
        rstd_table(ssq, u.pm, tab, wr, wc, fr, fq);
        const LAS float* tl = tab + wr * 64 + fr;
        if (t < 6) {
            if (!is_ret) {
                const f32x4 lb0 = *(const GAS f32x4*)((const GAS float*)lb + t * 128 + (jl >> 1)), lb1 = *(const GAS f32x4*)((const GAS float*)lb + t * 128 + (jl >> 1) + 64);
#pragma unroll
                for (int ai = 0; ai < 2; ++ai)
#pragma unroll
                    for (int mp = 0; mp < 2; ++mp) {
                        const int tok0 = u.pm * 256 + ai * 128 + wr * 64 + mp * 32, rlo = tok0 + fr, rhi = rlo + 16;
                        const float rs0 = tl[ai * 128 + mp * 32], rs1 = tl[ai * 128 + mp * 32 + 16];
                        f32x4 qsv[2][2], ksv[2][2], ktv[2][2], erv[2], dcv[2];
#pragma unroll
                        for (int n = 0; n < 2; ++n)
#pragma unroll
                            for (int i = 0; i < 4; ++i) {
                                const float lbv = n ? lb1[i] : lb0[i];
                                float g[2], kk[2], qq[2];
#pragma unroll
                                for (int e = 0; e < 2; ++e) {
                                    const float x = acc[ai][1][2 * mp + e][n][i] * (e ? rs1 : rs0), za = acc[ai][0][2 * mp + e][n][i] * (e ? rs1 : rs0);
                                    const float a = __builtin_amdgcn_exp2f(-1.4426950408889634f * fabsf(x)), r = fast_rcp(1.0f + a);
                                    const float sneg = x >= 0.f ? a * r : r;
                                    const float em = x >= 0.f ? a : fminf(fast_rcp(a), 1.0686475e13f);
                                    g[e] = fmaf(fminf(x, 0.f), 1.4426950408889634f, __builtin_amdgcn_logf(r * (1.0f + lbv * em)));
                                    kk[e] = (1.0f - lbv) * sneg;
                                    qq[e] = siluf_(za);
                                }
                                const float blo = rowscan16(g[0]), ref = bcast15(blo, fq * 16 + fr), bhi = ref + rowscan16(g[1]), blast = bcast15(bhi, fq * 16 + fr);
                                qsv[0][n][i] = qq[0] * exp2c(blo - ref); qsv[1][n][i] = qq[1] * exp2c(bhi - ref);
                                ksv[0][n][i] = kk[0] * exp2c(ref - blo); ksv[1][n][i] = kk[1] * exp2c(ref - bhi);
                                ktv[0][n][i] = kk[0] * __builtin_amdgcn_exp2f(blast - blo); ktv[1][n][i] = kk[1] * __builtin_amdgcn_exp2f(blast - bhi);
                                erv[n][i] = __builtin_amdgcn_exp2f(ref); dcv[n][i] = __builtin_amdgcn_exp2f(blast);
                            }
                        GAS bf16_t* zlo = (GAS bf16_t*)Z + (size_t)rlo * NIN + t * 256 + jl; GAS bf16_t* zhi = (GAS bf16_t*)Z + (size_t)rhi * NIN + t * 256 + jl;
                        *(GAS u32x4*)zlo = pack8(qsv[0][0], qsv[0][1]); *(GAS u32x4*)(zlo + 128) = pack8(ksv[0][0], ksv[0][1]);
                        *(GAS u32x4*)zhi = pack8(qsv[1][0], qsv[1][1]); *(GAS u32x4*)(zhi + 128) = pack8(ksv[1][0], ksv[1][1]);
                        *(GAS u32x4*)((GAS bf16_t*)KST + (size_t)rlo * MIXW + t * 128 + jl) = pack8(ktv[0][0], ktv[0][1]);
                        *(GAS u32x4*)((GAS bf16_t*)KST + (size_t)rhi * MIXW + t * 128 + jl) = pack8(ktv[1][0], ktv[1][1]);
                        if (fr == 15) { GAS float* ap = (GAS float*)AUX + ((size_t)((tok0 >> 11) * NH + t) * 64 + ((tok0 & 2047) >> 5)) * 256 + jl;
                            *(GAS f32x4*)ap = erv[0]; *(GAS f32x4*)(ap + 4) = erv[1]; *(GAS f32x4*)(ap + 128) = dcv[0]; *(GAS f32x4*)(ap + 132) = dcv[1]; }
                    }
            } else {
                const float lg = __log2f(1.0f - exp2f(-5.0f - (float)t));
                f32x4 csv[2][4], snv[2][4];
#pragma unroll
                for (int ai = 0; ai < 2; ++ai)
#pragma unroll
                    for (int m = 0; m < 4; ++m) { const int row = row0 + ai * 128 + m * 16;
                        csv[ai][m] = *(const GAS f32x4*)((const GAS float*)cosT + (size_t)row * 64 + (jl >> 1)); snv[ai][m] = *(const GAS f32x4*)((const GAS float*)sinT + (size_t)row * 64 + (jl >> 1)); }
#pragma unroll
                for (int ai = 0; ai < 2; ++ai)
#pragma unroll
                    for (int m = 0; m < 4; ++m) { const int row = row0 + ai * 128 + m * 16; const float rs = tl[ai * 128 + m * 16];
                        const f32x4 cs = csv[ai][m], sn = snv[ai][m];
                        const float cp1 = (float)(16 * (m & 1) + fr + 1), pw = exp2f(cp1 * lg), ipw = exp2f(-cp1 * lg);
                        const float qsc = rs * pw, ksc = rs * 0.08838834764831845f * ipw;
                        f32x4 q0, q1, k0, k1;
#pragma unroll
                        for (int i = 0; i < 4; ++i) {
                            const float a1 = acc[ai][0][m][0][i] * qsc, a2 = acc[ai][0][m][1][i] * qsc; q0[i] = a1 * cs[i] - a2 * sn[i]; q1[i] = a1 * sn[i] + a2 * cs[i];
                            const float b1 = acc[ai][1][m][0][i] * ksc, b2 = acc[ai][1][m][1][i] * ksc; k0[i] = b1 * cs[i] - b2 * sn[i]; k1[i] = b1 * sn[i] + b2 * cs[i];
                        }
                        GAS bf16_t* zp = (GAS bf16_t*)Z + (size_t)row * NIN + t * 256 + jl; *(GAS u32x4*)zp = pack8(q0, q1); *(GAS u32x4*)(zp + 128) = pack8(k0, k1); }
            }
        } else {
            const int mode = (t >= 9 && t < 12) ? (is_ret ? 2 : 1) : 0;
#pragma unroll
            for (int ai = 0; ai < 2; ++ai)
#pragma unroll
                for (int m = 0; m < 4; ++m) { const int row = row0 + ai * 128 + m * 16; const float rs = tl[ai * 128 + m * 16];
                    GAS bf16_t* zp = (GAS bf16_t*)Z + (size_t)row * NIN + t * 256 + jl;
#pragma unroll
                    for (int bj = 0; bj < 2; ++bj) { f32x4 v0 = acc[ai][bj][m][0] * rs, v1 = acc[ai][bj][m][1] * rs;
                        if (mode == 1) {
#pragma unroll
                            for (int i = 0; i < 4; ++i) { v0[i] = sigmoidf_(v0[i]); v1[i] = sigmoidf_(v1[i]); } }
                        else if (mode == 2) {
#pragma unroll
                            for (int i = 0; i < 4; ++i) { v0[i] = siluf_(v0[i]); v1[i] = siluf_(v1[i]); } }
                        *(GAS u32x4*)(zp + bj * 128) = pack8(v0, v1); } }
        }
    }
};
struct EpiRes {
    static constexpr bool PERM = true; static constexpr int MID_T = 0;
    const bf16_t* xin; bf16_t* xb; float* ssq;
    __device__ __forceinline__ void operator()(const f32x4 (&acc)[2][2][4][2], const Unit& u, int wr, int wc, int fr, int fq) const {
        const int row0 = u.pm * 256 + wr * 64 + fr, col0 = u.pn * 256 + wc * 32 + 8 * fq;
        u32x4 rr[2][4][2];
#pragma unroll
        for (int ai = 0; ai < 2; ++ai)
#pragma unroll
            for (int m = 0; m < 4; ++m)
#pragma unroll
                for (int bj = 0; bj < 2; ++bj) rr[ai][m][bj] = *(const GAS u32x4*)((const GAS bf16_t*)xin + (size_t)(row0 + ai * 128 + m * 16) * D + col0 + bj * 128);
#pragma unroll
        for (int ai = 0; ai < 2; ++ai)
#pragma unroll
            for (int m = 0; m < 4; ++m) { const int row = row0 + ai * 128 + m * 16; const size_t off = (size_t)row * D + col0; float s = 0.f;
#pragma unroll
                for (int bj = 0; bj < 2; ++bj) {
                    const u32x4 r = rr[ai][m][bj];
                    f32x4 v0, v1;
                    v0[0] = bf2f(r.x & 0xffffu); v0[1] = bf2f(r.x >> 16); v0[2] = bf2f(r.y & 0xffffu); v0[3] = bf2f(r.y >> 16);
                    v1[0] = bf2f(r.z & 0xffffu); v1[1] = bf2f(r.z >> 16); v1[2] = bf2f(r.w & 0xffffu); v1[3] = bf2f(r.w >> 16);
                    v0 = v0 + acc[ai][bj][m][0]; v1 = v1 + acc[ai][bj][m][1];
                    *(GAS u32x4*)((GAS bf16_t*)xb + off + bj * 128) = pack8(v0, v1);
                    s += (v0[0] * v0[0] + v0[1] * v0[1]) + (v0[2] * v0[2] + v0[3] * v0[3]) + (v1[0] * v1[0] + v1[1] * v1[1]) + (v1[2] * v1[2] + v1[3] * v1[3]);
                }
                s += shfl_xor_l(s, fq * 16 + fr, 16); s += shfl_xor_l(s, fq * 16 + fr, 32);
                if (fq == 0) ((GAS float*)ssq)[(size_t)row * 16 + u.pn * 4 + wc] = s; }
    }
};
__device__ __forceinline__ void ret_norm_table(const float* ssqo, int pm, LAS float* rtab, int tid) {
    if (tid < 256) { const GAS f32x4* sp = (const GAS f32x4*)((const GAS float*)ssqo + (size_t)(pm * 256 + tid) * 16);
        const f32x4 a = sp[0], b = sp[1], c = sp[2];
        static_assert(NH == 6 && NVS == 2, "six heads, two partial sums each");
        const float s0 = rsqrtf((a[0] + a[1]) * (1.0f / HD) + EPS), s1 = rsqrtf((a[2] + a[3]) * (1.0f / HD) + EPS), s2 = rsqrtf((b[0] + b[1]) * (1.0f / HD) + EPS),
                    s3 = rsqrtf((b[2] + b[3]) * (1.0f / HD) + EPS), s4 = rsqrtf((c[0] + c[1]) * (1.0f / HD) + EPS), s5 = rsqrtf((c[2] + c[3]) * (1.0f / HD) + EPS);
        rtab[tid] = s0 * fast_rcp(s1); rtab[256 + tid] = s1 * fast_rcp(s2); rtab[512 + tid] = s2 * fast_rcp(s3); rtab[768 + tid] = s3 * fast_rcp(s4); rtab[1024 + tid] = s4 * fast_rcp(s5); rtab[1280 + tid] = s5; }
    __syncthreads();
}
__device__ __forceinline__ void hgrn_norm_table(const float* ssqo, int pm, LAS float* rtab, int tid) {
    if (tid < 256) { const GAS f32x4* sp = (const GAS f32x4*)((const GAS float*)ssqo + (size_t)(pm * 256 + tid) * 16);
        const f32x4 a = sp[0], b = sp[1], c = sp[2]; const f32x4 sm = (a + b) + c;
        rtab[tid] = rsqrtf(((sm[0] + sm[1]) + (sm[2] + sm[3])) * (1.0f / MIXW) + EPS); }
    __syncthreads();
}
template <int is_ret, int TAB> struct EpiResC {
    static constexpr bool PERM = true; static constexpr int MID_T = 12;
    EpiRes base; const float* ssqo; LAS float* rtab;
    __device__ __forceinline__ bool mid_at(int t) const { return is_ret ? (t >= 2 && t <= 12) : (ssqo != nullptr && t == 12); }
    __device__ __forceinline__ void mid(f32x4 (&acc)[2][2][4][2], const Unit& u, int wr, int wc, int fr, int fq, int t) const {
        const int row0 = u.pm * 256 + wr * 64 + fr;
        if (is_ret) {
            const LAS float* tl = rtab + ((t >> 1) - 1) * 256 + wr * 64 + fr;
#pragma unroll
            for (int ai = 0; ai < 2; ++ai)
#pragma unroll
                for (int m = 0; m < 4; ++m) { const float rs = tl[ai * 128 + m * 16];
#pragma unroll
                    for (int bj = 0; bj < 2; ++bj)
#pragma unroll
                        for (int n = 0; n < 2; ++n) acc[ai][bj][m][n] = acc[ai][bj][m][n] * rs;
                    asm volatile("" ::: "memory"); }
            return;
        }
        if (TAB) { const LAS float* tl = rtab + wr * 64 + fr;
#pragma unroll
            for (int ai = 0; ai < 2; ++ai)
#pragma unroll
                for (int m = 0; m < 4; ++m) { const float rs = tl[ai * 128 + m * 16];
#pragma unroll
                    for (int bj = 0; bj < 2; ++bj)
#pragma unroll
                        for (int n = 0; n < 2; ++n) acc[ai][bj][m][n] = acc[ai][bj][m][n] * rs;
                    asm volatile("" ::: "memory"); }
            return; }
#pragma unroll
        for (int ai = 0; ai < 2; ++ai)
#pragma unroll
            for (int m = 0; m < 4; ++m) { const int row = row0 + ai * 128 + m * 16;
                const GAS f32x4* sp = (const GAS f32x4*)((const GAS float*)ssqo + (size_t)row * 16); float tot = 0.f;
#pragma unroll
                for (int q4 = 0; q4 < (NH * NVS + 3) / 4; ++q4) { const f32x4 a = sp[q4];
#pragma unroll
                    for (int e = 0; e < 4; ++e) if (4 * q4 + e < NH * NVS) tot += a[e]; }
                const float rs = rsqrtf(tot * (1.0f / MIXW) + EPS);
#pragma unroll
                for (int bj = 0; bj < 2; ++bj)
#pragma unroll
                    for (int n = 0; n < 2; ++n) acc[ai][bj][m][n] = acc[ai][bj][m][n] * rs;
                asm volatile("" ::: "memory"); }
    }
    __device__ __forceinline__ void operator()(const f32x4 (&acc)[2][2][4][2], const Unit& u, int wr, int wc, int fr, int fq) const { base(acc, u, wr, wc, fr, fq); }
};
struct EpiFfn {
    static constexpr bool PERM = true; static constexpr int MID_T = 0;
    bf16_t* act; const float* ssq; LAS float* tab; int half;
    __device__ __forceinline__ void operator()(const f32x4 (&acc)[2][2][4][2], const Unit& u, int wr, int wc, int fr, int fq) const {
        const int hb = half < 0 ? 0 : 128 * half;
        const int row0 = u.pm * 256 + hb + wr * 64 + fr, jl = wc * 32 + 8 * fq;
        rstd_table(ssq, u.pm, tab, wr, wc, fr, fq);
        const LAS float* tl = tab + hb + wr * 64 + fr;
#pragma unroll
        for (int ai = 0; ai < 2; ++ai)
#pragma unroll
            for (int m = 0; m < 4; ++m) { if (ai == 1 && half >= 0) break; const int row = row0 + ai * 128 + m * 16; const float rs = tl[ai * 128 + m * 16];
                f32x4 v0, v1;
#pragma unroll
                for (int i = 0; i < 4; ++i) { v0[i] = siluf_(acc[ai][0][m][0][i] * rs) * (acc[ai][1][m][0][i] * rs); v1[i] = siluf_(acc[ai][0][m][1][i] * rs) * (acc[ai][1][m][1][i] * rs); }
                *(GAS u32x4*)((GAS bf16_t*)act + (size_t)row * DFF + u.pn * 128 + jl) = pack8(v0, v1); }
    }
};

#define XB_TMO      128
#define XB_XCNT(j)  (256  + 64 * (j))
#define XB_XSUB(j)  (1280 + 64 * (j))
#define XB_XGEN(j)  (2304 + 64 * (j))
#define XB_TOP      3328
#define XB_TOPGEN   3392
#define XCD_BAR_WORDS 3456
#define XB_SPIN_CAP (1u << 18)
__device__ __forceinline__ unsigned xb_ld(unsigned* p)              { return __hip_atomic_load(p, __ATOMIC_RELAXED, __HIP_MEMORY_SCOPE_AGENT); }
__device__ __forceinline__ unsigned xb_add(unsigned* p, unsigned v) { return __hip_atomic_fetch_add(p, v, __ATOMIC_RELAXED, __HIP_MEMORY_SCOPE_AGENT); }
__device__ __forceinline__ unsigned xb_xcc_id() { return (unsigned)__builtin_amdgcn_s_getreg((3 << 11) | 20) & 0xFu; }
#define XB_SPIN(cond, bar) do { unsigned _sp = 0; while (cond) { __builtin_amdgcn_s_sleep(1); \
    if ((++_sp & 255u) == 0u) { if (xb_ld(&(bar)[XB_TMO])) break; if (_sp > XB_SPIN_CAP) { atomicAdd(&(bar)[XB_TMO], 1u); break; } } } } while (0)
struct XcdBarrier { unsigned* bar; unsigned x; volatile LAS unsigned* st; };
__device__ __forceinline__ XcdBarrier xcd_barrier_post(unsigned* bar, volatile LAS unsigned* st) {
    XcdBarrier b; b.bar = bar; b.x = xb_xcc_id(); b.st = st;
    if (threadIdx.x == 0) st[2] = xb_add(&bar[XB_XCNT(b.x)], 1u);
    return b;
}
#define XB_LOC(j) (3456 + 64 * (j))
#define XB_SLOT(j) (8192 + 64 * (j))
__device__ __forceinline__ void xcc_arrive(const XcdBarrier& b, unsigned rank, int wave, unsigned k) {
    asm volatile("s_waitcnt vmcnt(0)" ::: "memory");
    __syncthreads();
    if (wave == 0 && lane_id_volatile() == 0) { __builtin_amdgcn_s_waitcnt(0); __hip_atomic_store(&b.bar[XB_SLOT(b.x) + rank], k, __ATOMIC_RELAXED, __HIP_MEMORY_SCOPE_WORKGROUP); }
}
__device__ __forceinline__ void xcc_wait(const XcdBarrier& b, unsigned n, int wave, unsigned k) {
    if (wave == 0) {
        unsigned* bar = b.bar; unsigned* slots = &bar[XB_SLOT(b.x)];
        const unsigned lane = (unsigned)lane_id_volatile();
        unsigned sp_ = 0;
        for (;;) {
            const unsigned v = lane < n ? xb_ld(&slots[lane]) : k;
            if (__builtin_amdgcn_ballot_w64(v < k) == 0ull) break;
            if ((++sp_ & 1023u) == 0u) { if (xb_ld(&bar[XB_TMO])) break; if (sp_ > 4u * XB_SPIN_CAP) { if (lane == 0) atomicAdd(&bar[XB_TMO], 1u); break; } }
        }
        __builtin_amdgcn_fence(__ATOMIC_ACQUIRE, "agent");
        asm volatile("s_waitcnt vmcnt(0)" ::: "memory");
    }
    __syncthreads();
}
__device__ __forceinline__ void xcc_barrier(const XcdBarrier& b, unsigned n, unsigned rank, int wave, unsigned k) { xcc_arrive(b, rank, wave, k); xcc_wait(b, n, wave, k); }
#define XB_FIN(pm, pn) (9216 + 4 * (pm) + (pn))
static_assert((size_t)(CW_BAR + 9600 + 64) * 4 <= CTL_ZERO_BYTES, "control words beyond the per-call memset");
#define XB_ZX(rb)      (9600 + (rb))
struct EpiResFin {
    static constexpr bool PERM = true; static constexpr int MID_T = 0;
    const bf16_t* xin; float* out; float* ssq; const float* gain; unsigned* bar; LAS float* tab;
    __device__ __forceinline__ void operator()(const f32x4 (&acc_)[2][2][4][2], const Unit& u, int wr, int wc, int fr, int fq) const {
        f32x4 (&acc)[2][2][4][2] = const_cast<f32x4 (&)[2][2][4][2]>(acc_);
        const int row0 = u.pm * 256 + wr * 64 + fr, col0 = u.pn * 256 + wc * 32 + 8 * fq;
        u32x4 rr[2][4][2];
#pragma unroll
        for (int ai = 0; ai < 2; ++ai)
#pragma unroll
            for (int m = 0; m < 4; ++m)
#pragma unroll
                for (int bj = 0; bj < 2; ++bj) rr[ai][m][bj] = *(const GAS u32x4*)((const GAS bf16_t*)xin + (size_t)(row0 + ai * 128 + m * 16) * D + col0 + bj * 128);
#pragma unroll
        for (int ai = 0; ai < 2; ++ai)
#pragma unroll
            for (int m = 0; m < 4; ++m) { const int row = row0 + ai * 128 + m * 16; float s = 0.f;
#pragma unroll
                for (int bj = 0; bj < 2; ++bj) { const u32x4 r = rr[ai][m][bj]; f32x4 v0, v1;
                    v0[0] = bf2f(r.x & 0xffffu); v0[1] = bf2f(r.x >> 16); v0[2] = bf2f(r.y & 0xffffu); v0[3] = bf2f(r.y >> 16);
                    v1[0] = bf2f(r.z & 0xffffu); v1[1] = bf2f(r.z >> 16); v1[2] = bf2f(r.w & 0xffffu); v1[3] = bf2f(r.w >> 16);
                    v0 = v0 + acc[ai][bj][m][0]; v1 = v1 + acc[ai][bj][m][1]; acc[ai][bj][m][0] = v0; acc[ai][bj][m][1] = v1;
                    s += (v0[0] * v0[0] + v0[1] * v0[1]) + (v0[2] * v0[2] + v0[3] * v0[3]) + (v1[0] * v1[0] + v1[1] * v1[1]) + (v1[2] * v1[2] + v1[3] * v1[3]); }
                s += shfl_xor_l(s, fq * 16 + fr, 16); s += shfl_xor_l(s, fq * 16 + fr, 32);
                if (fq == 0) ((GAS float*)ssq)[(size_t)row * 16 + u.pn * 4 + wc] = s; }
        asm volatile("s_waitcnt vmcnt(0)" ::: "memory");
        __syncthreads();
        if (wr == 0 && wc == 0) {
            const unsigned lane = (unsigned)(fq * 16 + fr);
            __builtin_amdgcn_s_waitcnt(0);
            if (lane == 0) __hip_atomic_store(&bar[XB_FIN(u.pm, u.pn)], 1u, __ATOMIC_RELAXED, __HIP_MEMORY_SCOPE_WORKGROUP);
            unsigned sp_ = 0;
            for (;;) {
                const unsigned v = lane < 4u ? xb_ld(&bar[XB_FIN(u.pm, lane)]) : 1u;
                if (__builtin_amdgcn_ballot_w64(v == 0u) == 0ull) break;
                if ((++sp_ & 1023u) == 0u) { if (xb_ld(&bar[XB_TMO])) break; if (sp_ > 4u * XB_SPIN_CAP) { if (lane == 0) atomicAdd(&bar[XB_TMO], 1u); break; } }
            }
            __builtin_amdgcn_fence(__ATOMIC_ACQUIRE, "agent");
            asm volatile("s_waitcnt vmcnt(0)" ::: "memory");
        }
        __syncthreads();
        f32x4 gv[2][2];
#pragma unroll
        for (int bj = 0; bj < 2; ++bj)
#pragma unroll
            for (int n = 0; n < 2; ++n) gv[bj][n] = *(const GAS f32x4*)((const GAS float*)gain + col0 + bj * 128 + 4 * n);
        rstd_table(ssq, u.pm, tab, wr, wc, fr, fq);
        const LAS float* tl = tab + wr * 64 + fr;
#pragma unroll
        for (int ai = 0; ai < 2; ++ai)
#pragma unroll
            for (int m = 0; m < 4; ++m) { const int row = row0 + ai * 128 + m * 16;
                const float rs = tl[ai * 128 + m * 16];
#pragma unroll
                for (int bj = 0; bj < 2; ++bj)
#pragma unroll
                    for (int n = 0; n < 2; ++n) *(GAS f32x4*)((GAS float*)out + (size_t)row * D + col0 + bj * 128 + 4 * n) = acc[ai][bj][m][n] * rs * gv[bj][n]; }
    }
};
#define XB_CVX(k, j) (4608 + 64 * (16 * (k) + (j)))
#define XB_CVG(k)    (6656 + 64 * (k))
#define XB_MKV(j)    (6912 + 64 * (j))
__device__ __forceinline__ void cv_signal(const XcdBarrier& b, int k, unsigned nconv, bool leader) {
    asm volatile("s_waitcnt vmcnt(0)" ::: "memory");
    __syncthreads();
    if (leader) {
        __builtin_amdgcn_s_waitcnt(0);
        if (xb_add(&b.bar[XB_CVX(k, b.x)], 1u) + 1u == nconv) {
            __builtin_amdgcn_fence(__ATOMIC_RELEASE, "agent");
            asm volatile("s_waitcnt vmcnt(0)" ::: "memory");
            xb_add(&b.bar[XB_CVG(k)], 1u);
        }
    }
}
__device__ __forceinline__ void cv_wait(const XcdBarrier& b, int k, unsigned nx, bool leader) {
    if (leader) {
        unsigned* bar = b.bar;
        XB_SPIN(xb_ld(&bar[XB_CVG(k)]) < nx, bar);
        __builtin_amdgcn_fence(__ATOMIC_ACQUIRE, "agent");
        asm volatile("s_waitcnt vmcnt(0)" ::: "memory");
    }
    __syncthreads();
}
__device__ __forceinline__ void xcd_barrier_complete(unsigned* bar, unsigned x, unsigned& nloc, unsigned& nx) {
    const unsigned G = gridDim.x * gridDim.y * gridDim.z;
    unsigned sum, cnt, mine, sp = 0u;
    for (;;) {
        sum = 0u; cnt = 0u; mine = 0u;
#pragma unroll
        for (unsigned j = 0; j < 16; ++j) { const unsigned c = xb_ld(&bar[XB_XCNT(j)]); sum += c; cnt += (c > 0u) ? 1u : 0u; mine = (j == x) ? c : mine; }
        if (sum == G) break;
        __builtin_amdgcn_s_sleep(1);
        if ((++sp & 255u) == 0u) { if (xb_ld(&bar[XB_TMO])) break; if (sp > XB_SPIN_CAP) { atomicAdd(&bar[XB_TMO], 1u); break; } }
    }
    nloc = mine > 0u ? mine : 1u; nx = cnt > 0u ? cnt : 1u;
}
__device__ __forceinline__ void xcd_barrier(const XcdBarrier& b, bool leader) {
    asm volatile("s_waitcnt vmcnt(0)" ::: "memory");
    __syncthreads();
    if (leader) {
        unsigned* bar = b.bar;
        __builtin_amdgcn_s_waitcnt(0);
        unsigned nloc = b.st[0], nx = b.st[1];
        if (nloc == 0u) { xcd_barrier_complete(bar, b.x, nloc, nx); b.st[0] = nloc; b.st[1] = nx; }
        const unsigned old = xb_add(&bar[XB_XSUB(b.x)], 1u);
        const unsigned gen = old / nloc;
        if (old + 1u == (gen + 1u) * nloc) {
            __builtin_amdgcn_fence(__ATOMIC_RELEASE, "agent");
            asm volatile("s_waitcnt vmcnt(0)" ::: "memory");
            const unsigned og = xb_add(&bar[XB_TOP], 1u);
            const unsigned tg = og / nx;
            if (og + 1u == (tg + 1u) * nx) xb_add(&bar[XB_TOPGEN], 1u);
            else XB_SPIN(xb_ld(&bar[XB_TOPGEN]) == tg, bar);
            __builtin_amdgcn_fence(__ATOMIC_ACQUIRE, "agent");
            xb_add(&bar[XB_XGEN(b.x)], 1u);
            asm volatile("s_waitcnt vmcnt(0)" ::: "memory");
        } else {
            XB_SPIN(xb_ld(&bar[XB_XGEN(b.x)]) == gen, bar);
            __builtin_amdgcn_fence(__ATOMIC_ACQUIRE, "agent");
            asm volatile("s_waitcnt vmcnt(0)" ::: "memory");
        }
    }
    __syncthreads();
}

constexpr int RING_BYTES = 131072, LDSCTL_OFF = RING_BYTES, MISC_OFF = LDSCTL_OFF + 320, LDS_BYTES = 147456;
constexpr int NWAVES = 8;

__device__ __forceinline__ int misc_rd(LAS unsigned char* lds, int idx) { unsigned off = (unsigned)(MISC_OFF + 4 * idx); asm volatile("" : "+v"(off)); return __builtin_amdgcn_readfirstlane((int)*(volatile LAS unsigned*)(lds + off)); }
struct Args { const float* in[15]; float* out; unsigned char* ws; int ph_lo, ph_hi; };

__device__ __forceinline__ int win_srccol(int j) {
    const int t = j >> 8;
    if (t >= 6) return j;
    const int jj = j & 255, half = jj >> 7, p = jj & 127, d = 4 * (p >> 3) + (p & 3) + 64 * ((p >> 2) & 1);
    return half * MIXW + t * 128 + d;
}
__device__ __forceinline__ int wfi_srccol(int j) { const int t = j >> 8, jj = j & 255; return (jj < 128 ? 0 : DFF) + t * 128 + (jj & 127); }
struct TItem { const GAS float* W; GAS bf16_t* WT; const GAS float* kscale; int K, N, ndst, kind, nscale, item; };
__device__ __forceinline__ TItem titem_decode(const Args& a, unsigned char* ws, int it) {
    constexpr int I0 = 16 * (NIN / 32), I1 = 16 * 32, I2 = 16 * (NFI / 32), I3 = (DFF / 64) * 32, I4 = 16 * 16, IL = I0 + I1 + I2 + I3 + I4;
    const int l = it / IL; int r = it % IL; TItem t;
    if (r < I0) { t.W = (const GAS float*)a.in[4] + (size_t)l * D * NIN; t.WT = (GAS bf16_t*)(ws + WS_WIN) + (size_t)l * NIN * D; t.kscale = (const GAS float*)a.in[3] + l * D; t.K = D; t.N = NIN; t.ndst = NIN; t.kind = 0; t.nscale = D; t.item = r; return t; } r -= I0;
    if (r < I1) { t.W = (const GAS float*)a.in[5] + (size_t)l * D * D; t.WT = (GAS bf16_t*)(ws + WS_WOUT) + (size_t)l * D * D; t.kscale = (const GAS float*)((l & 1) ? a.in[10] : a.in[9]) + (l >> 1) * MIXW; t.K = D; t.N = D; t.ndst = D; t.kind = 1; t.nscale = MIXW; t.item = r; return t; } r -= I1;
    if (r < I2) { t.W = (const GAS float*)a.in[12] + (size_t)l * D * NFI; t.WT = (GAS bf16_t*)(ws + WS_WFI) + (size_t)l * NFI * D; t.kscale = (const GAS float*)a.in[11] + l * D; t.K = D; t.N = NFI; t.ndst = NFI; t.kind = 2; t.nscale = D; t.item = r; return t; } r -= I2;
    if (r < I3) { t.W = (const GAS float*)a.in[13] + (size_t)l * DFF * D; t.WT = (GAS bf16_t*)(ws + WS_WFO) + (size_t)l * D * DFF; t.kscale = (const GAS float*)a.in[13]; t.K = DFF; t.N = D; t.ndst = D; t.kind = 3; t.nscale = 0; t.item = r; return t; } r -= I3;
    t.W = (const GAS float*)a.in[7] + (size_t)l * D * 512; t.WT = (GAS bf16_t*)(ws + WS_WM) + (size_t)l * 512 * D; t.kscale = (const GAS float*)a.in[6] + l * D; t.K = D; t.N = 512; t.ndst = 512; t.kind = 4; t.nscale = D; t.item = r; return t;
}
__device__ __forceinline__ void titem_load(const TItem& t, f32x4 (&v)[8], int lane) {
    const int nblk = t.ndst / 32, kb = t.item / nblk, nb = t.item % nblk, k0 = 64 * kb, n0 = 32 * nb, kq = lane >> 3, jd = n0 + 4 * (lane & 7);
    const int sc = t.kind == 0 ? win_srccol(jd) : (t.kind == 2 ? wfi_srccol(jd) : jd);
#pragma unroll
    for (int i = 0; i < 8; ++i) v[i] = *(const GAS f32x4*)(t.W + (size_t)(k0 + 8 * i + kq) * t.N + sc);
}
__device__ __forceinline__ void titem_store(const TItem& t, const f32x4 (&v)[8], LAS float* scr, int lane) {
    const int nblk = t.ndst / 32, kb = t.item / nblk, nb = t.item % nblk, k0 = 64 * kb, n0 = 32 * nb, kq = lane >> 3, nq = lane & 7;
#pragma unroll
    for (int i = 0; i < 8; ++i)
#pragma unroll
        for (int e = 0; e < 4; ++e) scr[(8 * i + kq) * 33 + 4 * nq + e] = v[i][e];
    const int c = lane & 7;
    f32x4 s0 = (f32x4){1.f, 1.f, 1.f, 1.f}, s1 = s0;
    if (k0 + 8 * c < t.nscale) { s0 = *(const GAS f32x4*)(t.kscale + k0 + 8 * c); s1 = *(const GAS f32x4*)(t.kscale + k0 + 8 * c + 4); }
    asm volatile("s_waitcnt lgkmcnt(0)" ::: "memory");
#pragma unroll
    for (int j = 0; j < 4; ++j) { const int n = (lane >> 3) + 8 * j; const LAS float* s = scr + (8 * c) * 33 + n;
        u32x4 o; o.x = pk2(s[0 * 33] * s0[0], s[1 * 33] * s0[1]); o.y = pk2(s[2 * 33] * s0[2], s[3 * 33] * s0[3]); o.z = pk2(s[4 * 33] * s1[0], s[5 * 33] * s1[1]); o.w = pk2(s[6 * 33] * s1[2], s[7 * 33] * s1[3]);
        *(GAS u32x4*)(t.WT + (size_t)(n0 + n) * t.K + k0 + 8 * c) = o; }
    asm volatile("s_waitcnt lgkmcnt(0)" ::: "memory");
}

constexpr int TITEMS_PER_LAYER = 16 * (NIN / 32) + 16 * 32 + 16 * (NFI / 32) + (DFF / 64) * 32 + 16 * 16;
__device__ __forceinline__ void convert_weights(const Args& a, unsigned char* ws, LAS float* scr, int it0, int it1, int w, int nw, int lane, int off = 0, int mul = 1) {
    f32x4 va[8], vb[8];
    nw *= mul;
    int it = it0 + off + mul * w;
    if (it < it1) { const TItem t = titem_decode(a, ws, it); titem_load(t, va, lane); }
    while (it < it1) {
        const int itn = it + nw;
        if (itn < it1) { const TItem t = titem_decode(a, ws, itn); titem_load(t, vb, lane); }
        { const TItem t = titem_decode(a, ws, it); titem_store(t, va, scr, lane); }
        it = itn;
        if (it >= it1) break;
        const int itn2 = it + nw;
        if (itn2 < it1) { const TItem t = titem_decode(a, ws, itn2); titem_load(t, va, lane); }
        { const TItem t = titem_decode(a, ws, it); titem_store(t, vb, scr, lane); }
        it = itn2;
    }
}

__device__ __forceinline__ void p0_prologue(const Args& a, unsigned char* ws, LAS unsigned char* lds, int gw, int NGW, int wave, int lane) {
    LAS float* scr = (LAS float*)(lds + wave * 16384);
    convert_weights(a, ws, scr, 0, 16 * (NIN / 32), gw, NGW, lane);
    for (int l = 0; l < DEPTH; ++l) convert_weights(a, ws, scr, l * TITEMS_PER_LAYER + TITEMS_PER_LAYER - 256, (l + 1) * TITEMS_PER_LAYER, gw, NGW, lane);
    for (int m = gw; m < M; m += NGW) {
        const f32x4* xr = (const f32x4*)(a.in[0] + (size_t)m * D) + lane; f32x4 v[4]; float s = 0.f;
#pragma unroll
        for (int j = 0; j < 4; ++j) { v[j] = xr[64 * j]; s += (v[j].x * v[j].x + v[j].y * v[j].y) + (v[j].z * v[j].z + v[j].w * v[j].w); }
        s = wave_sum(s, lane);
        u32x2* o8 = (u32x2*)((bf16_t*)(ws + WS_XB) + (size_t)m * D) + lane;
#pragma unroll
        for (int j = 0; j < 4; ++j) { u32x2 w; w.x = pk2(v[j].x, v[j].y); w.y = pk2(v[j].z, v[j].w); o8[64 * j] = w; }
        if (lane < 16) ((float*)(ws + WS_SSQA))[(size_t)m * 16 + lane] = lane == 0 ? s : 0.f;
    }
    for (int m = gw; m < MROWS; m += NGW) {
        const f32x4* xr = (const f32x4*)(a.in[1] + (size_t)m * D) + lane; f32x4 v[4]; float s = 0.f;
#pragma unroll
        for (int j = 0; j < 4; ++j) { v[j] = xr[64 * j]; s += (v[j].x * v[j].x + v[j].y * v[j].y) + (v[j].z * v[j].z + v[j].w * v[j].w); }
        const float rs = rsqrtf(wave_sum(s, lane) * (1.0f / D) + EPS);
        u32x2* o8 = (u32x2*)((bf16_t*)(ws + WS_MEMB) + (size_t)m * D) + lane;
#pragma unroll
        for (int j = 0; j < 4; ++j) { u32x2 w; w.x = pk2(v[j].x * rs, v[j].y * rs); w.y = pk2(v[j].z * rs, v[j].w * rs); o8[64 * j] = w; }
    }
    {   const double invf = exp(-9.210340371976184 * ((double)lane / 63.0));
        for (int m = gw; m < M; m += NGW) {
            const double ang = (double)((const GAS int*)a.in[2])[m] * invf;
            const double kr = rint(ang * 0.15915494309189535);
            const float r = (float)fma(-kr, 1.2246467991473532e-16 * 2.0, fma(-kr, 6.283185307179586, ang));
            float sn, cs; sincosf(r, &sn, &cs);
            ((GAS float*)(ws + WS_COS))[(size_t)m * 64 + lane] = cs;
            ((GAS float*)(ws + WS_SIN))[(size_t)m * 64 + lane] = sn;
        }
    }
    for (int c = gw * 64 + lane; c < MIXW; c += NGW * 64) {
        const float l0 = a.in[8][c], l1 = a.in[8][MIXW + c]; const float mx = fmaxf(l0, l1), e0 = expf(l0 - mx), e1 = expf(l1 - mx);
        ((float*)(ws + WS_LB))[c] = 0.f; ((float*)(ws + WS_LB))[MIXW + c] = e1 / (e0 + e1);
    }
}

typedef float f32x16 __attribute__((ext_vector_type(16)));
typedef float f32x8_ __attribute__((ext_vector_type(8)));
constexpr int SC_QS = 0, SC_KS = 8704, SC_KST = 17408, SC_V = 27648, SC_P = 37888, SC_AUX = 40448, SC_OUT = 41472, SC_SSQ = 50176, SC_GATE = 50688, SC_BUF = 50688 + 32 * VPR * 16;
constexpr int PQ = 272, PT = 320;
constexpr int NCHUNK = SEQ / 32;
typedef const GAS bf16_t* gbf;
struct HRegs { u32x4 x0[8], x1[8]; float aux[2]; };
__device__ __forceinline__ bf16x8 as_bf16x8(u32x4 v) { return __builtin_bit_cast(bf16x8, v); }

struct StLane { unsigned g0, g1, gg, ga, l0, l1, lg, la, sk; };
template <int IS_RET>
__device__ __forceinline__ void stager_load(HRegs& R, gbf Z, gbf KST, const GAS float* AUXG, int b, int h, int unit, int sw, const StLane& L, int chunk) {
    chunk = chunk < NCHUNK ? chunk : NCHUNK - 1;
    const size_t tok0 = (size_t)b * SEQ + chunk * 32;
    const int p0 = (sw == 0 || IS_RET) ? NIN : MIXW;
    const GAS char* s0 = (const GAS char*)(sw == 0 ? Z + h * 256 : (IS_RET ? Z + h * 256 + 128 : KST + h * 128)) + tok0 * p0 * 2;
    const GAS char* s1 = (const GAS char*)(sw == 0 ? Z + h * 256 + 128 : Z + 1536 + h * 128) + tok0 * NIN * 2;
#pragma unroll
    for (int i = 0; i < 8; ++i) R.x0[i] = *(const GAS u32x4*)(s0 + (size_t)(4 * i) * p0 * 2 + L.g0);
    if (sw == 0) {
#pragma unroll
        for (int i = 0; i < 8; ++i) R.x1[i] = *(const GAS u32x4*)(s1 + 32 * i + L.g1);
    } else {
#pragma unroll
        for (int i = 0; i < 8 / NVS; ++i) R.x1[i] = *(const GAS u32x4*)(s1 + (size_t)(4 * NVS * i) * NIN * 2 + L.g1);
    }
    if (!IS_RET) { const GAS char* ag = (const GAS char*)(AUXG + ((size_t)unit * 64 + chunk) * 256 + 128 * sw); R.aux[0] = *(const GAS float*)(ag + L.ga); R.aux[1] = *(const GAS float*)(ag + 256 + L.ga); }
}
template <int IS_RET>
__device__ __forceinline__ void stager_stage(const HRegs& R, LAS unsigned char* buf, LAS unsigned char* gbuf, int sw, const StLane& L) {
    const int o0 = sw == 0 ? SC_QS : SC_KST, o1 = sw == 0 ? SC_KS : SC_V, pit = sw == 0 ? PQ : PT;
    LAS unsigned char* d0 = buf + o0 + L.l0; LAS unsigned char* d1 = buf + o1 + L.l1;
#pragma unroll
    for (int i = 0; i < 8; ++i) *(LAS u32x4*)(d0 + 4 * i * pit) = R.x0[i];
    if (sw != 0) {
#pragma unroll
        for (int i = 0; i < 8 / NVS; ++i) *(LAS u32x4*)(d1 + 4 * NVS * i * PT) = R.x1[i];
    }
    if (!IS_RET) { LAS unsigned char* al = buf + SC_AUX + 512 * sw + L.la; *(LAS float*)al = R.aux[0]; *(LAS float*)(al + 256) = R.aux[1]; }
}
__device__ __forceinline__ void scores_stage(const HRegs& R, LAS unsigned char* buf, const StLane& L, int l31, int hh) {
    f32x16 d;
#pragma unroll
    for (int r = 0; r < 16; ++r) d[r] = 0.f;
    u32x4 qf[8];
    {   const unsigned aq = (unsigned)(size_t)(buf + SC_QS) + L.sk;
        asm volatile(
            "ds_read_b128 %0, %8 offset:0\n\tds_read_b128 %1, %8 offset:32\n\tds_read_b128 %2, %8 offset:64\n\tds_read_b128 %3, %8 offset:96\n\t"
            "ds_read_b128 %4, %8 offset:128\n\tds_read_b128 %5, %8 offset:160\n\tds_read_b128 %6, %8 offset:192\n\tds_read_b128 %7, %8 offset:224\n\t"
            "s_waitcnt lgkmcnt(0)"
            : "=&v"(qf[0]), "=&v"(qf[1]), "=&v"(qf[2]), "=&v"(qf[3]), "=&v"(qf[4]), "=&v"(qf[5]), "=&v"(qf[6]), "=&v"(qf[7])
            : "v"(aq) : "memory");
        __builtin_amdgcn_sched_barrier(0);
    }
#pragma unroll
    for (int kk = 0; kk < 8; ++kk) d = __builtin_amdgcn_mfma_f32_32x32x16_bf16(as_bf16x8(R.x1[kk]), as_bf16x8(qf[kk]), d, 0, 0, 0);
#pragma unroll
    for (int q = 0; q < 4; ++q) { float v4[4];
#pragma unroll
        for (int i = 0; i < 4; ++i) { const int srow = 8 * q + 4 * hh + i; v4[i] = (srow <= l31) ? d[4 * q + i] : 0.f; }
        u32x2 w; w.x = pg8::cvt_pk_bf16(v4[0], v4[1]); w.y = pg8::cvt_pk_bf16(v4[2], v4[3]);
        *(LAS u32x2*)(buf + SC_P + l31 * 80 + (8 * q + 4 * hh) * 2) = w; }
}
struct FinLane { unsigned lo, ls, go, gs, gz; };
constexpr int FPT = 32 * VPR / 64;
template <int IS_RET>
__device__ __forceinline__ void gate_load(u32x4 (&g)[FPT], gbf Z, int b, int h, const FinLane& L, int chunk) {
    chunk = chunk < NCHUNK ? chunk : NCHUNK - 1;
    const GAS char* sg = (const GAS char*)(Z + 2304 + h * 128) + ((size_t)b * SEQ + chunk * 32) * NIN * 2;
#pragma unroll
    for (int i = 0; i < FPT; ++i) g[i] = *(const GAS u32x4*)(sg + (size_t)(64 / VPR * i) * NIN * 2 + L.gz);
}
__device__ __forceinline__ void gate_stage(const u32x4 (&g)[FPT], LAS unsigned char* buf, int lane) {
#pragma unroll
    for (int i = 0; i < FPT; ++i) *(LAS u32x4*)(buf + SC_GATE + (lane + 64 * i) * 16) = g[i];
}
template <int IS_RET>
__device__ __forceinline__ void fin_store(LAS unsigned char* buf, GAS bf16_t* CAT, GAS float* SSQO, int b, int h, int vh, const FinLane& L, int lane, bool first, int chunk) {
    const size_t tok0 = (size_t)b * SEQ + chunk * 32;
    GAS char* cg = (GAS char*)(CAT + tok0 * D + h * 128); GAS char* sgp = (GAS char*)(SSQO + tok0 * 16 + h * NVS + vh);
#pragma unroll
    for (int i = 0; i < FPT; ++i) {
        const u32x2 lo = *(const LAS u32x2*)(buf + SC_OUT + (64 / VPR) * i * PQ + L.lo), hi = *(const LAS u32x2*)(buf + SC_OUT + (64 / VPR) * i * PQ + 8 + L.lo);
        const LAS unsigned char* sq = buf + SC_SSQ + (64 / VPR) * 4 * i + L.ls;
        float ssum = *(const LAS float*)sq;
#pragma unroll
        for (int w = 1; w < 8 / NVS; ++w) ssum += *(const LAS float*)(sq + 128 * w);
        const float sc = (IS_RET && NVS == 1) ? rsqrtf(ssum * (1.0f / HD) + EPS) : 1.0f;
        const u32x4 gt = *(const LAS u32x4*)(buf + SC_GATE + (lane + 64 * i) * 16);
        const unsigned ow[4] = {lo.x, lo.y, hi.x, hi.y}; u32x4 out;
#pragma unroll
        for (int j = 0; j < 4; ++j) out[j] = pg8::cvt_pk_bf16(__uint_as_float(ow[j] << 16) * sc * __uint_as_float(gt[j] << 16), __uint_as_float(ow[j] & 0xffff0000u) * sc * __uint_as_float(gt[j] & 0xffff0000u));
        *(GAS u32x4*)(cg + (size_t)(64 / VPR * i) * D * 2 + L.go) = out;
        if ((!IS_RET || NVS > 1) && first) *(GAS float*)(sgp + (size_t)(64 / VPR * i) * 64 + L.gs) = ssum; }
}
__device__ __forceinline__ void norm_rows(unsigned char* ws, int row0, int row1, int gw, int NGW, int lane) {
    GAS bf16_t* CAT = (GAS bf16_t*)(ws + WS_CAT); const GAS float* SSQO = (const GAS float*)(ws + WS_SSQO);
    static_assert(NVS == 2, "the two partial sums of a head are read as one 8-byte pair");
    for (int rowb = row0 + gw; rowb < row1; rowb += 4 * NGW) {
        u32x2 w[4][3]; f32x2 sq[4][3];
#pragma unroll
        for (int k = 0; k < 4; ++k) { const int row = rowb + k * NGW < row1 ? rowb + k * NGW : rowb;
#pragma unroll
            for (int j = 0; j < 3; ++j) { const int e = lane * 4 + 256 * j, h = e >> 7;
                sq[k][j] = *(const GAS f32x2*)(SSQO + (size_t)row * 16 + h * NVS); w[k][j] = *(const GAS u32x2*)(CAT + (size_t)row * D + e); } }
#pragma unroll
        for (int k = 0; k < 4; ++k) { const int row = rowb + k * NGW;
            if (row < row1) {
#pragma unroll
                for (int j = 0; j < 3; ++j) { const int e = lane * 4 + 256 * j;
                    const float sc = rsqrtf((sq[k][j][0] + sq[k][j][1]) * (1.0f / HD) + EPS); u32x2 o;
                    o.x = pg8::cvt_pk_bf16(__uint_as_float(w[k][j].x << 16) * sc, __uint_as_float(w[k][j].x & 0xffff0000u) * sc); o.y = pg8::cvt_pk_bf16(__uint_as_float(w[k][j].y << 16) * sc, __uint_as_float(w[k][j].y & 0xffff0000u) * sc);
                    *(GAS u32x2*)(CAT + (size_t)row * D + e) = o; } } }
    }
}
#define TRR(dst, areg, off) "ds_read_b64_tr_b16 " dst ", " areg " offset:" #off "\n\t"
template <int R> __device__ __forceinline__ float row_bcast(float v) { return __int_as_float(__builtin_amdgcn_update_dpp(0, __float_as_int(v), 0x150 + R, 0xF, 0xF, true)); }
#define SCALE16(t, ev) do { t[0] *= row_bcast<0>(ev); t[1] *= row_bcast<1>(ev); t[2] *= row_bcast<2>(ev); t[3] *= row_bcast<3>(ev); t[4] *= row_bcast<4>(ev); t[5] *= row_bcast<5>(ev); t[6] *= row_bcast<6>(ev); t[7] *= row_bcast<7>(ev); \
    t[8] *= row_bcast<8>(ev); t[9] *= row_bcast<9>(ev); t[10] *= row_bcast<10>(ev); t[11] *= row_bcast<11>(ev); t[12] *= row_bcast<12>(ev); t[13] *= row_bcast<13>(ev); t[14] *= row_bcast<14>(ev); t[15] *= row_bcast<15>(ev); } while (0)
struct MLane { unsigned av, ak, aq, aaux, ap, aout, assq; };
template <int IS_RET, int PAR>
__device__ __forceinline__ void mfma_step(f32x16 (&S)[4], const MLane& A, int lane, float g32) {
    constexpr unsigned PB = PAR * SC_BUF;
    u32x2 v00, v01, v10, v11, k[4][2][2]; u32x4 qf[4][2];
    const unsigned av = A.av + PB, ak = A.ak + PB, aq = A.aq + PB, ax = A.aaux + PB;
    float ee0 = 0.f, ee1 = 0.f, ee2 = 0.f, ee3 = 0.f, dd0 = 0.f, dd1 = 0.f, dd2 = 0.f, dd3 = 0.f;
    if (!IS_RET) asm volatile("ds_read_b32 %0, %4 offset:0\n\tds_read_b32 %1, %4 offset:128\n\tds_read_b32 %2, %4 offset:256\n\tds_read_b32 %3, %4 offset:384"
        : "=&v"(ee0), "=&v"(ee1), "=&v"(ee2), "=&v"(ee3) : "v"(ax) : "memory");
    u32x4 pf0, pf1;
    const unsigned apq = A.ap + PB;
    asm volatile(
        "ds_read_b128 %0, %10 offset:0\n\tds_read_b128 %1, %10 offset:32\n\tds_read_b128 %2, %10 offset:64\n\tds_read_b128 %3, %10 offset:96\n\t"
        "ds_read_b128 %4, %10 offset:128\n\tds_read_b128 %5, %10 offset:160\n\tds_read_b128 %6, %10 offset:192\n\tds_read_b128 %7, %10 offset:224\n\t"
        "ds_read_b128 %8, %11 offset:0\n\tds_read_b128 %9, %11 offset:32"
        : "=&v"(qf[0][0]), "=&v"(qf[0][1]), "=&v"(qf[1][0]), "=&v"(qf[1][1]), "=&v"(qf[2][0]), "=&v"(qf[2][1]), "=&v"(qf[3][0]), "=&v"(qf[3][1]), "=&v"(pf0), "=&v"(pf1)
        : "v"(aq), "v"(apq) : "memory");
    if (!IS_RET) asm volatile("s_waitcnt lgkmcnt(10)" : "+v"(ee0), "+v"(ee1), "+v"(ee2), "+v"(ee3) :: "memory");
    asm volatile(
        TRR("%0", "%12", 0) TRR("%1", "%12", 1280) TRR("%2", "%12", 5120) TRR("%3", "%12", 6400)
        TRR("%4", "%13", 0) TRR("%5", "%13", 1280) TRR("%6", "%13", 5120) TRR("%7", "%13", 6400)
        TRR("%8", "%13", 64) TRR("%9", "%13", 1344) TRR("%10", "%13", 5184) TRR("%11", "%13", 6464)
        : "=&v"(v00), "=&v"(v01), "=&v"(v10), "=&v"(v11),
          "=&v"(k[0][0][0]), "=&v"(k[0][0][1]), "=&v"(k[0][1][0]), "=&v"(k[0][1][1]), "=&v"(k[1][0][0]), "=&v"(k[1][0][1]), "=&v"(k[1][1][0]), "=&v"(k[1][1][1])
        : "v"(av), "v"(ak) : "memory");
    bf16x8 sf[4][2];
#define MAKE_SF(kt, s2) do { f32x8_ t; _Pragma("unroll") for (int j = 0; j < 8; ++j) t[j] = S[kt][8 * (s2) + j]; \
        if (!IS_RET) { const float ev = (kt) == 0 ? ee0 : ((kt) == 1 ? ee1 : ((kt) == 2 ? ee2 : ee3)); \
            if ((s2) == 0) { t[0] *= row_bcast<0>(ev); t[1] *= row_bcast<1>(ev); t[2] *= row_bcast<2>(ev); t[3] *= row_bcast<3>(ev); t[4] *= row_bcast<4>(ev); t[5] *= row_bcast<5>(ev); t[6] *= row_bcast<6>(ev); t[7] *= row_bcast<7>(ev); } \
            else { t[0] *= row_bcast<8>(ev); t[1] *= row_bcast<9>(ev); t[2] *= row_bcast<10>(ev); t[3] *= row_bcast<11>(ev); t[4] *= row_bcast<12>(ev); t[5] *= row_bcast<13>(ev); t[6] *= row_bcast<14>(ev); t[7] *= row_bcast<15>(ev); } } \
        u32x4 pk; _Pragma("unroll") for (int j = 0; j < 4; ++j) pk[j] = pg8::cvt_pk_bf16(t[2 * j], t[2 * j + 1]); sf[kt][s2] = as_bf16x8(pk); } while (0)
    MAKE_SF(0, 0); MAKE_SF(0, 1);
    if (IS_RET) { MAKE_SF(1, 0); MAKE_SF(1, 1); MAKE_SF(2, 0); MAKE_SF(2, 1); MAKE_SF(3, 0); MAKE_SF(3, 1); }
    asm volatile("s_waitcnt lgkmcnt(12)" : "+v"(qf[0][0]), "+v"(qf[0][1]), "+v"(qf[1][0]), "+v"(qf[1][1]), "+v"(qf[2][0]), "+v"(qf[2][1]), "+v"(qf[3][0]), "+v"(qf[3][1]) :: "memory");
    asm volatile(
        TRR("%0", "%8", 128) TRR("%1", "%8", 1408) TRR("%2", "%8", 5248) TRR("%3", "%8", 6528)
        TRR("%4", "%8", 192) TRR("%5", "%8", 1472) TRR("%6", "%8", 5312) TRR("%7", "%8", 6592)
        : "=&v"(k[2][0][0]), "=&v"(k[2][0][1]), "=&v"(k[2][1][0]), "=&v"(k[2][1][1]), "=&v"(k[3][0][0]), "=&v"(k[3][0][1]), "=&v"(k[3][1][0]), "=&v"(k[3][1][1])
        : "v"(ak) : "memory");
    if (!IS_RET) asm volatile("ds_read_b32 %0, %4 offset:512\n\tds_read_b32 %1, %4 offset:640\n\tds_read_b32 %2, %4 offset:768\n\tds_read_b32 %3, %4 offset:896"
        : "=&v"(dd0), "=&v"(dd1), "=&v"(dd2), "=&v"(dd3) : "v"(ax) : "memory");
    __builtin_amdgcn_sched_barrier(0);
    f32x16 o;
#pragma unroll
    for (int r = 0; r < 16; ++r) o[r] = 0.f;
#define CHAIN(kt) do { o = __builtin_amdgcn_mfma_f32_32x32x16_bf16(sf[kt][0], as_bf16x8(qf[kt][0]), o, 0, 0, 0); if (!IS_RET) { __builtin_amdgcn_sched_barrier(0); if ((kt) < 3) MAKE_SF((kt) + 1 > 3 ? 3 : (kt) + 1, 0); __builtin_amdgcn_sched_barrier(0); } \
        o = __builtin_amdgcn_mfma_f32_32x32x16_bf16(sf[kt][1], as_bf16x8(qf[kt][1]), o, 0, 0, 0); if (!IS_RET) { __builtin_amdgcn_sched_barrier(0); if ((kt) < 3) MAKE_SF((kt) + 1 > 3 ? 3 : (kt) + 1, 1); __builtin_amdgcn_sched_barrier(0); } } while (0)
    CHAIN(0); CHAIN(1); CHAIN(2); CHAIN(3);
#undef CHAIN
#undef MAKE_SF
    __builtin_amdgcn_sched_barrier(0);
    asm volatile("s_waitcnt lgkmcnt(0)" : "+v"(pf0), "+v"(pf1), "+v"(dd0), "+v"(dd1), "+v"(dd2), "+v"(dd3), "+v"(v00), "+v"(v01), "+v"(v10), "+v"(v11),
          "+v"(k[0][0][0]), "+v"(k[0][0][1]), "+v"(k[0][1][0]), "+v"(k[0][1][1]), "+v"(k[1][0][0]), "+v"(k[1][0][1]), "+v"(k[1][1][0]), "+v"(k[1][1][1]),
          "+v"(k[2][0][0]), "+v"(k[2][0][1]), "+v"(k[2][1][0]), "+v"(k[2][1][1]), "+v"(k[3][0][0]), "+v"(k[3][0][1]), "+v"(k[3][1][0]), "+v"(k[3][1][1]) :: "memory");
    __builtin_amdgcn_sched_barrier(0);
    const bf16x8 vt[2] = {as_bf16x8((u32x4){v00.x, v00.y, v01.x, v01.y}), as_bf16x8((u32x4){v10.x, v10.y, v11.x, v11.y})};
    o = __builtin_amdgcn_mfma_f32_32x32x16_bf16(vt[0], as_bf16x8(pf0), o, 0, 0, 0);
    o = __builtin_amdgcn_mfma_f32_32x32x16_bf16(vt[1], as_bf16x8(pf1), o, 0, 0, 0);
#pragma unroll
    for (int kt = 0; kt < 4; ++kt) {
        if (!IS_RET) { const float dv = kt == 0 ? dd0 : (kt == 1 ? dd1 : (kt == 2 ? dd2 : dd3));
            SCALE16(S[kt], dv); }
#pragma unroll
        for (int kk = 0; kk < 2; ++kk) S[kt] = __builtin_amdgcn_mfma_f32_32x32x16_bf16(as_bf16x8((u32x4){k[kt][kk][0].x, k[kt][kk][0].y, k[kt][kk][1].x, k[kt][kk][1].y}), vt[kk], S[kt], 0, 0, 0);
        if (IS_RET) S[kt] = S[kt] * g32;
    }
    float ss = 0.f;
#pragma unroll
    for (int r = 0; r < 16; ++r) ss += o[r] * o[r];
    *(LAS float*)(size_t)(A.assq + PB) = ss;
    LAS unsigned char* op = (LAS unsigned char*)(size_t)(A.aout + PB);
#pragma unroll
    for (int q = 0; q < 4; ++q) { u32x2 wv; wv.x = pg8::cvt_pk_bf16(o[4 * q], o[4 * q + 1]); wv.y = pg8::cvt_pk_bf16(o[4 * q + 2], o[4 * q + 3]);
        *(LAS u32x2*)(op + 16 * q) = wv; }
}
template <int IS_RET, int VAR>
__device__ __forceinline__ void scan2_unit(unsigned char* ws, LAS unsigned char* lds, int unit, int tid) {
    constexpr bool MF_ON = VAR == 0 || ((VAR & 16) && (VAR & 1)), ST_ON = VAR == 0 || ((VAR & 16) && (VAR & 2)), FI_ON = VAR == 0 || ((VAR & 16) && (VAR & 4)), ST_LD = ST_ON && !(VAR & 64), ST_ST = ST_ON && !(VAR & 32);
    gbf Z = (gbf)(ws + WS_Z); gbf KST = (gbf)(ws + WS_KST); const GAS float* AUXG = (const GAS float*)(ws + WS_AUX);
    GAS bf16_t* CAT = (GAS bf16_t*)(ws + WS_CAT); GAS float* SSQO = (GAS float*)(ws + WS_SSQO);
    const int b = unit / (NH * NVS), h = (unit / NVS) % NH, vh = unit % NVS, hu = b * NH + h, wave = __builtin_amdgcn_readfirstlane(tid >> 6); int lane = tid & 63;
    const float g32 = exp2f(32.0f * __log2f(1.0f - exp2f(-5.0f - (float)h)));
    __syncthreads();
    static_assert(NVS == 2, "wave roles below are written for two value slices per head");
    if (wave == 5 || wave == 6) {
        __syncthreads();
        for (int n = 0; n < NCHUNK; ++n) __syncthreads();
    } else if (wave < 2) {
        asm volatile("" : "+v"(lane));
        const int l31 = lane & 31, hh = lane >> 5, vs = (128 / NVS) * vh + 32 * wave;
        const unsigned base = (unsigned)(size_t)lds, trl = (unsigned)((8 * hh + ((lane & 15) >> 2)) * PT + (16 * ((lane >> 4) & 1) + 4 * (lane & 3)) * 2);
        const int psw = ((lane & 3) == 1) ? 2 : (((lane & 3) == 2) ? 1 : (lane & 3));
        const unsigned trk = (unsigned)((8 * hh + ((lane & 15) >> 2)) * PT + (16 * ((lane >> 4) & 1) + 4 * psw) * 2);
        MLane A;
        A.av = base + SC_V + trl + vs * 2; A.ak = base + SC_KST + trk; A.aq = base + SC_QS + l31 * PQ + 16 * hh; A.aaux = base + SC_AUX + (16 * ((lane & 15) >> 3) + 8 * hh + 4 * (((lane & 15) >> 2) & 1) + (lane & 3)) * 4;   A.ap = base + SC_P + l31 * 80 + 16 * hh;
        A.aout = base + SC_OUT + l31 * PQ + (vs + 4 * hh) * 2; A.assq = base + SC_SSQ + ((wave * 2 + hh) * 32 + l31) * 4;
        asm volatile("" : "+v"(A.av), "+v"(A.ak), "+v"(A.aq), "+v"(A.aaux), "+v"(A.ap), "+v"(A.aout), "+v"(A.assq));
        f32x16 S[4];
#pragma unroll
        for (int kt = 0; kt < 4; ++kt)
#pragma unroll
            for (int r = 0; r < 16; ++r) S[kt][r] = 0.f;
        __syncthreads();
        for (int n = 0; n < NCHUNK; n += 2) {
            if (MF_ON) mfma_step<IS_RET, 0>(S, A, lane, g32);
            __syncthreads();
            if (MF_ON) mfma_step<IS_RET, 1>(S, A, lane, g32);
            __syncthreads();
        }
        if (!MF_ON) asm volatile("" :: "v"(S[0][0]));
    } else if (wave < 4) {
        const int sw = wave - 2;
        if (!ST_ON) { __syncthreads(); for (int n = 0; n < NCHUNK; ++n) __syncthreads(); }
        else {
        asm volatile("" : "+v"(lane));
        const int l31 = lane & 31, hh = lane >> 5, r4 = lane >> 4, c16 = lane & 15, p0 = (sw == 0 || IS_RET) ? NIN : MIXW;
        StLane L;
        L.g0 = (unsigned)((r4 * p0 + 8 * c16) * 2); L.gg = 0; L.ga = (unsigned)(lane * 4);
        L.l0 = (unsigned)(r4 * (sw == 0 ? PQ : PT) + 16 * c16); L.lg = (unsigned)(lane * 16); L.la = (unsigned)(lane * 4); L.sk = (unsigned)(l31 * PQ + 16 * hh);
        if (sw == 0) { L.g1 = (unsigned)((l31 * NIN + 8 * hh) * 2); L.l1 = 0; }
        else { const int rv = lane / VPR, cv = VPR * vh + lane % VPR; L.g1 = (unsigned)((rv * NIN + 8 * cv) * 2); L.l1 = (unsigned)(rv * PT + 16 * cv); }
        asm volatile("" : "+v"(L.g0), "+v"(L.g1), "+v"(L.gg), "+v"(L.ga), "+v"(L.l0), "+v"(L.l1), "+v"(L.lg), "+v"(L.la), "+v"(L.sk));
        HRegs RA, RB;
        stager_load<IS_RET>(RA, Z, KST, AUXG, b, h, hu, sw, L, 0);
        stager_stage<IS_RET>(RA, lds, lds + SC_BUF, sw, L);
        if (sw == 0) scores_stage(RA, lds, L, l31, hh);
        stager_load<IS_RET>(RB, Z, KST, AUXG, b, h, hu, sw, L, 1);
        __syncthreads();
        for (int n = 0; n < NCHUNK; n += 2) {
            if (ST_LD) stager_load<IS_RET>(RA, Z, KST, AUXG, b, h, hu, sw, L, n + 2);
            if (ST_ST) { stager_stage<IS_RET>(RB, lds + SC_BUF, lds, sw, L);
                if (sw == 0) scores_stage(RB, lds + SC_BUF, L, l31, hh); }
            else asm volatile("" :: "v"(RB.x0[0]), "v"(RB.x0[7]), "v"(RB.x1[0]), "v"(RB.aux[1]));
            __syncthreads();
            if (ST_LD) stager_load<IS_RET>(RB, Z, KST, AUXG, b, h, hu, sw, L, n + 3);
            if (ST_ST) { stager_stage<IS_RET>(RA, lds, lds + SC_BUF, sw, L);
                if (sw == 0) scores_stage(RA, lds, L, l31, hh); }
            else asm volatile("" :: "v"(RA.x0[0]), "v"(RA.x0[7]), "v"(RA.x1[0]), "v"(RA.aux[1]));
            __syncthreads();
        }
        }
    } else {
        asm volatile("" : "+v"(lane));
        FinLane L;
        {   const int c0 = lane / VPR, v0 = 8 * (VPR * vh + lane % VPR);
            L.lo = (unsigned)(c0 * PQ + v0 * 2); L.ls = (unsigned)(c0 * 4); L.go = (unsigned)((c0 * D + v0) * 2); L.gs = (unsigned)(c0 * 64); L.gz = (unsigned)((c0 * NIN + v0) * 2); }
        asm volatile("" : "+v"(L.lo), "+v"(L.ls), "+v"(L.go), "+v"(L.gs), "+v"(L.gz));
        if (wave == 4) {
            u32x4 gA[FPT], gB[FPT];
            gate_load<IS_RET>(gA, Z, b, h, L, 0); gate_load<IS_RET>(gB, Z, b, h, L, 1);
            __syncthreads();
            for (int n = 0; n < NCHUNK; n += 2) {
                if (FI_ON) { gate_stage(gA, lds, lane_id_volatile()); gate_load<IS_RET>(gA, Z, b, h, L, n + 2); }
                __syncthreads();
                if (FI_ON) { gate_stage(gB, lds + SC_BUF, lane_id_volatile()); gate_load<IS_RET>(gB, Z, b, h, L, n + 3); }
                __syncthreads();
            }
        } else {
            const bool first = (lane % VPR) == 0;
            __syncthreads();
            __syncthreads();
            for (int n = 1; n < NCHUNK; ++n) { if (FI_ON) fin_store<IS_RET>(lds + ((n - 1) & 1) * SC_BUF, CAT, SSQO, b, h, vh, L, lane, first, n - 1); __syncthreads(); }
            if (FI_ON) fin_store<IS_RET>(lds + ((NCHUNK - 1) & 1) * SC_BUF, CAT, SSQO, b, h, vh, L, lane, first, NCHUNK - 1);
        }
    }
}

constexpr int XA_K = 0, XA_KP = 144, XA_V = 256 * XA_KP, XA_VP = 192;
#define XRD(dst, areg, off) "ds_read_b128 " dst ", " areg " offset:" #off "\n\t"
__device__ __forceinline__ void xattn2_unit(unsigned char* ws, LAS unsigned char* lds, int unit, int layer, int tid) {
    gbf Z = (gbf)(ws + WS_Z); gbf MKV = (gbf)(ws + WS_MKV); GAS bf16_t* CAT = (GAS bf16_t*)(ws + WS_CAT);
    const int b = unit >> 5, hx = (unit >> 3) & 3, qb = unit & 7;
    const int wave = tid >> 6, lane = tid & 63, l31 = lane & 31, hh = lane >> 5;
    const size_t tok = (size_t)b * SEQ + qb * 256 + wave * 32 + l31;
    bf16x8 qf[4];
#pragma unroll
    for (int ks = 0; ks < 4; ++ks) qf[ks] = *(const GAS bf16x8*)(Z + tok * NIN + 3072 + hx * 64 + 16 * ks + 8 * hh);
    __syncthreads();
    {   gbf src = MKV + (size_t)(b * NMEM) * 2048 + layer * 512 + hx * 64;
        u32x4 kr[4], vr[4];
#pragma unroll
        for (int i = 0; i < 4; ++i) { const int piece = tid + 512 * i, key = piece >> 3, j = piece & 7;
            kr[i] = *(const GAS u32x4*)(src + (size_t)key * 2048 + 8 * j); vr[i] = *(const GAS u32x4*)(src + (size_t)key * 2048 + 256 + 8 * j); }
#pragma unroll
        for (int i = 0; i < 4; ++i) { const int piece = tid + 512 * i, key = piece >> 3, j = piece & 7;
            *(LAS u32x4*)(lds + XA_K + key * XA_KP + 16 * j) = kr[i]; *(LAS u32x4*)(lds + XA_V + key * XA_VP + 16 * j) = vr[i]; }
    }
    __syncthreads();
    f32x16 st[8];
    const unsigned ak = (unsigned)(size_t)(lds + XA_K) + (unsigned)(l31 * XA_KP + 16 * hh);
#define XBLK(T0, o0, o1, o2, o3, o4, o5, o6, o7) { u32x4 f0, f1, f2, f3, f4, f5, f6, f7; \
        asm volatile(XRD("%0", "%8", o0) XRD("%1", "%8", o1) XRD("%2", "%8", o2) XRD("%3", "%8", o3) XRD("%4", "%8", o4) XRD("%5", "%8", o5) XRD("%6", "%8", o6) XRD("%7", "%8", o7) "s_waitcnt lgkmcnt(0)" \
            : "=&v"(f0), "=&v"(f1), "=&v"(f2), "=&v"(f3), "=&v"(f4), "=&v"(f5), "=&v"(f6), "=&v"(f7) : "v"(ak) : "memory"); \
        __builtin_amdgcn_sched_barrier(0); \
        f32x16 a0, a1; _Pragma("unroll") for (int r = 0; r < 16; ++r) { a0[r] = 0.f; a1[r] = 0.f; } \
        a0 = __builtin_amdgcn_mfma_f32_32x32x16_bf16(as_bf16x8(f0), qf[0], a0, 0, 0, 0); a1 = __builtin_amdgcn_mfma_f32_32x32x16_bf16(as_bf16x8(f4), qf[0], a1, 0, 0, 0); \
        a0 = __builtin_amdgcn_mfma_f32_32x32x16_bf16(as_bf16x8(f1), qf[1], a0, 0, 0, 0); a1 = __builtin_amdgcn_mfma_f32_32x32x16_bf16(as_bf16x8(f5), qf[1], a1, 0, 0, 0); \
        a0 = __builtin_amdgcn_mfma_f32_32x32x16_bf16(as_bf16x8(f2), qf[2], a0, 0, 0, 0); a1 = __builtin_amdgcn_mfma_f32_32x32x16_bf16(as_bf16x8(f6), qf[2], a1, 0, 0, 0); \
        a0 = __builtin_amdgcn_mfma_f32_32x32x16_bf16(as_bf16x8(f3), qf[3], a0, 0, 0, 0); a1 = __builtin_amdgcn_mfma_f32_32x32x16_bf16(as_bf16x8(f7), qf[3], a1, 0, 0, 0); \
        st[T0] = a0; st[T0 + 1] = a1; }
    XBLK(0, 0, 32, 64, 96, 4608, 4640, 4672, 4704)
    XBLK(2, 9216, 9248, 9280, 9312, 13824, 13856, 13888, 13920)
    XBLK(4, 18432, 18464, 18496, 18528, 23040, 23072, 23104, 23136)
    XBLK(6, 27648, 27680, 27712, 27744, 32256, 32288, 32320, 32352)
#undef XBLK
    float mx = -1e30f;
#pragma unroll
    for (int T = 0; T < 8; ++T)
#pragma unroll
        for (int r = 0; r < 16; ++r) mx = fmaxf(mx, st[T][r]);
    mx = fmaxf(mx, shfl_xor_l(mx, lane, 32));
    const float c2 = 0.125f * 1.4426950408889634f, mc = mx * c2;
    float sum = 0.f;
#pragma unroll
    for (int T = 0; T < 8; ++T)
#pragma unroll
        for (int r = 0; r < 16; ++r) { const float p = exp2f(st[T][r] * c2 - mc); st[T][r] = p; sum += p; }
    sum += shfl_xor_l(sum, lane, 32);
    f32x16 ot[2];
#pragma unroll
    for (int dt = 0; dt < 2; ++dt)
#pragma unroll
        for (int r = 0; r < 16; ++r) ot[dt][r] = 0.f;
    const unsigned av = (unsigned)(size_t)(lds + XA_V) + (unsigned)((4 * hh + ((lane & 15) >> 2)) * XA_VP + (16 * ((lane >> 4) & 1) + 4 * (lane & 3)) * 2);
#define XTR(dst, off) "ds_read_b64_tr_b16 " dst ", %8 offset:" #off "\n\t"
#define VBLK(T, o00, o01, o10, o11, o20, o21, o30, o31) { u32x2 g0, g1, g2, g3, g4, g5, g6, g7; \
        asm volatile(XTR("%0", o00) XTR("%1", o01) XTR("%2", o10) XTR("%3", o11) XTR("%4", o20) XTR("%5", o21) XTR("%6", o30) XTR("%7", o31) "s_waitcnt lgkmcnt(0)" \
            : "=&v"(g0), "=&v"(g1), "=&v"(g2), "=&v"(g3), "=&v"(g4), "=&v"(g5), "=&v"(g6), "=&v"(g7) : "v"(av) : "memory"); \
        __builtin_amdgcn_sched_barrier(0); \
        u32x4 p0, p1; _Pragma("unroll") for (int j = 0; j < 4; ++j) { p0[j] = pg8::cvt_pk_bf16(st[T][2 * j], st[T][2 * j + 1]); p1[j] = pg8::cvt_pk_bf16(st[T][8 + 2 * j], st[T][8 + 2 * j + 1]); } \
        ot[0] = __builtin_amdgcn_mfma_f32_32x32x16_bf16(as_bf16x8((u32x4){g0.x, g0.y, g1.x, g1.y}), as_bf16x8(p0), ot[0], 0, 0, 0); \
        ot[1] = __builtin_amdgcn_mfma_f32_32x32x16_bf16(as_bf16x8((u32x4){g2.x, g2.y, g3.x, g3.y}), as_bf16x8(p0), ot[1], 0, 0, 0); \
        ot[0] = __builtin_amdgcn_mfma_f32_32x32x16_bf16(as_bf16x8((u32x4){g4.x, g4.y, g5.x, g5.y}), as_bf16x8(p1), ot[0], 0, 0, 0); \
        ot[1] = __builtin_amdgcn_mfma_f32_32x32x16_bf16(as_bf16x8((u32x4){g6.x, g6.y, g7.x, g7.y}), as_bf16x8(p1), ot[1], 0, 0, 0); }
    VBLK(0, 0, 1536, 64, 1600, 3072, 4608, 3136, 4672)
    VBLK(1, 6144, 7680, 6208, 7744, 9216, 10752, 9280, 10816)
    VBLK(2, 12288, 13824, 12352, 13888, 15360, 16896, 15424, 16960)
    VBLK(3, 18432, 19968, 18496, 20032, 21504, 23040, 21568, 23104)
    VBLK(4, 24576, 26112, 24640, 26176, 27648, 29184, 27712, 29248)
    VBLK(5, 30720, 32256, 30784, 32320, 33792, 35328, 33856, 35392)
    VBLK(6, 36864, 38400, 36928, 38464, 39936, 41472, 40000, 41536)
    VBLK(7, 43008, 44544, 43072, 44608, 46080, 47616, 46144, 47680)
#undef VBLK
#undef XTR
    const float il = 1.0f / sum;
    GAS bf16_t* op = CAT + tok * D + MIXW + hx * 64 + 4 * hh;
#pragma unroll
    for (int dt = 0; dt < 2; ++dt)
#pragma unroll
        for (int q = 0; q < 4; ++q) { u32x2 w; w.x = pg8::cvt_pk_bf16(ot[dt][4 * q] * il, ot[dt][4 * q + 1] * il); w.y = pg8::cvt_pk_bf16(ot[dt][4 * q + 2] * il, ot[dt][4 * q + 3] * il);
            *(GAS u32x2*)(op + 32 * dt + 8 * q) = w; }
}

__device__ __forceinline__ void final_rows(const unsigned char* ws, float* out, const float* nf, int row0, int row1, int gw, int NGW, int lane) {
    const GAS f32x4* wv = (const GAS f32x4*)nf + lane;
    for (int row = row0 + gw; row < row1; row += NGW) {
        const GAS u32x2* xr = (const GAS u32x2*)((const GAS bf16_t*)(ws + WS_XB) + (size_t)row * D) + lane; f32x4 v[4]; float s = 0.f;
#pragma unroll
        for (int j = 0; j < 4; ++j) { const u32x2 w = xr[64 * j]; v[j][0] = bf2f(w.x & 0xffffu); v[j][1] = bf2f(w.x >> 16); v[j][2] = bf2f(w.y & 0xffffu); v[j][3] = bf2f(w.y >> 16);
            s += (v[j].x * v[j].x + v[j].y * v[j].y) + (v[j].z * v[j].z + v[j].w * v[j].w); }
        const float rs = rsqrtf(wave_sum(s, lane) * (1.0f / D) + EPS);
        GAS f32x4* orow = (GAS f32x4*)(out + (size_t)row * D) + lane;
#pragma unroll
        for (int j = 0; j < 4; ++j) orow[64 * j] = v[j] * rs * wv[64 * j];
    }
}

__global__ void __launch_bounds__(NWAVES * 64, 2) mega_fwd(Args args) {
    extern __shared__ __attribute__((aligned(16))) unsigned char lds_raw[];
    LAS unsigned char* lds = (LAS unsigned char*)lds_raw;
    volatile LAS unsigned* MISC = (volatile LAS unsigned*)(lds + MISC_OFF);
    const int G = gridDim.x, bx = blockIdx.x;
    const int wave_s = __builtin_amdgcn_readfirstlane(threadIdx.x >> 6);
    unsigned char* ws = args.ws;
    for (int u = threadIdx.x; u < (LDS_BYTES - LDSCTL_OFF) / 4; u += NWAVES * 64) ((LAS unsigned*)(lds + LDSCTL_OFF))[u] = 0u;
    __syncthreads();
    XcdBarrier bar = xcd_barrier_post((unsigned*)(ws + WS_CTL) + CW_BAR, MISC + 8);
#define GBAR() xcd_barrier(bar, wave_s == 0 && lane_id_volatile() == 0)
#define OPAQ() unsigned char* wsp = ws; int Gp = G, bxp = bx, tidp = wave_s * 64 + lane_id_volatile(); asm volatile("" : "+s"(wsp), "+s"(Gp), "+s"(bxp), "+v"(tidp)); \
    const int lanep = tidp & 63, wavep = __builtin_amdgcn_readfirstlane(tidp >> 6), vcup = (Gp % 8 == 0) ? (bxp % 8) * (Gp / 8) + bxp / 8 : bxp, gwp = vcup * NWAVES + wavep, NGWp = Gp * NWAVES; \
    (void)lanep; (void)gwp; (void)NGWp
#define XPART() const int xn = misc_rd(lds, 8), xnx = misc_rd(lds, 9), xrank = misc_rd(lds, 10), xslot = misc_rd(lds, 11); \
    (void)xn; (void)xnx; (void)xrank; (void)xslot
    unsigned lbar_k = 0;
#define LBAR() xcc_barrier(bar, (unsigned)misc_rd(lds, 8), (unsigned)misc_rd(lds, 10), wave_s, ++lbar_k)

    { OPAQ(); p0_prologue(args, wsp, lds, gwp, NGWp, wavep, lanep); }
    GBAR();
    if (threadIdx.x == 0) {
        unsigned slot = 0;
        for (unsigned j = 0; j < 16; ++j) { const unsigned c = xb_ld(&bar.bar[XB_XCNT(j)]); if (j < bar.x && c > 0u) ++slot; }
        MISC[11] = slot;
    }
    __syncthreads();
    for (int l = 0; l < DEPTH; ++l) {
        const int is_ret = l & 1;
        if (l >= 2) cv_wait(bar, l - 2, (unsigned)misc_rd(lds, 9), wave_s == 0 && lane_id_volatile() == 0);
        { OPAQ(); XPART();
            pg8::Gemm g{(const bf16_t*)(wsp + WS_XB), (const bf16_t*)(wsp + WS_WIN) + (size_t)l * NIN * D, M, NIN, D}; pg8::XccOrder S{xrank, xn, xslot, xnx, (NIN - XW) / 256, RBG_A, 1 << 30};
            EpiIn E{(bf16_t*)(wsp + WS_Z), (bf16_t*)(wsp + WS_KST), (float*)(wsp + WS_AUX), (const float*)(wsp + WS_SSQA), (const float*)(wsp + WS_LB) + (l >> 1) * MIXW, (const float*)(wsp + WS_COS), (const float*)(wsp + WS_SIN), is_ret, (LAS float*)(lds + RSTD_TAB_OFF)};
            pg8::gemm_phase<EpiIn, pg8::XccOrder, true, true>(lds, g, S, E, tidp);
        }
        {
            xcc_arrive(bar, (unsigned)misc_rd(lds, 10), wave_s, ++lbar_k);
            OPAQ(); XPART();
            constexpr int UBs = NH * NVS + 8; const int nbs = xslot < 8 ? (8 - xslot + xnx - 1) / xnx : 0, busys = UBs * nbs < xn ? UBs * nbs : 0;
            const int UBXs = (l > 0 && busys > 0 && xn - busys >= 8 * nbs) ? UBs + 8 : UBs;
            bool hs = false;
            for (int u = xrank; u < UBXs * nbs; u += xn) hs = hs || (u % UBXs < NH * NVS);
            if (hs) xcc_wait(bar, (unsigned)xn, wave_s, lbar_k);
        }
        if (l == 0) { OPAQ(); XPART();
            constexpr int UB = NH * NVS + 8; const int nb = xslot < 8 ? (8 - xslot + xnx - 1) / xnx : 0, busy = UB * nb < xn ? UB * nb : 0, nidle = xn - busy;
            {
                if (xrank >= busy) {
                    pg8::Gemm g{(const bf16_t*)(wsp + WS_MEMB), (const bf16_t*)(wsp + WS_WM), MROWS, 2048, D}; pg8::XccOrderMem S{xrank - busy, nidle, xslot, xnx};
                    EpiPlain E{(bf16_t*)(wsp + WS_MKV), 2048};
                    pg8::gemm_phase<EpiPlain, pg8::XccOrderMem, true, true>(lds, g, S, E, tidp);
                }
                if (busy == 0) { xcc_barrier(bar, (unsigned)xn, (unsigned)xrank, wave_s, ++lbar_k); }
                else if (xrank >= busy) {
                    asm volatile("s_waitcnt vmcnt(0)" ::: "memory"); __syncthreads();
                    if (wave_s == 0 && lane_id_volatile() == 0) { __builtin_amdgcn_s_waitcnt(0); xb_add(&bar.bar[XB_MKV(bar.x)], 1u); }
                }
            }
        }
        { OPAQ(); XPART();
            constexpr int UB = NH * NVS + 8; const int nb = xslot < 8 ? (8 - xslot + xnx - 1) / xnx : 0, busy = UB * nb < xn ? UB * nb : 0, nidle = xn - busy;
            {   const int UBX1 = (l > 0 && busy > 0 && nidle >= 8 * nb) ? UB + 8 : UB;
                for (int u = xrank; u < UBX1 * nb; u += xn) { const int b = xslot + (u / UBX1) * xnx, uu = u % UBX1;
                    if (uu < NH * NVS) { if (is_ret) scan2_unit<1, 0>(wsp, lds, b * NH * NVS + uu, tidp); else scan2_unit<0, 0>(wsp, lds, b * NH * NVS + uu, tidp); } } }
        }
        { OPAQ(); XPART();
            constexpr int UB = NH * NVS + 8;
            const int nb = xslot < 8 ? (8 - xslot + xnx - 1) / xnx : 0;
            const int busy = UB * nb < xn ? UB * nb : 0, nidle = xn - busy;
            if (l < DEPTH - 1) {
                if (xrank >= busy) {
                    const int j = xrank - busy, n3 = (l == 0 && nidle > 8 * nb) ? 8 * nb : 0, m5 = l == 0 ? 5 : 1, sh = j < n3 ? 3 : m5;
                    const int wv0 = j < n3 ? (j * NWAVES + wavep) * 3 : n3 * NWAVES * 3 + ((j - n3) * NWAVES + wavep) * m5, nwv = n3 * NWAVES * 3 + (nidle - n3) * NWAVES * m5;
                    __syncthreads();
                    for (int l2 = (l == 0 ? 0 : l + 1); l2 < l + 2; ++l2)
                        for (int v = 0; v < sh; ++v) convert_weights(args, wsp, (LAS float*)(lds + wavep * 16384), l2 * TITEMS_PER_LAYER + (l2 == 0 ? 16 * (NIN / 32) : 0), (l2 + 1) * TITEMS_PER_LAYER - 256, wv0 + v, nwv, lanep, xslot < xnx ? xslot : 0, xnx);
                    if (l > 0) cv_signal(bar, l - 1, (unsigned)nidle, wave_s == 0 && lane_id_volatile() == 0);
                }
            }
            const bool helpers = l > 0 && busy > 0 && nidle >= 8 * nb;
            const int UBX = helpers ? UB + 8 : UB;
            for (int u = xrank; u < UBX * nb; u += xn) {
                const int b = xslot + (u / UBX) * xnx, uu = u % UBX;
                if (uu >= NH * NVS) { const bool hlp = uu >= UB; const int rb = 8 * b + (hlp ? uu - UB : uu - NH * NVS);
                    if (!hlp) {
                    {   pg8::Gemm g{(const bf16_t*)(wsp + WS_XB), (const bf16_t*)(wsp + WS_WIN) + (size_t)l * NIN * D, M, NIN, D}; pg8::OneUnit S{rb, 12};
                        EpiIn E{(bf16_t*)(wsp + WS_Z), (bf16_t*)(wsp + WS_KST), (float*)(wsp + WS_AUX), (const float*)(wsp + WS_SSQA), (const float*)(wsp + WS_LB) + (l >> 1) * MIXW, (const float*)(wsp + WS_COS), (const float*)(wsp + WS_SIN), is_ret, (LAS float*)(lds + RSTD_TAB_OFF)};
                        pg8::gemm_phase<EpiIn, pg8::OneUnit, true, true>(lds, g, S, E, tidp); }
                    if (l == 0 && busy > 0) {
                        if (wave_s == 0 && lane_id_volatile() == 0) { unsigned* bb = bar.bar; XB_SPIN(xb_ld(&bb[XB_MKV(bar.x)]) < (unsigned)nidle, bb); }
                    }
                    asm volatile("s_waitcnt vmcnt(0)" ::: "memory"); __builtin_amdgcn_fence(__ATOMIC_RELEASE, "agent"); __syncthreads(); __builtin_amdgcn_fence(__ATOMIC_ACQUIRE, "agent");
                    if (helpers && wave_s == 0 && lane_id_volatile() == 0) __hip_atomic_store(&bar.bar[XB_ZX(rb)], (unsigned)(l + 1), __ATOMIC_RELAXED, __HIP_MEMORY_SCOPE_WORKGROUP);
                    } else {
                        __syncthreads();
                        if (wave_s == 0 && lane_id_volatile() == 0) { unsigned* bb = bar.bar; XB_SPIN(xb_ld(&bb[XB_ZX(rb)]) < (unsigned)(l + 1), bb); }
                        __syncthreads(); __builtin_amdgcn_fence(__ATOMIC_ACQUIRE, "agent");
                    }
                    int tidq = wave_s * 64 + lane_id_volatile(); asm volatile("" : "+v"(tidq));
                    const int hx0 = hlp ? NXH / 2 : 0, hx1 = (helpers && !hlp) ? NXH / 2 : NXH;
                    for (int hx = hx0; hx < hx1; ++hx) xattn2_unit(wsp, lds, (rb >> 3) * 32 + hx * 8 + (rb & 7), l, tidq);
                }
            }
            __syncthreads();
        }
        if (l == 0) GBAR(); else LBAR();
        bool retC = false;
        if (NVS > 1 && is_ret) {
            OPAQ(); XPART();
            const int nbC = xslot < 8 ? (8 - xslot + xnx - 1) / xnx : 0;
            retC = nbC * 32 <= xn;
            if (!retC) { for (int b = xslot; b < BATCH; b += xnx) norm_rows(wsp, b * SEQ, (b + 1) * SEQ, xrank * NWAVES + wavep, xn * NWAVES, lanep); LBAR(); }
        }
        { OPAQ(); XPART();
            pg8::Gemm g{(const bf16_t*)(wsp + WS_CAT), (const bf16_t*)(wsp + WS_WOUT) + (size_t)l * D * D, M, D, D}; pg8::XccOrder S{xrank, xn, xslot, xnx, D / 256, 4, 1 << 30};
            if (retC) { pg8::Unit u0; if (S.next(0, u0)) ret_norm_table((const float*)(wsp + WS_SSQO), u0.pm, (LAS float*)(lds + 133120), tidp); else __syncthreads(); }
            const int nbC0 = xslot < 8 ? (8 - xslot + xnx - 1) / xnx : 0; const bool hgC = !is_ret && nbC0 * 32 <= xn;
            if (retC) { EpiResC<1, 1> E{EpiRes{(const bf16_t*)(wsp + WS_XB), (bf16_t*)(wsp + WS_XB), (float*)(wsp + WS_SSQD)}, (const float*)(wsp + WS_SSQO), (LAS float*)(lds + 133120)};
                pg8::gemm_phase<EpiResC<1, 1>, pg8::XccOrder, true, true>(lds, g, S, E, tidp); }
            else if (hgC) { { pg8::Unit u0; if (S.next(0, u0)) hgrn_norm_table((const float*)(wsp + WS_SSQO), u0.pm, (LAS float*)(lds + 133120), tidp); else __syncthreads(); }
                EpiResC<0, 1> E{EpiRes{(const bf16_t*)(wsp + WS_XB), (bf16_t*)(wsp + WS_XB), (float*)(wsp + WS_SSQD)}, (const float*)(wsp + WS_SSQO), (LAS float*)(lds + 133120)};
                pg8::gemm_phase<EpiResC<0, 1>, pg8::XccOrder, true, true>(lds, g, S, E, tidp); }
            else { EpiResC<0, 0> E{EpiRes{(const bf16_t*)(wsp + WS_XB), (bf16_t*)(wsp + WS_XB), (float*)(wsp + WS_SSQD)}, is_ret ? nullptr : (const float*)(wsp + WS_SSQO), (LAS float*)(lds + 133120)};
                pg8::gemm_phase<EpiResC<0, 0>, pg8::XccOrder, true, true>(lds, g, S, E, tidp); }
        }
        LBAR();
        { OPAQ(); XPART();
            pg8::Gemm g{(const bf16_t*)(wsp + WS_XB), (const bf16_t*)(wsp + WS_WFI) + (size_t)l * NFI * D, M, NFI, D};
            const int totD = (xslot < 8 ? (8 - xslot + xnx - 1) / xnx : 0) * 8 * (NFI / 256), fullD = (totD / xn) * xn, leftD = totD - fullD; const bool halves = leftD > 0 && 2 * leftD <= xn;
            pg8::XccOrder S{xrank, xn, xslot, xnx, NFI / 256, RBG_D, halves ? fullD : (1 << 30)};
            EpiFfn E{(bf16_t*)(wsp + WS_ACT), (const float*)(wsp + WS_SSQD), (LAS float*)(lds + RSTD_TAB_OFF), -1};
            pg8::gemm_phase<EpiFfn, pg8::XccOrder, true, true>(lds, g, S, E, tidp);
            if (halves && xrank < 2 * leftD) { pg8::Unit hu; S.decode(fullD + xrank % leftD, hu);
                pg8::HalfUnit SH{hu.pm, hu.pn, xrank / leftD}; EpiFfn EH{(bf16_t*)(wsp + WS_ACT), (const float*)(wsp + WS_SSQD), (LAS float*)(lds + RSTD_TAB_OFF), xrank / leftD};
                pg8::gemm_phase<EpiFfn, pg8::HalfUnit, true, true, true>(lds, g, SH, EH, tidp); }
        }
        LBAR();
        { OPAQ(); XPART();
            pg8::Gemm g{(const bf16_t*)(wsp + WS_ACT), (const bf16_t*)(wsp + WS_WFO) + (size_t)l * D * DFF, M, D, DFF}; pg8::XccOrder S{xrank, xn, xslot, xnx, D / 256, 4, 1 << 30};
            const int nbE = xslot < 8 ? (8 - xslot + xnx - 1) / xnx : 0;
            if (l == DEPTH - 1 && nbE * 32 <= xn) {
                EpiResFin E{(const bf16_t*)(wsp + WS_XB), args.out, (float*)(wsp + WS_SSQA), args.in[14], bar.bar, (LAS float*)(lds + RSTD_TAB_OFF)};
                pg8::gemm_phase<EpiResFin, pg8::XccOrder, true, true>(lds, g, S, E, tidp);
            } else {
                EpiRes E{(const bf16_t*)(wsp + WS_XB), (bf16_t*)(wsp + WS_XB), (float*)(wsp + WS_SSQA)};
                pg8::gemm_phase<EpiRes, pg8::XccOrder, true, true>(lds, g, S, E, tidp);
            }
        }
        if (l < DEPTH - 1) LBAR();
    }
    { OPAQ(); XPART();
        const int nbE = xslot < 8 ? (8 - xslot + xnx - 1) / xnx : 0;
        if (!(nbE * 32 <= xn)) {
            LBAR();
            for (int b = xslot; b < BATCH; b += xnx) final_rows(wsp, args.out, args.in[14], b * SEQ, (b + 1) * SEQ, xrank * NWAVES + wavep, xn * NWAVES, lanep);
        }
    }
#undef OPAQ
#undef XPART
#undef GBAR
#undef LBAR
}

extern "C" void kernel_launch(void* const* d_in, const int* in_sizes, int n_in, void* d_out, int out_size, void* d_ws, size_t ws_size, hipStream_t stream) {
    static int grid = 0;
    if (grid == 0) {
        if (n_in != 15 || in_sizes[0] != M * D || out_size != M * D || ws_size < WS_END) {
            fprintf(stderr, "kernel_launch: unexpected shapes: n_in %d in0 %d out %d ws %zu (need %zu)\n", n_in, n_in > 0 ? in_sizes[0] : -1, out_size, ws_size, (size_t)WS_END); grid = -1; return; }
        int dev = 0, cus = 0, per_cu = 0;
        if (hipGetDevice(&dev) != hipSuccess || hipDeviceGetAttribute(&cus, hipDeviceAttributeMultiprocessorCount, dev) != hipSuccess) { grid = -1; return; }
        if (hipFuncSetAttribute((const void*)mega_fwd, hipFuncAttributeMaxDynamicSharedMemorySize, LDS_BYTES) != hipSuccess) { fprintf(stderr, "kernel_launch: hipFuncSetAttribute failed\n"); grid = -1; return; }
        if (hipOccupancyMaxActiveBlocksPerMultiprocessor(&per_cu, (const void*)mega_fwd, NWAVES * 64, LDS_BYTES) != hipSuccess || per_cu < 1)
            fprintf(stderr, "kernel_launch: occupancy query reports %d workgroups per CU\n", per_cu);
        (void)hipGetLastError();
        grid = cus;
        if (grid < 176) { fprintf(stderr, "kernel_launch: this kernel needs at least 176 CUs (found %d)\n", cus); grid = -1; return; }
    }
    if (grid < 0) return;
    if (hipMemsetAsync((char*)d_ws + WS_CTL, 0, CTL_ZERO_BYTES, stream) != hipSuccess) { fprintf(stderr, "kernel_launch: memset failed\n"); return; }
    Args a{};
    for (int i = 0; i < 15; ++i) a.in[i] = (const float*)d_in[i];
    a.out = (float*)d_out; a.ws = (unsigned char*)d_ws;
    a.ph_lo = 0; a.ph_hi = 0;
    hipLaunchKernelGGL(mega_fwd, dim3(grid), dim3(NWAVES * 64), LDS_BYTES, stream, a);
    const hipError_t le = hipPeekAtLastError();
    if (le != hipSuccess) fprintf(stderr, "kernel_launch: launch failed: %s\n", hipGetErrorName(le));
}
```
